# Optimizing an MI355X kernel written in HIP

```python
import math
import jax, jax.numpy as jnp
from jax import lax
import numpy as np

D_MODEL = 1024
BATCH = 32
SEQ = 2048
DEPTH = 2

EPS = 1e-6
N_BRANCH = 3
BRANCH_W = D_MODEL // 2
SSM_GROUP = 16
SSM_GROUPS = BRANCH_W // SSM_GROUP
SSM_STATE = 64
DT_MIN = 1e-3
DT_MAX = 1e-1
HEAD_DIM = 64
ATT_HEADS = BRANCH_W // HEAD_DIM
DILATED_PATTERNS = ((128, 1), (512, 4), (2048, 16))
N_PAT = len(DILATED_PATTERNS)
ATT_BLOCK = 128
ATT_SCALE = HEAD_DIM ** -0.5
CONV_WIDTH = 31
D_FF = -(-(8 * D_MODEL) // (3 * 256)) * 256

COL_U = BRANCH_W
COL_Q = N_PAT * BRANCH_W
COL_KV = BRANCH_W
COL_CONV = 2 * BRANCH_W
COL_GATE = N_BRANCH * D_MODEL
SPLIT_POINTS = (COL_U,
                COL_U + COL_Q,
                COL_U + COL_Q + COL_KV,
                COL_U + COL_Q + 2 * COL_KV,
                COL_U + COL_Q + 2 * COL_KV + COL_CONV)
IN_COLS = SPLIT_POINTS[-1] + COL_GATE

kernel_name = 'hybrid_s5_dilated_attn_conformer_conv_block'


def rms_norm(x, g):
    xf = x.astype(jnp.float32)
    y = xf * lax.rsqrt(jnp.mean(xf * xf, axis=-1, keepdims=True) + EPS)
    return (y * g.astype(jnp.float32)).astype(x.dtype)


def _complex_affine_combine(e1, e2):
    a1r, a1i, b1r, b1i = e1
    a2r, a2i, b2r, b2i = e2
    return (a1r * a2r - a1i * a2i,
            a1r * a2i + a1i * a2r,
            a2r * b1r - a2i * b1i + b2r,
            a2r * b1i + a2i * b1r + b2i)


def s5_branch(u, lam_re, lam_im, log_dt, b_re, b_im, c_re, c_im, d_skip, w_glu):
    bsz, seq, _ = u.shape
    f32 = jnp.float32
    uf = u.astype(f32).reshape(bsz, seq, SSM_GROUPS, SSM_GROUP)
    lam_re = lam_re.astype(f32)
    lam_im = lam_im.astype(f32)
    dt = jnp.exp(log_dt.astype(f32))[:, None]
    mag = jnp.exp(lam_re * dt)
    ab_re = mag * jnp.cos(lam_im * dt)
    ab_im = mag * jnp.sin(lam_im * dt)
    nr, ni = ab_re - 1.0, ab_im
    den = lam_re * lam_re + lam_im * lam_im
    z_re = ((nr * lam_re + ni * lam_im) / den)[..., None]
    z_im = ((ni * lam_re - nr * lam_im) / den)[..., None]
    b_re = b_re.astype(f32)
    b_im = b_im.astype(f32)
    bb_re = z_re * b_re - z_im * b_im
    bb_im = z_re * b_im + z_im * b_re
    bu_re = jnp.einsum('blgh,gph->blgp', uf, bb_re)
    bu_im = jnp.einsum('blgh,gph->blgp', uf, bb_im)
    a_re = jnp.broadcast_to(ab_re, (1, seq, SSM_GROUPS, SSM_STATE))
    a_im = jnp.broadcast_to(ab_im, (1, seq, SSM_GROUPS, SSM_STATE))
    _, _, s_re, s_im = lax.associative_scan(
        _complex_affine_combine, (a_re, a_im, bu_re, bu_im), axis=1)
    y = (jnp.einsum('blgp,ghp->blgh', s_re, c_re.astype(f32))
         - jnp.einsum('blgp,ghp->blgh', s_im, c_im.astype(f32)))
    y = y.reshape(bsz, seq, BRANCH_W) + d_skip.astype(f32) * uf.reshape(bsz, seq, BRANCH_W)
    y = jax.nn.gelu(y).astype(u.dtype)
    z = y @ w_glu
    return z[..., :D_MODEL] * jax.nn.sigmoid(z[..., D_MODEL:])


def _dilated_group(q, k, v, window, dilation):
    bsz, seq, nh, hd = q.shape
    ls = seq // dilation
    nb = -(-ls // ATT_BLOCK)
    lp = nb * ATT_BLOCK
    w_sub = window // dilation

    def to_sub(t):
        t = t.reshape(bsz, ls, dilation, nh, hd).transpose(0, 2, 3, 1, 4)
        t = jnp.pad(t, ((0, 0), (0, 0), (0, 0), (0, lp - ls), (0, 0)))
        return t.reshape(bsz, dilation, nh, nb, ATT_BLOCK, hd)

    def with_prev(t):
        prev = jnp.pad(t, ((0, 0), (0, 0), (0, 0), (1, 0), (0, 0), (0, 0)))[:, :, :, :-1]
        return jnp.concatenate([prev, t], axis=4)

    qb = to_sub(q)
    kc = with_prev(to_sub(k))
    vc = with_prev(to_sub(v))
    s = jnp.einsum('bdhnqe,bdhnke->bdhnqk', qb, kc).astype(jnp.float32) * ATT_SCALE
    qi = jnp.arange(ATT_BLOCK)[:, None]
    kj = jnp.arange(2 * ATT_BLOCK)[None, :]
    dist = qi - kj + ATT_BLOCK
    kpos = jnp.arange(nb)[:, None, None] * ATT_BLOCK + kj[None] - ATT_BLOCK
    valid = (dist >= 0) & (dist <= w_sub) & (kpos >= 0)
    s = jnp.where(valid, s, -jnp.inf)
    m = jnp.max(s, axis=-1, keepdims=True)
    p = jnp.exp(s - m)
    den = jnp.sum(p, axis=-1, keepdims=True)
    o = jnp.einsum('bdhnqk,bdhnke->bdhnqe', p, vc.astype(jnp.float32)) / den
    lse = (m + jnp.log(den))[..., 0]
    o = o.reshape(bsz, dilation, nh, lp, hd)[:, :, :, :ls]
    o = o.transpose(0, 3, 1, 2, 4).reshape(bsz, seq, nh, hd)
    lse = lse.reshape(bsz, dilation, nh, lp)[:, :, :, :ls]
    lse = lse.transpose(0, 3, 1, 2).reshape(bsz, seq, nh)
    return o, lse


def dilated_attention(q, k, v):
    outs, lses = [], []
    for p_idx, (window, dilation) in enumerate(DILATED_PATTERNS):
        o, lse = _dilated_group(q[:, :, p_idx], k, v, window, dilation)
        outs.append(o)
        lses.append(lse)
    wts = jax.nn.softmax(jnp.stack(lses, axis=0), axis=0)
    return jnp.sum(wts[..., None] * jnp.stack(outs, axis=0), axis=0)


def conformer_conv(cv, conv_w, conv_b, ln_g, ln_b, w_pw2):
    a, g = jnp.split(cv, 2, axis=-1)
    h = a * jax.nn.sigmoid(g)
    h = lax.conv_general_dilated(
        h, conv_w[:, None, :], window_strides=(1,),
        padding=[(CONV_WIDTH - 1, 0)],
        dimension_numbers=('NWC', 'WIO', 'NWC'),
        feature_group_count=BRANCH_W) + conv_b
    hf = h.astype(jnp.float32)
    mu = jnp.mean(hf, axis=-1, keepdims=True)
    var = jnp.mean(jnp.square(hf - mu), axis=-1, keepdims=True)
    hn = (hf - mu) * lax.rsqrt(var + EPS) * ln_g.astype(jnp.float32) + ln_b.astype(jnp.float32)
    h = jax.nn.silu(hn).astype(cv.dtype)
    return h @ w_pw2


def setup_inputs(seed: int = 0) -> dict:
    key = jax.random.key(seed)
    ks = jax.random.split(key, 24)
    f32 = jnp.float32

    def nrm(k, shape, scale):
        return jax.random.normal(k, shape, f32) * scale

    lam_im_base = jnp.pi * jnp.arange(SSM_STATE, dtype=f32)
    return {
        'x': nrm(ks[0], (BATCH, SEQ, D_MODEL), 1.0),
        'norm1_g': 1.0 + nrm(ks[1], (DEPTH, D_MODEL), 0.05),
        'w_in': nrm(ks[2], (DEPTH, D_MODEL, IN_COLS), D_MODEL ** -0.5),
        'b_gate': nrm(ks[3], (DEPTH, COL_GATE), 0.02),
        'ssm_lambda_re': -0.5 + nrm(ks[4], (DEPTH, SSM_GROUPS, SSM_STATE), 0.01),
        'ssm_lambda_im': lam_im_base + nrm(ks[5], (DEPTH, SSM_GROUPS, SSM_STATE), 0.01),
        'ssm_log_dt': jax.random.uniform(ks[6], (DEPTH, SSM_GROUPS), f32,
                                         math.log(DT_MIN), math.log(DT_MAX)),
        'ssm_b_re': nrm(ks[7], (DEPTH, SSM_GROUPS, SSM_STATE, SSM_GROUP), (2 * SSM_GROUP) ** -0.5),
        'ssm_b_im': nrm(ks[8], (DEPTH, SSM_GROUPS, SSM_STATE, SSM_GROUP), (2 * SSM_GROUP) ** -0.5),
        'ssm_c_re': nrm(ks[9], (DEPTH, SSM_GROUPS, SSM_GROUP, SSM_STATE), SSM_STATE ** -0.25),
        'ssm_c_im': nrm(ks[10], (DEPTH, SSM_GROUPS, SSM_GROUP, SSM_STATE), SSM_STATE ** -0.25),
        'ssm_d': nrm(ks[11], (DEPTH, BRANCH_W), 1.0),
        'w_ssm_glu': nrm(ks[12], (DEPTH, BRANCH_W, 2 * D_MODEL), BRANCH_W ** -0.5),
        'w_att_up': nrm(ks[13], (DEPTH, BRANCH_W, D_MODEL), BRANCH_W ** -0.5),
        'conv_w': nrm(ks[14], (DEPTH, CONV_WIDTH, BRANCH_W), CONV_WIDTH ** -0.5),
        'conv_b': nrm(ks[15], (DEPTH, BRANCH_W), 0.02),
        'conv_ln_g': 1.0 + nrm(ks[16], (DEPTH, BRANCH_W), 0.05),
        'conv_ln_b': nrm(ks[17], (DEPTH, BRANCH_W), 0.02),
        'w_conv_pw2': nrm(ks[18], (DEPTH, BRANCH_W, D_MODEL), BRANCH_W ** -0.5),
        'w_out': nrm(ks[19], (DEPTH, D_MODEL, D_MODEL), D_MODEL ** -0.5),
        'norm2_g': 1.0 + nrm(ks[20], (DEPTH, D_MODEL), 0.05),
        'w_ffn_in': nrm(ks[21], (DEPTH, D_MODEL, 2 * D_FF), D_MODEL ** -0.5),
        'w_ffn_out': nrm(ks[22], (DEPTH, D_FF, D_MODEL), D_FF ** -0.5),
        'final_g': 1.0 + nrm(ks[23], (D_MODEL,), 0.05),
    }


def reference(x, norm1_g, w_in, b_gate, ssm_lambda_re, ssm_lambda_im, ssm_log_dt,
              ssm_b_re, ssm_b_im, ssm_c_re, ssm_c_im, ssm_d, w_ssm_glu, w_att_up,
              conv_w, conv_b, conv_ln_g, conv_ln_b, w_conv_pw2, w_out,
              norm2_g, w_ffn_in, w_ffn_out, final_g):
    bsz, seq, _ = x.shape
    for l in range(DEPTH):
        h = rms_norm(x, norm1_g[l])
        proj = h @ w_in[l]
        u, q, k, v, cv, g = jnp.split(proj, SPLIT_POINTS, axis=-1)
        y_s = s5_branch(u, ssm_lambda_re[l], ssm_lambda_im[l], ssm_log_dt[l],
                        ssm_b_re[l], ssm_b_im[l], ssm_c_re[l], ssm_c_im[l],
                        ssm_d[l], w_ssm_glu[l])
        q = q.reshape(bsz, seq, N_PAT, ATT_HEADS, HEAD_DIM)
        k = k.reshape(bsz, seq, ATT_HEADS, HEAD_DIM)
        v = v.reshape(bsz, seq, ATT_HEADS, HEAD_DIM)
        o = dilated_attention(q, k, v).astype(x.dtype).reshape(bsz, seq, BRANCH_W)
        y_a = o @ w_att_up[l]
        y_c = conformer_conv(cv, conv_w[l], conv_b[l], conv_ln_g[l], conv_ln_b[l], w_conv_pw2[l])
        gate = jax.nn.sigmoid((g + b_gate[l]).astype(jnp.float32)).astype(x.dtype)
        gate = gate.reshape(bsz, seq, N_BRANCH, D_MODEL)
        merged = gate[:, :, 0] * y_s + gate[:, :, 1] * y_a + gate[:, :, 2] * y_c
        x = x + merged @ w_out[l]
        h = rms_norm(x, norm2_g[l])
        z = h @ w_ffn_in[l]
        x = x + (jax.nn.silu(z[..., :D_FF]) * z[..., D_FF:]) @ w_ffn_out[l]
    return rms_norm(x, final_g)
```

```cpp
#include <hip/hip_runtime.h>
#include <hip/hip_cooperative_groups.h>
#include <cstdio>
namespace cg = cooperative_groups;
namespace pg8 {
#define PG8_LAS __attribute__((address_space(3)))
typedef unsigned short bf16_t;
typedef short bf16x8 __attribute__((ext_vector_type(8)));
typedef float f32x4 __attribute__((ext_vector_type(4)));
typedef unsigned u32x4 __attribute__((ext_vector_type(4)));
constexpr int BM = 256, BK = 64, HALF = 128, HTB = HALF * BK * 2  , STAGE_BYTES = 8 * HTB, NXCD = 8, WGM = 8;

__host__ __device__ __forceinline__ int lds_byte(int r, int c) { const int st = (r >> 4) * 2 + (c >> 5), rr = r & 15, cc = c & 31, ob = rr * 64 + cc * 2; return st * 1024 + (ob ^ (((ob >> 9) & 1) << 5)); }
__host__ __device__ __forceinline__ void stage_rc(int b, int& R, int& C) { const int st = b / 1024, sb = b % 1024, swz = sb ^ (((sb >> 9) & 1) << 5); R = (st >> 1) * 16 + swz / 64; C = (st & 1) * 32 + (swz % 64) / 2; }
__host__ __device__ __forceinline__ int perm32(int rho) { const int n = rho >> 4, i = rho & 15; return 8 * (i >> 2) + 4 * n + (i & 3); }

struct Unit { int pm, pn; };
struct Gemm { const bf16_t* A; const bf16_t* Bt; int M, N, K; };

struct StaticOrder {
    int nM, nN, nwg, G, c;
    __host__ __device__ void init(int M, int N, int G_, int c_) { nM = M / BM; nN = N / BM; nwg = nM * nN; G = G_; c = c_; }
    __host__ __device__ bool next(int i, Unit& u) const {
        const long L = (long)i * G + c; if (L >= nwg) return false;
        int wgid = (int)L; { const int q = nwg / NXCD, r = nwg % NXCD, xcd = wgid % NXCD, off = wgid / NXCD; wgid = (xcd < r ? xcd * (q + 1) : r * (q + 1) + (xcd - r) * q) + off; }
        const int nig = WGM * nN, gid = wgid / nig, fm = gid * WGM, gsz = (nM - fm) < WGM ? (nM - fm) : WGM;
        u.pm = fm + ((wgid % nig) % gsz); u.pn = (wgid % nig) / gsz; return true;
    }
    __device__ __forceinline__ void a_ready(const Unit&) const {}
    __device__ __forceinline__ void done(const Unit&) const {}
};
__device__ __forceinline__ unsigned cvt_pk_bf16(float lo, float hi) { unsigned r; asm volatile("v_cvt_pk_bf16_f32 %0, %1, %2" : "=v"(r) : "v"(lo), "v"(hi)); return r; }
template <class Epi, class Sched, bool STAMP = false>
__device__ __forceinline__ void gemm_phase(PG8_LAS unsigned char* lds, const Gemm g, const Sched& S, const Epi& E, unsigned long long* stamps) {
    int tid_o = threadIdx.x; asm volatile("" : "+v"(tid_o)); const int tid = tid_o, wid = __builtin_amdgcn_readfirstlane(tid >> 6), lane = tid & 63, wr = wid >> 2, wc = wid & 3, fr = lane & 15, fq = lane >> 4;
    const int K = g.K, nt = K / BK;
    int ts_lo = 0, ts_hi = 0, nts = 0; const unsigned long long rt_entry = STAMP ? (unsigned long long)wall_clock64() : 0ull;
#define PG8_STAMP() do { if (STAMP && wid == 0 && nts < 64) { const unsigned long long _c = (unsigned long long)clock64(); \
        ts_lo = (lane == nts) ? (int)(unsigned)_c : ts_lo; ts_hi = (lane == nts) ? (int)(unsigned)(_c >> 32) : ts_hi; ++nts; } } while (0)
    PG8_STAMP();
    unsigned voffA[2], voffB[2];
#pragma unroll
    for (int i = 0; i < 2; ++i) { int R, C; stage_rc(tid * 16 + i * 8192, R, C); const int Rb = Epi::PERM ? ((R & ~31) + perm32(R & 31)) : R;
        voffA[i] = (unsigned)(R * K + C) * 2u; voffB[i] = (unsigned)(Rb * K + C) * 2u; }
    const size_t kstep = (size_t)(BK * 2);
    const size_t hstep = (size_t)HALF * K * 2;
    const size_t tstep = 2 * hstep;
    const unsigned ldsw = (unsigned)wid * 1024u;
    const int aoff = lds_byte(wr * 64 + fr, fq * 8), boff = lds_byte(wc * 32 + fr, fq * 8);
#define PG8_SA(b, h) (((b) * 2 + (h)) * HTB)
#define PG8_SB(b, h) ((4 + (b) * 2 + (h)) * HTB)
#define PG8_STAGE(bufoff, gbase, voff) do { _Pragma("unroll") for (int _i = 0; _i < 2; ++_i) \
        __builtin_amdgcn_global_load_lds((const unsigned*)((const char*)(gbase) + (voff)[_i]), (PG8_LAS unsigned*)(lds + (bufoff) + ldsw + _i * 8192), 16, 0, 0); } while (0)
#define PG8_LDA(dst, b, h) do { _Pragma("unroll") for (int m = 0; m < 4; ++m) _Pragma("unroll") for (int k = 0; k < 2; ++k) dst[m][k] = *(const PG8_LAS bf16x8*)(lds + PG8_SA(b, h) + aoff + m * 2048 + k * 1024); } while (0)
#define PG8_LDB(dst, b, h) do { _Pragma("unroll") for (int n = 0; n < 2; ++n) _Pragma("unroll") for (int k = 0; k < 2; ++k) dst[n][k] = *(const PG8_LAS bf16x8*)(lds + PG8_SB(b, h) + boff + n * 2048 + k * 1024); } while (0)
#define PG8_MMA(ai, bj, At, Bt) do { __builtin_amdgcn_s_setprio(1); _Pragma("unroll") for (int m = 0; m < 4; ++m) _Pragma("unroll") for (int n = 0; n < 2; ++n) _Pragma("unroll") for (int k = 0; k < 2; ++k) \
        acc[ai][bj][m][n] = __builtin_amdgcn_mfma_f32_16x16x32_bf16(Bt[n][k], At[m][k], acc[ai][bj][m][n], 0, 0, 0); __builtin_amdgcn_s_setprio(0); } while (0)
#define PG8_WAIT_V(n) asm volatile("s_waitcnt vmcnt(" #n ")" ::: "memory")
#define PG8_WAIT_L(n) asm volatile("s_waitcnt lgkmcnt(" #n ")" ::: "memory")
#define PG8_BAR __builtin_amdgcn_s_barrier()
#define PG8_SCHED __builtin_amdgcn_sched_barrier(0)
    Unit cur, nxt; int ui = 0;
    if (!S.next(0, cur)) return;
    f32x4 acc[2][2][4][2];
#pragma unroll
    for (int a = 0; a < 2; ++a)
#pragma unroll
        for (int b = 0; b < 2; ++b)
#pragma unroll
            for (int m = 0; m < 4; ++m)
#pragma unroll
                for (int n = 0; n < 2; ++n) acc[a][b][m][n] = (f32x4){0.f, 0.f, 0.f, 0.f};
    bf16x8 At[4][2], B0[2][2], B1[2][2];
    const char* cA = (const char*)g.A + (size_t)cur.pm * tstep; const char* cB = (const char*)g.Bt + (size_t)cur.pn * tstep;
    S.a_ready(cur);
    PG8_STAGE(PG8_SB(0, 0), cB, voffB); PG8_STAGE(PG8_SA(0, 0), cA, voffA); PG8_STAGE(PG8_SB(0, 1), cB + hstep, voffB); PG8_STAGE(PG8_SA(0, 1), cA + hstep, voffA);
    if (wr == 1) PG8_BAR;
    PG8_WAIT_V(4); PG8_BAR;
    PG8_STAGE(PG8_SB(1, 0), cB + kstep, voffB); PG8_STAGE(PG8_SA(1, 0), cA + kstep, voffA); PG8_STAGE(PG8_SB(1, 1), cB + hstep + kstep, voffB);
    PG8_WAIT_V(6); PG8_BAR;
    PG8_STAMP();
    for (;;) {
        const bool has_next = S.next(ui + 1, nxt);
        const char* nA = has_next ? (const char*)g.A + (size_t)nxt.pm * tstep : cA; const char* nB = has_next ? (const char*)g.Bt + (size_t)nxt.pn * tstep : cB;
        for (int t = 0; t < nt; t += 2) {
            const bool last = (t == nt - 2);
            const char* a1 = cA + (size_t)(t + 1) * kstep;
            const char* a2 = last ? nA : cA + (size_t)(t + 2) * kstep; const char* b2 = last ? nB : cB + (size_t)(t + 2) * kstep;
            const char* a3 = a2 + kstep; const char* b3 = b2 + kstep;
            if (last && has_next) S.a_ready(nxt);
            PG8_LDB(B0, 0, 0); PG8_SCHED; PG8_LDA(At, 0, 0); PG8_STAGE(PG8_SA(1, 1), a1 + hstep, voffA);
            PG8_WAIT_L(8); PG8_BAR; PG8_WAIT_L(0); PG8_MMA(0, 0, At, B0); PG8_BAR; PG8_SCHED;
            PG8_LDB(B1, 0, 1); PG8_STAGE(PG8_SB(0, 0), b2, voffB);
            PG8_BAR; PG8_WAIT_L(0); PG8_MMA(0, 1, At, B1); PG8_BAR;
            PG8_LDA(At, 0, 1); PG8_STAGE(PG8_SA(0, 0), a2, voffA);
            PG8_BAR; PG8_WAIT_L(0); PG8_MMA(1, 0, At, B0); PG8_BAR; PG8_SCHED;
            PG8_STAGE(PG8_SB(0, 1), b2 + hstep, voffB);
            PG8_WAIT_V(6); PG8_BAR; PG8_MMA(1, 1, At, B1); PG8_BAR;
            PG8_LDB(B0, 1, 0); PG8_SCHED; PG8_LDA(At, 1, 0); PG8_STAGE(PG8_SA(0, 1), a2 + hstep, voffA);
            PG8_WAIT_L(8); PG8_BAR; PG8_WAIT_L(0); PG8_MMA(0, 0, At, B0); PG8_BAR; PG8_SCHED;
            PG8_LDB(B1, 1, 1); PG8_STAGE(PG8_SB(1, 0), b3, voffB);
            PG8_BAR; PG8_WAIT_L(0); PG8_MMA(0, 1, At, B1); PG8_BAR;
            PG8_LDA(At, 1, 1); PG8_STAGE(PG8_SA(1, 0), a3, voffA);
            PG8_BAR; PG8_WAIT_L(0); PG8_MMA(1, 0, At, B0); PG8_BAR; PG8_SCHED;
            PG8_STAGE(PG8_SB(1, 1), b3 + hstep, voffB);
            PG8_WAIT_V(6); PG8_BAR; PG8_MMA(1, 1, At, B1); PG8_BAR;
        }
        PG8_STAMP();
        if constexpr (!Epi::AFTER_DRAIN) { E(acc, cur, wr, wc, fr, fq); S.done(cur); }
        PG8_STAMP();
        if (!has_next) break;
#pragma unroll
        for (int a = 0; a < 2; ++a)
#pragma unroll
            for (int b = 0; b < 2; ++b)
#pragma unroll
                for (int m = 0; m < 4; ++m)
#pragma unroll
                    for (int n = 0; n < 2; ++n) acc[a][b][m][n] = (f32x4){0.f, 0.f, 0.f, 0.f};
        cur = nxt; cA = nA; cB = nB; ++ui;
    }
    PG8_WAIT_V(0);
    if (wr == 0) PG8_BAR;
    PG8_BAR;
    if constexpr (Epi::AFTER_DRAIN) { E.fused(acc, cur, wr, wc, fr, fq, lds, wid, lane); S.done(cur); }
    PG8_STAMP();
    if (STAMP && wid == 0) { stamps[lane] = lane < nts ? (((unsigned long long)(unsigned)ts_hi << 32) | (unsigned)ts_lo) : 0ull;
        if (lane == 62) stamps[62] = rt_entry; if (lane == 63) stamps[63] = (unsigned long long)wall_clock64(); }
#undef PG8_STAMP
#undef PG8_SA
#undef PG8_SB
#undef PG8_STAGE
#undef PG8_LDA
#undef PG8_LDB
#undef PG8_MMA
#undef PG8_WAIT_V
#undef PG8_WAIT_L
#undef PG8_BAR
#undef PG8_SCHED
}
}

using namespace pg8;
#define LAS __attribute__((address_space(3)))
typedef short s16x4 __attribute__((ext_vector_type(4)));
typedef short v4i16_t __attribute__((ext_vector_type(4)));
typedef float f32x16 __attribute__((ext_vector_type(16)));
typedef unsigned u32x2 __attribute__((ext_vector_type(2)));
typedef float f32x2v __attribute__((ext_vector_type(2)));

#ifndef MK_PER_PHASE
#define MK_PER_PHASE 0
#endif

constexpr int NTOK = 65536, SEQL = 2048;
constexpr float EPSN = 1e-6f;
constexpr int LDS_BYTES = 155648;
constexpr int S5_WL = 25088;
constexpr int ATT_OFF = 4 * S5_WL;
constexpr int VSTR = 192;
constexpr int ATT_WL = 32 * VSTR;
static_assert(ATT_OFF + 8 * ATT_WL <= LDS_BYTES, "lds");

constexpr size_t OFF_WIN = 0;
constexpr size_t OFF_WGLU = OFF_WIN + 2ull * 7168 * 1024 * 2;
constexpr size_t OFF_WATT = OFF_WGLU + 2ull * 2048 * 512 * 2;
constexpr size_t OFF_WPW2 = OFF_WATT + 2ull * 1024 * 512 * 2;
constexpr size_t OFF_WOUT = OFF_WPW2 + 2ull * 1024 * 512 * 2;
constexpr size_t OFF_WF1 = OFF_WOUT + 2ull * 1024 * 1024 * 2;
constexpr size_t OFF_WF2 = OFF_WF1 + 2ull * 5632 * 1024 * 2;
constexpr size_t OFF_S5BB = OFF_WF2 + 2ull * 1024 * 2816 * 2;
constexpr size_t OFF_S5CM = OFF_S5BB + 2ull * 32 * 128 * 16 * 2;
constexpr size_t OFF_S5A = OFF_S5CM + 2ull * 32 * 16 * 128 * 2;
constexpr size_t OFF_CONVW = OFF_S5A + 2ull * 32 * 64 * 8;
constexpr size_t OFF_CTL = OFF_CONVW + 65536;
constexpr size_t OFF_RSQ1 = OFF_CTL + 4096;
constexpr size_t OFF_RSQ2 = OFF_RSQ1 + 65536ull * 8;
constexpr size_t OFF_LSE = OFF_RSQ2 + 65536ull * 8;
constexpr size_t OFF_XB = OFF_LSE + 2ull * 65536 * 8 * 4;
constexpr size_t OFF_G = OFF_XB + 65536ull * 1024 * 2;
constexpr size_t OFF_QO = OFF_G + 65536ull * 3072 * 2;
constexpr size_t OFF_CG = OFF_QO + 65536ull * 1536 * 2;
constexpr size_t OFF_HC = OFF_CG + 65536ull * 512 * 2;
constexpr size_t OFF_OC = OFF_HC + 65536ull * 512 * 2;
constexpr size_t WS_END = OFF_OC + 65536ull * 512 * 2;
constexpr size_t DO_U = 0, DO_K = 64ull << 20, DO_V = 128ull << 20, DO_Y = 192ull << 20, DO_MG = 64ull << 20;

struct Params {
    const float* in[24];
    float* out; unsigned char* ws;
    int ph_lo, ph_hi;
};
enum { I_X = 0, I_N1G, I_WIN, I_BGATE, I_LRE, I_LIM, I_LOGDT, I_BRE, I_BIM, I_CRE, I_CIM, I_SSMD, I_WGLU, I_WATT, I_CONVW, I_CONVB, I_LNG, I_LNB, I_WPW2, I_WOUT, I_N2G, I_WF1, I_WF2, I_FING };

__device__ __forceinline__ float bf_lo(unsigned u) { return __uint_as_float(u << 16); }
__device__ __forceinline__ float bf_hi(unsigned u) { return __uint_as_float(u & 0xffff0000u); }
__device__ __forceinline__ float sigm(float x) { return __builtin_amdgcn_rcpf(1.f + __expf(-x)); }
__device__ __forceinline__ unsigned short f2bf(float f) { unsigned u = __float_as_uint(f); u += 0x7FFFu + ((u >> 16) & 1u); return (unsigned short)(u >> 16); }
__device__ __forceinline__ float wave_sum(float v) {
#pragma unroll
    for (int o = 1; o < 64; o <<= 1) v += __shfl_xor(v, o);
    return v;
}
__device__ __forceinline__ s16x4 vtr(const LAS unsigned char* p) { return __builtin_bit_cast(s16x4, __builtin_amdgcn_ds_read_tr16_b64_v4i16((LAS v4i16_t*)p)); }

__device__ __forceinline__ u32x4 pack8(const f32x4 a, const f32x4 b) { u32x4 w; w.x = cvt_pk_bf16(a[0], a[1]); w.y = cvt_pk_bf16(a[2], a[3]); w.z = cvt_pk_bf16(b[0], b[1]); w.w = cvt_pk_bf16(b[2], b[3]); return w; }
__device__ __forceinline__ void unpack8(const u32x4 w, f32x4& a, f32x4& b) { a[0] = bf_lo(w.x); a[1] = bf_hi(w.x); a[2] = bf_lo(w.y); a[3] = bf_hi(w.y); b[0] = bf_lo(w.z); b[1] = bf_hi(w.z); b[2] = bf_lo(w.w); b[3] = bf_hi(w.w); }

struct EpiIn {
    static constexpr bool PERM = true, AFTER_DRAIN = false;
    bf16_t *U, *QO, *Kb, *Vb, *CG, *G; const unsigned long long* rowsq; const float* bgate;
    __device__ __forceinline__ void operator()(const f32x4 (&acc)[2][2][4][2], const Unit& u, int wr, int wc, int fr, int fq) const {
        const int row0 = u.pm * 256 + wr * 64 + fr, cl = wc * 32 + 8 * fq, pn = u.pn;
        if (pn < 12) {
            bf16_t* base; int ld, col0;
            if (pn < 2) { base = U; ld = 512; col0 = pn * 256; }
            else if (pn < 8) { base = QO; ld = 1536; col0 = (pn - 2) * 256; }
            else if (pn < 10) { base = Kb; ld = 512; col0 = (pn - 8) * 256; }
            else { base = Vb; ld = 512; col0 = (pn - 10) * 256; }
#pragma unroll
            for (int ai = 0; ai < 2; ++ai)
#pragma unroll
                for (int m = 0; m < 4; ++m) { const int r = row0 + ai * 128 + m * 16; const float rs = rsqrtf((float)rowsq[r] * (1.f / (1024.f * 1048576.f)) + EPSN);
#pragma unroll
                    for (int bj = 0; bj < 2; ++bj) *(u32x4*)(base + (size_t)r * ld + col0 + bj * 128 + cl) = pack8(acc[ai][bj][m][0] * rs, acc[ai][bj][m][1] * rs); }
        } else if (pn < 16) {
            const int c0 = (pn - 12) * 128 + cl;
#pragma unroll
            for (int ai = 0; ai < 2; ++ai)
#pragma unroll
                for (int m = 0; m < 4; ++m) { const int r = row0 + ai * 128 + m * 16; const float rs = rsqrtf((float)rowsq[r] * (1.f / (1024.f * 1048576.f)) + EPSN);
                    f32x4 o[2];
#pragma unroll
                    for (int n = 0; n < 2; ++n)
#pragma unroll
                        for (int j = 0; j < 4; ++j) o[n][j] = acc[ai][0][m][n][j] * rs * sigm(acc[ai][1][m][n][j] * rs);
                    *(u32x4*)(CG + (size_t)r * 512 + c0) = pack8(o[0], o[1]); }
        } else {
            const int c0 = (pn - 16) * 256 + cl;
            f32x4 bv[2][2];
#pragma unroll
            for (int bj = 0; bj < 2; ++bj)
#pragma unroll
                for (int n = 0; n < 2; ++n) bv[bj][n] = *(const f32x4*)(bgate + c0 + bj * 128 + 4 * n);
#pragma unroll
            for (int ai = 0; ai < 2; ++ai)
#pragma unroll
                for (int m = 0; m < 4; ++m) { const int r = row0 + ai * 128 + m * 16; const float rs = rsqrtf((float)rowsq[r] * (1.f / (1024.f * 1048576.f)) + EPSN);
#pragma unroll
                    for (int bj = 0; bj < 2; ++bj) { f32x4 o[2];
#pragma unroll
                        for (int n = 0; n < 2; ++n)
#pragma unroll
                            for (int j = 0; j < 4; ++j) o[n][j] = sigm(acc[ai][bj][m][n][j] * rs + bv[bj][n][j]);
                        *(u32x4*)(G + (size_t)r * 3072 + c0 + bj * 128) = pack8(o[0], o[1]); } }
        }
    }
};
struct EpiGluMerge {
    static constexpr bool PERM = true, AFTER_DRAIN = false;
    bf16_t* Mg; const bf16_t* G;
    __device__ __forceinline__ void operator()(const f32x4 (&acc)[2][2][4][2], const Unit& u, int wr, int wc, int fr, int fq) const {
        const int row0 = u.pm * 256 + wr * 64 + fr, c0 = u.pn * 128 + wc * 32 + 8 * fq;
#pragma unroll
        for (int ai = 0; ai < 2; ++ai)
#pragma unroll
            for (int m = 0; m < 4; ++m) { const int r = row0 + ai * 128 + m * 16;
                f32x4 g0, g1; unpack8(*(const u32x4*)(G + (size_t)r * 3072 + c0), g0, g1);
                f32x4 o[2];
#pragma unroll
                for (int j = 0; j < 4; ++j) { o[0][j] = g0[j] * acc[ai][0][m][0][j] * sigm(acc[ai][1][m][0][j]); o[1][j] = g1[j] * acc[ai][0][m][1][j] * sigm(acc[ai][1][m][1][j]); }
                *(u32x4*)(Mg + (size_t)r * 1024 + c0) = pack8(o[0], o[1]); }
    }
};
struct EpiAccMerge {
    static constexpr bool PERM = true, AFTER_DRAIN = false;
    bf16_t* Mg; const bf16_t* G; int gate_off;
    __device__ __forceinline__ void operator()(const f32x4 (&acc)[2][2][4][2], const Unit& u, int wr, int wc, int fr, int fq) const {
        const int row0 = u.pm * 256 + wr * 64 + fr, cb = u.pn * 256 + wc * 32 + 8 * fq;
#pragma unroll
        for (int ai = 0; ai < 2; ++ai)
#pragma unroll
            for (int m = 0; m < 4; ++m) { const int r = row0 + ai * 128 + m * 16;
#pragma unroll
                for (int bj = 0; bj < 2; ++bj) { const int c0 = cb + bj * 128;
                    f32x4 g0, g1, m0, m1; unpack8(*(const u32x4*)(G + (size_t)r * 3072 + gate_off + c0), g0, g1); unpack8(*(const u32x4*)(Mg + (size_t)r * 1024 + c0), m0, m1);
                    *(u32x4*)(Mg + (size_t)r * 1024 + c0) = pack8(m0 + g0 * acc[ai][bj][m][0], m1 + g1 * acc[ai][bj][m][1]); } }
    }
};
struct EpiXUpd {
    static constexpr bool PERM = true, AFTER_DRAIN = false;
    bf16_t* xb; unsigned long long* rowsq;
    __device__ __forceinline__ void operator()(const f32x4 (&acc)[2][2][4][2], const Unit& u, int wr, int wc, int fr, int fq) const {
        const int row0 = u.pm * 256 + wr * 64 + fr, cb = u.pn * 256 + wc * 32 + 8 * fq;
#pragma unroll
        for (int ai = 0; ai < 2; ++ai)
#pragma unroll
            for (int m = 0; m < 4; ++m) { const int r = row0 + ai * 128 + m * 16; float ss = 0.f;
#pragma unroll
                for (int bj = 0; bj < 2; ++bj) { const int c0 = cb + bj * 128;
                    f32x4 x0, x1; unpack8(*(const u32x4*)(xb + (size_t)r * 1024 + c0), x0, x1);
                    const u32x4 w = pack8(x0 + acc[ai][bj][m][0], x1 + acc[ai][bj][m][1]);
                    *(u32x4*)(xb + (size_t)r * 1024 + c0) = w;
                    unpack8(w, x0, x1);
#pragma unroll
                    for (int j = 0; j < 4; ++j) ss += x0[j] * x0[j] + x1[j] * x1[j]; }
                ss += __shfl_xor(ss, 16); ss += __shfl_xor(ss, 32);
                if (fq == 0) atomicAdd(rowsq + r, (unsigned long long)(ss * 1048576.f)); }
    }
};
struct EpiFfn1 {
    static constexpr bool PERM = true, AFTER_DRAIN = false;
    bf16_t* Hf; const unsigned long long* rowsq;
    __device__ __forceinline__ void operator()(const f32x4 (&acc)[2][2][4][2], const Unit& u, int wr, int wc, int fr, int fq) const {
        const int row0 = u.pm * 256 + wr * 64 + fr, c0 = u.pn * 128 + wc * 32 + 8 * fq;
#pragma unroll
        for (int ai = 0; ai < 2; ++ai)
#pragma unroll
            for (int m = 0; m < 4; ++m) { const int r = row0 + ai * 128 + m * 16; const float rs = rsqrtf((float)rowsq[r] * (1.f / (1024.f * 1048576.f)) + EPSN);
                f32x4 o[2];
#pragma unroll
                for (int n = 0; n < 2; ++n)
#pragma unroll
                    for (int j = 0; j < 4; ++j) { const float a = acc[ai][0][m][n][j] * rs, b = acc[ai][1][m][n][j] * rs; o[n][j] = a * sigm(a) * b; }
                *(u32x4*)(Hf + (size_t)r * 2816 + c0) = pack8(o[0], o[1]); }
    }
};

__device__ __forceinline__ void p0_tr_item(const float* W, int K, int N, bf16_t* WT, int kb, int nd0, int ns0, const float* gk, float scale, LAS float* scr, int lane) {
    const int k0 = 64 * kb;
#pragma unroll 8
    for (int i = 0; i < 32; ++i) { const int kk = 2 * i + (lane >> 5); float s = scale; if (gk) s *= gk[k0 + kk]; scr[kk * 33 + (lane & 31)] = W[(size_t)(k0 + kk) * N + ns0 + (lane & 31)] * s; }
    asm volatile("" ::: "memory");
    const int c = lane & 7;
#pragma unroll
    for (int j = 0; j < 4; ++j) { const int n = (lane >> 3) + 8 * j; const LAS float* s = scr + (8 * c) * 33 + n;
        u32x4 o; o.x = cvt_pk_bf16(s[0 * 33], s[1 * 33]); o.y = cvt_pk_bf16(s[2 * 33], s[3 * 33]); o.z = cvt_pk_bf16(s[4 * 33], s[5 * 33]); o.w = cvt_pk_bf16(s[6 * 33], s[7 * 33]);
        *(u32x4*)(WT + (size_t)(nd0 + n) * K + k0 + 8 * c) = o; }
    asm volatile("" ::: "memory");
}
__device__ __forceinline__ void phase_p0(const Params& P, LAS unsigned char* lds, int wave, int lane, int tid) {
    unsigned char* ws = P.ws;
    const int gw = blockIdx.x * 8 + wave, NGW = gridDim.x * 8;
    LAS float* scr = (LAS float*)(lds + wave * 16384);
    constexpr int PER_L = 3584 + 512 + 256 + 256 + 512 + 2816 + 1408;
    for (int it = gw; it < 2 * PER_L; it += NGW) {
        const int l = it / PER_L; int r = it % PER_L;
        const float* W; bf16_t* WT; int K, N, type = 0; const float* gk = nullptr;
        if (r < 3584) { W = P.in[I_WIN] + (size_t)l * 1024 * 7168; WT = (bf16_t*)(ws + OFF_WIN) + (size_t)l * 7168 * 1024; K = 1024; N = 7168; type = 1; gk = P.in[I_N1G] + l * 1024; }
        else if ((r -= 3584) < 512) { W = P.in[I_WGLU] + (size_t)l * 512 * 2048; WT = (bf16_t*)(ws + OFF_WGLU) + (size_t)l * 2048 * 512; K = 512; N = 2048; type = 3; }
        else if ((r -= 512) < 256) { W = P.in[I_WATT] + (size_t)l * 512 * 1024; WT = (bf16_t*)(ws + OFF_WATT) + (size_t)l * 1024 * 512; K = 512; N = 1024; }
        else if ((r -= 256) < 256) { W = P.in[I_WPW2] + (size_t)l * 512 * 1024; WT = (bf16_t*)(ws + OFF_WPW2) + (size_t)l * 1024 * 512; K = 512; N = 1024; }
        else if ((r -= 256) < 512) { W = P.in[I_WOUT] + (size_t)l * 1024 * 1024; WT = (bf16_t*)(ws + OFF_WOUT) + (size_t)l * 1024 * 1024; K = 1024; N = 1024; }
        else if ((r -= 512) < 2816) { W = P.in[I_WF1] + (size_t)l * 1024 * 5632; WT = (bf16_t*)(ws + OFF_WF1) + (size_t)l * 5632 * 1024; K = 1024; N = 5632; type = 2; gk = P.in[I_N2G] + l * 1024; }
        else { r -= 2816; W = P.in[I_WF2] + (size_t)l * 2816 * 1024; WT = (bf16_t*)(ws + OFF_WF2) + (size_t)l * 1024 * 2816; K = 2816; N = 1024; }
        const int nblk = N / 32, kb = r / nblk, nd0 = (r % nblk) * 32;
        int ns0 = nd0; float scale = 1.f;
        if (type == 1) { if (nd0 >= 3072 && nd0 < 4096) { const int t = nd0 - 3072, j = t & 255; ns0 = 3072 + (t >> 8) * 128 + (j & 127) + (j >= 128 ? 512 : 0); }
                         if (nd0 >= 512 && nd0 < 2048) scale = 0.125f * 1.4426950408889634f; }
        else if (type == 2) { const int j = nd0 & 255; ns0 = (nd0 >> 8) * 128 + (j & 127) + (j >= 128 ? 2816 : 0); }
        else if (type == 3) { const int j = nd0 & 255; ns0 = (nd0 >> 8) * 128 + (j & 127) + (j >= 128 ? 1024 : 0); }
        p0_tr_item(W, K, N, WT, kb, nd0, ns0, gk, scale, scr, lane);
    }
    { const float* x = P.in[I_X]; bf16_t* xb = (bf16_t*)(ws + OFF_XB); unsigned long long* rsq = (unsigned long long*)(ws + OFF_RSQ1);
      for (int row = gw; row < NTOK; row += NGW) { float ss = 0.f;
#pragma unroll
          for (int j = 0; j < 4; ++j) { const f32x4 v = *(const f32x4*)(x + (size_t)row * 1024 + 4 * lane + 256 * j); u32x2 w; w.x = cvt_pk_bf16(v[0], v[1]); w.y = cvt_pk_bf16(v[2], v[3]);
              *(u32x2*)(xb + (size_t)row * 1024 + 4 * lane + 256 * j) = w; const float a = bf_lo(w.x), b = bf_hi(w.x), c = bf_lo(w.y), d = bf_hi(w.y); ss += a * a + b * b + c * c + d * d; }
          ss = wave_sum(ss); if (lane == 0) rsq[row] = (unsigned long long)(ss * 1048576.f); } }
    const int gt = blockIdx.x * 512 + tid, NGT = gridDim.x * 512;
    for (int idx = gt; idx < 2 * 32 * 64; idx += NGT) {
        const int lg = idx >> 6, p = idx & 63;
        const float lre = P.in[I_LRE][idx], lim = P.in[I_LIM][idx], dt = expf(P.in[I_LOGDT][lg]);
        const float mag = expf(lre * dt);
        const double rev = (double)lim * (double)dt * 0.15915494309189535; const float frc = (float)(rev - rint(rev));
        const float sn = __builtin_amdgcn_sinf(frc), cs = __builtin_amdgcn_cosf(frc);
        const float are = mag * cs, aim = mag * sn, nr = are - 1.f, ni = aim, den = lre * lre + lim * lim;
        const float zre = (nr * lre + ni * lim) / den, zim = (ni * lre - nr * lim) / den;
        { f32x2v t2; t2.x = are; t2.y = aim; ((f32x2v*)(ws + OFF_S5A))[idx] = t2; }
        bf16_t* bbt = (bf16_t*)(ws + OFF_S5BB) + (size_t)lg * 128 * 16; bf16_t* cm = (bf16_t*)(ws + OFF_S5CM) + (size_t)lg * 16 * 128;
        for (int h = 0; h < 16; ++h) { const float br = P.in[I_BRE][(size_t)idx * 16 + h], bi = P.in[I_BIM][(size_t)idx * 16 + h];
            bbt[p * 16 + h] = f2bf(zre * br - zim * bi); bbt[(64 + p) * 16 + h] = f2bf(zre * bi + zim * br);
            cm[h * 128 + p] = f2bf(P.in[I_CRE][((size_t)lg * 16 + h) * 64 + p]); cm[h * 128 + 64 + p] = f2bf(-P.in[I_CIM][((size_t)lg * 16 + h) * 64 + p]); }
    }
    for (int idx = gt; idx < 2 * 31 * 256; idx += NGT) { const float a = P.in[I_CONVW][2 * idx], b = P.in[I_CONVW][2 * idx + 1]; ((unsigned*)(ws + OFF_CONVW))[idx] = cvt_pk_bf16(a, b); }
}
__device__ __forceinline__ void phase_final(const Params& P, int wave, int lane) {
    const int gw = blockIdx.x * 8 + wave, NGW = gridDim.x * 8;
    const bf16_t* xb = (const bf16_t*)(P.ws + OFF_XB); const unsigned long long* rsq = (const unsigned long long*)(P.ws + OFF_RSQ1); const float* fg = P.in[I_FING];
    for (int row = gw; row < NTOK; row += NGW) { const float rs = rsqrtf((float)rsq[row] * (1.f / (1024.f * 1048576.f)) + EPSN);
#pragma unroll
        for (int j = 0; j < 4; ++j) { const int c = 4 * lane + 256 * j; const u32x2 w = *(const u32x2*)(xb + (size_t)row * 1024 + c); const f32x4 g = *(const f32x4*)(fg + c);
            f32x4 o; o[0] = bf_lo(w.x) * rs * g[0]; o[1] = bf_hi(w.x) * rs * g[1]; o[2] = bf_lo(w.y) * rs * g[2]; o[3] = bf_hi(w.y) * rs * g[3];
            *(f32x4*)(P.out + (size_t)row * 1024 + c) = o; } }
}

__device__ __forceinline__ void s5_item(const Params& P, int l, int it, LAS unsigned char* wl, int lane) {
    const int b = it >> 5, g = it & 31, lg = l * 32 + g;
    LAS float* bu = (LAS float*)wl; LAS unsigned char* sl = wl + 16384;
    const int c32 = lane & 31, hi = lane >> 5, fr = lane & 15, fq = lane >> 4;
    const bf16_t* bbt = (const bf16_t*)(P.ws + OFF_S5BB) + (size_t)lg * 128 * 16; const bf16_t* cm = (const bf16_t*)(P.ws + OFF_S5CM) + (size_t)lg * 16 * 128;
    bf16x8 bbreg[4], cmreg[4];
#pragma unroll
    for (int j = 0; j < 4; ++j) { bbreg[j] = *(const bf16x8*)(bbt + (32 * j + c32) * 16 + 8 * hi); cmreg[j] = *(const bf16x8*)(cm + fr * 128 + 32 * j + 8 * fq); }
    const f32x2v av = ((const f32x2v*)(P.ws + OFF_S5A))[lg * 64 + lane]; const float a_re = av.x, a_im = av.y;
    const float dsk = P.in[I_SSMD][l * 512 + g * 16 + fr];
    float s_re = 0.f, s_im = 0.f;
    const bf16_t* Ub = (const bf16_t*)((unsigned char*)P.out + DO_U) + (size_t)b * SEQL * 512 + g * 16; bf16_t* Yb = (bf16_t*)((unsigned char*)P.out + DO_Y) + (size_t)b * SEQL * 512 + g * 16;
    for (int c = 0; c < 64; ++c) {
        const int t0 = c * 32;
        const bf16x8 ureg = *(const bf16x8*)(Ub + (size_t)(t0 + c32) * 512 + 8 * hi);
        unsigned short uep[2][4];
#pragma unroll
        for (int mt = 0; mt < 2; ++mt)
#pragma unroll
            for (int i = 0; i < 4; ++i) uep[mt][i] = Ub[(size_t)(t0 + 16 * mt + 4 * fq + i) * 512 + fr];
#pragma unroll
        for (int j = 0; j < 4; ++j) { f32x16 a;
#pragma unroll
            for (int r = 0; r < 16; ++r) a[r] = 0.f;
            a = __builtin_amdgcn_mfma_f32_32x32x16_bf16(ureg, bbreg[j], a, 0, 0, 0);
#pragma unroll
            for (int r = 0; r < 16; ++r) { const int tok = (r & 3) + 8 * (r >> 2) + 4 * hi; bu[tok * 128 + ((32 * (j & 1) + c32) << 1) + (j >> 1)] = a[r]; } }
        asm volatile("" ::: "memory");
#pragma unroll 8
        for (int t = 0; t < 32; ++t) { const f32x2v v = *(const LAS f32x2v*)(bu + t * 128 + 2 * lane);
            const float nre = fmaf(a_re, s_re, fmaf(-a_im, s_im, v.x)), nim = fmaf(a_re, s_im, fmaf(a_im, s_re, v.y)); s_re = nre; s_im = nim;
            *(LAS unsigned short*)(sl + t * 272 + lane * 2) = f2bf(s_re); *(LAS unsigned short*)(sl + t * 272 + 128 + lane * 2) = f2bf(s_im); }
        asm volatile("" ::: "memory");
#pragma unroll
        for (int mt = 0; mt < 2; ++mt) { f32x4 ya = {0.f, 0.f, 0.f, 0.f};
#pragma unroll
            for (int ks = 0; ks < 4; ++ks) { const bf16x8 a = *(const LAS bf16x8*)(sl + (16 * mt + fr) * 272 + (32 * ks + 8 * fq) * 2); ya = __builtin_amdgcn_mfma_f32_16x16x32_bf16(a, cmreg[ks], ya, 0, 0, 0); }
#pragma unroll
            for (int i = 0; i < 4; ++i) { const float y = ya[i] + dsk * __uint_as_float((unsigned)uep[mt][i] << 16);
                const float ge = y * sigm(1.5957691216057308f * (y + 0.044715f * y * y * y));
                Yb[(size_t)(t0 + 16 * mt + 4 * fq + i) * 512 + fr] = f2bf(ge); } }
        asm volatile("" ::: "memory");
    }
}

template <int PAT> __device__ __forceinline__ void attn_item(const Params& P, int it, LAS unsigned char* vl, int lane) {
    constexpr int d = PAT == 0 ? 1 : (PAT == 1 ? 4 : 16);
    constexpr int ngrp = (SEQL / d) / 32;
    const int j = it % ngrp; int t = it / ngrp; const int r = t % d; t /= d; const int h = t & 7, b = t >> 3;
    const int c32 = lane & 31, hi = lane >> 5, i0 = 32 * j;
    const size_t tokbase = (size_t)b * SEQL; const size_t tq = tokbase + (size_t)(i0 + c32) * d + r;
    bf16_t* QO = (bf16_t*)(P.ws + OFF_QO); const bf16_t* Kb = (const bf16_t*)((unsigned char*)P.out + DO_K); const bf16_t* Vb = (const bf16_t*)((unsigned char*)P.out + DO_V);
    float* LSE = (float*)(P.ws + OFF_LSE);
    bf16x8 qreg[4];
    { const bf16_t* qp = QO + tq * 1536 + PAT * 512 + h * 64 + 8 * hi;
#pragma unroll
      for (int ks = 0; ks < 4; ++ks) qreg[ks] = *(const bf16x8*)(qp + 16 * ks); }
    f32x16 s[5];
#pragma unroll
    for (int kt = 0; kt < 5; ++kt) { const int kb = i0 - 128 + 32 * kt;
        f32x16 a;
        if (kb >= 0) {
#pragma unroll
            for (int q = 0; q < 16; ++q) a[q] = 0.f;
            const bf16_t* kp = Kb + (tokbase + (size_t)(kb + c32) * d + r) * 512 + h * 64 + 8 * hi;
#pragma unroll
            for (int ks = 0; ks < 4; ++ks) { const bf16x8 kreg = *(const bf16x8*)(kp + 16 * ks); a = __builtin_amdgcn_mfma_f32_32x32x16_bf16(kreg, qreg[ks], a, 0, 0, 0); }
        } else {
#pragma unroll
            for (int q = 0; q < 16; ++q) a[q] = (-__builtin_inff());
        }
        s[kt] = a; }
#pragma unroll
    for (int q = 0; q < 16; ++q) { const int kr = (q & 3) + 8 * (q >> 2) + 4 * hi; if (kr < c32) s[0][q] = (-__builtin_inff()); if (kr > c32) s[4][q] = (-__builtin_inff()); }
    float mx = (-__builtin_inff());
#pragma unroll
    for (int kt = 0; kt < 5; ++kt)
#pragma unroll
        for (int q = 0; q < 16; ++q) mx = fmaxf(mx, s[kt][q]);
    mx = fmaxf(mx, __shfl_xor(mx, 32));
    float den = 0.f;
#pragma unroll
    for (int kt = 0; kt < 5; ++kt)
#pragma unroll
        for (int q = 0; q < 16; ++q) { const float p = __builtin_amdgcn_exp2f(s[kt][q] - mx); s[kt][q] = p; den += p; }
    den += __shfl_xor(den, 32);
    f32x16 o[2];
#pragma unroll
    for (int q = 0; q < 16; ++q) { o[0][q] = 0.f; o[1][q] = 0.f; }
    const int gi = lane >> 4, li = lane & 15;
    const LAS unsigned char* vrd = vl + (4 * hi + (li >> 2)) * VSTR + (16 * (gi & 1) + 4 * (li & 3)) * 2;
#pragma unroll
    for (int kt = 0; kt < 5; ++kt) { const int kb = i0 - 128 + 32 * kt;
        if (kb >= 0) {
#pragma unroll
            for (int i4 = 0; i4 < 4; ++i4) { const int row = (lane >> 3) + 8 * i4, ch = lane & 7;
                const u32x4 v = *(const u32x4*)(Vb + (tokbase + (size_t)(kb + row) * d + r) * 512 + h * 64 + ch * 8); *(LAS u32x4*)(vl + row * VSTR + ch * 16) = v; }
            asm volatile("" ::: "memory");
#pragma unroll
            for (int ks2 = 0; ks2 < 2; ++ks2) { u32x4 pw;
                pw.x = cvt_pk_bf16(s[kt][8 * ks2 + 0], s[kt][8 * ks2 + 1]); pw.y = cvt_pk_bf16(s[kt][8 * ks2 + 2], s[kt][8 * ks2 + 3]);
                pw.z = cvt_pk_bf16(s[kt][8 * ks2 + 4], s[kt][8 * ks2 + 5]); pw.w = cvt_pk_bf16(s[kt][8 * ks2 + 6], s[kt][8 * ks2 + 7]);
                const bf16x8 pb = __builtin_bit_cast(bf16x8, pw);
#pragma unroll
                for (int mt = 0; mt < 2; ++mt) { const LAS unsigned char* a1 = vrd + (16 * ks2) * VSTR + 64 * mt;
                    const s16x4 lo = vtr(a1), up = vtr(a1 + 8 * VSTR);
                    bf16x8 av; av[0] = lo[0]; av[1] = lo[1]; av[2] = lo[2]; av[3] = lo[3]; av[4] = up[0]; av[5] = up[1]; av[6] = up[2]; av[7] = up[3];
                    o[mt] = __builtin_amdgcn_mfma_f32_32x32x16_bf16(av, pb, o[mt], 0, 0, 0); } }
            asm volatile("" ::: "memory");
        } }
    const float inv = __builtin_amdgcn_rcpf(den);
    const float l2 = mx + __builtin_amdgcn_logf(den);
    if (PAT != 0) {
        bf16_t* op = QO + tq * 1536 + PAT * 512 + h * 64 + 4 * hi;
#pragma unroll
        for (int mt = 0; mt < 2; ++mt)
#pragma unroll
            for (int rg = 0; rg < 4; ++rg) { u32x2 w; w.x = cvt_pk_bf16(o[mt][4 * rg] * inv, o[mt][4 * rg + 1] * inv); w.y = cvt_pk_bf16(o[mt][4 * rg + 2] * inv, o[mt][4 * rg + 3] * inv);
                *(u32x2*)(op + 32 * mt + 8 * rg) = w; }
        if (hi == 0) LSE[((size_t)(PAT - 1) * NTOK + tq) * 8 + h] = l2;
    } else {
        const float l2b = LSE[(tq) * 8 + h], l2c = LSE[((size_t)NTOK + tq) * 8 + h];
        const float M = fmaxf(l2, fmaxf(l2b, l2c));
        float w1 = __builtin_amdgcn_exp2f(l2 - M), w2 = __builtin_amdgcn_exp2f(l2b - M), w3 = __builtin_amdgcn_exp2f(l2c - M);
        const float wi = __builtin_amdgcn_rcpf(w1 + w2 + w3); w1 *= wi * inv; w2 *= wi; w3 *= wi;
        const bf16_t* o2p = QO + tq * 1536 + 512 + h * 64 + 4 * hi; const bf16_t* o3p = o2p + 512;
        bf16_t* op = (bf16_t*)(P.ws + OFF_OC) + tq * 512 + h * 64 + 4 * hi;
#pragma unroll
        for (int mt = 0; mt < 2; ++mt)
#pragma unroll
            for (int rg = 0; rg < 4; ++rg) { const u32x2 b2 = *(const u32x2*)(o2p + 32 * mt + 8 * rg), b3 = *(const u32x2*)(o3p + 32 * mt + 8 * rg);
                const float e0 = w1 * o[mt][4 * rg] + w2 * bf_lo(b2.x) + w3 * bf_lo(b3.x), e1 = w1 * o[mt][4 * rg + 1] + w2 * bf_hi(b2.x) + w3 * bf_hi(b3.x);
                const float e2 = w1 * o[mt][4 * rg + 2] + w2 * bf_lo(b2.y) + w3 * bf_lo(b3.y), e3 = w1 * o[mt][4 * rg + 3] + w2 * bf_hi(b2.y) + w3 * bf_hi(b3.y);
                u32x2 w; w.x = cvt_pk_bf16(e0, e1); w.y = cvt_pk_bf16(e2, e3); *(u32x2*)(op + 32 * mt + 8 * rg) = w; }
    }
}

__device__ __forceinline__ void conv_item(const Params& P, int l, int it, int lane) {
    const int b = it >> 8, t0 = (it & 255) * 8, ch0 = 8 * lane;
    const bf16_t* in = (const bf16_t*)(P.ws + OFF_CG) + (size_t)b * SEQL * 512 + ch0;
    const unsigned* cw = (const unsigned*)(P.ws + OFF_CONVW) + (size_t)l * 31 * 256 + 4 * lane;
    float acc[8][8], win[8][8];
    { const f32x4 b0 = *(const f32x4*)(P.in[I_CONVB] + l * 512 + ch0), b1 = *(const f32x4*)(P.in[I_CONVB] + l * 512 + ch0 + 4);
#pragma unroll
      for (int i = 0; i < 8; ++i) { acc[i][0] = b0[0]; acc[i][1] = b0[1]; acc[i][2] = b0[2]; acc[i][3] = b0[3]; acc[i][4] = b1[0]; acc[i][5] = b1[1]; acc[i][6] = b1[2]; acc[i][7] = b1[3]; } }
#define CONV_LOADROW(rr, dst) do { const int t_ = t0 - 30 + (rr); if (t_ >= 0) { const u32x4 v_ = *(const u32x4*)(in + (size_t)t_ * 512); \
        dst[0] = bf_lo(v_.x); dst[1] = bf_hi(v_.x); dst[2] = bf_lo(v_.y); dst[3] = bf_hi(v_.y); dst[4] = bf_lo(v_.z); dst[5] = bf_hi(v_.z); dst[6] = bf_lo(v_.w); dst[7] = bf_hi(v_.w); } \
        else { _Pragma("unroll") for (int c_ = 0; c_ < 8; ++c_) dst[c_] = 0.f; } } while (0)
#pragma unroll
    for (int rr = 0; rr < 8; ++rr) CONV_LOADROW(rr, win[rr]);
    for (int jb = 0; jb < 32; jb += 8) {
        asm volatile("" ::: "memory");
#pragma unroll
        for (int jj = 0; jj < 8; ++jj) { const int j = jb + jj;
            if (jj & 1) asm volatile("" ::: "memory");
            if (j < 31) { const u32x4 wv = *(const u32x4*)(cw + j * 256);
                float w[8]; w[0] = bf_lo(wv.x); w[1] = bf_hi(wv.x); w[2] = bf_lo(wv.y); w[3] = bf_hi(wv.y); w[4] = bf_lo(wv.z); w[5] = bf_hi(wv.z); w[6] = bf_lo(wv.w); w[7] = bf_hi(wv.w);
#pragma unroll
                for (int i = 0; i < 8; ++i)
#pragma unroll
                    for (int c = 0; c < 8; ++c) acc[i][c] = fmaf(w[c], win[(jj + i) & 7][c], acc[i][c]);
                if (j + 8 < 38) CONV_LOADROW(j + 8, win[jj]); } }
    }
#undef CONV_LOADROW
    const f32x4 g0 = *(const f32x4*)(P.in[I_LNG] + l * 512 + ch0), g1 = *(const f32x4*)(P.in[I_LNG] + l * 512 + ch0 + 4);
    const f32x4 e0 = *(const f32x4*)(P.in[I_LNB] + l * 512 + ch0), e1 = *(const f32x4*)(P.in[I_LNB] + l * 512 + ch0 + 4);
    bf16_t* outp = (bf16_t*)(P.ws + OFF_HC) + ((size_t)b * SEQL + t0) * 512 + ch0;
#pragma unroll
    for (int i = 0; i < 8; ++i) { float s1 = 0.f, s2 = 0.f;
#pragma unroll
        for (int c = 0; c < 8; ++c) { s1 += acc[i][c]; s2 += acc[i][c] * acc[i][c]; }
        s1 = wave_sum(s1); s2 = wave_sum(s2);
        const float mean = s1 * (1.f / 512.f), var = fmaxf(s2 * (1.f / 512.f) - mean * mean, 0.f), rs = rsqrtf(var + EPSN);
        f32x4 y0, y1;
#pragma unroll
        for (int c = 0; c < 4; ++c) { const float h0 = (acc[i][c] - mean) * rs * g0[c] + e0[c], h1 = (acc[i][4 + c] - mean) * rs * g1[c] + e1[c]; y0[c] = h0 * sigm(h0); y1[c] = h1 * sigm(h1); }
        *(u32x4*)(outp + (size_t)i * 512) = pack8(y0, y1); }
}

__device__ __forceinline__ int claim(unsigned* ctr, int& lane) { asm volatile("" : "+v"(lane)); int v = 0; if (lane == 0) v = (int)atomicAdd(ctr, 1u); return __builtin_amdgcn_readfirstlane(v); }

constexpr int NPHASE = 18;
__global__ void __launch_bounds__(512, 2) fwd_kernel(Params P) {
    extern __shared__ __attribute__((aligned(16))) unsigned char shm[];
    LAS unsigned char* lds = (LAS unsigned char*)shm;
        unsigned char* ws = P.ws; unsigned char* dout = (unsigned char*)P.out;
    bf16_t* xb = (bf16_t*)(ws + OFF_XB); bf16_t* Gt = (bf16_t*)(ws + OFF_G); bf16_t* Mg = (bf16_t*)(dout + DO_MG);
    unsigned long long* rsq1 = (unsigned long long*)(ws + OFF_RSQ1); unsigned long long* rsq2 = (unsigned long long*)(ws + OFF_RSQ2);
    unsigned* ctl = (unsigned*)(ws + OFF_CTL);
    StaticOrder S;
    for (int ph = P.ph_lo; ph < P.ph_hi; ++ph) {
        int tid = threadIdx.x; asm volatile("" : "+v"(tid));
        const int wave = __builtin_amdgcn_readfirstlane(tid >> 6); int lane = tid & 63;
        if (ph == 0) phase_p0(P, lds, wave, lane, tid);
        else if (ph == NPHASE - 1) phase_final(P, wave, lane);
        else {
            const int l = (ph - 1) >> 3, s = (ph - 1) & 7;
            if (s == 0) {
                S.init(NTOK, 7168, gridDim.x, blockIdx.x);
                Gemm g{xb, (const bf16_t*)(ws + OFF_WIN) + (size_t)l * 7168 * 1024, NTOK, 7168, 1024};
                EpiIn E{(bf16_t*)(dout + DO_U), (bf16_t*)(ws + OFF_QO), (bf16_t*)(dout + DO_K), (bf16_t*)(dout + DO_V), (bf16_t*)(ws + OFF_CG), Gt, rsq1, P.in[I_BGATE] + l * 3072};
                gemm_phase<EpiIn, StaticOrder, false>(lds, g, S, E, nullptr);
            } else if (s == 1) {
                for (int i = blockIdx.x * 512 + tid; i < NTOK; i += gridDim.x * 512) { rsq1[i] = 0ull; rsq2[i] = 0ull; }
                if (wave < 4) { for (;;) { const int it = claim(ctl + (l * 4 + 0) * 32, lane); if (it >= 1024) break; s5_item(P, l, it, lds + wave * S5_WL, lane); } }
                LAS unsigned char* vl = lds + ATT_OFF + wave * ATT_WL;
                for (;;) { const int it = claim(ctl + (l * 4 + 1) * 32, lane); if (it >= 32768) break; if (it < 16384) attn_item<1>(P, it, vl, lane); else attn_item<2>(P, it - 16384, vl, lane); }
            } else if (s == 2) {
                LAS unsigned char* vl = lds + ATT_OFF + wave * ATT_WL;
                for (;;) { const int it = claim(ctl + (l * 4 + 2) * 32, lane); if (it >= 16384 + 8192) break; if (it < 16384) attn_item<0>(P, it, vl, lane); else conv_item(P, l, it - 16384, lane); }
            } else if (s == 3) {
                S.init(NTOK, 2048, gridDim.x, blockIdx.x);
                Gemm g{(const bf16_t*)(dout + DO_Y), (const bf16_t*)(ws + OFF_WGLU) + (size_t)l * 2048 * 512, NTOK, 2048, 512};
                EpiGluMerge E{Mg, Gt};
                gemm_phase<EpiGluMerge, StaticOrder, false>(lds, g, S, E, nullptr);
            } else if (s == 4) {
                S.init(NTOK, 1024, gridDim.x, blockIdx.x);
                for (int c = 0; c < 2; ++c) {
                    Gemm g{(const bf16_t*)(ws + (c == 0 ? OFF_HC : OFF_OC)), (const bf16_t*)(ws + (c == 0 ? OFF_WPW2 : OFF_WATT)) + (size_t)l * 1024 * 512, NTOK, 1024, 512};
                    EpiAccMerge E{Mg, Gt, c == 0 ? 2048 : 1024};
                    gemm_phase<EpiAccMerge, StaticOrder, false>(lds, g, S, E, nullptr);
                    __syncthreads();
                }
            } else if (s == 5 || s == 7) {
                S.init(NTOK, 1024, gridDim.x, blockIdx.x);
                Gemm g{s == 5 ? (const bf16_t*)Mg : (const bf16_t*)Gt, s == 5 ? (const bf16_t*)(ws + OFF_WOUT) + (size_t)l * 1024 * 1024 : (const bf16_t*)(ws + OFF_WF2) + (size_t)l * 1024 * 2816, NTOK, 1024, s == 5 ? 1024 : 2816};
                EpiXUpd E{xb, s == 5 ? rsq2 : rsq1};
                gemm_phase<EpiXUpd, StaticOrder, false>(lds, g, S, E, nullptr);
            } else {
                S.init(NTOK, 5632, gridDim.x, blockIdx.x);
                Gemm g{xb, (const bf16_t*)(ws + OFF_WF1) + (size_t)l * 5632 * 1024, NTOK, 5632, 1024};
                EpiFfn1 E{Gt, rsq2};
                gemm_phase<EpiFfn1, StaticOrder, false>(lds, g, S, E, nullptr);
            }
        }
        if (ph + 1 < P.ph_hi) cg::this_grid().sync();
    }
}

extern "C" void kernel_launch(void* const* d_in, const int* in_sizes, int n_in, void* d_out, int out_size, void* d_ws, size_t ws_size, hipStream_t stream) {
    static int grid = 0;
    if (grid == 0) {
        if (n_in != 24 || out_size != NTOK * 1024 || ws_size < WS_END) { fprintf(stderr, "kernel_launch: unexpected problem (n_in %d out %d ws %zu need %zu)\n", n_in, out_size, ws_size, (size_t)WS_END); grid = -1; return; }
        int dev = 0, cus = 0, per_cu = 0;
        hipGetDevice(&dev); hipDeviceGetAttribute(&cus, hipDeviceAttributeMultiprocessorCount, dev);
        if (hipFuncSetAttribute((const void*)fwd_kernel, hipFuncAttributeMaxDynamicSharedMemorySize, LDS_BYTES) != hipSuccess) { fprintf(stderr, "kernel_launch: hipFuncSetAttribute failed\n"); grid = -1; return; }
        hipOccupancyMaxActiveBlocksPerMultiprocessor(&per_cu, (const void*)fwd_kernel, 512, LDS_BYTES);
        if (per_cu < 1) { fprintf(stderr, "kernel_launch: occupancy query says %d blocks/CU\n", per_cu); per_cu = 1; }
        (void)hipGetLastError();
        grid = cus * per_cu; if (grid > 256) grid = 256;
    }
    if (grid < 0) return;
    hipMemsetAsync((unsigned char*)d_ws + OFF_CTL, 0, 4096, stream);
    Params p{};
    for (int i = 0; i < 24; ++i) p.in[i] = (const float*)d_in[i];
    p.out = (float*)d_out; p.ws = (unsigned char*)d_ws;
#if MK_PER_PHASE
    for (int ph = 0; ph < NPHASE; ++ph) { p.ph_lo = ph; p.ph_hi = ph + 1; hipLaunchKernelGGL(fwd_kernel, dim3(grid), dim3(512), LDS_BYTES, stream, p); }
#else
    p.ph_lo = 0; p.ph_hi = NPHASE;
    void* args[] = {&p};
    hipError_t e = hipLaunchCooperativeKernel((const void*)fwd_kernel, dim3(grid), dim3(512), args, LDS_BYTES, stream);
    if (e != hipSuccess) fprintf(stderr, "cooperative launch failed: %s (grid %d)\n", hipGetErrorString(e), grid);
#endif
}
```

```cpp
#include <hip/hip_runtime.h>
#include <hip/hip_cooperative_groups.h>
#include <cstdio>
namespace cg = cooperative_groups;
namespace pg8 {
#define PG8_LAS __attribute__((address_space(3)))
typedef unsigned short bf16_t;
typedef short bf16x8 __attribute__((ext_vector_type(8)));
typedef float f32x4 __attribute__((ext_vector_type(4)));
typedef unsigned u32x4 __attribute__((ext_vector_type(4)));
constexpr int BM = 256, BK = 64, HALF = 128, HTB = HALF * BK * 2  , STAGE_BYTES = 8 * HTB, NXCD = 8, WGM = 8;

__host__ __device__ __forceinline__ int lds_byte(int r, int c) { const int st = (r >> 4) * 2 + (c >> 5), rr = r & 15, cc = c & 31, ob = rr * 64 + cc * 2; return st * 1024 + (ob ^ (((ob >> 9) & 1) << 5)); }
__host__ __device__ __forceinline__ void stage_rc(int b, int& R, int& C) { const int st = b / 1024, sb = b % 1024, swz = sb ^ (((sb >> 9) & 1) << 5); R = (st >> 1) * 16 + swz / 64; C = (st & 1) * 32 + (swz % 64) / 2; }
__host__ __device__ __forceinline__ int perm32(int rho) { const int n = rho >> 4, i = rho & 15; return 8 * (i >> 2) + 4 * n + (i & 3); }

struct Unit { int pm, pn; };
struct Gemm { const bf16_t* A; const bf16_t* Bt; int M, N, K; };

struct StaticOrder {
    int nM, nN, nwg, G, c;
    __host__ __device__ void init(int M, int N, int G_, int c_) { nM = M / BM; nN = N / BM; nwg = nM * nN; G = G_; c = c_; }
    __host__ __device__ bool next(int i, Unit& u) const {
        const long L = (long)i * G + c; if (L >= nwg) return false;
        int wgid = (int)L; { const int q = nwg / NXCD, r = nwg % NXCD, xcd = wgid % NXCD, off = wgid / NXCD; wgid = (xcd < r ? xcd * (q + 1) : r * (q + 1) + (xcd - r) * q) + off; }
        const int nig = WGM * nN, gid = wgid / nig, fm = gid * WGM, gsz = (nM - fm) < WGM ? (nM - fm) : WGM;
        u.pm = fm + ((wgid % nig) % gsz); u.pn = (wgid % nig) / gsz; return true;
    }
    __device__ __forceinline__ void a_ready(const Unit&) const {}
    __device__ __forceinline__ void done(const Unit&) const {}
};
__device__ __forceinline__ unsigned cvt_pk_bf16(float lo, float hi) { unsigned r; asm volatile("v_cvt_pk_bf16_f32 %0, %1, %2" : "=v"(r) : "v"(lo), "v"(hi)); return r; }
template <class Epi, class Sched, bool STAMP = false>
__device__ __forceinline__ void gemm_phase(PG8_LAS unsigned char* lds, const Gemm g, const Sched& S, const Epi& E, unsigned long long* stamps) {
    int tid_o = threadIdx.x; asm volatile("" : "+v"(tid_o)); const int tid = tid_o, wid = __builtin_amdgcn_readfirstlane(tid >> 6), lane = tid & 63, wr = wid >> 2, wc = wid & 3, fr = lane & 15, fq = lane >> 4;
    const int K = g.K, nt = K / BK;
    int ts_lo = 0, ts_hi = 0, nts = 0; const unsigned long long rt_entry = STAMP ? (unsigned long long)wall_clock64() : 0ull;
#define PG8_STAMP() do { if (STAMP && wid == 0 && nts < 64) { const unsigned long long _c = (unsigned long long)clock64(); \
        ts_lo = (lane == nts) ? (int)(unsigned)_c : ts_lo; ts_hi = (lane == nts) ? (int)(unsigned)(_c >> 32) : ts_hi; ++nts; } } while (0)
    PG8_STAMP();
    unsigned voffA[2], voffB[2];
#pragma unroll
    for (int i = 0; i < 2; ++i) { int R, C; stage_rc(tid * 16 + i * 8192, R, C); const int Rb = Epi::PERM ? ((R & ~31) + perm32(R & 31)) : R;
        voffA[i] = (unsigned)(R * K + C) * 2u; voffB[i] = (unsigned)(Rb * K + C) * 2u; }
    const size_t kstep = (size_t)(BK * 2);
    const size_t hstep = (size_t)HALF * K * 2;
    const size_t tstep = 2 * hstep;
    const unsigned ldsw = (unsigned)wid * 1024u;
    const int aoff = lds_byte(wr * 64 + fr, fq * 8), boff = lds_byte(wc * 32 + fr, fq * 8);
#define PG8_SA(b, h) (((b) * 2 + (h)) * HTB)
#define PG8_SB(b, h) ((4 + (b) * 2 + (h)) * HTB)
#define PG8_STAGE(bufoff, gbase, voff) do { _Pragma("unroll") for (int _i = 0; _i < 2; ++_i) \
        __builtin_amdgcn_global_load_lds((const unsigned*)((const char*)(gbase) + (voff)[_i]), (PG8_LAS unsigned*)(lds + (bufoff) + ldsw + _i * 8192), 16, 0, 0); } while (0)
#define PG8_LDA(dst, b, h) do { _Pragma("unroll") for (int m = 0; m < 4; ++m) _Pragma("unroll") for (int k = 0; k < 2; ++k) dst[m][k] = *(const PG8_LAS bf16x8*)(lds + PG8_SA(b, h) + aoff + m * 2048 + k * 1024); } while (0)
#define PG8_LDB(dst, b, h) do { _Pragma("unroll") for (int n = 0; n < 2; ++n) _Pragma("unroll") for (int k = 0; k < 2; ++k) dst[n][k] = *(const PG8_LAS bf16x8*)(lds + PG8_SB(b, h) + boff + n * 2048 + k * 1024); } while (0)
#define PG8_MMA(ai, bj, At, Bt) do { __builtin_amdgcn_s_setprio(1); _Pragma("unroll") for (int m = 0; m < 4; ++m) _Pragma("unroll") for (int n = 0; n < 2; ++n) _Pragma("unroll") for (int k = 0; k < 2; ++k) \
        acc[ai][bj][m][n] = __builtin_amdgcn_mfma_f32_16x16x32_bf16(Bt[n][k], At[m][k], acc[ai][bj][m][n], 0, 0, 0); __builtin_amdgcn_s_setprio(0); } while (0)
#define PG8_WAIT_V(n) asm volatile("s_waitcnt vmcnt(" #n ")" ::: "memory")
#define PG8_WAIT_L(n) asm volatile("s_waitcnt lgkmcnt(" #n ")" ::: "memory")
#define PG8_BAR __builtin_amdgcn_s_barrier()
#define PG8_SCHED __builtin_amdgcn_sched_barrier(0)
    Unit cur, nxt; int ui = 0;
    if (!S.next(0, cur)) return;
    f32x4 acc[2][2][4][2];
#pragma unroll
    for (int a = 0; a < 2; ++a)
#pragma unroll
        for (int b = 0; b < 2; ++b)
#pragma unroll
            for (int m = 0; m < 4; ++m)
#pragma unroll
                for (int n = 0; n < 2; ++n) acc[a][b][m][n] = (f32x4){0.f, 0.f, 0.f, 0.f};
    bf16x8 At[4][2], B0[2][2], B1[2][2];
    const char* cA = (const char*)g.A + (size_t)cur.pm * tstep; const char* cB = (const char*)g.Bt + (size_t)cur.pn * tstep;
    S.a_ready(cur);
    PG8_STAGE(PG8_SB(0, 0), cB, voffB); PG8_STAGE(PG8_SA(0, 0), cA, voffA); PG8_STAGE(PG8_SB(0, 1), cB + hstep, voffB); PG8_STAGE(PG8_SA(0, 1), cA + hstep, voffA);
    if (wr == 1) PG8_BAR;
    PG8_WAIT_V(4); PG8_BAR;
    PG8_STAGE(PG8_SB(1, 0), cB + kstep, voffB); PG8_STAGE(PG8_SA(1, 0), cA + kstep, voffA); PG8_STAGE(PG8_SB(1, 1), cB + hstep + kstep, voffB);
    PG8_WAIT_V(6); PG8_BAR;
    PG8_STAMP();
    for (;;) {
        const bool has_next = S.next(ui + 1, nxt);
        const char* nA = has_next ? (const char*)g.A + (size_t)nxt.pm * tstep : cA; const char* nB = has_next ? (const char*)g.Bt + (size_t)nxt.pn * tstep : cB;
        for (int t = 0; t < nt; t += 2) {
            const bool last = (t == nt - 2);
            const char* a1 = cA + (size_t)(t + 1) * kstep;
            const char* a2 = last ? nA : cA + (size_t)(t + 2) * kstep; const char* b2 = last ? nB : cB + (size_t)(t + 2) * kstep;
            const char* a3 = a2 + kstep; const char* b3 = b2 + kstep;
            if (last && has_next) S.a_ready(nxt);
            PG8_LDB(B0, 0, 0); PG8_SCHED; PG8_LDA(At, 0, 0); PG8_STAGE(PG8_SA(1, 1), a1 + hstep, voffA);
            PG8_WAIT_L(8); PG8_BAR; PG8_WAIT_L(0); PG8_MMA(0, 0, At, B0); PG8_BAR; PG8_SCHED;
            PG8_LDB(B1, 0, 1); PG8_STAGE(PG8_SB(0, 0), b2, voffB);
            PG8_BAR; PG8_WAIT_L(0); PG8_MMA(0, 1, At, B1); PG8_BAR;
            PG8_LDA(At, 0, 1); PG8_STAGE(PG8_SA(0, 0), a2, voffA);
            PG8_BAR; PG8_WAIT_L(0); PG8_MMA(1, 0, At, B0); PG8_BAR; PG8_SCHED;
            PG8_STAGE(PG8_SB(0, 1), b2 + hstep, voffB);
            PG8_WAIT_V(6); PG8_BAR; PG8_MMA(1, 1, At, B1); PG8_BAR;
            PG8_LDB(B0, 1, 0); PG8_SCHED; PG8_LDA(At, 1, 0); PG8_STAGE(PG8_SA(0, 1), a2 + hstep, voffA);
            PG8_WAIT_L(8); PG8_BAR; PG8_WAIT_L(0); PG8_MMA(0, 0, At, B0); PG8_BAR; PG8_SCHED;
            PG8_LDB(B1, 1, 1); PG8_STAGE(PG8_SB(1, 0), b3, voffB);
            PG8_BAR; PG8_WAIT_L(0); PG8_MMA(0, 1, At, B1); PG8_BAR;
            PG8_LDA(At, 1, 1); PG8_STAGE(PG8_SA(1, 0), a3, voffA);
            PG8_BAR; PG8_WAIT_L(0); PG8_MMA(1, 0, At, B0); PG8_BAR; PG8_SCHED;
            PG8_STAGE(PG8_SB(1, 1), b3 + hstep, voffB);
            PG8_WAIT_V(6); PG8_BAR; PG8_MMA(1, 1, At, B1); PG8_BAR;
        }
        PG8_STAMP();
        if constexpr (!Epi::AFTER_DRAIN) { E(acc, cur, wr, wc, fr, fq); S.done(cur); }
        PG8_STAMP();
        if (!has_next) break;
#pragma unroll
        for (int a = 0; a < 2; ++a)
#pragma unroll
            for (int b = 0; b < 2; ++b)
#pragma unroll
                for (int m = 0; m < 4; ++m)
#pragma unroll
                    for (int n = 0; n < 2; ++n) acc[a][b][m][n] = (f32x4){0.f, 0.f, 0.f, 0.f};
        cur = nxt; cA = nA; cB = nB; ++ui;
    }
    PG8_WAIT_V(0);
    if (wr == 0) PG8_BAR;
    PG8_BAR;
    if constexpr (Epi::AFTER_DRAIN) { E.fused(acc, cur, wr, wc, fr, fq, lds, wid, lane); S.done(cur); }
    PG8_STAMP();
    if (STAMP && wid == 0) { stamps[lane] = lane < nts ? (((unsigned long long)(unsigned)ts_hi << 32) | (unsigned)ts_lo) : 0ull;
        if (lane == 62) stamps[62] = rt_entry; if (lane == 63) stamps[63] = (unsigned long long)wall_clock64(); }
#undef PG8_STAMP
#undef PG8_SA
#undef PG8_SB
#undef PG8_STAGE
#undef PG8_LDA
#undef PG8_LDB
#undef PG8_MMA
#undef PG8_WAIT_V
#undef PG8_WAIT_L
#undef PG8_BAR
#undef PG8_SCHED
}
}

using namespace pg8;
#define LAS __attribute__((address_space(3)))
typedef short s16x4 __attribute__((ext_vector_type(4)));
typedef short v4i16_t __attribute__((ext_vector_type(4)));
typedef float f32x16 __attribute__((ext_vector_type(16)));
typedef unsigned u32x2 __attribute__((ext_vector_type(2)));
typedef float f32x2v __attribute__((ext_vector_type(2)));

#ifndef NREP_S5
#define NREP_S5 1
#endif
#ifndef NREP_B2
#define NREP_B2 1
#endif
#ifndef NREP_P0
#define NREP_P0 1
#endif
#ifndef MK_PER_PHASE
#define MK_PER_PHASE 0
#endif

constexpr int NTOK = 65536, SEQL = 2048;
constexpr float EPSN = 1e-6f;
constexpr int LDS_BYTES = 155648;
constexpr int S5_WL = 25088;
constexpr int ATT_OFF = 4 * S5_WL;
constexpr int VSTR = 192;
constexpr int ATT_WL = 32 * VSTR;
static_assert(ATT_OFF + 8 * ATT_WL <= LDS_BYTES, "lds");

constexpr size_t OFF_WIN = 0;
constexpr size_t OFF_WGLU = OFF_WIN + 2ull * 7168 * 1024 * 2;
constexpr size_t OFF_WATT = OFF_WGLU + 2ull * 2048 * 512 * 2;
constexpr size_t OFF_WPW2 = OFF_WATT + 2ull * 1024 * 512 * 2;
constexpr size_t OFF_WOUT = OFF_WPW2 + 2ull * 1024 * 512 * 2;
constexpr size_t OFF_WF1 = OFF_WOUT + 2ull * 1024 * 1024 * 2;
constexpr size_t OFF_WF2 = OFF_WF1 + 2ull * 5632 * 1024 * 2;
constexpr size_t OFF_S5BB = OFF_WF2 + 2ull * 1024 * 2816 * 2;
constexpr size_t OFF_S5CM = OFF_S5BB + 2ull * 32 * 128 * 16 * 2;
constexpr size_t OFF_S5A = OFF_S5CM + 2ull * 32 * 16 * 128 * 2;
constexpr size_t OFF_CONVW = OFF_S5A + 2ull * 32 * 64 * 8;
constexpr size_t OFF_CTL = OFF_CONVW + 65536;
constexpr size_t OFF_RSQ1 = OFF_CTL + 16384;
constexpr size_t OFF_RSQ2 = OFF_RSQ1 + 65536ull * 8;
constexpr size_t OFF_LSE = OFF_RSQ2 + 65536ull * 8;
constexpr size_t OFF_XB = OFF_LSE + 2ull * 65536 * 8 * 4;
constexpr size_t OFF_G = OFF_XB + 65536ull * 1024 * 2;
constexpr size_t OFF_QO = OFF_G + 65536ull * 3072 * 2;
constexpr size_t OFF_CG = OFF_QO + 65536ull * 1536 * 2;
constexpr size_t OFF_HC = OFF_CG + 65536ull * 512 * 2;
constexpr size_t OFF_OC = OFF_HC + 65536ull * 512 * 2;
constexpr size_t WS_END = OFF_OC + 65536ull * 512 * 2;
constexpr size_t DO_U = 0, DO_K = 64ull << 20, DO_V = 128ull << 20, DO_Y = 192ull << 20, DO_MG = 64ull << 20;

struct Params {
    const float* in[24];
    float* out; unsigned char* ws;
    int ph_lo, ph_hi;
};
enum { I_X = 0, I_N1G, I_WIN, I_BGATE, I_LRE, I_LIM, I_LOGDT, I_BRE, I_BIM, I_CRE, I_CIM, I_SSMD, I_WGLU, I_WATT, I_CONVW, I_CONVB, I_LNG, I_LNB, I_WPW2, I_WOUT, I_N2G, I_WF1, I_WF2, I_FING };

__device__ __forceinline__ float bf_lo(unsigned u) { return __uint_as_float(u << 16); }
__device__ __forceinline__ float bf_hi(unsigned u) { return __uint_as_float(u & 0xffff0000u); }
__device__ __forceinline__ float sigm(float x) { return __builtin_amdgcn_rcpf(1.f + __expf(-x)); }
__device__ __forceinline__ unsigned short f2bf(float f) { unsigned u = __float_as_uint(f); u += 0x7FFFu + ((u >> 16) & 1u); return (unsigned short)(u >> 16); }
__device__ __forceinline__ float wave_sum(float v) {
#pragma unroll
    for (int o = 1; o < 64; o <<= 1) v += __shfl_xor(v, o);
    return v;
}
__device__ __forceinline__ s16x4 vtr(const LAS unsigned char* p) { return __builtin_bit_cast(s16x4, __builtin_amdgcn_ds_read_tr16_b64_v4i16((LAS v4i16_t*)p)); }

__device__ __forceinline__ u32x4 pack8(const f32x4 a, const f32x4 b) { u32x4 w; w.x = cvt_pk_bf16(a[0], a[1]); w.y = cvt_pk_bf16(a[2], a[3]); w.z = cvt_pk_bf16(b[0], b[1]); w.w = cvt_pk_bf16(b[2], b[3]); return w; }
__device__ __forceinline__ void unpack8(const u32x4 w, f32x4& a, f32x4& b) { a[0] = bf_lo(w.x); a[1] = bf_hi(w.x); a[2] = bf_lo(w.y); a[3] = bf_hi(w.y); b[0] = bf_lo(w.z); b[1] = bf_hi(w.z); b[2] = bf_lo(w.w); b[3] = bf_hi(w.w); }

struct EpiIn {
    static constexpr bool PERM = true, AFTER_DRAIN = false;
    bf16_t *U, *QO, *Kb, *Vb, *CG, *G; const unsigned long long* rowsq; const float* bgate;
    __device__ __forceinline__ void operator()(const f32x4 (&acc)[2][2][4][2], const Unit& u, int wr, int wc, int fr, int fq) const {
        const int row0 = u.pm * 256 + wr * 64 + fr, cl = wc * 32 + 8 * fq, pn = u.pn;
        if (pn < 12) {
            bf16_t* base; int ld, col0;
            if (pn < 2) { base = U; ld = 512; col0 = pn * 256; }
            else if (pn < 8) { base = QO; ld = 1536; col0 = (pn - 2) * 256; }
            else if (pn < 10) { base = Kb; ld = 512; col0 = (pn - 8) * 256; }
            else { base = Vb; ld = 512; col0 = (pn - 10) * 256; }
#pragma unroll
            for (int ai = 0; ai < 2; ++ai)
#pragma unroll
                for (int m = 0; m < 4; ++m) { const int r = row0 + ai * 128 + m * 16; const float rs = rsqrtf((float)rowsq[r] * (1.f / (1024.f * 1048576.f)) + EPSN);
#pragma unroll
                    for (int bj = 0; bj < 2; ++bj) *(u32x4*)(base + (size_t)r * ld + col0 + bj * 128 + cl) = pack8(acc[ai][bj][m][0] * rs, acc[ai][bj][m][1] * rs); }
        } else if (pn < 16) {
            const int c0 = (pn - 12) * 128 + cl;
#pragma unroll
            for (int ai = 0; ai < 2; ++ai)
#pragma unroll
                for (int m = 0; m < 4; ++m) { const int r = row0 + ai * 128 + m * 16; const float rs = rsqrtf((float)rowsq[r] * (1.f / (1024.f * 1048576.f)) + EPSN);
                    f32x4 o[2];
#pragma unroll
                    for (int n = 0; n < 2; ++n)
#pragma unroll
                        for (int j = 0; j < 4; ++j) o[n][j] = acc[ai][0][m][n][j] * rs * sigm(acc[ai][1][m][n][j] * rs);
                    *(u32x4*)(CG + (size_t)r * 512 + c0) = pack8(o[0], o[1]); }
        } else {
            const int c0 = (pn - 16) * 256 + cl;
            f32x4 bv[2][2];
#pragma unroll
            for (int bj = 0; bj < 2; ++bj)
#pragma unroll
                for (int n = 0; n < 2; ++n) bv[bj][n] = *(const f32x4*)(bgate + c0 + bj * 128 + 4 * n);
#pragma unroll
            for (int ai = 0; ai < 2; ++ai)
#pragma unroll
                for (int m = 0; m < 4; ++m) { const int r = row0 + ai * 128 + m * 16; const float rs = rsqrtf((float)rowsq[r] * (1.f / (1024.f * 1048576.f)) + EPSN);
#pragma unroll
                    for (int bj = 0; bj < 2; ++bj) { f32x4 o[2];
#pragma unroll
                        for (int n = 0; n < 2; ++n)
#pragma unroll
                            for (int j = 0; j < 4; ++j) o[n][j] = sigm(acc[ai][bj][m][n][j] * rs + bv[bj][n][j]);
                        *(u32x4*)(G + (size_t)r * 3072 + c0 + bj * 128) = pack8(o[0], o[1]); } }
        }
    }
};
struct EpiGluMerge {
    static constexpr bool PERM = true, AFTER_DRAIN = false;
    bf16_t* Mg; const bf16_t* G;
    __device__ __forceinline__ void operator()(const f32x4 (&acc)[2][2][4][2], const Unit& u, int wr, int wc, int fr, int fq) const {
        const int row0 = u.pm * 256 + wr * 64 + fr, c0 = u.pn * 128 + wc * 32 + 8 * fq;
#pragma unroll
        for (int ai = 0; ai < 2; ++ai)
#pragma unroll
            for (int m = 0; m < 4; ++m) { const int r = row0 + ai * 128 + m * 16;
                f32x4 g0, g1; unpack8(*(const u32x4*)(G + (size_t)r * 3072 + c0), g0, g1);
                f32x4 o[2];
#pragma unroll
                for (int j = 0; j < 4; ++j) { o[0][j] = g0[j] * acc[ai][0][m][0][j] * sigm(acc[ai][1][m][0][j]); o[1][j] = g1[j] * acc[ai][0][m][1][j] * sigm(acc[ai][1][m][1][j]); }
                *(u32x4*)(Mg + (size_t)r * 1024 + c0) = pack8(o[0], o[1]); }
    }
};
struct EpiAccMerge {
    static constexpr bool PERM = true, AFTER_DRAIN = false;
    bf16_t* Mg; const bf16_t* G; int gate_off;
    __device__ __forceinline__ void operator()(const f32x4 (&acc)[2][2][4][2], const Unit& u, int wr, int wc, int fr, int fq) const {
        const int row0 = u.pm * 256 + wr * 64 + fr, cb = u.pn * 256 + wc * 32 + 8 * fq;
#pragma unroll
        for (int ai = 0; ai < 2; ++ai)
#pragma unroll
            for (int m = 0; m < 4; ++m) { const int r = row0 + ai * 128 + m * 16;
#pragma unroll
                for (int bj = 0; bj < 2; ++bj) { const int c0 = cb + bj * 128;
                    f32x4 g0, g1, m0, m1; unpack8(*(const u32x4*)(G + (size_t)r * 3072 + gate_off + c0), g0, g1); unpack8(*(const u32x4*)(Mg + (size_t)r * 1024 + c0), m0, m1);
                    *(u32x4*)(Mg + (size_t)r * 1024 + c0) = pack8(m0 + g0 * acc[ai][bj][m][0], m1 + g1 * acc[ai][bj][m][1]); } }
    }
};
struct EpiXUpd {
    static constexpr bool PERM = true, AFTER_DRAIN = false;
    bf16_t* xb; unsigned long long* rowsq;
    __device__ __forceinline__ void operator()(const f32x4 (&acc)[2][2][4][2], const Unit& u, int wr, int wc, int fr, int fq) const {
        const int row0 = u.pm * 256 + wr * 64 + fr, cb = u.pn * 256 + wc * 32 + 8 * fq;
#pragma unroll
        for (int ai = 0; ai < 2; ++ai)
#pragma unroll
            for (int m = 0; m < 4; ++m) { const int r = row0 + ai * 128 + m * 16; float ss = 0.f;
#pragma unroll
                for (int bj = 0; bj < 2; ++bj) { const int c0 = cb + bj * 128;
                    f32x4 x0, x1; unpack8(*(const u32x4*)(xb + (size_t)r * 1024 + c0), x0, x1);
                    const u32x4 w = pack8(x0 + acc[ai][bj][m][0], x1 + acc[ai][bj][m][1]);
                    *(u32x4*)(xb + (size_t)r * 1024 + c0) = w;
                    unpack8(w, x0, x1);
#pragma unroll
                    for (int j = 0; j < 4; ++j) ss += x0[j] * x0[j] + x1[j] * x1[j]; }
                ss += __shfl_xor(ss, 16); ss += __shfl_xor(ss, 32);
                if (fq == 0) atomicAdd(rowsq + r, (unsigned long long)(ss * 1048576.f)); }
    }
};
struct EpiFfn1 {
    static constexpr bool PERM = true, AFTER_DRAIN = false;
    bf16_t* Hf; const unsigned long long* rowsq;
    __device__ __forceinline__ void operator()(const f32x4 (&acc)[2][2][4][2], const Unit& u, int wr, int wc, int fr, int fq) const {
        const int row0 = u.pm * 256 + wr * 64 + fr, c0 = u.pn * 128 + wc * 32 + 8 * fq;
#pragma unroll
        for (int ai = 0; ai < 2; ++ai)
#pragma unroll
            for (int m = 0; m < 4; ++m) { const int r = row0 + ai * 128 + m * 16; const float rs = rsqrtf((float)rowsq[r] * (1.f / (1024.f * 1048576.f)) + EPSN);
                f32x4 o[2];
#pragma unroll
                for (int n = 0; n < 2; ++n)
#pragma unroll
                    for (int j = 0; j < 4; ++j) { const float a = acc[ai][0][m][n][j] * rs, b = acc[ai][1][m][n][j] * rs; o[n][j] = a * sigm(a) * b; }
                *(u32x4*)(Hf + (size_t)r * 2816 + c0) = pack8(o[0], o[1]); }
    }
};

__device__ __forceinline__ void p0_tr_item(const float* W, int K, int N, bf16_t* WT, int kb, int nd0, int ns0, const float* gk, float scale, LAS float* scr, int lane) {
    const int k0 = 64 * kb;
#pragma unroll 8
    for (int i = 0; i < 32; ++i) { const int kk = 2 * i + (lane >> 5); float s = scale; if (gk) s *= gk[k0 + kk]; scr[kk * 33 + (lane & 31)] = W[(size_t)(k0 + kk) * N + ns0 + (lane & 31)] * s; }
    asm volatile("" ::: "memory");
    const int c = lane & 7;
#pragma unroll
    for (int j = 0; j < 4; ++j) { const int n = (lane >> 3) + 8 * j; const LAS float* s = scr + (8 * c) * 33 + n;
        u32x4 o; o.x = cvt_pk_bf16(s[0 * 33], s[1 * 33]); o.y = cvt_pk_bf16(s[2 * 33], s[3 * 33]); o.z = cvt_pk_bf16(s[4 * 33], s[5 * 33]); o.w = cvt_pk_bf16(s[6 * 33], s[7 * 33]);
        *(u32x4*)(WT + (size_t)(nd0 + n) * K + k0 + 8 * c) = o; }
    asm volatile("" ::: "memory");
}
__device__ __forceinline__ void phase_p0(const Params& P, LAS unsigned char* lds, int wave, int lane, int tid) {
    unsigned char* ws = P.ws;
    const int gw = blockIdx.x * 8 + wave, NGW = gridDim.x * 8;
    LAS float* scr = (LAS float*)(lds + wave * 16384);
    constexpr int PER_L = 3584 + 512 + 256 + 256 + 512 + 2816 + 1408;
    for (int it = gw; it < 2 * PER_L; it += NGW) {
        const int l = it / PER_L; int r = it % PER_L;
        const float* W; bf16_t* WT; int K, N, type = 0; const float* gk = nullptr;
        if (r < 3584) { W = P.in[I_WIN] + (size_t)l * 1024 * 7168; WT = (bf16_t*)(ws + OFF_WIN) + (size_t)l * 7168 * 1024; K = 1024; N = 7168; type = 1; gk = P.in[I_N1G] + l * 1024; }
        else if ((r -= 3584) < 512) { W = P.in[I_WGLU] + (size_t)l * 512 * 2048; WT = (bf16_t*)(ws + OFF_WGLU) + (size_t)l * 2048 * 512; K = 512; N = 2048; type = 3; }
        else if ((r -= 512) < 256) { W = P.in[I_WATT] + (size_t)l * 512 * 1024; WT = (bf16_t*)(ws + OFF_WATT) + (size_t)l * 1024 * 512; K = 512; N = 1024; }
        else if ((r -= 256) < 256) { W = P.in[I_WPW2] + (size_t)l * 512 * 1024; WT = (bf16_t*)(ws + OFF_WPW2) + (size_t)l * 1024 * 512; K = 512; N = 1024; }
        else if ((r -= 256) < 512) { W = P.in[I_WOUT] + (size_t)l * 1024 * 1024; WT = (bf16_t*)(ws + OFF_WOUT) + (size_t)l * 1024 * 1024; K = 1024; N = 1024; }
        else if ((r -= 512) < 2816) { W = P.in[I_WF1] + (size_t)l * 1024 * 5632; WT = (bf16_t*)(ws + OFF_WF1) + (size_t)l * 5632 * 1024; K = 1024; N = 5632; type = 2; gk = P.in[I_N2G] + l * 1024; }
        else { r -= 2816; W = P.in[I_WF2] + (size_t)l * 2816 * 1024; WT = (bf16_t*)(ws + OFF_WF2) + (size_t)l * 1024 * 2816; K = 2816; N = 1024; }
        const int nblk = N / 32, kb = r / nblk, nd0 = (r % nblk) * 32;
        int ns0 = nd0; float scale = 1.f;
        if (type == 1) { if (nd0 >= 3072 && nd0 < 4096) { const int t = nd0 - 3072, j = t & 255; ns0 = 3072 + (t >> 8) * 128 + (j & 127) + (j >= 128 ? 512 : 0); }
                         if (nd0 >= 512 && nd0 < 2048) scale = 0.125f * 1.4426950408889634f; }
        else if (type == 2) { const int j = nd0 & 255; ns0 = (nd0 >> 8) * 128 + (j & 127) + (j >= 128 ? 2816 : 0); }
        else if (type == 3) { const int j = nd0 & 255; ns0 = (nd0 >> 8) * 128 + (j & 127) + (j >= 128 ? 1024 : 0); }
        p0_tr_item(W, K, N, WT, kb, nd0, ns0, gk, scale, scr, lane);
    }
    { const float* x = P.in[I_X]; bf16_t* xb = (bf16_t*)(ws + OFF_XB); unsigned long long* rsq = (unsigned long long*)(ws + OFF_RSQ1);
      for (int row = gw; row < NTOK; row += NGW) { float ss = 0.f;
#pragma unroll
          for (int j = 0; j < 4; ++j) { const f32x4 v = *(const f32x4*)(x + (size_t)row * 1024 + 4 * lane + 256 * j); u32x2 w; w.x = cvt_pk_bf16(v[0], v[1]); w.y = cvt_pk_bf16(v[2], v[3]);
              *(u32x2*)(xb + (size_t)row * 1024 + 4 * lane + 256 * j) = w; const float a = bf_lo(w.x), b = bf_hi(w.x), c = bf_lo(w.y), d = bf_hi(w.y); ss += a * a + b * b + c * c + d * d; }
          ss = wave_sum(ss); if (lane == 0) rsq[row] = (unsigned long long)(ss * 1048576.f); } }
    const int gt = blockIdx.x * 512 + tid, NGT = gridDim.x * 512;
    for (int idx = gt; idx < 2 * 32 * 64; idx += NGT) {
        const int lg = idx >> 6, p = idx & 63;
        const float lre = P.in[I_LRE][idx], lim = P.in[I_LIM][idx], dt = expf(P.in[I_LOGDT][lg]);
        const float mag = expf(lre * dt);
        const double rev = (double)lim * (double)dt * 0.15915494309189535; const float frc = (float)(rev - rint(rev));
        const float sn = __builtin_amdgcn_sinf(frc), cs = __builtin_amdgcn_cosf(frc);
        const float are = mag * cs, aim = mag * sn, nr = are - 1.f, ni = aim, den = lre * lre + lim * lim;
        const float zre = (nr * lre + ni * lim) / den, zim = (ni * lre - nr * lim) / den;
        { f32x2v t2; t2.x = are; t2.y = aim; ((f32x2v*)(ws + OFF_S5A))[idx] = t2; }
        bf16_t* bbt = (bf16_t*)(ws + OFF_S5BB) + (size_t)lg * 128 * 16; bf16_t* cm = (bf16_t*)(ws + OFF_S5CM) + (size_t)lg * 16 * 128;
        for (int h = 0; h < 16; ++h) { const float br = P.in[I_BRE][(size_t)idx * 16 + h], bi = P.in[I_BIM][(size_t)idx * 16 + h];
            bbt[p * 16 + h] = f2bf(zre * br - zim * bi); bbt[(64 + p) * 16 + h] = f2bf(zre * bi + zim * br);
            cm[h * 128 + p] = f2bf(P.in[I_CRE][((size_t)lg * 16 + h) * 64 + p]); cm[h * 128 + 64 + p] = f2bf(-P.in[I_CIM][((size_t)lg * 16 + h) * 64 + p]); }
    }
    for (int idx = gt; idx < 2 * 31 * 256; idx += NGT) { const float a = P.in[I_CONVW][2 * idx], b = P.in[I_CONVW][2 * idx + 1]; ((unsigned*)(ws + OFF_CONVW))[idx] = cvt_pk_bf16(a, b); }
}
__device__ __forceinline__ void phase_final(const Params& P, int wave, int lane) {
    const int gw = blockIdx.x * 8 + wave, NGW = gridDim.x * 8;
    const bf16_t* xb = (const bf16_t*)(P.ws + OFF_XB); const unsigned long long* rsq = (const unsigned long long*)(P.ws + OFF_RSQ1); const float* fg = P.in[I_FING];
    for (int row = gw; row < NTOK; row += NGW) { const float rs = rsqrtf((float)rsq[row] * (1.f / (1024.f * 1048576.f)) + EPSN);
#pragma unroll
        for (int j = 0; j < 4; ++j) { const int c = 4 * lane + 256 * j; const u32x2 w = *(const u32x2*)(xb + (size_t)row * 1024 + c); const f32x4 g = *(const f32x4*)(fg + c);
            f32x4 o; o[0] = bf_lo(w.x) * rs * g[0]; o[1] = bf_hi(w.x) * rs * g[1]; o[2] = bf_lo(w.y) * rs * g[2]; o[3] = bf_hi(w.y) * rs * g[3];
            *(f32x4*)(P.out + (size_t)row * 1024 + c) = o; } }
}

__device__ __forceinline__ void s5_item(const Params& P, int l, int it, LAS unsigned char* wl, int lane) {
    const int b = it >> 5, g = it & 31, lg = l * 32 + g;
    LAS float* bu = (LAS float*)wl; LAS unsigned char* sl = wl + 16384;
    const int c32 = lane & 31, hi = lane >> 5, fr = lane & 15, fq = lane >> 4;
    const bf16_t* bbt = (const bf16_t*)(P.ws + OFF_S5BB) + (size_t)lg * 128 * 16; const bf16_t* cm = (const bf16_t*)(P.ws + OFF_S5CM) + (size_t)lg * 16 * 128;
    bf16x8 bbreg[4], cmreg[4];
#pragma unroll
    for (int j = 0; j < 4; ++j) { bbreg[j] = *(const bf16x8*)(bbt + (32 * j + c32) * 16 + 8 * hi); cmreg[j] = *(const bf16x8*)(cm + fr * 128 + 32 * j + 8 * fq); }
    const f32x2v av = ((const f32x2v*)(P.ws + OFF_S5A))[lg * 64 + lane]; const float a_re = av.x, a_im = av.y;
    const float dsk = P.in[I_SSMD][l * 512 + g * 16 + fr];
    float s_re = 0.f, s_im = 0.f;
    const bf16_t* Ub = (const bf16_t*)((unsigned char*)P.out + DO_U) + (size_t)b * SEQL * 512 + g * 16; bf16_t* Yb = (bf16_t*)((unsigned char*)P.out + DO_Y) + (size_t)b * SEQL * 512 + g * 16;
    for (int c = 0; c < 64; ++c) {
        const int t0 = c * 32;
        const bf16x8 ureg = *(const bf16x8*)(Ub + (size_t)(t0 + c32) * 512 + 8 * hi);
        unsigned short uep[2][4];
#pragma unroll
        for (int mt = 0; mt < 2; ++mt)
#pragma unroll
            for (int i = 0; i < 4; ++i) uep[mt][i] = Ub[(size_t)(t0 + 16 * mt + 4 * fq + i) * 512 + fr];
#pragma unroll
        for (int j = 0; j < 4; ++j) { f32x16 a;
#pragma unroll
            for (int r = 0; r < 16; ++r) a[r] = 0.f;
            a = __builtin_amdgcn_mfma_f32_32x32x16_bf16(ureg, bbreg[j], a, 0, 0, 0);
#pragma unroll
            for (int r = 0; r < 16; ++r) { const int tok = (r & 3) + 8 * (r >> 2) + 4 * hi; bu[tok * 128 + ((32 * (j & 1) + c32) << 1) + (j >> 1)] = a[r]; } }
        asm volatile("" ::: "memory");
#pragma unroll 8
        for (int t = 0; t < 32; ++t) { const f32x2v v = *(const LAS f32x2v*)(bu + t * 128 + 2 * lane);
            const float nre = fmaf(a_re, s_re, fmaf(-a_im, s_im, v.x)), nim = fmaf(a_re, s_im, fmaf(a_im, s_re, v.y)); s_re = nre; s_im = nim;
            *(LAS unsigned short*)(sl + t * 272 + lane * 2) = f2bf(s_re); *(LAS unsigned short*)(sl + t * 272 + 128 + lane * 2) = f2bf(s_im); }
        asm volatile("" ::: "memory");
#pragma unroll
        for (int mt = 0; mt < 2; ++mt) { f32x4 ya = {0.f, 0.f, 0.f, 0.f};
#pragma unroll
            for (int ks = 0; ks < 4; ++ks) { const bf16x8 a = *(const LAS bf16x8*)(sl + (16 * mt + fr) * 272 + (32 * ks + 8 * fq) * 2); ya = __builtin_amdgcn_mfma_f32_16x16x32_bf16(a, cmreg[ks], ya, 0, 0, 0); }
#pragma unroll
            for (int i = 0; i < 4; ++i) { const float y = ya[i] + dsk * __uint_as_float((unsigned)uep[mt][i] << 16);
                const float ge = y * sigm(1.5957691216057308f * (y + 0.044715f * y * y * y));
                Yb[(size_t)(t0 + 16 * mt + 4 * fq + i) * 512 + fr] = f2bf(ge); } }
        asm volatile("" ::: "memory");
    }
}

template <int PAT> __device__ __forceinline__ void attn_item(const Params& P, int it, LAS unsigned char* vl, int lane) {
    constexpr int d = PAT == 0 ? 1 : (PAT == 1 ? 4 : 16);
    constexpr int ngrp = (SEQL / d) / 32;
    const int j = it % ngrp; int t = it / ngrp; const int r = t % d; t /= d; const int h = t & 7, b = t >> 3;
    const int c32 = lane & 31, hi = lane >> 5, i0 = 32 * j;
    const size_t tokbase = (size_t)b * SEQL; const size_t tq = tokbase + (size_t)(i0 + c32) * d + r;
    bf16_t* QO = (bf16_t*)(P.ws + OFF_QO); const bf16_t* Kb = (const bf16_t*)((unsigned char*)P.out + DO_K); const bf16_t* Vb = (const bf16_t*)((unsigned char*)P.out + DO_V);
    float* LSE = (float*)(P.ws + OFF_LSE);
    bf16x8 qreg[4];
    { const bf16_t* qp = QO + tq * 1536 + PAT * 512 + h * 64 + 8 * hi;
#pragma unroll
      for (int ks = 0; ks < 4; ++ks) qreg[ks] = *(const bf16x8*)(qp + 16 * ks); }
    f32x16 s[5];
    {
        bf16x8 kreg[5][4];
#pragma unroll
        for (int kt = 0; kt < 5; ++kt) { const int kb = i0 - 128 + 32 * kt;
            if (kb >= 0) { const bf16_t* kp = Kb + (tokbase + (size_t)(kb + c32) * d + r) * 512 + h * 64 + 8 * hi;
#pragma unroll
                for (int ks = 0; ks < 4; ++ks) kreg[kt][ks] = *(const bf16x8*)(kp + 16 * ks); } }
#pragma unroll
        for (int kt = 0; kt < 5; ++kt) { const int kb = i0 - 128 + 32 * kt;
            f32x16 a;
            if (kb >= 0) {
#pragma unroll
                for (int q = 0; q < 16; ++q) a[q] = 0.f;
#pragma unroll
                for (int ks = 0; ks < 4; ++ks) a = __builtin_amdgcn_mfma_f32_32x32x16_bf16(kreg[kt][ks], qreg[ks], a, 0, 0, 0);
            } else {
#pragma unroll
                for (int q = 0; q < 16; ++q) a[q] = (-__builtin_inff());
            }
            s[kt] = a; }
    }
    u32x4 vreg[5][4];
#pragma unroll
    for (int kt = 0; kt < 5; ++kt) { const int kb = i0 - 128 + 32 * kt;
        if (kb >= 0) {
#pragma unroll
            for (int i4 = 0; i4 < 4; ++i4) { const int row = (lane >> 3) + 8 * i4, ch = lane & 7;
                vreg[kt][i4] = *(const u32x4*)(Vb + (tokbase + (size_t)(kb + row) * d + r) * 512 + h * 64 + ch * 8); } } }
#pragma unroll
    for (int q = 0; q < 16; ++q) { const int kr = (q & 3) + 8 * (q >> 2) + 4 * hi; if (kr < c32) s[0][q] = (-__builtin_inff()); if (kr > c32) s[4][q] = (-__builtin_inff()); }
    float mx = (-__builtin_inff());
#pragma unroll
    for (int kt = 0; kt < 5; ++kt)
#pragma unroll
        for (int q = 0; q < 16; ++q) mx = fmaxf(mx, s[kt][q]);
    mx = fmaxf(mx, __shfl_xor(mx, 32));
    float den = 0.f;
#pragma unroll
    for (int kt = 0; kt < 5; ++kt)
#pragma unroll
        for (int q = 0; q < 16; ++q) { const float p = __builtin_amdgcn_exp2f(s[kt][q] - mx); s[kt][q] = p; den += p; }
    den += __shfl_xor(den, 32);
    f32x16 o[2];
#pragma unroll
    for (int q = 0; q < 16; ++q) { o[0][q] = 0.f; o[1][q] = 0.f; }
    const int gi = lane >> 4, li = lane & 15;
    const LAS unsigned char* vrd = vl + (4 * hi + (li >> 2)) * VSTR + (16 * (gi & 1) + 4 * (li & 3)) * 2;
#pragma unroll
    for (int kt = 0; kt < 5; ++kt) { const int kb = i0 - 128 + 32 * kt;
        if (kb >= 0) {
#pragma unroll
            for (int i4 = 0; i4 < 4; ++i4) { const int row = (lane >> 3) + 8 * i4, ch = lane & 7; *(LAS u32x4*)(vl + row * VSTR + ch * 16) = vreg[kt][i4]; }
            asm volatile("" ::: "memory");
#pragma unroll
            for (int ks2 = 0; ks2 < 2; ++ks2) { u32x4 pw;
                pw.x = cvt_pk_bf16(s[kt][8 * ks2 + 0], s[kt][8 * ks2 + 1]); pw.y = cvt_pk_bf16(s[kt][8 * ks2 + 2], s[kt][8 * ks2 + 3]);
                pw.z = cvt_pk_bf16(s[kt][8 * ks2 + 4], s[kt][8 * ks2 + 5]); pw.w = cvt_pk_bf16(s[kt][8 * ks2 + 6], s[kt][8 * ks2 + 7]);
                const bf16x8 pb = __builtin_bit_cast(bf16x8, pw);
#pragma unroll
                for (int mt = 0; mt < 2; ++mt) { const LAS unsigned char* a1 = vrd + (16 * ks2) * VSTR + 64 * mt;
                    const s16x4 lo = vtr(a1), up = vtr(a1 + 8 * VSTR);
                    bf16x8 av; av[0] = lo[0]; av[1] = lo[1]; av[2] = lo[2]; av[3] = lo[3]; av[4] = up[0]; av[5] = up[1]; av[6] = up[2]; av[7] = up[3];
                    o[mt] = __builtin_amdgcn_mfma_f32_32x32x16_bf16(av, pb, o[mt], 0, 0, 0); } }
            asm volatile("" ::: "memory");
        } }
    const float inv = __builtin_amdgcn_rcpf(den);
    const float l2 = mx + __builtin_amdgcn_logf(den);
    if (PAT != 0) {
        bf16_t* op = QO + tq * 1536 + PAT * 512 + h * 64 + 4 * hi;
#pragma unroll
        for (int mt = 0; mt < 2; ++mt)
#pragma unroll
            for (int rg = 0; rg < 4; ++rg) { u32x2 w; w.x = cvt_pk_bf16(o[mt][4 * rg] * inv, o[mt][4 * rg + 1] * inv); w.y = cvt_pk_bf16(o[mt][4 * rg + 2] * inv, o[mt][4 * rg + 3] * inv);
                *(u32x2*)(op + 32 * mt + 8 * rg) = w; }
        if (hi == 0) LSE[((size_t)(PAT - 1) * NTOK + tq) * 8 + h] = l2;
    } else {
        const float l2b = LSE[(tq) * 8 + h], l2c = LSE[((size_t)NTOK + tq) * 8 + h];
        const float M = fmaxf(l2, fmaxf(l2b, l2c));
        float w1 = __builtin_amdgcn_exp2f(l2 - M), w2 = __builtin_amdgcn_exp2f(l2b - M), w3 = __builtin_amdgcn_exp2f(l2c - M);
        const float wi = __builtin_amdgcn_rcpf(w1 + w2 + w3); w1 *= wi * inv; w2 *= wi; w3 *= wi;
        const bf16_t* o2p = QO + tq * 1536 + 512 + h * 64 + 4 * hi; const bf16_t* o3p = o2p + 512;
        bf16_t* op = (bf16_t*)(P.ws + OFF_OC) + tq * 512 + h * 64 + 4 * hi;
#pragma unroll
        for (int mt = 0; mt < 2; ++mt)
#pragma unroll
            for (int rg = 0; rg < 4; ++rg) { const u32x2 b2 = *(const u32x2*)(o2p + 32 * mt + 8 * rg), b3 = *(const u32x2*)(o3p + 32 * mt + 8 * rg);
                const float e0 = w1 * o[mt][4 * rg] + w2 * bf_lo(b2.x) + w3 * bf_lo(b3.x), e1 = w1 * o[mt][4 * rg + 1] + w2 * bf_hi(b2.x) + w3 * bf_hi(b3.x);
                const float e2 = w1 * o[mt][4 * rg + 2] + w2 * bf_lo(b2.y) + w3 * bf_lo(b3.y), e3 = w1 * o[mt][4 * rg + 3] + w2 * bf_hi(b2.y) + w3 * bf_hi(b3.y);
                u32x2 w; w.x = cvt_pk_bf16(e0, e1); w.y = cvt_pk_bf16(e2, e3); *(u32x2*)(op + 32 * mt + 8 * rg) = w; }
    }
}

__device__ __forceinline__ void conv_item(const Params& P, int l, int it, int lane) {
    const int b = it >> 8, t0 = (it & 255) * 8, ch0 = 8 * lane;
    const bf16_t* in = (const bf16_t*)(P.ws + OFF_CG) + (size_t)b * SEQL * 512 + ch0;
    const unsigned* cw = (const unsigned*)(P.ws + OFF_CONVW) + (size_t)l * 31 * 256 + 4 * lane;
    float acc[8][8], win[8][8];
    { const f32x4 b0 = *(const f32x4*)(P.in[I_CONVB] + l * 512 + ch0), b1 = *(const f32x4*)(P.in[I_CONVB] + l * 512 + ch0 + 4);
#pragma unroll
      for (int i = 0; i < 8; ++i) { acc[i][0] = b0[0]; acc[i][1] = b0[1]; acc[i][2] = b0[2]; acc[i][3] = b0[3]; acc[i][4] = b1[0]; acc[i][5] = b1[1]; acc[i][6] = b1[2]; acc[i][7] = b1[3]; } }
#define CONV_LOADROW(rr, dst) do { const int t_ = t0 - 30 + (rr); if (t_ >= 0) { const u32x4 v_ = *(const u32x4*)(in + (size_t)t_ * 512); \
        dst[0] = bf_lo(v_.x); dst[1] = bf_hi(v_.x); dst[2] = bf_lo(v_.y); dst[3] = bf_hi(v_.y); dst[4] = bf_lo(v_.z); dst[5] = bf_hi(v_.z); dst[6] = bf_lo(v_.w); dst[7] = bf_hi(v_.w); } \
        else { _Pragma("unroll") for (int c_ = 0; c_ < 8; ++c_) dst[c_] = 0.f; } } while (0)
#pragma unroll
    for (int rr = 0; rr < 8; ++rr) CONV_LOADROW(rr, win[rr]);
    for (int jb = 0; jb < 32; jb += 8) {
        asm volatile("" ::: "memory");
#pragma unroll
        for (int jj = 0; jj < 8; ++jj) { const int j = jb + jj;
            if (j < 31) { const u32x4 wv = *(const u32x4*)(cw + j * 256);
                float w[8]; w[0] = bf_lo(wv.x); w[1] = bf_hi(wv.x); w[2] = bf_lo(wv.y); w[3] = bf_hi(wv.y); w[4] = bf_lo(wv.z); w[5] = bf_hi(wv.z); w[6] = bf_lo(wv.w); w[7] = bf_hi(wv.w);
#pragma unroll
                for (int i = 0; i < 8; ++i)
#pragma unroll
                    for (int c = 0; c < 8; ++c) acc[i][c] = fmaf(w[c], win[(jj + i) & 7][c], acc[i][c]);
                if (j + 8 < 38) CONV_LOADROW(j + 8, win[jj]); } }
    }
#undef CONV_LOADROW
    const f32x4 g0 = *(const f32x4*)(P.in[I_LNG] + l * 512 + ch0), g1 = *(const f32x4*)(P.in[I_LNG] + l * 512 + ch0 + 4);
    const f32x4 e0 = *(const f32x4*)(P.in[I_LNB] + l * 512 + ch0), e1 = *(const f32x4*)(P.in[I_LNB] + l * 512 + ch0 + 4);
    bf16_t* outp = (bf16_t*)(P.ws + OFF_HC) + ((size_t)b * SEQL + t0) * 512 + ch0;
#pragma unroll
    for (int i = 0; i < 8; ++i) { float s1 = 0.f, s2 = 0.f;
#pragma unroll
        for (int c = 0; c < 8; ++c) { s1 += acc[i][c]; s2 += acc[i][c] * acc[i][c]; }
        s1 = wave_sum(s1); s2 = wave_sum(s2);
        const float mean = s1 * (1.f / 512.f), var = fmaxf(s2 * (1.f / 512.f) - mean * mean, 0.f), rs = rsqrtf(var + EPSN);
        f32x4 y0, y1;
#pragma unroll
        for (int c = 0; c < 4; ++c) { const float h0 = (acc[i][c] - mean) * rs * g0[c] + e0[c], h1 = (acc[i][4 + c] - mean) * rs * g1[c] + e1[c]; y0[c] = h0 * sigm(h0); y1[c] = h1 * sigm(h1); }
        *(u32x4*)(outp + (size_t)i * 512) = pack8(y0, y1); }
}

__device__ __forceinline__ int xcc_id() { return (int)(__builtin_amdgcn_s_getreg((3 << 11) | 20) & 7u); }
__device__ __forceinline__ int claim(unsigned* ctr, int& lane) { asm volatile("" : "+v"(lane)); int v = 0; if (lane == 0) v = (int)atomicAdd(ctr, 1u); return __builtin_amdgcn_readfirstlane(v); }


__device__ __forceinline__ void grid_barrier(unsigned* bar, unsigned target, int tid) {
    asm volatile("s_waitcnt vmcnt(0) lgkmcnt(0)" ::: "memory");
    __syncthreads();
    if (tid == 0) {
        __builtin_amdgcn_fence(__ATOMIC_RELEASE, "agent");
        asm volatile("s_waitcnt vmcnt(0) lgkmcnt(0)" ::: "memory");
        __hip_atomic_fetch_add(bar, 1u, __ATOMIC_RELAXED, __HIP_MEMORY_SCOPE_AGENT);
        while (__hip_atomic_load(bar, __ATOMIC_RELAXED, __HIP_MEMORY_SCOPE_AGENT) < target) __builtin_amdgcn_s_sleep(2);
        __builtin_amdgcn_fence(__ATOMIC_ACQUIRE, "agent");
        asm volatile("s_waitcnt vmcnt(0) lgkmcnt(0)" ::: "memory");
    }
    __syncthreads();
}

constexpr int NPHASE = 18;
__global__ void __launch_bounds__(512, 2) fwd_kernel(Params P) {
    extern __shared__ __attribute__((aligned(16))) unsigned char shm[];
    LAS unsigned char* lds = (LAS unsigned char*)shm;
        unsigned char* ws = P.ws; unsigned char* dout = (unsigned char*)P.out;
    bf16_t* xb = (bf16_t*)(ws + OFF_XB); bf16_t* Gt = (bf16_t*)(ws + OFF_G); bf16_t* Mg = (bf16_t*)(dout + DO_MG);
    unsigned long long* rsq1 = (unsigned long long*)(ws + OFF_RSQ1); unsigned long long* rsq2 = (unsigned long long*)(ws + OFF_RSQ2);
    unsigned* ctl = (unsigned*)(ws + OFF_CTL);
    StaticOrder S;
    unsigned nbar = 0;
    if (P.ph_hi - P.ph_lo > 1) cg::this_grid().sync();
    for (int ph = P.ph_lo; ph < P.ph_hi; ++ph) {
        int tid = threadIdx.x; asm volatile("" : "+v"(tid));
        const int wave = __builtin_amdgcn_readfirstlane(tid >> 6); int lane = tid & 63;
        if (ph == 0) { for (int rp = 0; rp < NREP_P0; ++rp) phase_p0(P, lds, wave, lane, tid); }
        else if (ph == NPHASE - 1) phase_final(P, wave, lane);
        else {
            const int l = (ph - 1) >> 3, s = (ph - 1) & 7;
            if (s == 0) {
                S.init(NTOK, 7168, gridDim.x, blockIdx.x);
                Gemm g{xb, (const bf16_t*)(ws + OFF_WIN) + (size_t)l * 7168 * 1024, NTOK, 7168, 1024};
                EpiIn E{(bf16_t*)(dout + DO_U), (bf16_t*)(ws + OFF_QO), (bf16_t*)(dout + DO_K), (bf16_t*)(dout + DO_V), (bf16_t*)(ws + OFF_CG), Gt, rsq1, P.in[I_BGATE] + l * 3072};
                gemm_phase<EpiIn, StaticOrder, false>(lds, g, S, E, nullptr);
            } else if (s == 1) {
                for (int i = blockIdx.x * 512 + tid; i < NTOK; i += gridDim.x * 512) { rsq1[i] = 0ull; rsq2[i] = 0ull; }
                unsigned* cb = ctl + l * 1024; const int xq = xcc_id();
                if (wave < 4) { for (int rp = 0; rp < NREP_S5; ++rp) for (;;) { const int it = claim(cb + rp * 16, lane); if (it >= 1024) break; s5_item(P, l, it, lds + wave * S5_WL, lane); } }
                LAS unsigned char* vl = lds + ATT_OFF + wave * ATT_WL;
                for (int qc = 0; qc < 8;) { const int q = (xq + qc) & 7; const int li = claim(cb + 32 * (1 + q), lane); if (li >= 4096) { ++qc; continue; }
                    const int b = q + 8 * (li >> 10), rest = li & 1023;
                    if (rest < 512) attn_item<1>(P, b * 512 + rest, vl, lane); else attn_item<2>(P, b * 512 + rest - 512, vl, lane); }
            } else if (s == 2) {
                unsigned* cb = ctl + l * 1024; const int xq = xcc_id();
                LAS unsigned char* vl = lds + ATT_OFF + wave * ATT_WL;
                for (int rp = 0; rp < NREP_B2; ++rp)
                for (int qc = 0; qc < 8;) { const int q = (xq + qc) & 7; const int li = claim(cb + 32 * (9 + q) + rp * 16, lane); if (li >= 3072) { ++qc; continue; }
                    const int b = q + 8 * (li / 768), rest = li % 768;
                    if (rest < 512) attn_item<0>(P, b * 512 + rest, vl, lane); else conv_item(P, l, b * 256 + rest - 512, lane); }
            } else if (s == 3) {
                S.init(NTOK, 2048, gridDim.x, blockIdx.x);
                Gemm g{(const bf16_t*)(dout + DO_Y), (const bf16_t*)(ws + OFF_WGLU) + (size_t)l * 2048 * 512, NTOK, 2048, 512};
                EpiGluMerge E{Mg, Gt};
                gemm_phase<EpiGluMerge, StaticOrder, false>(lds, g, S, E, nullptr);
            } else if (s == 4) {
                S.init(NTOK, 1024, gridDim.x, blockIdx.x);
                for (int c = 0; c < 2; ++c) {
                    Gemm g{(const bf16_t*)(ws + (c == 0 ? OFF_HC : OFF_OC)), (const bf16_t*)(ws + (c == 0 ? OFF_WPW2 : OFF_WATT)) + (size_t)l * 1024 * 512, NTOK, 1024, 512};
                    EpiAccMerge E{Mg, Gt, c == 0 ? 2048 : 1024};
                    gemm_phase<EpiAccMerge, StaticOrder, false>(lds, g, S, E, nullptr);
                    __syncthreads();
                }
            } else if (s == 5 || s == 7) {
                S.init(NTOK, 1024, gridDim.x, blockIdx.x);
                Gemm g{s == 5 ? (const bf16_t*)Mg : (const bf16_t*)Gt, s == 5 ? (const bf16_t*)(ws + OFF_WOUT) + (size_t)l * 1024 * 1024 : (const bf16_t*)(ws + OFF_WF2) + (size_t)l * 1024 * 2816, NTOK, 1024, s == 5 ? 1024 : 2816};
                EpiXUpd E{xb, s == 5 ? rsq2 : rsq1};
                gemm_phase<EpiXUpd, StaticOrder, false>(lds, g, S, E, nullptr);
            } else {
                S.init(NTOK, 5632, gridDim.x, blockIdx.x);
                Gemm g{xb, (const bf16_t*)(ws + OFF_WF1) + (size_t)l * 5632 * 1024, NTOK, 5632, 1024};
                EpiFfn1 E{Gt, rsq2};
                gemm_phase<EpiFfn1, StaticOrder, false>(lds, g, S, E, nullptr);
            }
        }
        if (ph + 1 < P.ph_hi) { ++nbar; grid_barrier(ctl + 3072, nbar * gridDim.x, threadIdx.x); }
    }
}

extern "C" void kernel_launch(void* const* d_in, const int* in_sizes, int n_in, void* d_out, int out_size, void* d_ws, size_t ws_size, hipStream_t stream) {
    static int grid = 0;
    if (grid == 0) {
        if (n_in != 24 || out_size != NTOK * 1024 || ws_size < WS_END) { fprintf(stderr, "kernel_launch: unexpected problem (n_in %d out %d ws %zu need %zu)\n", n_in, out_size, ws_size, (size_t)WS_END); grid = -1; return; }
        int dev = 0, cus = 0, per_cu = 0;
        hipGetDevice(&dev); hipDeviceGetAttribute(&cus, hipDeviceAttributeMultiprocessorCount, dev);
        if (hipFuncSetAttribute((const void*)fwd_kernel, hipFuncAttributeMaxDynamicSharedMemorySize, LDS_BYTES) != hipSuccess) { fprintf(stderr, "kernel_launch: hipFuncSetAttribute failed\n"); grid = -1; return; }
        hipOccupancyMaxActiveBlocksPerMultiprocessor(&per_cu, (const void*)fwd_kernel, 512, LDS_BYTES);
        if (per_cu < 1) { fprintf(stderr, "kernel_launch: occupancy query says %d blocks/CU\n", per_cu); per_cu = 1; }
        (void)hipGetLastError();
        grid = cus * per_cu; if (grid > 256) grid = 256;
    }
    if (grid < 0) return;
    hipMemsetAsync((unsigned char*)d_ws + OFF_CTL, 0, 16384, stream);
    Params p{};
    for (int i = 0; i < 24; ++i) p.in[i] = (const float*)d_in[i];
    p.out = (float*)d_out; p.ws = (unsigned char*)d_ws;
#if MK_PER_PHASE
    for (int ph = 0; ph < NPHASE; ++ph) { p.ph_lo = ph; p.ph_hi = ph + 1; hipLaunchKernelGGL(fwd_kernel, dim3(grid), dim3(512), LDS_BYTES, stream, p); }
#else
    p.ph_lo = 0; p.ph_hi = NPHASE;
    void* args[] = {&p};
    hipError_t e = hipLaunchCooperativeKernel((const void*)fwd_kernel, dim3(grid), dim3(512), args, LDS_BYTES, stream);
    if (e != hipSuccess) fprintf(stderr, "cooperative launch failed: %s (grid %d)\n", hipGetErrorString(e), grid);
#endif
}
```

```cpp
#include <hip/hip_runtime.h>
#include <hip/hip_cooperative_groups.h>
#include <cstdio>
namespace cg = cooperative_groups;
namespace pg8 {
#define PG8_LAS __attribute__((address_space(3)))
typedef unsigned short bf16_t;
typedef short bf16x8 __attribute__((ext_vector_type(8)));
typedef float f32x4 __attribute__((ext_vector_type(4)));
typedef unsigned u32x4 __attribute__((ext_vector_type(4)));
constexpr int BM = 256, BK = 64, HALF = 128, HTB = HALF * BK * 2  , STAGE_BYTES = 8 * HTB, NXCD = 8, WGM = 8;

__host__ __device__ __forceinline__ int lds_byte(int r, int c) { const int st = (r >> 4) * 2 + (c >> 5), rr = r & 15, cc = c & 31, ob = rr * 64 + cc * 2; return st * 1024 + (ob ^ (((ob >> 9) & 1) << 5)); }
__host__ __device__ __forceinline__ void stage_rc(int b, int& R, int& C) { const int st = b / 1024, sb = b % 1024, swz = sb ^ (((sb >> 9) & 1) << 5); R = (st >> 1) * 16 + swz / 64; C = (st & 1) * 32 + (swz % 64) / 2; }
__host__ __device__ __forceinline__ int perm32(int rho) { const int n = rho >> 4, i = rho & 15; return 8 * (i >> 2) + 4 * n + (i & 3); }

struct Unit { int pm, pn; };
struct Gemm { const bf16_t* A; const bf16_t* Bt; int M, N, K; };

struct StaticOrder {
    int nM, nN, nwg, G, c;
    __host__ __device__ void init(int M, int N, int G_, int c_) { nM = M / BM; nN = N / BM; nwg = nM * nN; G = G_; c = c_; }
    __host__ __device__ bool next(int i, Unit& u) const {
        const long L = (long)i * G + c; if (L >= nwg) return false;
        int wgid = (int)L; { const int q = nwg / NXCD, r = nwg % NXCD, xcd = wgid % NXCD, off = wgid / NXCD; wgid = (xcd < r ? xcd * (q + 1) : r * (q + 1) + (xcd - r) * q) + off; }
        const int nig = WGM * nN, gid = wgid / nig, fm = gid * WGM, gsz = (nM - fm) < WGM ? (nM - fm) : WGM;
        u.pm = fm + ((wgid % nig) % gsz); u.pn = (wgid % nig) / gsz; return true;
    }
    __device__ __forceinline__ void a_ready(const Unit&) const {}
    __device__ __forceinline__ void done(const Unit&) const {}
};
__device__ __forceinline__ unsigned cvt_pk_bf16(float lo, float hi) { unsigned r; asm volatile("v_cvt_pk_bf16_f32 %0, %1, %2" : "=v"(r) : "v"(lo), "v"(hi)); return r; }
template <class Epi, class Sched, bool STAMP = false>
__device__ __forceinline__ void gemm_phase(PG8_LAS unsigned char* lds, const Gemm g, const Sched& S, const Epi& E, unsigned long long* stamps, int tid_in) {
    int tid_o = tid_in; asm volatile("" : "+v"(tid_o)); const int tid = tid_o, wid = __builtin_amdgcn_readfirstlane(tid >> 6), lane = tid & 63, wr = wid >> 2, wc = wid & 3, fr = lane & 15, fq = lane >> 4;
    const int K = g.K, nt = K / BK;
    int ts_lo = 0, ts_hi = 0, nts = 0; const unsigned long long rt_entry = STAMP ? (unsigned long long)wall_clock64() : 0ull;
#define PG8_STAMP() do { if (STAMP && wid == 0 && nts < 64) { const unsigned long long _c = (unsigned long long)clock64(); \
        ts_lo = (lane == nts) ? (int)(unsigned)_c : ts_lo; ts_hi = (lane == nts) ? (int)(unsigned)(_c >> 32) : ts_hi; ++nts; } } while (0)
    PG8_STAMP();
    unsigned voffA[2], voffB[2];
#pragma unroll
    for (int i = 0; i < 2; ++i) { int R, C; stage_rc(tid * 16 + i * 8192, R, C); const int Rb = Epi::PERM ? ((R & ~31) + perm32(R & 31)) : R;
        voffA[i] = (unsigned)(R * K + C) * 2u; voffB[i] = (unsigned)(Rb * K + C) * 2u; }
    const size_t kstep = (size_t)(BK * 2);
    const size_t hstep = (size_t)HALF * K * 2;
    const size_t tstep = 2 * hstep;
    const unsigned ldsw = (unsigned)wid * 1024u;
    const int aoff = lds_byte(wr * 64 + fr, fq * 8), boff = lds_byte(wc * 32 + fr, fq * 8);
#define PG8_SA(b, h) (((b) * 2 + (h)) * HTB)
#define PG8_SB(b, h) ((4 + (b) * 2 + (h)) * HTB)
#define PG8_STAGE(bufoff, gbase, voff) do { _Pragma("unroll") for (int _i = 0; _i < 2; ++_i) \
        __builtin_amdgcn_global_load_lds((const unsigned*)((const char*)(gbase) + (voff)[_i]), (PG8_LAS unsigned*)(lds + (bufoff) + ldsw + _i * 8192), 16, 0, 0); } while (0)
#define PG8_LDA(dst, b, h) do { _Pragma("unroll") for (int m = 0; m < 4; ++m) _Pragma("unroll") for (int k = 0; k < 2; ++k) dst[m][k] = *(const PG8_LAS bf16x8*)(lds + PG8_SA(b, h) + aoff + m * 2048 + k * 1024); } while (0)
#define PG8_LDB(dst, b, h) do { _Pragma("unroll") for (int n = 0; n < 2; ++n) _Pragma("unroll") for (int k = 0; k < 2; ++k) dst[n][k] = *(const PG8_LAS bf16x8*)(lds + PG8_SB(b, h) + boff + n * 2048 + k * 1024); } while (0)
#define PG8_MMA(ai, bj, At, Bt) do { __builtin_amdgcn_s_setprio(1); _Pragma("unroll") for (int m = 0; m < 4; ++m) _Pragma("unroll") for (int n = 0; n < 2; ++n) _Pragma("unroll") for (int k = 0; k < 2; ++k) \
        acc[ai][bj][m][n] = __builtin_amdgcn_mfma_f32_16x16x32_bf16(Bt[n][k], At[m][k], acc[ai][bj][m][n], 0, 0, 0); __builtin_amdgcn_s_setprio(0); } while (0)
#define PG8_WAIT_V(n) asm volatile("s_waitcnt vmcnt(" #n ")" ::: "memory")
#define PG8_WAIT_L(n) asm volatile("s_waitcnt lgkmcnt(" #n ")" ::: "memory")
#define PG8_BAR __builtin_amdgcn_s_barrier()
#define PG8_SCHED __builtin_amdgcn_sched_barrier(0)
    Unit cur, nxt; int ui = 0;
    if (!S.next(0, cur)) return;
    f32x4 acc[2][2][4][2];
#pragma unroll
    for (int a = 0; a < 2; ++a)
#pragma unroll
        for (int b = 0; b < 2; ++b)
#pragma unroll
            for (int m = 0; m < 4; ++m)
#pragma unroll
                for (int n = 0; n < 2; ++n) acc[a][b][m][n] = (f32x4){0.f, 0.f, 0.f, 0.f};
    bf16x8 At[4][2], B0[2][2], B1[2][2];
    const char* cA = (const char*)g.A + (size_t)cur.pm * tstep; const char* cB = (const char*)g.Bt + (size_t)cur.pn * tstep;
    S.a_ready(cur);
    PG8_STAGE(PG8_SB(0, 0), cB, voffB); PG8_STAGE(PG8_SA(0, 0), cA, voffA); PG8_STAGE(PG8_SB(0, 1), cB + hstep, voffB); PG8_STAGE(PG8_SA(0, 1), cA + hstep, voffA);
    if (wr == 1) PG8_BAR;
    PG8_WAIT_V(4); PG8_BAR;
    PG8_STAGE(PG8_SB(1, 0), cB + kstep, voffB); PG8_STAGE(PG8_SA(1, 0), cA + kstep, voffA); PG8_STAGE(PG8_SB(1, 1), cB + hstep + kstep, voffB);
    PG8_WAIT_V(6); PG8_BAR;
    PG8_STAMP();
    for (;;) {
        const bool has_next = S.next(ui + 1, nxt);
        const char* nA = has_next ? (const char*)g.A + (size_t)nxt.pm * tstep : cA; const char* nB = has_next ? (const char*)g.Bt + (size_t)nxt.pn * tstep : cB;
        for (int t = 0; t < nt; t += 2) {
            const bool last = (t == nt - 2);
            const char* a1 = cA + (size_t)(t + 1) * kstep;
            const char* a2 = last ? nA : cA + (size_t)(t + 2) * kstep; const char* b2 = last ? nB : cB + (size_t)(t + 2) * kstep;
            const char* a3 = a2 + kstep; const char* b3 = b2 + kstep;
            if (last && has_next) S.a_ready(nxt);
            PG8_LDB(B0, 0, 0); PG8_SCHED; PG8_LDA(At, 0, 0); PG8_STAGE(PG8_SA(1, 1), a1 + hstep, voffA);
            PG8_WAIT_L(8); PG8_BAR; PG8_WAIT_L(0); PG8_MMA(0, 0, At, B0); PG8_BAR; PG8_SCHED;
            PG8_LDB(B1, 0, 1); PG8_STAGE(PG8_SB(0, 0), b2, voffB);
            PG8_BAR; PG8_WAIT_L(0); PG8_MMA(0, 1, At, B1); PG8_BAR;
            PG8_LDA(At, 0, 1); PG8_STAGE(PG8_SA(0, 0), a2, voffA);
            PG8_BAR; PG8_WAIT_L(0); PG8_MMA(1, 0, At, B0); PG8_BAR; PG8_SCHED;
            PG8_STAGE(PG8_SB(0, 1), b2 + hstep, voffB);
            PG8_WAIT_V(6); PG8_BAR; PG8_MMA(1, 1, At, B1); PG8_BAR;
            PG8_LDB(B0, 1, 0); PG8_SCHED; PG8_LDA(At, 1, 0); PG8_STAGE(PG8_SA(0, 1), a2 + hstep, voffA);
            PG8_WAIT_L(8); PG8_BAR; PG8_WAIT_L(0); PG8_MMA(0, 0, At, B0); PG8_BAR; PG8_SCHED;
            PG8_LDB(B1, 1, 1); PG8_STAGE(PG8_SB(1, 0), b3, voffB);
            PG8_BAR; PG8_WAIT_L(0); PG8_MMA(0, 1, At, B1); PG8_BAR;
            PG8_LDA(At, 1, 1); PG8_STAGE(PG8_SA(1, 0), a3, voffA);
            PG8_BAR; PG8_WAIT_L(0); PG8_MMA(1, 0, At, B0); PG8_BAR; PG8_SCHED;
            PG8_STAGE(PG8_SB(1, 1), b3 + hstep, voffB);
            PG8_WAIT_V(6); PG8_BAR; PG8_MMA(1, 1, At, B1); PG8_BAR;
        }
        PG8_STAMP();
        if constexpr (!Epi::AFTER_DRAIN) { E(acc, cur, wr, wc, fr, fq); S.done(cur); }
        PG8_STAMP();
        if (!has_next) break;
#pragma unroll
        for (int a = 0; a < 2; ++a)
#pragma unroll
            for (int b = 0; b < 2; ++b)
#pragma unroll
                for (int m = 0; m < 4; ++m)
#pragma unroll
                    for (int n = 0; n < 2; ++n) acc[a][b][m][n] = (f32x4){0.f, 0.f, 0.f, 0.f};
        cur = nxt; cA = nA; cB = nB; ++ui;
    }
    PG8_WAIT_V(0);
    if (wr == 0) PG8_BAR;
    PG8_BAR;
    if constexpr (Epi::AFTER_DRAIN) { E.fused(acc, cur, wr, wc, fr, fq, lds, wid, lane); S.done(cur); }
    PG8_STAMP();
    if (STAMP && wid == 0) { stamps[lane] = lane < nts ? (((unsigned long long)(unsigned)ts_hi << 32) | (unsigned)ts_lo) : 0ull;
        if (lane == 62) stamps[62] = rt_entry; if (lane == 63) stamps[63] = (unsigned long long)wall_clock64(); }
#undef PG8_STAMP
#undef PG8_SA
#undef PG8_SB
#undef PG8_STAGE
#undef PG8_LDA
#undef PG8_LDB
#undef PG8_MMA
#undef PG8_WAIT_V
#undef PG8_WAIT_L
#undef PG8_BAR
#undef PG8_SCHED
}
}

using namespace pg8;
#define LAS __attribute__((address_space(3)))
typedef short s16x4 __attribute__((ext_vector_type(4)));
typedef short v4i16_t __attribute__((ext_vector_type(4)));
typedef float f32x16 __attribute__((ext_vector_type(16)));
typedef unsigned u32x2 __attribute__((ext_vector_type(2)));
typedef float f32x2v __attribute__((ext_vector_type(2)));

#ifndef NREP_S5
#define NREP_S5 1
#endif
#ifndef NREP_B2
#define NREP_B2 1
#endif
#ifndef NREP_P0
#define NREP_P0 1
#endif
#ifndef MK_PER_PHASE
#define MK_PER_PHASE 0
#endif

constexpr int NTOK = 65536, SEQL = 2048;
constexpr float EPSN = 1e-6f;
constexpr int LDS_BYTES = 155648;
constexpr int S5_WL = 25088;
constexpr int ATT_OFF = 4 * S5_WL;
constexpr int VSTR = 192;
constexpr int ATT_WL = 32 * VSTR;
constexpr int CTR_OFF = LDS_BYTES - 256;
static_assert(ATT_OFF + 8 * ATT_WL <= CTR_OFF, "lds");

constexpr size_t OFF_WIN = 0;
constexpr size_t OFF_WGLU = OFF_WIN + 2ull * 7168 * 1024 * 2;
constexpr size_t OFF_WATT = OFF_WGLU + 2ull * 2048 * 512 * 2;
constexpr size_t OFF_WPW2 = OFF_WATT + 2ull * 1024 * 512 * 2;
constexpr size_t OFF_WOUT = OFF_WPW2 + 2ull * 1024 * 512 * 2;
constexpr size_t OFF_WF1 = OFF_WOUT + 2ull * 1024 * 1024 * 2;
constexpr size_t OFF_WF2 = OFF_WF1 + 2ull * 5632 * 1024 * 2;
constexpr size_t OFF_S5BB = OFF_WF2 + 2ull * 1024 * 2816 * 2;
constexpr size_t OFF_S5CM = OFF_S5BB + 2ull * 32 * 128 * 16 * 2;
constexpr size_t OFF_S5A = OFF_S5CM + 2ull * 32 * 16 * 128 * 2;
constexpr size_t OFF_CONVW = OFF_S5A + 2ull * 32 * 64 * 8;
constexpr size_t OFF_CTL = OFF_CONVW + 65536;
constexpr size_t OFF_RSQ1 = OFF_CTL + 16384;
constexpr size_t OFF_RSQ2 = OFF_RSQ1 + 65536ull * 8;
constexpr size_t OFF_LSE = OFF_RSQ2 + 65536ull * 8;
constexpr size_t OFF_XB = OFF_LSE + 2ull * 65536 * 8 * 4;
constexpr size_t OFF_G = OFF_XB + 65536ull * 1024 * 2;
constexpr size_t OFF_QO = OFF_G + 65536ull * 3072 * 2;
constexpr size_t OFF_CG = OFF_QO + 65536ull * 1536 * 2;
constexpr size_t OFF_HC = OFF_CG + 65536ull * 512 * 2;
constexpr size_t OFF_OC = OFF_HC + 65536ull * 512 * 2;
constexpr size_t WS_END = OFF_OC + 65536ull * 512 * 2;
constexpr size_t DO_U = 0, DO_K = 64ull << 20, DO_V = 128ull << 20, DO_Y = 192ull << 20, DO_MG = 64ull << 20;

struct Params {
    const float* in[24];
    float* out; unsigned char* ws;
    int ph_lo, ph_hi;
};
enum { I_X = 0, I_N1G, I_WIN, I_BGATE, I_LRE, I_LIM, I_LOGDT, I_BRE, I_BIM, I_CRE, I_CIM, I_SSMD, I_WGLU, I_WATT, I_CONVW, I_CONVB, I_LNG, I_LNB, I_WPW2, I_WOUT, I_N2G, I_WF1, I_WF2, I_FING };

__device__ __forceinline__ float bf_lo(unsigned u) { return __uint_as_float(u << 16); }
__device__ __forceinline__ float bf_hi(unsigned u) { return __uint_as_float(u & 0xffff0000u); }
__device__ __forceinline__ float sigm(float x) { return __builtin_amdgcn_rcpf(1.f + __expf(-x)); }
__device__ __forceinline__ unsigned short f2bf(float f) { unsigned u = __float_as_uint(f); u += 0x7FFFu + ((u >> 16) & 1u); return (unsigned short)(u >> 16); }
__device__ __forceinline__ float wave_sum(float v) {
#pragma unroll
    for (int o = 1; o < 64; o <<= 1) v += __shfl_xor(v, o);
    return v;
}
__device__ __forceinline__ s16x4 vtr(const LAS unsigned char* p) { return __builtin_bit_cast(s16x4, __builtin_amdgcn_ds_read_tr16_b64_v4i16((LAS v4i16_t*)p)); }

__device__ __forceinline__ u32x4 pack8(const f32x4 a, const f32x4 b) { u32x4 w; w.x = cvt_pk_bf16(a[0], a[1]); w.y = cvt_pk_bf16(a[2], a[3]); w.z = cvt_pk_bf16(b[0], b[1]); w.w = cvt_pk_bf16(b[2], b[3]); return w; }
__device__ __forceinline__ void unpack8(const u32x4 w, f32x4& a, f32x4& b) { a[0] = bf_lo(w.x); a[1] = bf_hi(w.x); a[2] = bf_lo(w.y); a[3] = bf_hi(w.y); b[0] = bf_lo(w.z); b[1] = bf_hi(w.z); b[2] = bf_lo(w.w); b[3] = bf_hi(w.w); }

struct EpiIn {
    static constexpr bool PERM = true, AFTER_DRAIN = false;
    bf16_t *U, *QO, *Kb, *Vb, *CG, *G; const float* rowsq; const float* bgate;
    __device__ __forceinline__ void operator()(const f32x4 (&acc)[2][2][4][2], const Unit& u, int wr, int wc, int fr, int fq) const {
        const int row0 = u.pm * 256 + wr * 64 + fr, cl = wc * 32 + 8 * fq, pn = u.pn;
        if (pn < 12) {
            bf16_t* base; int ld, col0;
            if (pn < 2) { base = U; ld = 512; col0 = pn * 256; }
            else if (pn < 8) { base = QO; ld = 1536; col0 = (pn - 2) * 256; }
            else if (pn < 10) { base = Kb; ld = 512; col0 = (pn - 8) * 256; }
            else { base = Vb; ld = 512; col0 = (pn - 10) * 256; }
#pragma unroll
            for (int ai = 0; ai < 2; ++ai)
#pragma unroll
                for (int m = 0; m < 4; ++m) { const int r = row0 + ai * 128 + m * 16; const float rs = rowsq[r];
#pragma unroll
                    for (int bj = 0; bj < 2; ++bj) *(u32x4*)(base + (size_t)r * ld + col0 + bj * 128 + cl) = pack8(acc[ai][bj][m][0] * rs, acc[ai][bj][m][1] * rs); }
        } else if (pn < 16) {
            const int c0 = (pn - 12) * 128 + cl;
#pragma unroll
            for (int ai = 0; ai < 2; ++ai)
#pragma unroll
                for (int m = 0; m < 4; ++m) { const int r = row0 + ai * 128 + m * 16; const float rs = rowsq[r];
                    f32x4 o[2];
#pragma unroll
                    for (int n = 0; n < 2; ++n)
#pragma unroll
                        for (int j = 0; j < 4; ++j) o[n][j] = acc[ai][0][m][n][j] * rs * sigm(acc[ai][1][m][n][j] * rs);
                    *(u32x4*)(CG + (size_t)r * 512 + c0) = pack8(o[0], o[1]); }
        } else {
            const int c0 = (pn - 16) * 256 + cl;
            f32x4 bv[2][2];
#pragma unroll
            for (int bj = 0; bj < 2; ++bj)
#pragma unroll
                for (int n = 0; n < 2; ++n) bv[bj][n] = *(const f32x4*)(bgate + c0 + bj * 128 + 4 * n);
#pragma unroll
            for (int ai = 0; ai < 2; ++ai)
#pragma unroll
                for (int m = 0; m < 4; ++m) { const int r = row0 + ai * 128 + m * 16; const float rs = rowsq[r];
#pragma unroll
                    for (int bj = 0; bj < 2; ++bj) { f32x4 o[2];
#pragma unroll
                        for (int n = 0; n < 2; ++n)
#pragma unroll
                            for (int j = 0; j < 4; ++j) o[n][j] = sigm(acc[ai][bj][m][n][j] * rs + bv[bj][n][j]);
                        *(u32x4*)(G + (size_t)r * 3072 + c0 + bj * 128) = pack8(o[0], o[1]); } }
        }
    }
};
struct EpiGluMerge {
    static constexpr bool PERM = true, AFTER_DRAIN = false;
    bf16_t* Mg; const bf16_t* G;
    __device__ __forceinline__ void operator()(const f32x4 (&acc)[2][2][4][2], const Unit& u, int wr, int wc, int fr, int fq) const {
        const int row0 = u.pm * 256 + wr * 64 + fr, c0 = u.pn * 128 + wc * 32 + 8 * fq;
#pragma unroll
        for (int ai = 0; ai < 2; ++ai)
#pragma unroll
            for (int m = 0; m < 4; ++m) { const int r = row0 + ai * 128 + m * 16;
                f32x4 g0, g1; unpack8(*(const u32x4*)(G + (size_t)r * 3072 + c0), g0, g1);
                f32x4 o[2];
#pragma unroll
                for (int j = 0; j < 4; ++j) { o[0][j] = g0[j] * acc[ai][0][m][0][j] * sigm(acc[ai][1][m][0][j]); o[1][j] = g1[j] * acc[ai][0][m][1][j] * sigm(acc[ai][1][m][1][j]); }
                *(u32x4*)(Mg + (size_t)r * 1024 + c0) = pack8(o[0], o[1]); }
    }
};
struct EpiAccMerge {
    static constexpr bool PERM = true, AFTER_DRAIN = false;
    bf16_t* Mg; const bf16_t* G; int gate_off;
    __device__ __forceinline__ void operator()(const f32x4 (&acc)[2][2][4][2], const Unit& u, int wr, int wc, int fr, int fq) const {
        const int row0 = u.pm * 256 + wr * 64 + fr, cb = u.pn * 256 + wc * 32 + 8 * fq;
#pragma unroll
        for (int ai = 0; ai < 2; ++ai)
#pragma unroll
            for (int m = 0; m < 4; ++m) { const int r = row0 + ai * 128 + m * 16;
#pragma unroll
                for (int bj = 0; bj < 2; ++bj) { const int c0 = cb + bj * 128;
                    f32x4 g0, g1, m0, m1; unpack8(*(const u32x4*)(G + (size_t)r * 3072 + gate_off + c0), g0, g1); unpack8(*(const u32x4*)(Mg + (size_t)r * 1024 + c0), m0, m1);
                    *(u32x4*)(Mg + (size_t)r * 1024 + c0) = pack8(m0 + g0 * acc[ai][bj][m][0], m1 + g1 * acc[ai][bj][m][1]); } }
    }
};
struct EpiDelta {
    static constexpr bool PERM = true, AFTER_DRAIN = false;
    bf16_t* D;
    __device__ __forceinline__ void operator()(const f32x4 (&acc)[2][2][4][2], const Unit& u, int wr, int wc, int fr, int fq) const {
        const int row0 = u.pm * 256 + wr * 64 + fr, cb = u.pn * 256 + wc * 32 + 8 * fq;
#pragma unroll
        for (int ai = 0; ai < 2; ++ai)
#pragma unroll
            for (int m = 0; m < 4; ++m)
#pragma unroll
                for (int bj = 0; bj < 2; ++bj) *(u32x4*)(D + (size_t)(row0 + ai * 128 + m * 16) * 1024 + cb + bj * 128) = pack8(acc[ai][bj][m][0], acc[ai][bj][m][1]);
    }
};
struct EpiFfn1 {
    static constexpr bool PERM = true, AFTER_DRAIN = false;
    bf16_t* Hf; const float* rowsq;
    __device__ __forceinline__ void operator()(const f32x4 (&acc)[2][2][4][2], const Unit& u, int wr, int wc, int fr, int fq) const {
        const int row0 = u.pm * 256 + wr * 64 + fr, c0 = u.pn * 128 + wc * 32 + 8 * fq;
#pragma unroll
        for (int ai = 0; ai < 2; ++ai)
#pragma unroll
            for (int m = 0; m < 4; ++m) { const int r = row0 + ai * 128 + m * 16; const float rs = rowsq[r];
                f32x4 o[2];
#pragma unroll
                for (int n = 0; n < 2; ++n)
#pragma unroll
                    for (int j = 0; j < 4; ++j) { const float a = acc[ai][0][m][n][j] * rs, b = acc[ai][1][m][n][j] * rs; o[n][j] = a * sigm(a) * b; }
                *(u32x4*)(Hf + (size_t)r * 2816 + c0) = pack8(o[0], o[1]); }
    }
};

__device__ __forceinline__ void p0_tr_item(const float* W, int K, int N, bf16_t* WT, int kb, int nd0, int ns0, const float* gk, float scale, LAS float* scr, int lane) {
    const int k0 = 64 * kb;
#pragma unroll 8
    for (int i = 0; i < 32; ++i) { const int kk = 2 * i + (lane >> 5); float s = scale; if (gk) s *= gk[k0 + kk]; scr[kk * 33 + (lane & 31)] = W[(size_t)(k0 + kk) * N + ns0 + (lane & 31)] * s; }
    asm volatile("" ::: "memory");
    const int c = lane & 7;
#pragma unroll
    for (int j = 0; j < 4; ++j) { const int n = (lane >> 3) + 8 * j; const LAS float* s = scr + (8 * c) * 33 + n;
        u32x4 o; o.x = cvt_pk_bf16(s[0 * 33], s[1 * 33]); o.y = cvt_pk_bf16(s[2 * 33], s[3 * 33]); o.z = cvt_pk_bf16(s[4 * 33], s[5 * 33]); o.w = cvt_pk_bf16(s[6 * 33], s[7 * 33]);
        *(u32x4*)(WT + (size_t)(nd0 + n) * K + k0 + 8 * c) = o; }
    asm volatile("" ::: "memory");
}
__device__ __forceinline__ void phase_p0(const Params& P, LAS unsigned char* lds, int wave, int lane, int tid) {
    unsigned char* ws = P.ws;
    const int gw = blockIdx.x * 8 + wave, NGW = gridDim.x * 8;
    LAS float* scr = (LAS float*)(lds + wave * 16384);
    constexpr int PER_L = 3584 + 512 + 256 + 256 + 512 + 2816 + 1408;
    for (int it = gw; it < 2 * PER_L; it += NGW) {
        const int l = it / PER_L; int r = it % PER_L;
        const float* W; bf16_t* WT; int K, N, type = 0; const float* gk = nullptr;
        if (r < 3584) { W = P.in[I_WIN] + (size_t)l * 1024 * 7168; WT = (bf16_t*)(ws + OFF_WIN) + (size_t)l * 7168 * 1024; K = 1024; N = 7168; type = 1; gk = P.in[I_N1G] + l * 1024; }
        else if ((r -= 3584) < 512) { W = P.in[I_WGLU] + (size_t)l * 512 * 2048; WT = (bf16_t*)(ws + OFF_WGLU) + (size_t)l * 2048 * 512; K = 512; N = 2048; type = 3; }
        else if ((r -= 512) < 256) { W = P.in[I_WATT] + (size_t)l * 512 * 1024; WT = (bf16_t*)(ws + OFF_WATT) + (size_t)l * 1024 * 512; K = 512; N = 1024; }
        else if ((r -= 256) < 256) { W = P.in[I_WPW2] + (size_t)l * 512 * 1024; WT = (bf16_t*)(ws + OFF_WPW2) + (size_t)l * 1024 * 512; K = 512; N = 1024; }
        else if ((r -= 256) < 512) { W = P.in[I_WOUT] + (size_t)l * 1024 * 1024; WT = (bf16_t*)(ws + OFF_WOUT) + (size_t)l * 1024 * 1024; K = 1024; N = 1024; }
        else if ((r -= 512) < 2816) { W = P.in[I_WF1] + (size_t)l * 1024 * 5632; WT = (bf16_t*)(ws + OFF_WF1) + (size_t)l * 5632 * 1024; K = 1024; N = 5632; type = 2; gk = P.in[I_N2G] + l * 1024; }
        else { r -= 2816; W = P.in[I_WF2] + (size_t)l * 2816 * 1024; WT = (bf16_t*)(ws + OFF_WF2) + (size_t)l * 1024 * 2816; K = 2816; N = 1024; }
        const int nblk = N / 32, kb = r / nblk, nd0 = (r % nblk) * 32;
        int ns0 = nd0; float scale = 1.f;
        if (type == 1) { if (nd0 >= 3072 && nd0 < 4096) { const int t = nd0 - 3072, j = t & 255; ns0 = 3072 + (t >> 8) * 128 + (j & 127) + (j >= 128 ? 512 : 0); }
                         if (nd0 >= 512 && nd0 < 2048) scale = 0.125f * 1.4426950408889634f; }
        else if (type == 2) { const int j = nd0 & 255; ns0 = (nd0 >> 8) * 128 + (j & 127) + (j >= 128 ? 2816 : 0); }
        else if (type == 3) { const int j = nd0 & 255; ns0 = (nd0 >> 8) * 128 + (j & 127) + (j >= 128 ? 1024 : 0); }
        p0_tr_item(W, K, N, WT, kb, nd0, ns0, gk, scale, scr, lane);
    }
    { const float* x = P.in[I_X]; bf16_t* xb = (bf16_t*)(ws + OFF_XB); bf16_t* xn = (bf16_t*)(ws + OFF_HC);
      for (int row = gw; row < NTOK; row += NGW) { float ss = 0.f; f32x4 v[4];
#pragma unroll
          for (int j = 0; j < 4; ++j) { const f32x4 t = *(const f32x4*)(x + (size_t)row * 1024 + 4 * lane + 256 * j); u32x2 w; w.x = cvt_pk_bf16(t[0], t[1]); w.y = cvt_pk_bf16(t[2], t[3]);
              *(u32x2*)(xb + (size_t)row * 1024 + 4 * lane + 256 * j) = w; v[j][0] = bf_lo(w.x); v[j][1] = bf_hi(w.x); v[j][2] = bf_lo(w.y); v[j][3] = bf_hi(w.y);
              ss += v[j][0] * v[j][0] + v[j][1] * v[j][1] + v[j][2] * v[j][2] + v[j][3] * v[j][3]; }
          ss = wave_sum(ss); const float rs = rsqrtf(ss * (1.f / 1024.f) + EPSN); if (lane == 0) ((float*)(ws + OFF_RSQ1))[row] = rs;
#pragma unroll
          for (int j = 0; j < 4; ++j) { u32x2 w; w.x = cvt_pk_bf16(v[j][0] * rs, v[j][1] * rs); w.y = cvt_pk_bf16(v[j][2] * rs, v[j][3] * rs); *(u32x2*)(xn + (size_t)row * 1024 + 4 * lane + 256 * j) = w; } } }
    const int gt = blockIdx.x * 512 + tid, NGT = gridDim.x * 512;
    for (int idx = gt; idx < 2 * 32 * 64; idx += NGT) {
        const int lg = idx >> 6, p = idx & 63;
        const float lre = P.in[I_LRE][idx], lim = P.in[I_LIM][idx], dt = expf(P.in[I_LOGDT][lg]);
        const float mag = expf(lre * dt);
        const double rev = (double)lim * (double)dt * 0.15915494309189535; const float frc = (float)(rev - rint(rev));
        const float sn = __builtin_amdgcn_sinf(frc), cs = __builtin_amdgcn_cosf(frc);
        const float are = mag * cs, aim = mag * sn, nr = are - 1.f, ni = aim, den = lre * lre + lim * lim;
        const float zre = (nr * lre + ni * lim) / den, zim = (ni * lre - nr * lim) / den;
        { f32x2v t2; t2.x = are; t2.y = aim; ((f32x2v*)(ws + OFF_S5A))[idx] = t2; }
        bf16_t* bbt = (bf16_t*)(ws + OFF_S5BB) + (size_t)lg * 128 * 16; bf16_t* cm = (bf16_t*)(ws + OFF_S5CM) + (size_t)lg * 16 * 128;
        for (int h = 0; h < 16; ++h) { const float br = P.in[I_BRE][(size_t)idx * 16 + h], bi = P.in[I_BIM][(size_t)idx * 16 + h];
            bbt[p * 16 + h] = f2bf(zre * br - zim * bi); bbt[(64 + p) * 16 + h] = f2bf(zre * bi + zim * br);
            cm[h * 128 + p] = f2bf(P.in[I_CRE][((size_t)lg * 16 + h) * 64 + p]); cm[h * 128 + 64 + p] = f2bf(-P.in[I_CIM][((size_t)lg * 16 + h) * 64 + p]); }
    }
    for (int idx = gt; idx < 2 * 31 * 256; idx += NGT) { const float a = P.in[I_CONVW][2 * idx], b = P.in[I_CONVW][2 * idx + 1]; ((unsigned*)(ws + OFF_CONVW))[idx] = cvt_pk_bf16(a, b); }
}
template <bool FINAL> __device__ __forceinline__ void phase_rows(const Params& P, int wave, int lane) {
    const int gw = blockIdx.x * 8 + wave, NGW = gridDim.x * 8;
    bf16_t* xb = (bf16_t*)(P.ws + OFF_XB); const bf16_t* D = (const bf16_t*)(P.ws + OFF_QO); bf16_t* xn = (bf16_t*)(P.ws + OFF_HC); const float* fg = P.in[I_FING];
    for (int row = gw; row < NTOK; row += NGW) {
        const size_t o0 = (size_t)row * 1024 + 8 * lane, o1 = o0 + 512;
        const u32x4 w0 = *(const u32x4*)(xb + o0), w1 = *(const u32x4*)(xb + o1), d0 = *(const u32x4*)(D + o0), d1 = *(const u32x4*)(D + o1);
        f32x4 a0, a1, b0, b1, e0, e1, g0, g1; unpack8(w0, a0, a1); unpack8(w1, b0, b1); unpack8(d0, e0, e1); unpack8(d1, g0, g1);
        const u32x4 n0 = pack8(a0 + e0, a1 + e1), n1 = pack8(b0 + g0, b1 + g1);
        unpack8(n0, a0, a1); unpack8(n1, b0, b1);
        float ss = 0.f;
#pragma unroll
        for (int j = 0; j < 4; ++j) ss += a0[j] * a0[j] + a1[j] * a1[j] + b0[j] * b0[j] + b1[j] * b1[j];
        ss = wave_sum(ss);
        const float rs = rsqrtf(ss * (1.f / 1024.f) + EPSN);
        if (!FINAL) { if (lane == 0) ((float*)(P.ws + OFF_RSQ1))[row] = rs; *(u32x4*)(xb + o0) = n0; *(u32x4*)(xb + o1) = n1; *(u32x4*)(xn + o0) = pack8(a0 * rs, a1 * rs); *(u32x4*)(xn + o1) = pack8(b0 * rs, b1 * rs); }
        else { const f32x4 q0 = *(const f32x4*)(fg + 8 * lane), q1 = *(const f32x4*)(fg + 8 * lane + 4), q2 = *(const f32x4*)(fg + 512 + 8 * lane), q3 = *(const f32x4*)(fg + 512 + 8 * lane + 4);
            float* o = P.out + (size_t)row * 1024;
            *(f32x4*)(o + 8 * lane) = a0 * q0 * rs; *(f32x4*)(o + 8 * lane + 4) = a1 * q1 * rs; *(f32x4*)(o + 512 + 8 * lane) = b0 * q2 * rs; *(f32x4*)(o + 512 + 8 * lane + 4) = b1 * q3 * rs; }
    }
}

__device__ __forceinline__ void s5_item(const Params& P, int l, int it, LAS unsigned char* wl, int lane) {
    const int b = it >> 5, g = it & 31, lg = l * 32 + g;
    LAS float* bu = (LAS float*)wl; LAS unsigned char* sl = wl + 16384;
    const int c32 = lane & 31, hi = lane >> 5, fr = lane & 15, fq = lane >> 4;
    const bf16_t* bbt = (const bf16_t*)(P.ws + OFF_S5BB) + (size_t)lg * 128 * 16; const bf16_t* cm = (const bf16_t*)(P.ws + OFF_S5CM) + (size_t)lg * 16 * 128;
    bf16x8 bbreg[4], cmreg[4];
#pragma unroll
    for (int j = 0; j < 4; ++j) { bbreg[j] = *(const bf16x8*)(bbt + (32 * j + c32) * 16 + 8 * hi); cmreg[j] = *(const bf16x8*)(cm + fr * 128 + 32 * j + 8 * fq); }
    const f32x2v av = ((const f32x2v*)(P.ws + OFF_S5A))[lg * 64 + lane]; const float a_re = av.x, a_im = av.y;
    const float dsk = P.in[I_SSMD][l * 512 + g * 16 + fr];
    float s_re = 0.f, s_im = 0.f;
    const bf16_t* Ub = (const bf16_t*)((unsigned char*)P.out + DO_U) + (size_t)b * SEQL * 512 + g * 16; bf16_t* Yb = (bf16_t*)((unsigned char*)P.out + DO_Y) + (size_t)b * SEQL * 512 + g * 16;
    for (int c = 0; c < 64; ++c) {
        const int t0 = c * 32;
        const bf16x8 ureg = *(const bf16x8*)(Ub + (size_t)(t0 + c32) * 512 + 8 * hi);
        unsigned short uep[2][4];
#pragma unroll
        for (int mt = 0; mt < 2; ++mt)
#pragma unroll
            for (int i = 0; i < 4; ++i) uep[mt][i] = Ub[(size_t)(t0 + 16 * mt + 4 * fq + i) * 512 + fr];
#pragma unroll
        for (int j = 0; j < 4; ++j) { f32x16 a;
#pragma unroll
            for (int r = 0; r < 16; ++r) a[r] = 0.f;
            a = __builtin_amdgcn_mfma_f32_32x32x16_bf16(ureg, bbreg[j], a, 0, 0, 0);
#pragma unroll
            for (int r = 0; r < 16; ++r) { const int tok = (r & 3) + 8 * (r >> 2) + 4 * hi; bu[tok * 128 + ((32 * (j & 1) + c32) << 1) + (j >> 1)] = a[r]; } }
        asm volatile("" ::: "memory");
#pragma unroll 8
        for (int t = 0; t < 32; ++t) { const f32x2v v = *(const LAS f32x2v*)(bu + t * 128 + 2 * lane);
            const float nre = fmaf(a_re, s_re, fmaf(-a_im, s_im, v.x)), nim = fmaf(a_re, s_im, fmaf(a_im, s_re, v.y)); s_re = nre; s_im = nim;
            *(LAS unsigned short*)(sl + t * 272 + lane * 2) = f2bf(s_re); *(LAS unsigned short*)(sl + t * 272 + 128 + lane * 2) = f2bf(s_im); }
        asm volatile("" ::: "memory");
#pragma unroll
        for (int mt = 0; mt < 2; ++mt) { f32x4 ya = {0.f, 0.f, 0.f, 0.f};
#pragma unroll
            for (int ks = 0; ks < 4; ++ks) { const bf16x8 a = *(const LAS bf16x8*)(sl + (16 * mt + fr) * 272 + (32 * ks + 8 * fq) * 2); ya = __builtin_amdgcn_mfma_f32_16x16x32_bf16(a, cmreg[ks], ya, 0, 0, 0); }
#pragma unroll
            for (int i = 0; i < 4; ++i) { const float y = ya[i] + dsk * __uint_as_float((unsigned)uep[mt][i] << 16);
                const float ge = y * sigm(1.5957691216057308f * (y + 0.044715f * y * y * y));
                Yb[(size_t)(t0 + 16 * mt + 4 * fq + i) * 512 + fr] = f2bf(ge); } }
        asm volatile("" ::: "memory");
    }
}

template <int PAT> __device__ __forceinline__ void attn_item(const Params& P, int it, LAS unsigned char* vl, int lane) {
    constexpr int d = PAT == 0 ? 1 : (PAT == 1 ? 4 : 16);
    constexpr int ngrp = (SEQL / d) / 32;
    constexpr int KSTR = 144;
    const int j = it % ngrp; int t = it / ngrp; const int r = t % d; t /= d; const int h = t & 7, b = t >> 3;
    const int c32 = lane & 31, hi = lane >> 5, i0 = 32 * j;
    const int lrow = lane >> 3, lch = lane & 7;
    const size_t tokbase = (size_t)b * SEQL;
    bf16_t* QO = (bf16_t*)(P.ws + OFF_QO); const bf16_t* Kb = (const bf16_t*)((unsigned char*)P.out + DO_K); const bf16_t* Vb = (const bf16_t*)((unsigned char*)P.out + DO_V);
    float* LSE = (float*)(P.ws + OFF_LSE);
    const unsigned char* qrow0 = (const unsigned char*)QO + ((tokbase + (size_t)i0 * d + r) * 1536 + PAT * 512 + h * 64) * 2;
    const unsigned char* krow0 = (const unsigned char*)Kb + ((tokbase + (size_t)(i0 - 128) * d + r) * 512 + h * 64) * 2;
    const unsigned char* vrow0 = (const unsigned char*)Vb + ((tokbase + (size_t)(i0 - 128) * d + r) * 512 + h * 64) * 2;
    const unsigned qlo = (unsigned)(lrow * d * 3072 + lch * 16), klo = (unsigned)(lrow * d * 1024 + lch * 16);
    u32x4 qraw[4], kraw[5][4];
#pragma unroll
    for (int i4 = 0; i4 < 4; ++i4) qraw[i4] = *(const u32x4*)(qrow0 + (qlo + (unsigned)(8 * i4 * d * 3072)));
#pragma unroll
    for (int kt = 0; kt < 5; ++kt) { const int kb = i0 - 128 + 32 * kt;
        if (kb >= 0) {
#pragma unroll
            for (int i4 = 0; i4 < 4; ++i4) kraw[kt][i4] = *(const u32x4*)(krow0 + (klo + (unsigned)((32 * kt + 8 * i4) * d * 1024))); } }
    bf16x8 qreg[4];
#pragma unroll
    for (int i4 = 0; i4 < 4; ++i4) *(LAS u32x4*)(vl + (lrow + 8 * i4) * KSTR + lch * 16) = qraw[i4];
    asm volatile("" ::: "memory");
#pragma unroll
    for (int ks = 0; ks < 4; ++ks) qreg[ks] = *(const LAS bf16x8*)(vl + c32 * KSTR + (16 * ks + 8 * hi) * 2);
    asm volatile("" ::: "memory");
    f32x16 s[5];
#pragma unroll
    for (int kt = 0; kt < 5; ++kt) { const int kb = i0 - 128 + 32 * kt;
        f32x16 a;
        if (kb >= 0) {
#pragma unroll
            for (int q = 0; q < 16; ++q) a[q] = 0.f;
#pragma unroll
            for (int i4 = 0; i4 < 4; ++i4) *(LAS u32x4*)(vl + (lrow + 8 * i4) * KSTR + lch * 16) = kraw[kt][i4];
            asm volatile("" ::: "memory");
#pragma unroll
            for (int ks = 0; ks < 4; ++ks) { const bf16x8 kreg = *(const LAS bf16x8*)(vl + c32 * KSTR + (16 * ks + 8 * hi) * 2); a = __builtin_amdgcn_mfma_f32_32x32x16_bf16(kreg, qreg[ks], a, 0, 0, 0); }
            asm volatile("" ::: "memory");
        } else {
#pragma unroll
            for (int q = 0; q < 16; ++q) a[q] = (-__builtin_inff());
        }
        s[kt] = a; }
    u32x4 vreg[5][4];
#pragma unroll
    for (int kt = 0; kt < 3; ++kt) { const int kb = i0 - 128 + 32 * kt;
        if (kb >= 0) {
#pragma unroll
            for (int i4 = 0; i4 < 4; ++i4) vreg[kt][i4] = *(const u32x4*)(vrow0 + (klo + (unsigned)((32 * kt + 8 * i4) * d * 1024))); } }
#pragma unroll
    for (int q = 0; q < 16; ++q) { const int kr = (q & 3) + 8 * (q >> 2) + 4 * hi; if (kr < c32) s[0][q] = (-__builtin_inff()); if (kr > c32) s[4][q] = (-__builtin_inff()); }
    float mx = (-__builtin_inff());
#pragma unroll
    for (int kt = 0; kt < 5; ++kt)
#pragma unroll
        for (int q = 0; q < 16; ++q) mx = fmaxf(mx, s[kt][q]);
    mx = fmaxf(mx, __shfl_xor(mx, 32));
    float den = 0.f;
#pragma unroll
    for (int kt = 0; kt < 5; ++kt)
#pragma unroll
        for (int q = 0; q < 16; ++q) { const float p = __builtin_amdgcn_exp2f(s[kt][q] - mx); s[kt][q] = p; den += p; }
    den += __shfl_xor(den, 32);
    u32x4 pw[5][2];
#pragma unroll
    for (int kt = 0; kt < 5; ++kt)
#pragma unroll
        for (int ks2 = 0; ks2 < 2; ++ks2) { pw[kt][ks2].x = cvt_pk_bf16(s[kt][8 * ks2 + 0], s[kt][8 * ks2 + 1]); pw[kt][ks2].y = cvt_pk_bf16(s[kt][8 * ks2 + 2], s[kt][8 * ks2 + 3]);
            pw[kt][ks2].z = cvt_pk_bf16(s[kt][8 * ks2 + 4], s[kt][8 * ks2 + 5]); pw[kt][ks2].w = cvt_pk_bf16(s[kt][8 * ks2 + 6], s[kt][8 * ks2 + 7]); }
#pragma unroll
    for (int kt = 3; kt < 5; ++kt) { const int kb = i0 - 128 + 32 * kt;
        if (kb >= 0) {
#pragma unroll
            for (int i4 = 0; i4 < 4; ++i4) vreg[kt][i4] = *(const u32x4*)(vrow0 + (klo + (unsigned)((32 * kt + 8 * i4) * d * 1024))); } }
    u32x4 mraw[2][4]; float l2b = 0.f, l2c = 0.f;
    if (PAT == 0) {
#pragma unroll
        for (int pp = 0; pp < 2; ++pp)
#pragma unroll
            for (int i4 = 0; i4 < 4; ++i4) mraw[pp][i4] = *(const u32x4*)(qrow0 + (qlo + (unsigned)(8 * i4 * 3072 + (pp + 1) * 1024)));
        l2b = LSE[((size_t)(0 * 32 + b) * 8 + h) * SEQL + i0 + c32]; l2c = LSE[((size_t)(1 * 32 + b) * 8 + h) * SEQL + i0 + c32];
    }
    f32x16 o[2];
#pragma unroll
    for (int q = 0; q < 16; ++q) { o[0][q] = 0.f; o[1][q] = 0.f; }
    const int gi = lane >> 4, li = lane & 15;
    const LAS unsigned char* vrd = vl + (4 * hi + (li >> 2)) * VSTR + (16 * (gi & 1) + 4 * (li & 3)) * 2;
#pragma unroll
    for (int kt = 0; kt < 5; ++kt) { const int kb = i0 - 128 + 32 * kt;
        if (kb >= 0) {
#pragma unroll
            for (int i4 = 0; i4 < 4; ++i4) *(LAS u32x4*)(vl + (lrow + 8 * i4) * VSTR + lch * 16) = vreg[kt][i4];
            asm volatile("" ::: "memory");
#pragma unroll
            for (int ks2 = 0; ks2 < 2; ++ks2) {
                const bf16x8 pb = __builtin_bit_cast(bf16x8, pw[kt][ks2]);
#pragma unroll
                for (int mt = 0; mt < 2; ++mt) { const LAS unsigned char* a1 = vrd + (16 * ks2) * VSTR + 64 * mt;
                    const s16x4 lo = vtr(a1), up = vtr(a1 + 8 * VSTR);
                    bf16x8 av; av[0] = lo[0]; av[1] = lo[1]; av[2] = lo[2]; av[3] = lo[3]; av[4] = up[0]; av[5] = up[1]; av[6] = up[2]; av[7] = up[3];
                    o[mt] = __builtin_amdgcn_mfma_f32_32x32x16_bf16(av, pb, o[mt], 0, 0, 0); } }
            asm volatile("" ::: "memory");
        } }
    const float inv = __builtin_amdgcn_rcpf(den);
    const float l2 = mx + __builtin_amdgcn_logf(den);
    const LAS unsigned char* frd = vl + c32 * KSTR + 8 * hi;
    float w1 = inv;
    if (PAT == 0) {
        const float M = fmaxf(l2, fmaxf(l2b, l2c));
        float e1 = __builtin_amdgcn_exp2f(l2 - M), e2 = __builtin_amdgcn_exp2f(l2b - M), e3 = __builtin_amdgcn_exp2f(l2c - M);
        const float wi = __builtin_amdgcn_rcpf(e1 + e2 + e3); w1 = e1 * wi * inv; const float wo[2] = {e2 * wi, e3 * wi};
#pragma unroll
        for (int q = 0; q < 16; ++q) { o[0][q] *= w1; o[1][q] *= w1; }
#pragma unroll
        for (int pp = 0; pp < 2; ++pp) {
#pragma unroll
            for (int i4 = 0; i4 < 4; ++i4) *(LAS u32x4*)(vl + (lrow + 8 * i4) * KSTR + lch * 16) = mraw[pp][i4];
            asm volatile("" ::: "memory");
#pragma unroll
            for (int mt = 0; mt < 2; ++mt)
#pragma unroll
                for (int rg = 0; rg < 4; ++rg) { const u32x2 bb = *(const LAS u32x2*)(frd + 64 * mt + 16 * rg);
                    o[mt][4 * rg] += wo[pp] * bf_lo(bb.x); o[mt][4 * rg + 1] += wo[pp] * bf_hi(bb.x); o[mt][4 * rg + 2] += wo[pp] * bf_lo(bb.y); o[mt][4 * rg + 3] += wo[pp] * bf_hi(bb.y); }
            asm volatile("" ::: "memory");
        }
    } else {
#pragma unroll
        for (int q = 0; q < 16; ++q) { o[0][q] *= w1; o[1][q] *= w1; }
    }
#pragma unroll
    for (int mt = 0; mt < 2; ++mt)
#pragma unroll
        for (int rg = 0; rg < 4; ++rg) { u32x2 w; w.x = cvt_pk_bf16(o[mt][4 * rg], o[mt][4 * rg + 1]); w.y = cvt_pk_bf16(o[mt][4 * rg + 2], o[mt][4 * rg + 3]);
            *(LAS u32x2*)(vl + c32 * KSTR + 8 * hi + 64 * mt + 16 * rg) = w; }
    asm volatile("" ::: "memory");
    if (PAT != 0) {
#pragma unroll
        for (int i4 = 0; i4 < 4; ++i4) *(u32x4*)((unsigned char*)qrow0 + (qlo + (unsigned)(8 * i4 * d * 3072))) = *(const LAS u32x4*)(vl + (lrow + 8 * i4) * KSTR + lch * 16);
        if (hi == 0) LSE[((size_t)((PAT - 1) * 32 + b) * 8 + h) * SEQL + (size_t)(i0 + c32) * d + r] = l2;
    } else {
        bf16_t* OC = (bf16_t*)(P.ws + OFF_OC);
#pragma unroll
        for (int i4 = 0; i4 < 4; ++i4) *(u32x4*)(OC + (tokbase + (size_t)(i0 + lrow + 8 * i4)) * 512 + h * 64 + lch * 8) = *(const LAS u32x4*)(vl + (lrow + 8 * i4) * KSTR + lch * 16);
    }
    asm volatile("" ::: "memory");
}

__device__ __forceinline__ void conv_item(const Params& P, int l, int it, int lane) {
    const int b = it >> 8, t0 = (it & 255) * 8, ch0 = 8 * lane;
    const bf16_t* in = (const bf16_t*)(P.ws + OFF_CG) + (size_t)b * SEQL * 512 + ch0;
    const unsigned* cw = (const unsigned*)(P.ws + OFF_CONVW) + (size_t)l * 31 * 256 + 4 * lane;
    float acc[8][8], win[8][8];
    { const f32x4 b0 = *(const f32x4*)(P.in[I_CONVB] + l * 512 + ch0), b1 = *(const f32x4*)(P.in[I_CONVB] + l * 512 + ch0 + 4);
#pragma unroll
      for (int i = 0; i < 8; ++i) { acc[i][0] = b0[0]; acc[i][1] = b0[1]; acc[i][2] = b0[2]; acc[i][3] = b0[3]; acc[i][4] = b1[0]; acc[i][5] = b1[1]; acc[i][6] = b1[2]; acc[i][7] = b1[3]; } }
#define CONV_LOADROW(rr, dst) do { const int t_ = t0 - 30 + (rr); if (t_ >= 0) { const u32x4 v_ = *(const u32x4*)(in + (size_t)t_ * 512); \
        dst[0] = bf_lo(v_.x); dst[1] = bf_hi(v_.x); dst[2] = bf_lo(v_.y); dst[3] = bf_hi(v_.y); dst[4] = bf_lo(v_.z); dst[5] = bf_hi(v_.z); dst[6] = bf_lo(v_.w); dst[7] = bf_hi(v_.w); } \
        else { _Pragma("unroll") for (int c_ = 0; c_ < 8; ++c_) dst[c_] = 0.f; } } while (0)
#pragma unroll
    for (int rr = 0; rr < 8; ++rr) CONV_LOADROW(rr, win[rr]);
    for (int jb = 0; jb < 32; jb += 8) {
        asm volatile("" ::: "memory");
#pragma unroll
        for (int jj = 0; jj < 8; ++jj) { const int j = jb + jj;
            if (j < 31) { const u32x4 wv = *(const u32x4*)(cw + j * 256);
                float w[8]; w[0] = bf_lo(wv.x); w[1] = bf_hi(wv.x); w[2] = bf_lo(wv.y); w[3] = bf_hi(wv.y); w[4] = bf_lo(wv.z); w[5] = bf_hi(wv.z); w[6] = bf_lo(wv.w); w[7] = bf_hi(wv.w);
#pragma unroll
                for (int i = 0; i < 8; ++i)
#pragma unroll
                    for (int c = 0; c < 8; ++c) acc[i][c] = fmaf(w[c], win[(jj + i) & 7][c], acc[i][c]);
                if (j + 8 < 38) CONV_LOADROW(j + 8, win[jj]); } }
    }
#undef CONV_LOADROW
    const f32x4 g0 = *(const f32x4*)(P.in[I_LNG] + l * 512 + ch0), g1 = *(const f32x4*)(P.in[I_LNG] + l * 512 + ch0 + 4);
    const f32x4 e0 = *(const f32x4*)(P.in[I_LNB] + l * 512 + ch0), e1 = *(const f32x4*)(P.in[I_LNB] + l * 512 + ch0 + 4);
    bf16_t* outp = (bf16_t*)(P.ws + OFF_HC) + ((size_t)b * SEQL + t0) * 512 + ch0;
#pragma unroll
    for (int i = 0; i < 8; ++i) { float s1 = 0.f, s2 = 0.f;
#pragma unroll
        for (int c = 0; c < 8; ++c) { s1 += acc[i][c]; s2 += acc[i][c] * acc[i][c]; }
        s1 = wave_sum(s1); s2 = wave_sum(s2);
        const float mean = s1 * (1.f / 512.f), var = fmaxf(s2 * (1.f / 512.f) - mean * mean, 0.f), rs = rsqrtf(var + EPSN);
        f32x4 y0, y1;
#pragma unroll
        for (int c = 0; c < 4; ++c) { const float h0 = (acc[i][c] - mean) * rs * g0[c] + e0[c], h1 = (acc[i][4 + c] - mean) * rs * g1[c] + e1[c]; y0[c] = h0 * sigm(h0); y1[c] = h1 * sigm(h1); }
        *(u32x4*)(outp + (size_t)i * 512) = pack8(y0, y1); }
}

__device__ __forceinline__ int xcc_id() { return (int)(__builtin_amdgcn_s_getreg((3 << 11) | 20) & 7u); }
__device__ __forceinline__ int claim_issue(unsigned* ctr, int& lane) { asm volatile("" : "+v"(lane)); int v = 0; if (lane == 0) v = (int)atomicAdd(ctr, 1u); return v; }
__device__ __forceinline__ int lane_now() { int l = (int)__builtin_amdgcn_mbcnt_hi(~0u, __builtin_amdgcn_mbcnt_lo(~0u, 0u)); asm volatile("" : "+v"(l)); return l; }
__device__ __forceinline__ int lds_claim(LAS unsigned* ctr, int lane) { int v = 0; if (lane == 0) v = (int)__hip_atomic_fetch_add(ctr, 1u, __ATOMIC_RELAXED, __HIP_MEMORY_SCOPE_WORKGROUP); return __builtin_amdgcn_readfirstlane(v); }
__device__ __forceinline__ int claim(unsigned* ctr, int& lane) { asm volatile("" : "+v"(lane)); int v = 0; if (lane == 0) v = (int)atomicAdd(ctr, 1u); return __builtin_amdgcn_readfirstlane(v); }


__device__ __forceinline__ void grid_barrier(unsigned* bar, unsigned target, int tid) {
    asm volatile("s_waitcnt vmcnt(0) lgkmcnt(0)" ::: "memory");
    __syncthreads();
    if (tid == 0) {
        __builtin_amdgcn_fence(__ATOMIC_RELEASE, "agent");
        asm volatile("s_waitcnt vmcnt(0) lgkmcnt(0)" ::: "memory");
        __hip_atomic_fetch_add(bar, 1u, __ATOMIC_RELAXED, __HIP_MEMORY_SCOPE_AGENT);
        while (__hip_atomic_load(bar, __ATOMIC_RELAXED, __HIP_MEMORY_SCOPE_AGENT) < target) __builtin_amdgcn_s_sleep(2);
        __builtin_amdgcn_fence(__ATOMIC_ACQUIRE, "agent");
        asm volatile("s_waitcnt vmcnt(0) lgkmcnt(0)" ::: "memory");
    }
    __syncthreads();
}

constexpr int NPHASE = 21;
__global__ void __launch_bounds__(512, 2) fwd_kernel(Params P) {
    extern __shared__ __attribute__((aligned(16))) unsigned char shm[];
    LAS unsigned char* lds = (LAS unsigned char*)shm;
        unsigned char* ws = P.ws; unsigned char* dout = (unsigned char*)P.out;
    bf16_t* xb = (bf16_t*)(ws + OFF_XB); bf16_t* Gt = (bf16_t*)(ws + OFF_G); bf16_t* Mg = (bf16_t*)(dout + DO_MG);
    bf16_t* xn = (bf16_t*)(ws + OFF_HC); bf16_t* Dl = (bf16_t*)(ws + OFF_QO);
    unsigned* ctl = (unsigned*)(ws + OFF_CTL);
    StaticOrder S;
    unsigned nbar = 0;
    const int wave_s = __builtin_amdgcn_readfirstlane((int)threadIdx.x >> 6);
    if (P.ph_hi - P.ph_lo > 1) cg::this_grid().sync();
    for (int ph = P.ph_lo; ph < P.ph_hi; ++ph) {
        const int wave = wave_s;
#define PHASE_IDS const int lane = lane_now(); const int tid = (wave_s << 6) | lane; (void)tid; (void)lane;
        if (ph == 0) { PHASE_IDS for (int rp = 0; rp < NREP_P0; ++rp) phase_p0(P, lds, wave, lane, tid); }
        else if (ph == NPHASE - 1) { PHASE_IDS phase_rows<true>(P, wave, lane); }
        else {
            const int l = (ph - 1) / 10, s = (ph - 1) % 10;
            if (s == 0) { PHASE_IDS
                S.init(NTOK, 7168, gridDim.x, blockIdx.x);
                Gemm g{xb, (const bf16_t*)(ws + OFF_WIN) + (size_t)l * 7168 * 1024, NTOK, 7168, 1024};
                EpiIn E{(bf16_t*)(dout + DO_U), (bf16_t*)(ws + OFF_QO), (bf16_t*)(dout + DO_K), (bf16_t*)(dout + DO_V), (bf16_t*)(ws + OFF_CG), Gt, (const float*)(ws + OFF_RSQ1), P.in[I_BGATE] + l * 3072};
                gemm_phase<EpiIn, StaticOrder, false>(lds, g, S, E, nullptr, tid);
            } else if (s == 1) { PHASE_IDS
                LAS unsigned* lctr = (LAS unsigned*)(lds + CTR_OFF);
                if (tid == 0) lctr[0] = 0u;
                __syncthreads();
                const int grp = blockIdx.x & 7, rank = blockIdx.x >> 3; constexpr int per = 128;
                if (wave < 4) { for (int it = blockIdx.x * 4 + wave; it < 1024; it += gridDim.x * 4) s5_item(P, l, it, lds + wave * S5_WL, lane_now()); }
                LAS unsigned char* vl = lds + ATT_OFF + wave * ATT_WL;
                for (;;) { const int ln = lane_now(); const int k = lds_claim(lctr, ln); const int li = rank * per + k; if (k >= per || li >= 4096) break;
                    const int b = grp + 8 * (li >> 10), rest = li & 1023;
                    if (rest < 512) attn_item<1>(P, b * 512 + rest, vl, ln); else attn_item<2>(P, b * 512 + rest - 512, vl, ln); }
            } else if (s == 2) { PHASE_IDS
                LAS unsigned* lctr = (LAS unsigned*)(lds + CTR_OFF);
                if (tid == 0) lctr[0] = 0u;
                __syncthreads();
                const int grp = blockIdx.x & 7, rank = blockIdx.x >> 3; constexpr int per = 96;
                LAS unsigned char* vl = lds + ATT_OFF + wave * ATT_WL;
                for (;;) { const int ln = lane_now(); const int k = lds_claim(lctr, ln); const int li = rank * per + k; if (k >= per || li >= 3072) break;
                    const int b = grp + 8 * (li / 768), rest = li % 768;
                    if (rest < 512) attn_item<0>(P, b * 512 + rest, vl, ln); else conv_item(P, l, b * 256 + rest - 512, ln); }
            } else if (s == 3) { PHASE_IDS
                S.init(NTOK, 2048, gridDim.x, blockIdx.x);
                Gemm g{(const bf16_t*)(dout + DO_Y), (const bf16_t*)(ws + OFF_WGLU) + (size_t)l * 2048 * 512, NTOK, 2048, 512};
                EpiGluMerge E{Mg, Gt};
                gemm_phase<EpiGluMerge, StaticOrder, false>(lds, g, S, E, nullptr, tid);
            } else if (s == 4) { PHASE_IDS
                S.init(NTOK, 1024, gridDim.x, blockIdx.x);
                for (int c = 0; c < 2; ++c) {
                    Gemm g{(const bf16_t*)(ws + (c == 0 ? OFF_HC : OFF_OC)), (const bf16_t*)(ws + (c == 0 ? OFF_WPW2 : OFF_WATT)) + (size_t)l * 1024 * 512, NTOK, 1024, 512};
                    EpiAccMerge E{Mg, Gt, c == 0 ? 2048 : 1024};
                    gemm_phase<EpiAccMerge, StaticOrder, false>(lds, g, S, E, nullptr, tid);
                    __syncthreads();
                }
            } else if (s == 6 || s == 9) { PHASE_IDS
                phase_rows<false>(P, wave, lane);
            } else if (s == 5 || s == 8) { PHASE_IDS
                S.init(NTOK, 1024, gridDim.x, blockIdx.x);
                Gemm g{s == 5 ? (const bf16_t*)Mg : (const bf16_t*)Gt, s == 5 ? (const bf16_t*)(ws + OFF_WOUT) + (size_t)l * 1024 * 1024 : (const bf16_t*)(ws + OFF_WF2) + (size_t)l * 1024 * 2816, NTOK, 1024, s == 5 ? 1024 : 2816};
                EpiDelta E{Dl};
                gemm_phase<EpiDelta, StaticOrder, false>(lds, g, S, E, nullptr, tid);
            } else {
                PHASE_IDS
                S.init(NTOK, 5632, gridDim.x, blockIdx.x);
                Gemm g{xb, (const bf16_t*)(ws + OFF_WF1) + (size_t)l * 5632 * 1024, NTOK, 5632, 1024};
                EpiFfn1 E{Gt, (const float*)(ws + OFF_RSQ1)};
                gemm_phase<EpiFfn1, StaticOrder, false>(lds, g, S, E, nullptr, tid);
            }
        }
        if (ph + 1 < P.ph_hi) { ++nbar; grid_barrier(ctl + 3072, nbar * gridDim.x, (wave_s << 6) | lane_now()); }
    }
}

extern "C" void kernel_launch(void* const* d_in, const int* in_sizes, int n_in, void* d_out, int out_size, void* d_ws, size_t ws_size, hipStream_t stream) {
    static int grid = 0;
    if (grid == 0) {
        if (n_in != 24 || out_size != NTOK * 1024 || ws_size < WS_END) { fprintf(stderr, "kernel_launch: unexpected problem (n_in %d out %d ws %zu need %zu)\n", n_in, out_size, ws_size, (size_t)WS_END); grid = -1; return; }
        int dev = 0, cus = 0, per_cu = 0;
        hipGetDevice(&dev); hipDeviceGetAttribute(&cus, hipDeviceAttributeMultiprocessorCount, dev);
        if (hipFuncSetAttribute((const void*)fwd_kernel, hipFuncAttributeMaxDynamicSharedMemorySize, LDS_BYTES) != hipSuccess) { fprintf(stderr, "kernel_launch: hipFuncSetAttribute failed\n"); grid = -1; return; }
        hipOccupancyMaxActiveBlocksPerMultiprocessor(&per_cu, (const void*)fwd_kernel, 512, LDS_BYTES);
        if (per_cu < 1) { fprintf(stderr, "kernel_launch: occupancy query says %d blocks/CU\n", per_cu); per_cu = 1; }
        (void)hipGetLastError();
        grid = cus * per_cu; if (grid > 256) grid = 256;
        if (grid != 256) { fprintf(stderr, "kernel_launch: this build partitions its work over exactly 256 workgroups (got %d)\n", grid); grid = -1; return; }
    }
    if (grid < 0) return;
    hipMemsetAsync((unsigned char*)d_ws + OFF_CTL, 0, 16384, stream);
    Params p{};
    for (int i = 0; i < 24; ++i) p.in[i] = (const float*)d_in[i];
    p.out = (float*)d_out; p.ws = (unsigned char*)d_ws;
#if MK_PER_PHASE
    for (int ph = 0; ph < NPHASE; ++ph) { p.ph_lo = ph; p.ph_hi = ph + 1; hipLaunchKernelGGL(fwd_kernel, dim3(grid), dim3(512), LDS_BYTES, stream, p); }
#else
    p.ph_lo = 0; p.ph_hi = NPHASE;
    void* args[] = {&p};
    hipError_t e = hipLaunchCooperativeKernel((const void*)fwd_kernel, dim3(grid), dim3(512), args, LDS_BYTES, stream);
    if (e != hipSuccess) fprintf(stderr, "cooperative launch failed: %s (grid %d)\n", hipGetErrorString(e), grid);
#endif
}
```

```cpp
#include <hip/hip_runtime.h>
#include <hip/hip_cooperative_groups.h>
#include <cstdio>
namespace cg = cooperative_groups;
namespace pg8 {
#define PG8_LAS __attribute__((address_space(3)))
typedef unsigned short bf16_t;
typedef short bf16x8 __attribute__((ext_vector_type(8)));
typedef float f32x4 __attribute__((ext_vector_type(4)));
typedef unsigned u32x4 __attribute__((ext_vector_type(4)));
constexpr int BM = 256, BK = 64, HALF = 128, HTB = HALF * BK * 2  , STAGE_BYTES = 8 * HTB, NXCD = 8, WGM = 8;

__host__ __device__ __forceinline__ int lds_byte(int r, int c) { const int st = (r >> 4) * 2 + (c >> 5), rr = r & 15, cc = c & 31, ob = rr * 64 + cc * 2; return st * 1024 + (ob ^ (((ob >> 9) & 1) << 5)); }
__host__ __device__ __forceinline__ void stage_rc(int b, int& R, int& C) { const int st = b / 1024, sb = b % 1024, swz = sb ^ (((sb >> 9) & 1) << 5); R = (st >> 1) * 16 + swz / 64; C = (st & 1) * 32 + (swz % 64) / 2; }
__host__ __device__ __forceinline__ int perm32(int rho) { const int n = rho >> 4, i = rho & 15; return 8 * (i >> 2) + 4 * n + (i & 3); }

struct Unit { int pm, pn; };
struct Gemm { const bf16_t* A; const bf16_t* Bt; int M, N, K; };

struct StaticOrder {
    int nM, nN, nwg, G, c;
    __host__ __device__ void init(int M, int N, int G_, int c_) { nM = M / BM; nN = N / BM; nwg = nM * nN; G = G_; c = c_; }
    __host__ __device__ bool next(int i, Unit& u) const {
        const long L = (long)i * G + c; if (L >= nwg) return false;
        int wgid = (int)L; { const int q = nwg / NXCD, r = nwg % NXCD, xcd = wgid % NXCD, off = wgid / NXCD; wgid = (xcd < r ? xcd * (q + 1) : r * (q + 1) + (xcd - r) * q) + off; }
        const int nig = WGM * nN, gid = wgid / nig, fm = gid * WGM, gsz = (nM - fm) < WGM ? (nM - fm) : WGM;
        u.pm = fm + ((wgid % nig) % gsz); u.pn = (wgid % nig) / gsz; return true;
    }
    __device__ __forceinline__ void a_ready(const Unit&) const {}
    __device__ __forceinline__ void done(const Unit&) const {}
};
__device__ __forceinline__ unsigned cvt_pk_bf16(float lo, float hi) { unsigned r; asm volatile("v_cvt_pk_bf16_f32 %0, %1, %2" : "=v"(r) : "v"(lo), "v"(hi)); return r; }
template <class Epi, class Sched, bool STAMP = false>
__device__ __forceinline__ void gemm_phase(PG8_LAS unsigned char* lds, const Gemm g, const Sched& S, const Epi& E, unsigned long long* stamps, int tid_in) {
    int tid_o = tid_in; asm volatile("" : "+v"(tid_o)); const int tid = tid_o, wid = __builtin_amdgcn_readfirstlane(tid >> 6), lane = tid & 63, wr = wid >> 2, wc = wid & 3, fr = lane & 15, fq = lane >> 4;
    const int K = g.K, nt = K / BK;
    int ts_lo = 0, ts_hi = 0, nts = 0; const unsigned long long rt_entry = STAMP ? (unsigned long long)wall_clock64() : 0ull;
#define PG8_STAMP() do { if (STAMP && wid == 0 && nts < 64) { const unsigned long long _c = (unsigned long long)clock64(); \
        ts_lo = (lane == nts) ? (int)(unsigned)_c : ts_lo; ts_hi = (lane == nts) ? (int)(unsigned)(_c >> 32) : ts_hi; ++nts; } } while (0)
    PG8_STAMP();
    unsigned voffA[2], voffB[2];
#pragma unroll
    for (int i = 0; i < 2; ++i) { int R, C; stage_rc(tid * 16 + i * 8192, R, C); const int Rb = Epi::PERM ? ((R & ~31) + perm32(R & 31)) : R;
        voffA[i] = (unsigned)(R * K + C) * 2u; voffB[i] = (unsigned)(Rb * K + C) * 2u; }
    const size_t kstep = (size_t)(BK * 2);
    const size_t hstep = (size_t)HALF * K * 2;
    const size_t tstep = 2 * hstep;
    const unsigned ldsw = (unsigned)wid * 1024u;
    const int aoff = lds_byte(wr * 64 + fr, fq * 8), boff = lds_byte(wc * 32 + fr, fq * 8);
#define PG8_SA(b, h) (((b) * 2 + (h)) * HTB)
#define PG8_SB(b, h) ((4 + (b) * 2 + (h)) * HTB)
#define PG8_STAGE(bufoff, gbase, voff) do { _Pragma("unroll") for (int _i = 0; _i < 2; ++_i) \
        __builtin_amdgcn_global_load_lds((const unsigned*)((const char*)(gbase) + (voff)[_i]), (PG8_LAS unsigned*)(lds + (bufoff) + ldsw + _i * 8192), 16, 0, 0); } while (0)
#define PG8_LDA(dst, b, h) do { _Pragma("unroll") for (int m = 0; m < 4; ++m) _Pragma("unroll") for (int k = 0; k < 2; ++k) dst[m][k] = *(const PG8_LAS bf16x8*)(lds + PG8_SA(b, h) + aoff + m * 2048 + k * 1024); } while (0)
#define PG8_LDB(dst, b, h) do { _Pragma("unroll") for (int n = 0; n < 2; ++n) _Pragma("unroll") for (int k = 0; k < 2; ++k) dst[n][k] = *(const PG8_LAS bf16x8*)(lds + PG8_SB(b, h) + boff + n * 2048 + k * 1024); } while (0)
#define PG8_MMA(ai, bj, At, Bt) do { __builtin_amdgcn_s_setprio(1); _Pragma("unroll") for (int m = 0; m < 4; ++m) _Pragma("unroll") for (int n = 0; n < 2; ++n) _Pragma("unroll") for (int k = 0; k < 2; ++k) \
        acc[ai][bj][m][n] = __builtin_amdgcn_mfma_f32_16x16x32_bf16(Bt[n][k], At[m][k], acc[ai][bj][m][n], 0, 0, 0); __builtin_amdgcn_s_setprio(0); } while (0)
#define PG8_WAIT_V(n) asm volatile("s_waitcnt vmcnt(" #n ")" ::: "memory")
#define PG8_WAIT_L(n) asm volatile("s_waitcnt lgkmcnt(" #n ")" ::: "memory")
#define PG8_BAR __builtin_amdgcn_s_barrier()
#define PG8_SCHED __builtin_amdgcn_sched_barrier(0)
    Unit cur, nxt; int ui = 0;
    if (!S.next(0, cur)) return;
    f32x4 acc[2][2][4][2];
#pragma unroll
    for (int a = 0; a < 2; ++a)
#pragma unroll
        for (int b = 0; b < 2; ++b)
#pragma unroll
            for (int m = 0; m < 4; ++m)
#pragma unroll
                for (int n = 0; n < 2; ++n) acc[a][b][m][n] = (f32x4){0.f, 0.f, 0.f, 0.f};
    bf16x8 At[4][2], B0[2][2], B1[2][2];
    const char* cA = (const char*)g.A + (size_t)cur.pm * tstep; const char* cB = (const char*)g.Bt + (size_t)cur.pn * tstep;
    S.a_ready(cur);
    PG8_STAGE(PG8_SB(0, 0), cB, voffB); PG8_STAGE(PG8_SA(0, 0), cA, voffA); PG8_STAGE(PG8_SB(0, 1), cB + hstep, voffB); PG8_STAGE(PG8_SA(0, 1), cA + hstep, voffA);
    if (wr == 1) PG8_BAR;
    PG8_WAIT_V(4); PG8_BAR;
    PG8_STAGE(PG8_SB(1, 0), cB + kstep, voffB); PG8_STAGE(PG8_SA(1, 0), cA + kstep, voffA); PG8_STAGE(PG8_SB(1, 1), cB + hstep + kstep, voffB);
    PG8_WAIT_V(6); PG8_BAR;
    PG8_STAMP();
    for (;;) {
        const bool has_next = S.next(ui + 1, nxt);
        const char* nA = has_next ? (const char*)g.A + (size_t)nxt.pm * tstep : cA; const char* nB = has_next ? (const char*)g.Bt + (size_t)nxt.pn * tstep : cB;
        for (int t = 0; t < nt; t += 2) {
            const bool last = (t == nt - 2);
            const char* a1 = cA + (size_t)(t + 1) * kstep;
            const char* a2 = last ? nA : cA + (size_t)(t + 2) * kstep; const char* b2 = last ? nB : cB + (size_t)(t + 2) * kstep;
            const char* a3 = a2 + kstep; const char* b3 = b2 + kstep;
            if (last && has_next) S.a_ready(nxt);
            PG8_LDB(B0, 0, 0); PG8_SCHED; PG8_LDA(At, 0, 0); PG8_STAGE(PG8_SA(1, 1), a1 + hstep, voffA);
            PG8_WAIT_L(8); PG8_BAR; PG8_WAIT_L(0); PG8_MMA(0, 0, At, B0); PG8_BAR; PG8_SCHED;
            PG8_LDB(B1, 0, 1); PG8_STAGE(PG8_SB(0, 0), b2, voffB);
            PG8_BAR; PG8_WAIT_L(0); PG8_MMA(0, 1, At, B1); PG8_BAR;
            PG8_LDA(At, 0, 1); PG8_STAGE(PG8_SA(0, 0), a2, voffA);
            PG8_BAR; PG8_WAIT_L(0); PG8_MMA(1, 0, At, B0); PG8_BAR; PG8_SCHED;
            PG8_STAGE(PG8_SB(0, 1), b2 + hstep, voffB);
            PG8_WAIT_V(6); PG8_BAR; PG8_MMA(1, 1, At, B1); PG8_BAR;
            PG8_LDB(B0, 1, 0); PG8_SCHED; PG8_LDA(At, 1, 0); PG8_STAGE(PG8_SA(0, 1), a2 + hstep, voffA);
            PG8_WAIT_L(8); PG8_BAR; PG8_WAIT_L(0); PG8_MMA(0, 0, At, B0); PG8_BAR; PG8_SCHED;
            PG8_LDB(B1, 1, 1); PG8_STAGE(PG8_SB(1, 0), b3, voffB);
            PG8_BAR; PG8_WAIT_L(0); PG8_MMA(0, 1, At, B1); PG8_BAR;
            PG8_LDA(At, 1, 1); PG8_STAGE(PG8_SA(1, 0), a3, voffA);
            PG8_BAR; PG8_WAIT_L(0); PG8_MMA(1, 0, At, B0); PG8_BAR; PG8_SCHED;
            PG8_STAGE(PG8_SB(1, 1), b3 + hstep, voffB);
            PG8_WAIT_V(6); PG8_BAR; PG8_MMA(1, 1, At, B1); PG8_BAR;
        }
        PG8_STAMP();
        if constexpr (!Epi::AFTER_DRAIN) { E(acc, cur, wr, wc, fr, fq); S.done(cur); }
        PG8_STAMP();
        if (!has_next) break;
#pragma unroll
        for (int a = 0; a < 2; ++a)
#pragma unroll
            for (int b = 0; b < 2; ++b)
#pragma unroll
                for (int m = 0; m < 4; ++m)
#pragma unroll
                    for (int n = 0; n < 2; ++n) acc[a][b][m][n] = (f32x4){0.f, 0.f, 0.f, 0.f};
        cur = nxt; cA = nA; cB = nB; ++ui;
    }
    PG8_WAIT_V(0);
    if (wr == 0) PG8_BAR;
    PG8_BAR;
    if constexpr (Epi::AFTER_DRAIN) { E.fused(acc, cur, wr, wc, fr, fq, lds, wid, lane); S.done(cur); }
    PG8_STAMP();
    if (STAMP && wid == 0) { stamps[lane] = lane < nts ? (((unsigned long long)(unsigned)ts_hi << 32) | (unsigned)ts_lo) : 0ull;
        if (lane == 62) stamps[62] = rt_entry; if (lane == 63) stamps[63] = (unsigned long long)wall_clock64(); }
#undef PG8_STAMP
#undef PG8_SA
#undef PG8_SB
#undef PG8_STAGE
#undef PG8_LDA
#undef PG8_LDB
#undef PG8_MMA
#undef PG8_WAIT_V
#undef PG8_WAIT_L
#undef PG8_BAR
#undef PG8_SCHED
}
}

using namespace pg8;
#define LAS __attribute__((address_space(3)))
typedef short s16x4 __attribute__((ext_vector_type(4)));
typedef short v4i16_t __attribute__((ext_vector_type(4)));
typedef float f32x16 __attribute__((ext_vector_type(16)));
typedef unsigned u32x2 __attribute__((ext_vector_type(2)));
typedef float f32x2v __attribute__((ext_vector_type(2)));

#ifndef NREP_S5
#define NREP_S5 1
#endif
#ifndef NREP_B2
#define NREP_B2 1
#endif
#ifndef NREP_P0
#define NREP_P0 1
#endif
#ifndef MK_PER_PHASE
#define MK_PER_PHASE 0
#endif

constexpr int NTOK = 65536, SEQL = 2048;
constexpr float EPSN = 1e-6f;
constexpr int LDS_BYTES = 155648;
constexpr int S5_WL = 25088;
constexpr int ATT_OFF = 4 * S5_WL;
constexpr int VSTR = 192;
constexpr int ATT_WL = 32 * VSTR;
constexpr int CTR_OFF = LDS_BYTES - 256;
static_assert(ATT_OFF + 8 * ATT_WL <= CTR_OFF, "lds");

constexpr size_t OFF_WIN = 0;
constexpr size_t OFF_WGLU = OFF_WIN + 2ull * 7168 * 1024 * 2;
constexpr size_t OFF_WATT = OFF_WGLU + 2ull * 2048 * 512 * 2;
constexpr size_t OFF_WPW2 = OFF_WATT + 2ull * 1024 * 512 * 2;
constexpr size_t OFF_WOUT = OFF_WPW2 + 2ull * 1024 * 512 * 2;
constexpr size_t OFF_WF1 = OFF_WOUT + 2ull * 1024 * 1024 * 2;
constexpr size_t OFF_WF2 = OFF_WF1 + 2ull * 5632 * 1024 * 2;
constexpr size_t OFF_S5BB = OFF_WF2 + 2ull * 1024 * 2816 * 2;
constexpr size_t OFF_S5CM = OFF_S5BB + 2ull * 32 * 128 * 16 * 2;
constexpr size_t OFF_S5A = OFF_S5CM + 2ull * 32 * 16 * 128 * 2;
constexpr size_t OFF_CONVW = OFF_S5A + 2ull * 32 * 64 * 8;
constexpr size_t OFF_CTL = OFF_CONVW + 65536;
constexpr size_t OFF_RSQ1 = OFF_CTL + 16384;
constexpr size_t OFF_RSQ2 = OFF_RSQ1 + 65536ull * 8;
constexpr size_t OFF_LSE = OFF_RSQ2 + 65536ull * 8;
constexpr size_t OFF_XB = OFF_LSE + 2ull * 65536 * 8 * 4;
constexpr size_t OFF_G = OFF_XB + 65536ull * 1024 * 2;
constexpr size_t OFF_QO = OFF_G + 65536ull * 3072 * 2;
constexpr size_t OFF_CG = OFF_QO + 65536ull * 1536 * 2;
constexpr size_t OFF_HC = OFF_CG + 65536ull * 512 * 2;
constexpr size_t OFF_OC = OFF_HC + 65536ull * 512 * 2;
constexpr size_t WS_END = OFF_OC + 65536ull * 512 * 2;
constexpr size_t DO_U = 0, DO_K = 64ull << 20, DO_V = 128ull << 20, DO_Y = 192ull << 20, DO_MG = 64ull << 20;

struct Params {
    const float* in[24];
    float* out; unsigned char* ws;
    int ph_lo, ph_hi;
};
enum { I_X = 0, I_N1G, I_WIN, I_BGATE, I_LRE, I_LIM, I_LOGDT, I_BRE, I_BIM, I_CRE, I_CIM, I_SSMD, I_WGLU, I_WATT, I_CONVW, I_CONVB, I_LNG, I_LNB, I_WPW2, I_WOUT, I_N2G, I_WF1, I_WF2, I_FING };

__device__ __forceinline__ float bf_lo(unsigned u) { return __uint_as_float(u << 16); }
__device__ __forceinline__ float bf_hi(unsigned u) { return __uint_as_float(u & 0xffff0000u); }
__device__ __forceinline__ float sigm(float x) { return __builtin_amdgcn_rcpf(1.f + __expf(-x)); }
__device__ __forceinline__ unsigned short f2bf(float f) { unsigned u = __float_as_uint(f); u += 0x7FFFu + ((u >> 16) & 1u); return (unsigned short)(u >> 16); }
__device__ __forceinline__ float wave_sum(float v) {
#pragma unroll
    for (int o = 1; o < 64; o <<= 1) v += __shfl_xor(v, o);
    return v;
}
__device__ __forceinline__ s16x4 vtr(const LAS unsigned char* p) { return __builtin_bit_cast(s16x4, __builtin_amdgcn_ds_read_tr16_b64_v4i16((LAS v4i16_t*)p)); }

__device__ __forceinline__ u32x4 pack8(const f32x4 a, const f32x4 b) { u32x4 w; w.x = cvt_pk_bf16(a[0], a[1]); w.y = cvt_pk_bf16(a[2], a[3]); w.z = cvt_pk_bf16(b[0], b[1]); w.w = cvt_pk_bf16(b[2], b[3]); return w; }
__device__ __forceinline__ void unpack8(const u32x4 w, f32x4& a, f32x4& b) { a[0] = bf_lo(w.x); a[1] = bf_hi(w.x); a[2] = bf_lo(w.y); a[3] = bf_hi(w.y); b[0] = bf_lo(w.z); b[1] = bf_hi(w.z); b[2] = bf_lo(w.w); b[3] = bf_hi(w.w); }

struct EpiIn {
    static constexpr bool PERM = true, AFTER_DRAIN = false;
    bf16_t *U, *QO, *Kb, *Vb, *CG, *G; const float* rowsq; const float* bgate;
    __device__ __forceinline__ void operator()(const f32x4 (&acc)[2][2][4][2], const Unit& u, int wr, int wc, int fr, int fq) const {
        const int row0 = u.pm * 256 + wr * 64 + fr, cl = wc * 32 + 8 * fq, pn = u.pn;
        if (pn < 12) {
            bf16_t* base; int ld, col0;
            if (pn < 2) { base = U; ld = 512; col0 = pn * 256; }
            else if (pn < 8) { base = QO; ld = 1536; col0 = (pn - 2) * 256; }
            else if (pn < 10) { base = Kb; ld = 512; col0 = (pn - 8) * 256; }
            else { base = Vb; ld = 512; col0 = (pn - 10) * 256; }
#pragma unroll
            for (int ai = 0; ai < 2; ++ai)
#pragma unroll
                for (int m = 0; m < 4; ++m) { const int r = row0 + ai * 128 + m * 16; const float rs = rowsq[r];
#pragma unroll
                    for (int bj = 0; bj < 2; ++bj) *(u32x4*)(base + (size_t)r * ld + col0 + bj * 128 + cl) = pack8(acc[ai][bj][m][0] * rs, acc[ai][bj][m][1] * rs); }
        } else if (pn < 16) {
            const int c0 = (pn - 12) * 128 + cl;
#pragma unroll
            for (int ai = 0; ai < 2; ++ai)
#pragma unroll
                for (int m = 0; m < 4; ++m) { const int r = row0 + ai * 128 + m * 16; const float rs = rowsq[r];
                    f32x4 o[2];
#pragma unroll
                    for (int n = 0; n < 2; ++n)
#pragma unroll
                        for (int j = 0; j < 4; ++j) o[n][j] = acc[ai][0][m][n][j] * rs * sigm(acc[ai][1][m][n][j] * rs);
                    *(u32x4*)(CG + (size_t)r * 512 + c0) = pack8(o[0], o[1]); }
        } else {
            const int c0 = (pn - 16) * 256 + cl;
            f32x4 bv[2][2];
#pragma unroll
            for (int bj = 0; bj < 2; ++bj)
#pragma unroll
                for (int n = 0; n < 2; ++n) bv[bj][n] = *(const f32x4*)(bgate + c0 + bj * 128 + 4 * n);
#pragma unroll
            for (int ai = 0; ai < 2; ++ai)
#pragma unroll
                for (int m = 0; m < 4; ++m) { const int r = row0 + ai * 128 + m * 16; const float rs = rowsq[r];
#pragma unroll
                    for (int bj = 0; bj < 2; ++bj) { f32x4 o[2];
#pragma unroll
                        for (int n = 0; n < 2; ++n)
#pragma unroll
                            for (int j = 0; j < 4; ++j) o[n][j] = sigm(acc[ai][bj][m][n][j] * rs + bv[bj][n][j]);
                        *(u32x4*)(G + (size_t)r * 3072 + c0 + bj * 128) = pack8(o[0], o[1]); } }
        }
    }
};
struct EpiGluMerge {
    static constexpr bool PERM = true, AFTER_DRAIN = false;
    bf16_t* Mg; const bf16_t* G;
    __device__ __forceinline__ void operator()(const f32x4 (&acc)[2][2][4][2], const Unit& u, int wr, int wc, int fr, int fq) const {
        const int row0 = u.pm * 256 + wr * 64 + fr, c0 = u.pn * 128 + wc * 32 + 8 * fq;
#pragma unroll
        for (int ai = 0; ai < 2; ++ai)
#pragma unroll
            for (int m = 0; m < 4; ++m) { const int r = row0 + ai * 128 + m * 16;
                f32x4 g0, g1; unpack8(*(const u32x4*)(G + (size_t)r * 3072 + c0), g0, g1);
                f32x4 o[2];
#pragma unroll
                for (int j = 0; j < 4; ++j) { o[0][j] = g0[j] * acc[ai][0][m][0][j] * sigm(acc[ai][1][m][0][j]); o[1][j] = g1[j] * acc[ai][0][m][1][j] * sigm(acc[ai][1][m][1][j]); }
                *(u32x4*)(Mg + (size_t)r * 1024 + c0) = pack8(o[0], o[1]); }
    }
};
struct EpiAccMerge {
    static constexpr bool PERM = true, AFTER_DRAIN = false;
    bf16_t* Mg; const bf16_t* G; int gate_off;
    __device__ __forceinline__ void operator()(const f32x4 (&acc)[2][2][4][2], const Unit& u, int wr, int wc, int fr, int fq) const {
        const int row0 = u.pm * 256 + wr * 64 + fr, cb = u.pn * 256 + wc * 32 + 8 * fq;
#pragma unroll
        for (int ai = 0; ai < 2; ++ai)
#pragma unroll
            for (int m = 0; m < 4; ++m) { const int r = row0 + ai * 128 + m * 16;
#pragma unroll
                for (int bj = 0; bj < 2; ++bj) { const int c0 = cb + bj * 128;
                    f32x4 g0, g1, m0, m1; unpack8(*(const u32x4*)(G + (size_t)r * 3072 + gate_off + c0), g0, g1); unpack8(*(const u32x4*)(Mg + (size_t)r * 1024 + c0), m0, m1);
                    *(u32x4*)(Mg + (size_t)r * 1024 + c0) = pack8(m0 + g0 * acc[ai][bj][m][0], m1 + g1 * acc[ai][bj][m][1]); } }
    }
};
struct EpiDelta {
    static constexpr bool PERM = true, AFTER_DRAIN = false;
    bf16_t* D;
    __device__ __forceinline__ void operator()(const f32x4 (&acc)[2][2][4][2], const Unit& u, int wr, int wc, int fr, int fq) const {
        const int row0 = u.pm * 256 + wr * 64 + fr, cb = u.pn * 256 + wc * 32 + 8 * fq;
#pragma unroll
        for (int ai = 0; ai < 2; ++ai)
#pragma unroll
            for (int m = 0; m < 4; ++m)
#pragma unroll
                for (int bj = 0; bj < 2; ++bj) *(u32x4*)(D + (size_t)(row0 + ai * 128 + m * 16) * 1024 + cb + bj * 128) = pack8(acc[ai][bj][m][0], acc[ai][bj][m][1]);
    }
};
struct EpiFfn1 {
    static constexpr bool PERM = true, AFTER_DRAIN = false;
    bf16_t* Hf;
    __device__ __forceinline__ void operator()(const f32x4 (&acc)[2][2][4][2], const Unit& u, int wr, int wc, int fr, int fq) const {
        const int row0 = u.pm * 256 + wr * 64 + fr, c0 = u.pn * 128 + wc * 32 + 8 * fq;
#pragma unroll
        for (int ai = 0; ai < 2; ++ai)
#pragma unroll
            for (int m = 0; m < 4; ++m) { const int r = row0 + ai * 128 + m * 16;
                f32x4 o[2];
#pragma unroll
                for (int n = 0; n < 2; ++n)
#pragma unroll
                    for (int j = 0; j < 4; ++j) { const float a = acc[ai][0][m][n][j], b = acc[ai][1][m][n][j]; o[n][j] = a * sigm(a) * b; }
                *(u32x4*)(Hf + (size_t)r * 2816 + c0) = pack8(o[0], o[1]); }
    }
};

__device__ __forceinline__ void p0_tr_item(const float* W, int K, int N, bf16_t* WT, int kb, int nd0, int ns0, const float* gk, float scale, LAS float* scr, int lane) {
    const int k0 = 64 * kb;
#pragma unroll 8
    for (int i = 0; i < 32; ++i) { const int kk = 2 * i + (lane >> 5); float s = scale; if (gk) s *= gk[k0 + kk]; scr[kk * 33 + (lane & 31)] = W[(size_t)(k0 + kk) * N + ns0 + (lane & 31)] * s; }
    asm volatile("" ::: "memory");
    const int c = lane & 7;
#pragma unroll
    for (int j = 0; j < 4; ++j) { const int n = (lane >> 3) + 8 * j; const LAS float* s = scr + (8 * c) * 33 + n;
        u32x4 o; o.x = cvt_pk_bf16(s[0 * 33], s[1 * 33]); o.y = cvt_pk_bf16(s[2 * 33], s[3 * 33]); o.z = cvt_pk_bf16(s[4 * 33], s[5 * 33]); o.w = cvt_pk_bf16(s[6 * 33], s[7 * 33]);
        *(u32x4*)(WT + (size_t)(nd0 + n) * K + k0 + 8 * c) = o; }
    asm volatile("" ::: "memory");
}
__device__ __forceinline__ void phase_p0(const Params& P, LAS unsigned char* lds, int wave, int lane, int tid) {
    unsigned char* ws = P.ws;
    const int gw = blockIdx.x * 8 + wave, NGW = gridDim.x * 8;
    LAS float* scr = (LAS float*)(lds + wave * 16384);
    constexpr int PER_L = 3584 + 512 + 256 + 256 + 512 + 2816 + 1408;
    for (int it = gw; it < 2 * PER_L; it += NGW) {
        const int l = it / PER_L; int r = it % PER_L;
        const float* W; bf16_t* WT; int K, N, type = 0; const float* gk = nullptr;
        if (r < 3584) { W = P.in[I_WIN] + (size_t)l * 1024 * 7168; WT = (bf16_t*)(ws + OFF_WIN) + (size_t)l * 7168 * 1024; K = 1024; N = 7168; type = 1; gk = P.in[I_N1G] + l * 1024; }
        else if ((r -= 3584) < 512) { W = P.in[I_WGLU] + (size_t)l * 512 * 2048; WT = (bf16_t*)(ws + OFF_WGLU) + (size_t)l * 2048 * 512; K = 512; N = 2048; type = 3; }
        else if ((r -= 512) < 256) { W = P.in[I_WATT] + (size_t)l * 512 * 1024; WT = (bf16_t*)(ws + OFF_WATT) + (size_t)l * 1024 * 512; K = 512; N = 1024; }
        else if ((r -= 256) < 256) { W = P.in[I_WPW2] + (size_t)l * 512 * 1024; WT = (bf16_t*)(ws + OFF_WPW2) + (size_t)l * 1024 * 512; K = 512; N = 1024; }
        else if ((r -= 256) < 512) { W = P.in[I_WOUT] + (size_t)l * 1024 * 1024; WT = (bf16_t*)(ws + OFF_WOUT) + (size_t)l * 1024 * 1024; K = 1024; N = 1024; }
        else if ((r -= 512) < 2816) { W = P.in[I_WF1] + (size_t)l * 1024 * 5632; WT = (bf16_t*)(ws + OFF_WF1) + (size_t)l * 5632 * 1024; K = 1024; N = 5632; type = 2; gk = P.in[I_N2G] + l * 1024; }
        else { r -= 2816; W = P.in[I_WF2] + (size_t)l * 2816 * 1024; WT = (bf16_t*)(ws + OFF_WF2) + (size_t)l * 1024 * 2816; K = 2816; N = 1024; }
        const int nblk = N / 32, kb = r / nblk, nd0 = (r % nblk) * 32;
        int ns0 = nd0; float scale = 1.f;
        if (type == 1) { if (nd0 >= 3072 && nd0 < 4096) { const int t = nd0 - 3072, j = t & 255; ns0 = 3072 + (t >> 8) * 128 + (j & 127) + (j >= 128 ? 512 : 0); }
                         if (nd0 >= 512 && nd0 < 2048) scale = 0.125f * 1.4426950408889634f; }
        else if (type == 2) { const int j = nd0 & 255; ns0 = (nd0 >> 8) * 128 + (j & 127) + (j >= 128 ? 2816 : 0); }
        else if (type == 3) { const int j = nd0 & 255; ns0 = (nd0 >> 8) * 128 + (j & 127) + (j >= 128 ? 1024 : 0); }
        p0_tr_item(W, K, N, WT, kb, nd0, ns0, gk, scale, scr, lane);
    }
    { const float* x = P.in[I_X]; bf16_t* xb = (bf16_t*)(ws + OFF_XB); bf16_t* xn = (bf16_t*)(ws + OFF_HC);
      for (int row = gw; row < NTOK; row += NGW) { float ss = 0.f; f32x4 v[4];
#pragma unroll
          for (int j = 0; j < 4; ++j) { const f32x4 t = *(const f32x4*)(x + (size_t)row * 1024 + 4 * lane + 256 * j); u32x2 w; w.x = cvt_pk_bf16(t[0], t[1]); w.y = cvt_pk_bf16(t[2], t[3]);
              *(u32x2*)(xb + (size_t)row * 1024 + 4 * lane + 256 * j) = w; v[j][0] = bf_lo(w.x); v[j][1] = bf_hi(w.x); v[j][2] = bf_lo(w.y); v[j][3] = bf_hi(w.y);
              ss += v[j][0] * v[j][0] + v[j][1] * v[j][1] + v[j][2] * v[j][2] + v[j][3] * v[j][3]; }
          ss = wave_sum(ss); const float rs = rsqrtf(ss * (1.f / 1024.f) + EPSN); if (lane == 0) ((float*)(ws + OFF_RSQ1))[row] = rs;
#pragma unroll
          for (int j = 0; j < 4; ++j) { u32x2 w; w.x = cvt_pk_bf16(v[j][0] * rs, v[j][1] * rs); w.y = cvt_pk_bf16(v[j][2] * rs, v[j][3] * rs); *(u32x2*)(xn + (size_t)row * 1024 + 4 * lane + 256 * j) = w; } } }
    const int gt = blockIdx.x * 512 + tid, NGT = gridDim.x * 512;
    for (int idx = gt; idx < 2 * 32 * 64; idx += NGT) {
        const int lg = idx >> 6, p = idx & 63;
        const float lre = P.in[I_LRE][idx], lim = P.in[I_LIM][idx], dt = expf(P.in[I_LOGDT][lg]);
        const float mag = expf(lre * dt);
        const double rev = (double)lim * (double)dt * 0.15915494309189535; const float frc = (float)(rev - rint(rev));
        const float sn = __builtin_amdgcn_sinf(frc), cs = __builtin_amdgcn_cosf(frc);
        const float are = mag * cs, aim = mag * sn, nr = are - 1.f, ni = aim, den = lre * lre + lim * lim;
        const float zre = (nr * lre + ni * lim) / den, zim = (ni * lre - nr * lim) / den;
        { f32x2v t2; t2.x = are; t2.y = aim; ((f32x2v*)(ws + OFF_S5A))[idx] = t2; }
        bf16_t* bbt = (bf16_t*)(ws + OFF_S5BB) + (size_t)lg * 128 * 16; bf16_t* cm = (bf16_t*)(ws + OFF_S5CM) + (size_t)lg * 16 * 128;
        for (int h = 0; h < 16; ++h) { const float br = P.in[I_BRE][(size_t)idx * 16 + h], bi = P.in[I_BIM][(size_t)idx * 16 + h];
            bbt[p * 16 + h] = f2bf(zre * br - zim * bi); bbt[(64 + p) * 16 + h] = f2bf(zre * bi + zim * br);
            cm[h * 128 + p] = f2bf(P.in[I_CRE][((size_t)lg * 16 + h) * 64 + p]); cm[h * 128 + 64 + p] = f2bf(-P.in[I_CIM][((size_t)lg * 16 + h) * 64 + p]); }
    }
    for (int idx = gt; idx < 2 * 31 * 256; idx += NGT) { const float a = P.in[I_CONVW][2 * idx], b = P.in[I_CONVW][2 * idx + 1]; ((unsigned*)(ws + OFF_CONVW))[idx] = cvt_pk_bf16(a, b); }
}
template <bool FINAL> __device__ __forceinline__ void phase_rows(const Params& P, int wave, int lane) {
    const int gw = blockIdx.x * 8 + wave, NGW = gridDim.x * 8;
    bf16_t* xb = (bf16_t*)(P.ws + OFF_XB); const bf16_t* D = (const bf16_t*)(P.ws + OFF_QO); bf16_t* xn = (bf16_t*)(P.ws + OFF_HC); const float* fg = P.in[I_FING];
    for (int row = gw; row < NTOK; row += NGW) {
        const size_t o0 = (size_t)row * 1024 + 8 * lane, o1 = o0 + 512;
        const u32x4 w0 = *(const u32x4*)(xb + o0), w1 = *(const u32x4*)(xb + o1), d0 = *(const u32x4*)(D + o0), d1 = *(const u32x4*)(D + o1);
        f32x4 a0, a1, b0, b1, e0, e1, g0, g1; unpack8(w0, a0, a1); unpack8(w1, b0, b1); unpack8(d0, e0, e1); unpack8(d1, g0, g1);
        const u32x4 n0 = pack8(a0 + e0, a1 + e1), n1 = pack8(b0 + g0, b1 + g1);
        unpack8(n0, a0, a1); unpack8(n1, b0, b1);
        float ss = 0.f;
#pragma unroll
        for (int j = 0; j < 4; ++j) ss += a0[j] * a0[j] + a1[j] * a1[j] + b0[j] * b0[j] + b1[j] * b1[j];
        ss = wave_sum(ss);
        const float rs = rsqrtf(ss * (1.f / 1024.f) + EPSN);
        if (!FINAL) { if (lane == 0) ((float*)(P.ws + OFF_RSQ1))[row] = rs; *(u32x4*)(xb + o0) = n0; *(u32x4*)(xb + o1) = n1; *(u32x4*)(xn + o0) = pack8(a0 * rs, a1 * rs); *(u32x4*)(xn + o1) = pack8(b0 * rs, b1 * rs); }
        else { const f32x4 q0 = *(const f32x4*)(fg + 8 * lane), q1 = *(const f32x4*)(fg + 8 * lane + 4), q2 = *(const f32x4*)(fg + 512 + 8 * lane), q3 = *(const f32x4*)(fg + 512 + 8 * lane + 4);
            float* o = P.out + (size_t)row * 1024;
            *(f32x4*)(o + 8 * lane) = a0 * q0 * rs; *(f32x4*)(o + 8 * lane + 4) = a1 * q1 * rs; *(f32x4*)(o + 512 + 8 * lane) = b0 * q2 * rs; *(f32x4*)(o + 512 + 8 * lane + 4) = b1 * q3 * rs; }
    }
}

__device__ __forceinline__ void s5_item(const Params& P, int l, int it, LAS unsigned char* wl, int lane) {
    const int b = it >> 5, g = it & 31, lg = l * 32 + g;
    LAS float* bu = (LAS float*)wl; LAS unsigned char* sl = wl + 16384;
    const int c32 = lane & 31, hi = lane >> 5, fr = lane & 15, fq = lane >> 4;
    const bf16_t* bbt = (const bf16_t*)(P.ws + OFF_S5BB) + (size_t)lg * 128 * 16; const bf16_t* cm = (const bf16_t*)(P.ws + OFF_S5CM) + (size_t)lg * 16 * 128;
    bf16x8 bbreg[4], cmreg[4];
#pragma unroll
    for (int j = 0; j < 4; ++j) { bbreg[j] = *(const bf16x8*)(bbt + (32 * j + c32) * 16 + 8 * hi); cmreg[j] = *(const bf16x8*)(cm + fr * 128 + 32 * j + 8 * fq); }
    const f32x2v av = ((const f32x2v*)(P.ws + OFF_S5A))[lg * 64 + lane]; const float a_re = av.x, a_im = av.y;
    const float dsk = P.in[I_SSMD][l * 512 + g * 16 + fr];
    float s_re = 0.f, s_im = 0.f;
    const bf16_t* Ub = (const bf16_t*)((unsigned char*)P.out + DO_U) + (size_t)b * SEQL * 512 + g * 16; bf16_t* Yb = (bf16_t*)((unsigned char*)P.out + DO_Y) + (size_t)b * SEQL * 512 + g * 16;
    for (int c = 0; c < 64; ++c) {
        const int t0 = c * 32;
        const bf16x8 ureg = *(const bf16x8*)(Ub + (size_t)(t0 + c32) * 512 + 8 * hi);
        unsigned short uep[2][4];
#pragma unroll
        for (int mt = 0; mt < 2; ++mt)
#pragma unroll
            for (int i = 0; i < 4; ++i) uep[mt][i] = Ub[(size_t)(t0 + 16 * mt + 4 * fq + i) * 512 + fr];
#pragma unroll
        for (int j = 0; j < 4; ++j) { f32x16 a;
#pragma unroll
            for (int r = 0; r < 16; ++r) a[r] = 0.f;
            a = __builtin_amdgcn_mfma_f32_32x32x16_bf16(ureg, bbreg[j], a, 0, 0, 0);
#pragma unroll
            for (int r = 0; r < 16; ++r) { const int tok = (r & 3) + 8 * (r >> 2) + 4 * hi; bu[tok * 128 + ((32 * (j & 1) + c32) << 1) + (j >> 1)] = a[r]; } }
        asm volatile("" ::: "memory");
#pragma unroll 8
        for (int t = 0; t < 32; ++t) { const f32x2v v = *(const LAS f32x2v*)(bu + t * 128 + 2 * lane);
            const float nre = fmaf(a_re, s_re, fmaf(-a_im, s_im, v.x)), nim = fmaf(a_re, s_im, fmaf(a_im, s_re, v.y)); s_re = nre; s_im = nim;
            *(LAS unsigned short*)(sl + t * 272 + lane * 2) = f2bf(s_re); *(LAS unsigned short*)(sl + t * 272 + 128 + lane * 2) = f2bf(s_im); }
        asm volatile("" ::: "memory");
#pragma unroll
        for (int mt = 0; mt < 2; ++mt) { f32x4 ya = {0.f, 0.f, 0.f, 0.f};
#pragma unroll
            for (int ks = 0; ks < 4; ++ks) { const bf16x8 a = *(const LAS bf16x8*)(sl + (16 * mt + fr) * 272 + (32 * ks + 8 * fq) * 2); ya = __builtin_amdgcn_mfma_f32_16x16x32_bf16(a, cmreg[ks], ya, 0, 0, 0); }
#pragma unroll
            for (int i = 0; i < 4; ++i) { const float y = ya[i] + dsk * __uint_as_float((unsigned)uep[mt][i] << 16);
                const float ge = y * sigm(1.5957691216057308f * (y + 0.044715f * y * y * y));
                Yb[(size_t)(t0 + 16 * mt + 4 * fq + i) * 512 + fr] = f2bf(ge); } }
        asm volatile("" ::: "memory");
    }
}

template <int PAT> __device__ __forceinline__ void attn_item(const Params& P, int it, LAS unsigned char* vl, int lane) {
    constexpr int d = PAT == 0 ? 1 : (PAT == 1 ? 4 : 16);
    constexpr int ngrp = (SEQL / d) / 32;
    constexpr int KSTR = 144;
    const int j = it % ngrp; int t = it / ngrp; const int r = t % d; t /= d; const int h = t & 7, b = t >> 3;
    const int c32 = lane & 31, hi = lane >> 5, i0 = 32 * j;
    const int lrow = lane >> 3, lch = lane & 7;
    const size_t tokbase = (size_t)b * SEQL;
    bf16_t* QO = (bf16_t*)(P.ws + OFF_QO); const bf16_t* Kb = (const bf16_t*)((unsigned char*)P.out + DO_K); const bf16_t* Vb = (const bf16_t*)((unsigned char*)P.out + DO_V);
    float* LSE = (float*)(P.ws + OFF_LSE);
    const unsigned char* qrow0 = (const unsigned char*)QO + ((tokbase + (size_t)i0 * d + r) * 1536 + PAT * 512 + h * 64) * 2;
    const unsigned char* krow0 = (const unsigned char*)Kb + ((tokbase + (size_t)(i0 - 128) * d + r) * 512 + h * 64) * 2;
    const unsigned char* vrow0 = (const unsigned char*)Vb + ((tokbase + (size_t)(i0 - 128) * d + r) * 512 + h * 64) * 2;
    const unsigned qlo = (unsigned)(lrow * d * 3072 + lch * 16), klo = (unsigned)(lrow * d * 1024 + lch * 16);
    u32x4 qraw[4], kraw[5][4];
#pragma unroll
    for (int i4 = 0; i4 < 4; ++i4) qraw[i4] = *(const u32x4*)(qrow0 + (qlo + (unsigned)(8 * i4 * d * 3072)));
#pragma unroll
    for (int kt = 0; kt < 5; ++kt) { const int kb = i0 - 128 + 32 * kt;
        if (kb >= 0) {
#pragma unroll
            for (int i4 = 0; i4 < 4; ++i4) kraw[kt][i4] = *(const u32x4*)(krow0 + (klo + (unsigned)((32 * kt + 8 * i4) * d * 1024))); } }
    bf16x8 qreg[4];
#pragma unroll
    for (int i4 = 0; i4 < 4; ++i4) *(LAS u32x4*)(vl + (lrow + 8 * i4) * KSTR + lch * 16) = qraw[i4];
    asm volatile("" ::: "memory");
#pragma unroll
    for (int ks = 0; ks < 4; ++ks) qreg[ks] = *(const LAS bf16x8*)(vl + c32 * KSTR + (16 * ks + 8 * hi) * 2);
    asm volatile("" ::: "memory");
    f32x16 s[5];
#pragma unroll
    for (int kt = 0; kt < 5; ++kt) { const int kb = i0 - 128 + 32 * kt;
        f32x16 a;
        if (kb >= 0) {
#pragma unroll
            for (int q = 0; q < 16; ++q) a[q] = 0.f;
#pragma unroll
            for (int i4 = 0; i4 < 4; ++i4) *(LAS u32x4*)(vl + (lrow + 8 * i4) * KSTR + lch * 16) = kraw[kt][i4];
            asm volatile("" ::: "memory");
#pragma unroll
            for (int ks = 0; ks < 4; ++ks) { const bf16x8 kreg = *(const LAS bf16x8*)(vl + c32 * KSTR + (16 * ks + 8 * hi) * 2); a = __builtin_amdgcn_mfma_f32_32x32x16_bf16(kreg, qreg[ks], a, 0, 0, 0); }
            asm volatile("" ::: "memory");
        } else {
#pragma unroll
            for (int q = 0; q < 16; ++q) a[q] = (-__builtin_inff());
        }
        s[kt] = a; }
    u32x4 vreg[5][4];
#pragma unroll
    for (int kt = 0; kt < 3; ++kt) { const int kb = i0 - 128 + 32 * kt;
        if (kb >= 0) {
#pragma unroll
            for (int i4 = 0; i4 < 4; ++i4) vreg[kt][i4] = *(const u32x4*)(vrow0 + (klo + (unsigned)((32 * kt + 8 * i4) * d * 1024))); } }
#pragma unroll
    for (int q = 0; q < 16; ++q) { const int kr = (q & 3) + 8 * (q >> 2) + 4 * hi; if (kr < c32) s[0][q] = (-__builtin_inff()); if (kr > c32) s[4][q] = (-__builtin_inff()); }
    float mx = (-__builtin_inff());
#pragma unroll
    for (int kt = 0; kt < 5; ++kt)
#pragma unroll
        for (int q = 0; q < 16; ++q) mx = fmaxf(mx, s[kt][q]);
    mx = fmaxf(mx, __shfl_xor(mx, 32));
    float den = 0.f;
#pragma unroll
    for (int kt = 0; kt < 5; ++kt)
#pragma unroll
        for (int q = 0; q < 16; ++q) { const float p = __builtin_amdgcn_exp2f(s[kt][q] - mx); s[kt][q] = p; den += p; }
    den += __shfl_xor(den, 32);
    u32x4 pw[5][2];
#pragma unroll
    for (int kt = 0; kt < 5; ++kt)
#pragma unroll
        for (int ks2 = 0; ks2 < 2; ++ks2) { pw[kt][ks2].x = cvt_pk_bf16(s[kt][8 * ks2 + 0], s[kt][8 * ks2 + 1]); pw[kt][ks2].y = cvt_pk_bf16(s[kt][8 * ks2 + 2], s[kt][8 * ks2 + 3]);
            pw[kt][ks2].z = cvt_pk_bf16(s[kt][8 * ks2 + 4], s[kt][8 * ks2 + 5]); pw[kt][ks2].w = cvt_pk_bf16(s[kt][8 * ks2 + 6], s[kt][8 * ks2 + 7]); }
#pragma unroll
    for (int kt = 3; kt < 5; ++kt) { const int kb = i0 - 128 + 32 * kt;
        if (kb >= 0) {
#pragma unroll
            for (int i4 = 0; i4 < 4; ++i4) vreg[kt][i4] = *(const u32x4*)(vrow0 + (klo + (unsigned)((32 * kt + 8 * i4) * d * 1024))); } }
    u32x4 mraw[2][4]; float l2b = 0.f, l2c = 0.f;
    if (PAT == 0) {
#pragma unroll
        for (int pp = 0; pp < 2; ++pp)
#pragma unroll
            for (int i4 = 0; i4 < 4; ++i4) mraw[pp][i4] = *(const u32x4*)(qrow0 + (qlo + (unsigned)(8 * i4 * 3072 + (pp + 1) * 1024)));
        l2b = LSE[((size_t)(0 * 32 + b) * 8 + h) * SEQL + i0 + c32]; l2c = LSE[((size_t)(1 * 32 + b) * 8 + h) * SEQL + i0 + c32];
    }
    f32x16 o[2];
#pragma unroll
    for (int q = 0; q < 16; ++q) { o[0][q] = 0.f; o[1][q] = 0.f; }
    const int gi = lane >> 4, li = lane & 15;
    const LAS unsigned char* vrd = vl + (4 * hi + (li >> 2)) * VSTR + (16 * (gi & 1) + 4 * (li & 3)) * 2;
#pragma unroll
    for (int kt = 0; kt < 5; ++kt) { const int kb = i0 - 128 + 32 * kt;
        if (kb >= 0) {
#pragma unroll
            for (int i4 = 0; i4 < 4; ++i4) *(LAS u32x4*)(vl + (lrow + 8 * i4) * VSTR + lch * 16) = vreg[kt][i4];
            asm volatile("" ::: "memory");
#pragma unroll
            for (int ks2 = 0; ks2 < 2; ++ks2) {
                const bf16x8 pb = __builtin_bit_cast(bf16x8, pw[kt][ks2]);
#pragma unroll
                for (int mt = 0; mt < 2; ++mt) { const LAS unsigned char* a1 = vrd + (16 * ks2) * VSTR + 64 * mt;
                    const s16x4 lo = vtr(a1), up = vtr(a1 + 8 * VSTR);
                    bf16x8 av; av[0] = lo[0]; av[1] = lo[1]; av[2] = lo[2]; av[3] = lo[3]; av[4] = up[0]; av[5] = up[1]; av[6] = up[2]; av[7] = up[3];
                    o[mt] = __builtin_amdgcn_mfma_f32_32x32x16_bf16(av, pb, o[mt], 0, 0, 0); } }
            asm volatile("" ::: "memory");
        } }
    const float inv = __builtin_amdgcn_rcpf(den);
    const float l2 = mx + __builtin_amdgcn_logf(den);
    const LAS unsigned char* frd = vl + c32 * KSTR + 8 * hi;
    float w1 = inv;
    if (PAT == 0) {
        const float M = fmaxf(l2, fmaxf(l2b, l2c));
        float e1 = __builtin_amdgcn_exp2f(l2 - M), e2 = __builtin_amdgcn_exp2f(l2b - M), e3 = __builtin_amdgcn_exp2f(l2c - M);
        const float wi = __builtin_amdgcn_rcpf(e1 + e2 + e3); w1 = e1 * wi * inv; const float wo[2] = {e2 * wi, e3 * wi};
#pragma unroll
        for (int q = 0; q < 16; ++q) { o[0][q] *= w1; o[1][q] *= w1; }
#pragma unroll
        for (int pp = 0; pp < 2; ++pp) {
#pragma unroll
            for (int i4 = 0; i4 < 4; ++i4) *(LAS u32x4*)(vl + (lrow + 8 * i4) * KSTR + lch * 16) = mraw[pp][i4];
            asm volatile("" ::: "memory");
#pragma unroll
            for (int mt = 0; mt < 2; ++mt)
#pragma unroll
                for (int rg = 0; rg < 4; ++rg) { const u32x2 bb = *(const LAS u32x2*)(frd + 64 * mt + 16 * rg);
                    o[mt][4 * rg] += wo[pp] * bf_lo(bb.x); o[mt][4 * rg + 1] += wo[pp] * bf_hi(bb.x); o[mt][4 * rg + 2] += wo[pp] * bf_lo(bb.y); o[mt][4 * rg + 3] += wo[pp] * bf_hi(bb.y); }
            asm volatile("" ::: "memory");
        }
    } else {
#pragma unroll
        for (int q = 0; q < 16; ++q) { o[0][q] *= w1; o[1][q] *= w1; }
    }
#pragma unroll
    for (int mt = 0; mt < 2; ++mt)
#pragma unroll
        for (int rg = 0; rg < 4; ++rg) { u32x2 w; w.x = cvt_pk_bf16(o[mt][4 * rg], o[mt][4 * rg + 1]); w.y = cvt_pk_bf16(o[mt][4 * rg + 2], o[mt][4 * rg + 3]);
            *(LAS u32x2*)(vl + c32 * KSTR + 8 * hi + 64 * mt + 16 * rg) = w; }
    asm volatile("" ::: "memory");
    if (PAT != 0) {
#pragma unroll
        for (int i4 = 0; i4 < 4; ++i4) *(u32x4*)((unsigned char*)qrow0 + (qlo + (unsigned)(8 * i4 * d * 3072))) = *(const LAS u32x4*)(vl + (lrow + 8 * i4) * KSTR + lch * 16);
        if (hi == 0) LSE[((size_t)((PAT - 1) * 32 + b) * 8 + h) * SEQL + (size_t)(i0 + c32) * d + r] = l2;
    } else {
        bf16_t* OC = (bf16_t*)(P.ws + OFF_OC);
#pragma unroll
        for (int i4 = 0; i4 < 4; ++i4) *(u32x4*)(OC + (tokbase + (size_t)(i0 + lrow + 8 * i4)) * 512 + h * 64 + lch * 8) = *(const LAS u32x4*)(vl + (lrow + 8 * i4) * KSTR + lch * 16);
    }
    asm volatile("" ::: "memory");
}

__device__ __forceinline__ void conv_item(const Params& P, int l, int it, int lane) {
    const int b = it >> 8, t0 = (it & 255) * 8, ch0 = 8 * lane;
    const bf16_t* in = (const bf16_t*)(P.ws + OFF_CG) + (size_t)b * SEQL * 512 + ch0;
    const unsigned* cw = (const unsigned*)(P.ws + OFF_CONVW) + (size_t)l * 31 * 256 + 4 * lane;
    float acc[8][8], win[8][8];
    { const f32x4 b0 = *(const f32x4*)(P.in[I_CONVB] + l * 512 + ch0), b1 = *(const f32x4*)(P.in[I_CONVB] + l * 512 + ch0 + 4);
#pragma unroll
      for (int i = 0; i < 8; ++i) { acc[i][0] = b0[0]; acc[i][1] = b0[1]; acc[i][2] = b0[2]; acc[i][3] = b0[3]; acc[i][4] = b1[0]; acc[i][5] = b1[1]; acc[i][6] = b1[2]; acc[i][7] = b1[3]; } }
#define CONV_LOADROW(rr, dst) do { const int t_ = t0 - 30 + (rr); if (t_ >= 0) { const u32x4 v_ = *(const u32x4*)(in + (size_t)t_ * 512); \
        dst[0] = bf_lo(v_.x); dst[1] = bf_hi(v_.x); dst[2] = bf_lo(v_.y); dst[3] = bf_hi(v_.y); dst[4] = bf_lo(v_.z); dst[5] = bf_hi(v_.z); dst[6] = bf_lo(v_.w); dst[7] = bf_hi(v_.w); } \
        else { _Pragma("unroll") for (int c_ = 0; c_ < 8; ++c_) dst[c_] = 0.f; } } while (0)
#pragma unroll
    for (int rr = 0; rr < 8; ++rr) CONV_LOADROW(rr, win[rr]);
    for (int jb = 0; jb < 32; jb += 8) {
        asm volatile("" ::: "memory");
#pragma unroll
        for (int jj = 0; jj < 8; ++jj) { const int j = jb + jj;
            if (j < 31) { const u32x4 wv = *(const u32x4*)(cw + j * 256);
                float w[8]; w[0] = bf_lo(wv.x); w[1] = bf_hi(wv.x); w[2] = bf_lo(wv.y); w[3] = bf_hi(wv.y); w[4] = bf_lo(wv.z); w[5] = bf_hi(wv.z); w[6] = bf_lo(wv.w); w[7] = bf_hi(wv.w);
#pragma unroll
                for (int i = 0; i < 8; ++i)
#pragma unroll
                    for (int c = 0; c < 8; ++c) acc[i][c] = fmaf(w[c], win[(jj + i) & 7][c], acc[i][c]);
                if (j + 8 < 38) CONV_LOADROW(j + 8, win[jj]); } }
    }
#undef CONV_LOADROW
    const f32x4 g0 = *(const f32x4*)(P.in[I_LNG] + l * 512 + ch0), g1 = *(const f32x4*)(P.in[I_LNG] + l * 512 + ch0 + 4);
    const f32x4 e0 = *(const f32x4*)(P.in[I_LNB] + l * 512 + ch0), e1 = *(const f32x4*)(P.in[I_LNB] + l * 512 + ch0 + 4);
    bf16_t* outp = (bf16_t*)(P.ws + OFF_HC) + ((size_t)b * SEQL + t0) * 512 + ch0;
#pragma unroll
    for (int i = 0; i < 8; ++i) { float s1 = 0.f, s2 = 0.f;
#pragma unroll
        for (int c = 0; c < 8; ++c) { s1 += acc[i][c]; s2 += acc[i][c] * acc[i][c]; }
        s1 = wave_sum(s1); s2 = wave_sum(s2);
        const float mean = s1 * (1.f / 512.f), var = fmaxf(s2 * (1.f / 512.f) - mean * mean, 0.f), rs = rsqrtf(var + EPSN);
        f32x4 y0, y1;
#pragma unroll
        for (int c = 0; c < 4; ++c) { const float h0 = (acc[i][c] - mean) * rs * g0[c] + e0[c], h1 = (acc[i][4 + c] - mean) * rs * g1[c] + e1[c]; y0[c] = h0 * sigm(h0); y1[c] = h1 * sigm(h1); }
        *(u32x4*)(outp + (size_t)i * 512) = pack8(y0, y1); }
}

__device__ __forceinline__ int xcc_id() { return (int)(__builtin_amdgcn_s_getreg((3 << 11) | 20) & 7u); }
__device__ __forceinline__ int claim_issue(unsigned* ctr, int& lane) { asm volatile("" : "+v"(lane)); int v = 0; if (lane == 0) v = (int)atomicAdd(ctr, 1u); return v; }
__device__ __forceinline__ int lane_now() { int l = (int)__builtin_amdgcn_mbcnt_hi(~0u, __builtin_amdgcn_mbcnt_lo(~0u, 0u)); asm volatile("" : "+v"(l)); return l; }
__device__ __forceinline__ int lds_claim(LAS unsigned* ctr, int lane) { int v = 0; if (lane == 0) v = (int)__hip_atomic_fetch_add(ctr, 1u, __ATOMIC_RELAXED, __HIP_MEMORY_SCOPE_WORKGROUP); return __builtin_amdgcn_readfirstlane(v); }
__device__ __forceinline__ int claim(unsigned* ctr, int& lane) { asm volatile("" : "+v"(lane)); int v = 0; if (lane == 0) v = (int)atomicAdd(ctr, 1u); return __builtin_amdgcn_readfirstlane(v); }


__device__ __forceinline__ void grid_barrier(unsigned* bar, unsigned target, int tid) {
    asm volatile("s_waitcnt vmcnt(0) lgkmcnt(0)" ::: "memory");
    __syncthreads();
    if (tid == 0) {
        __builtin_amdgcn_fence(__ATOMIC_RELEASE, "agent");
        asm volatile("s_waitcnt vmcnt(0) lgkmcnt(0)" ::: "memory");
        __hip_atomic_fetch_add(bar, 1u, __ATOMIC_RELAXED, __HIP_MEMORY_SCOPE_AGENT);
        while (__hip_atomic_load(bar, __ATOMIC_RELAXED, __HIP_MEMORY_SCOPE_AGENT) < target) __builtin_amdgcn_s_sleep(2);
        __builtin_amdgcn_fence(__ATOMIC_ACQUIRE, "agent");
        asm volatile("s_waitcnt vmcnt(0) lgkmcnt(0)" ::: "memory");
    }
    __syncthreads();
}

constexpr int NPHASE = 21;
__global__ void __launch_bounds__(512, 2) fwd_kernel(Params P) {
    extern __shared__ __attribute__((aligned(16))) unsigned char shm[];
    LAS unsigned char* lds = (LAS unsigned char*)shm;
        unsigned char* ws = P.ws; unsigned char* dout = (unsigned char*)P.out;
    bf16_t* xb = (bf16_t*)(ws + OFF_XB); bf16_t* Gt = (bf16_t*)(ws + OFF_G); bf16_t* Mg = (bf16_t*)(dout + DO_MG);
    bf16_t* xn = (bf16_t*)(ws + OFF_HC); bf16_t* Dl = (bf16_t*)(ws + OFF_QO);
    unsigned* ctl = (unsigned*)(ws + OFF_CTL);
    StaticOrder S;
    unsigned nbar = 0;
    const int wave_s = __builtin_amdgcn_readfirstlane((int)threadIdx.x >> 6);
    if (P.ph_hi - P.ph_lo > 1) cg::this_grid().sync();
    for (int ph = P.ph_lo; ph < P.ph_hi; ++ph) {
        const int wave = wave_s;
#define PHASE_IDS const int lane = lane_now(); const int tid = (wave_s << 6) | lane; (void)tid; (void)lane;
        if (ph == 0) { PHASE_IDS for (int rp = 0; rp < NREP_P0; ++rp) phase_p0(P, lds, wave, lane, tid); }
        else if (ph == NPHASE - 1) { PHASE_IDS phase_rows<true>(P, wave, lane); }
        else {
            const int l = (ph - 1) / 10, s = (ph - 1) % 10;
            if (s == 0) { PHASE_IDS
                S.init(NTOK, 7168, gridDim.x, blockIdx.x);
                Gemm g{xb, (const bf16_t*)(ws + OFF_WIN) + (size_t)l * 7168 * 1024, NTOK, 7168, 1024};
                EpiIn E{(bf16_t*)(dout + DO_U), (bf16_t*)(ws + OFF_QO), (bf16_t*)(dout + DO_K), (bf16_t*)(dout + DO_V), (bf16_t*)(ws + OFF_CG), Gt, (const float*)(ws + OFF_RSQ1), P.in[I_BGATE] + l * 3072};
                gemm_phase<EpiIn, StaticOrder, false>(lds, g, S, E, nullptr, tid);
            } else if (s == 1) { PHASE_IDS
                LAS unsigned* lctr = (LAS unsigned*)(lds + CTR_OFF);
                if (tid == 0) lctr[0] = 0u;
                __syncthreads();
                const int grp = blockIdx.x & 7, rank = blockIdx.x >> 3; constexpr int per = 128;
                if (wave < 4) { for (int it = blockIdx.x * 4 + wave; it < 1024; it += gridDim.x * 4) s5_item(P, l, it, lds + wave * S5_WL, lane_now()); }
                LAS unsigned char* vl = lds + ATT_OFF + wave * ATT_WL;
                for (;;) { const int ln = lane_now(); const int k = lds_claim(lctr, ln); const int li = rank * per + k; if (k >= per || li >= 4096) break;
                    const int b = grp + 8 * (li >> 10), rest = li & 1023;
                    if (rest < 512) attn_item<1>(P, b * 512 + rest, vl, ln); else attn_item<2>(P, b * 512 + rest - 512, vl, ln); }
            } else if (s == 2) { PHASE_IDS
                LAS unsigned* lctr = (LAS unsigned*)(lds + CTR_OFF);
                if (tid == 0) lctr[0] = 0u;
                __syncthreads();
                const int grp = blockIdx.x & 7, rank = blockIdx.x >> 3; constexpr int per = 96;
                LAS unsigned char* vl = lds + ATT_OFF + wave * ATT_WL;
                for (;;) { const int ln = lane_now(); const int k = lds_claim(lctr, ln); const int li = rank * per + k; if (k >= per || li >= 3072) break;
                    const int b = grp + 8 * (li / 768), rest = li % 768;
                    if (rest < 512) attn_item<0>(P, b * 512 + rest, vl, ln); else conv_item(P, l, b * 256 + rest - 512, ln); }
            } else if (s == 3) { PHASE_IDS
                S.init(NTOK, 2048, gridDim.x, blockIdx.x);
                Gemm g{(const bf16_t*)(dout + DO_Y), (const bf16_t*)(ws + OFF_WGLU) + (size_t)l * 2048 * 512, NTOK, 2048, 512};
                EpiGluMerge E{Mg, Gt};
                gemm_phase<EpiGluMerge, StaticOrder, false>(lds, g, S, E, nullptr, tid);
            } else if (s == 4) { PHASE_IDS
                S.init(NTOK, 1024, gridDim.x, blockIdx.x);
                for (int c = 0; c < 2; ++c) {
                    Gemm g{(const bf16_t*)(ws + (c == 0 ? OFF_HC : OFF_OC)), (const bf16_t*)(ws + (c == 0 ? OFF_WPW2 : OFF_WATT)) + (size_t)l * 1024 * 512, NTOK, 1024, 512};
                    EpiAccMerge E{Mg, Gt, c == 0 ? 2048 : 1024};
                    gemm_phase<EpiAccMerge, StaticOrder, false>(lds, g, S, E, nullptr, tid);
                    __syncthreads();
                }
            } else if (s == 6 || s == 9) { PHASE_IDS
                phase_rows<false>(P, wave, lane);
            } else if (s == 5 || s == 8) { PHASE_IDS
                S.init(NTOK, 1024, gridDim.x, blockIdx.x);
                Gemm g{s == 5 ? (const bf16_t*)Mg : (const bf16_t*)Gt, s == 5 ? (const bf16_t*)(ws + OFF_WOUT) + (size_t)l * 1024 * 1024 : (const bf16_t*)(ws + OFF_WF2) + (size_t)l * 1024 * 2816, NTOK, 1024, s == 5 ? 1024 : 2816};
                EpiDelta E{Dl};
                gemm_phase<EpiDelta, StaticOrder, false>(lds, g, S, E, nullptr, tid);
            } else {
                PHASE_IDS
                S.init(NTOK, 5632, gridDim.x, blockIdx.x);
                Gemm g{xn, (const bf16_t*)(ws + OFF_WF1) + (size_t)l * 5632 * 1024, NTOK, 5632, 1024};
                EpiFfn1 E{Gt};
                gemm_phase<EpiFfn1, StaticOrder, false>(lds, g, S, E, nullptr, tid);
            }
        }
        if (ph + 1 < P.ph_hi) { ++nbar; grid_barrier(ctl + 3072, nbar * gridDim.x, (wave_s << 6) | lane_now()); }
    }
}

extern "C" void kernel_launch(void* const* d_in, const int* in_sizes, int n_in, void* d_out, int out_size, void* d_ws, size_t ws_size, hipStream_t stream) {
    static int grid = 0;
    if (grid == 0) {
        if (n_in != 24 || out_size != NTOK * 1024 || ws_size < WS_END) { fprintf(stderr, "kernel_launch: unexpected problem (n_in %d out %d ws %zu need %zu)\n", n_in, out_size, ws_size, (size_t)WS_END); grid = -1; return; }
        int dev = 0, cus = 0, per_cu = 0;
        hipGetDevice(&dev); hipDeviceGetAttribute(&cus, hipDeviceAttributeMultiprocessorCount, dev);
        if (hipFuncSetAttribute((const void*)fwd_kernel, hipFuncAttributeMaxDynamicSharedMemorySize, LDS_BYTES) != hipSuccess) { fprintf(stderr, "kernel_launch: hipFuncSetAttribute failed\n"); grid = -1; return; }
        hipOccupancyMaxActiveBlocksPerMultiprocessor(&per_cu, (const void*)fwd_kernel, 512, LDS_BYTES);
        if (per_cu < 1) { fprintf(stderr, "kernel_launch: occupancy query says %d blocks/CU\n", per_cu); per_cu = 1; }
        (void)hipGetLastError();
        grid = cus * per_cu; if (grid > 256) grid = 256;
        if (grid != 256) { fprintf(stderr, "kernel_launch: this build partitions its work over exactly 256 workgroups (got %d)\n", grid); grid = -1; return; }
    }
    if (grid < 0) return;
    hipMemsetAsync((unsigned char*)d_ws + OFF_CTL, 0, 16384, stream);
    Params p{};
    for (int i = 0; i < 24; ++i) p.in[i] = (const float*)d_in[i];
    p.out = (float*)d_out; p.ws = (unsigned char*)d_ws;
#if MK_PER_PHASE
    for (int ph = 0; ph < NPHASE; ++ph) { p.ph_lo = ph; p.ph_hi = ph + 1; hipLaunchKernelGGL(fwd_kernel, dim3(grid), dim3(512), LDS_BYTES, stream, p); }
#else
    p.ph_lo = 0; p.ph_hi = NPHASE;
    void* args[] = {&p};
    hipError_t e = hipLaunchCooperativeKernel((const void*)fwd_kernel, dim3(grid), dim3(512), args, LDS_BYTES, stream);
    if (e != hipSuccess) fprintf(stderr, "cooperative launch failed: %s (grid %d)\n", hipGetErrorString(e), grid);
#endif
}
```

```cpp
#include <hip/hip_runtime.h>
#include <hip/hip_cooperative_groups.h>
#include <cstdio>
namespace cg = cooperative_groups;
namespace pg8 {
#define PG8_LAS __attribute__((address_space(3)))
typedef unsigned short bf16_t;
typedef short bf16x8 __attribute__((ext_vector_type(8)));
typedef float f32x4 __attribute__((ext_vector_type(4)));
typedef unsigned u32x4 __attribute__((ext_vector_type(4)));
constexpr int BM = 256, BK = 64, HALF = 128, HTB = HALF * BK * 2  , STAGE_BYTES = 8 * HTB, NXCD = 8, WGM = 8;

__host__ __device__ __forceinline__ int lds_byte(int r, int c) { const int st = (r >> 4) * 2 + (c >> 5), rr = r & 15, cc = c & 31, ob = rr * 64 + cc * 2; return st * 1024 + (ob ^ (((ob >> 9) & 1) << 5)); }
__host__ __device__ __forceinline__ void stage_rc(int b, int& R, int& C) { const int st = b / 1024, sb = b % 1024, swz = sb ^ (((sb >> 9) & 1) << 5); R = (st >> 1) * 16 + swz / 64; C = (st & 1) * 32 + (swz % 64) / 2; }
__host__ __device__ __forceinline__ int perm32(int rho) { const int n = rho >> 4, i = rho & 15; return 8 * (i >> 2) + 4 * n + (i & 3); }

struct Unit { int pm, pn; };
struct Gemm { const bf16_t* A; const bf16_t* Bt; int M, N, K; };

struct StaticOrder {
    int nM, nN, nwg, G, c;
    __host__ __device__ void init(int M, int N, int G_, int c_) { nM = M / BM; nN = N / BM; nwg = nM * nN; G = G_; c = c_; }
    __host__ __device__ bool next(int i, Unit& u) const {
        const long L = (long)i * G + c; if (L >= nwg) return false;
        int wgid = (int)L; { const int q = nwg / NXCD, r = nwg % NXCD, xcd = wgid % NXCD, off = wgid / NXCD; wgid = (xcd < r ? xcd * (q + 1) : r * (q + 1) + (xcd - r) * q) + off; }
        const int nig = WGM * nN, gid = wgid / nig, fm = gid * WGM, gsz = (nM - fm) < WGM ? (nM - fm) : WGM;
        u.pm = fm + ((wgid % nig) % gsz); u.pn = (wgid % nig) / gsz; return true;
    }
    __device__ __forceinline__ void a_ready(const Unit&) const {}
    __device__ __forceinline__ void done(const Unit&) const {}
};
__device__ __forceinline__ unsigned cvt_pk_bf16(float lo, float hi) { unsigned r; asm volatile("v_cvt_pk_bf16_f32 %0, %1, %2" : "=v"(r) : "v"(lo), "v"(hi)); return r; }
template <class Epi, class Sched, bool STAMP = false>
__device__ __forceinline__ void gemm_phase(PG8_LAS unsigned char* lds, const Gemm g, const Sched& S, const Epi& E, unsigned long long* stamps, int tid_in) {
    int tid_o = tid_in; asm volatile("" : "+v"(tid_o)); const int tid = tid_o, wid = __builtin_amdgcn_readfirstlane(tid >> 6), lane = tid & 63, wr = wid >> 2, wc = wid & 3, fr = lane & 15, fq = lane >> 4;
    const int K = g.K, nt = K / BK;
    int ts_lo = 0, ts_hi = 0, nts = 0; const unsigned long long rt_entry = STAMP ? (unsigned long long)wall_clock64() : 0ull;
#define PG8_STAMP() do { if (STAMP && wid == 0 && nts < 64) { const unsigned long long _c = (unsigned long long)clock64(); \
        ts_lo = (lane == nts) ? (int)(unsigned)_c : ts_lo; ts_hi = (lane == nts) ? (int)(unsigned)(_c >> 32) : ts_hi; ++nts; } } while (0)
    PG8_STAMP();
    unsigned voffA[2], voffB[2];
#pragma unroll
    for (int i = 0; i < 2; ++i) { int R, C; stage_rc(tid * 16 + i * 8192, R, C); const int Rb = Epi::PERM ? ((R & ~31) + perm32(R & 31)) : R;
        voffA[i] = (unsigned)(R * K + C) * 2u; voffB[i] = (unsigned)(Rb * K + C) * 2u; }
    const size_t kstep = (size_t)(BK * 2);
    const size_t hstep = (size_t)HALF * K * 2;
    const size_t tstep = 2 * hstep;
    const unsigned ldsw = (unsigned)wid * 1024u;
    const int aoff = lds_byte(wr * 64 + fr, fq * 8), boff = lds_byte(wc * 32 + fr, fq * 8);
#define PG8_SA(b, h) (((b) * 2 + (h)) * HTB)
#define PG8_SB(b, h) ((4 + (b) * 2 + (h)) * HTB)
#define PG8_STAGE(bufoff, gbase, voff) do { _Pragma("unroll") for (int _i = 0; _i < 2; ++_i) \
        __builtin_amdgcn_global_load_lds((const unsigned*)((const char*)(gbase) + (voff)[_i]), (PG8_LAS unsigned*)(lds + (bufoff) + ldsw + _i * 8192), 16, 0, 0); } while (0)
#define PG8_LDA(dst, b, h) do { _Pragma("unroll") for (int m = 0; m < 4; ++m) _Pragma("unroll") for (int k = 0; k < 2; ++k) dst[m][k] = *(const PG8_LAS bf16x8*)(lds + PG8_SA(b, h) + aoff + m * 2048 + k * 1024); } while (0)
#define PG8_LDB(dst, b, h) do { _Pragma("unroll") for (int n = 0; n < 2; ++n) _Pragma("unroll") for (int k = 0; k < 2; ++k) dst[n][k] = *(const PG8_LAS bf16x8*)(lds + PG8_SB(b, h) + boff + n * 2048 + k * 1024); } while (0)
#define PG8_MMA(ai, bj, At, Bt) do { __builtin_amdgcn_s_setprio(1); _Pragma("unroll") for (int m = 0; m < 4; ++m) _Pragma("unroll") for (int n = 0; n < 2; ++n) _Pragma("unroll") for (int k = 0; k < 2; ++k) \
        acc[ai][bj][m][n] = __builtin_amdgcn_mfma_f32_16x16x32_bf16(Bt[n][k], At[m][k], acc[ai][bj][m][n], 0, 0, 0); __builtin_amdgcn_s_setprio(0); } while (0)
#define PG8_WAIT_V(n) asm volatile("s_waitcnt vmcnt(" #n ")" ::: "memory")
#define PG8_WAIT_L(n) asm volatile("s_waitcnt lgkmcnt(" #n ")" ::: "memory")
#define PG8_BAR __builtin_amdgcn_s_barrier()
#define PG8_SCHED __builtin_amdgcn_sched_barrier(0)
    Unit cur, nxt; int ui = 0;
    if (!S.next(0, cur)) return;
    f32x4 acc[2][2][4][2];
#pragma unroll
    for (int a = 0; a < 2; ++a)
#pragma unroll
        for (int b = 0; b < 2; ++b)
#pragma unroll
            for (int m = 0; m < 4; ++m)
#pragma unroll
                for (int n = 0; n < 2; ++n) acc[a][b][m][n] = (f32x4){0.f, 0.f, 0.f, 0.f};
    bf16x8 At[4][2], B0[2][2], B1[2][2];
    const char* cA = (const char*)g.A + (size_t)cur.pm * tstep; const char* cB = (const char*)g.Bt + (size_t)cur.pn * tstep;
    S.a_ready(cur);
    PG8_STAGE(PG8_SB(0, 0), cB, voffB); PG8_STAGE(PG8_SA(0, 0), cA, voffA); PG8_STAGE(PG8_SB(0, 1), cB + hstep, voffB); PG8_STAGE(PG8_SA(0, 1), cA + hstep, voffA);
    if (wr == 1) PG8_BAR;
    PG8_WAIT_V(4); PG8_BAR;
    PG8_STAGE(PG8_SB(1, 0), cB + kstep, voffB); PG8_STAGE(PG8_SA(1, 0), cA + kstep, voffA); PG8_STAGE(PG8_SB(1, 1), cB + hstep + kstep, voffB);
    PG8_WAIT_V(6); PG8_BAR;
    PG8_STAMP();
    for (;;) {
        const bool has_next = S.next(ui + 1, nxt);
        const char* nA = has_next ? (const char*)g.A + (size_t)nxt.pm * tstep : cA; const char* nB = has_next ? (const char*)g.Bt + (size_t)nxt.pn * tstep : cB;
        for (int t = 0; t < nt; t += 2) {
            const bool last = (t == nt - 2);
            const char* a1 = cA + (size_t)(t + 1) * kstep;
            const char* a2 = last ? nA : cA + (size_t)(t + 2) * kstep; const char* b2 = last ? nB : cB + (size_t)(t + 2) * kstep;
            const char* a3 = a2 + kstep; const char* b3 = b2 + kstep;
            if (last && has_next) S.a_ready(nxt);
            PG8_LDB(B0, 0, 0); PG8_SCHED; PG8_LDA(At, 0, 0); PG8_STAGE(PG8_SA(1, 1), a1 + hstep, voffA);
            PG8_WAIT_L(8); PG8_BAR; PG8_WAIT_L(0); PG8_MMA(0, 0, At, B0); PG8_BAR; PG8_SCHED;
            PG8_LDB(B1, 0, 1); PG8_STAGE(PG8_SB(0, 0), b2, voffB);
            PG8_BAR; PG8_WAIT_L(0); PG8_MMA(0, 1, At, B1); PG8_BAR;
            PG8_LDA(At, 0, 1); PG8_STAGE(PG8_SA(0, 0), a2, voffA);
            PG8_BAR; PG8_WAIT_L(0); PG8_MMA(1, 0, At, B0); PG8_BAR; PG8_SCHED;
            PG8_STAGE(PG8_SB(0, 1), b2 + hstep, voffB);
            PG8_WAIT_V(6); PG8_BAR; PG8_MMA(1, 1, At, B1); PG8_BAR;
            PG8_LDB(B0, 1, 0); PG8_SCHED; PG8_LDA(At, 1, 0); PG8_STAGE(PG8_SA(0, 1), a2 + hstep, voffA);
            PG8_WAIT_L(8); PG8_BAR; PG8_WAIT_L(0); PG8_MMA(0, 0, At, B0); PG8_BAR; PG8_SCHED;
            PG8_LDB(B1, 1, 1); PG8_STAGE(PG8_SB(1, 0), b3, voffB);
            PG8_BAR; PG8_WAIT_L(0); PG8_MMA(0, 1, At, B1); PG8_BAR;
            PG8_LDA(At, 1, 1); PG8_STAGE(PG8_SA(1, 0), a3, voffA);
            PG8_BAR; PG8_WAIT_L(0); PG8_MMA(1, 0, At, B0); PG8_BAR; PG8_SCHED;
            PG8_STAGE(PG8_SB(1, 1), b3 + hstep, voffB);
            PG8_WAIT_V(6); PG8_BAR; PG8_MMA(1, 1, At, B1); PG8_BAR;
        }
        PG8_STAMP();
        if constexpr (!Epi::AFTER_DRAIN) { E(acc, cur, wr, wc, fr, fq); S.done(cur); }
        PG8_STAMP();
        if (!has_next) break;
#pragma unroll
        for (int a = 0; a < 2; ++a)
#pragma unroll
            for (int b = 0; b < 2; ++b)
#pragma unroll
                for (int m = 0; m < 4; ++m)
#pragma unroll
                    for (int n = 0; n < 2; ++n) acc[a][b][m][n] = (f32x4){0.f, 0.f, 0.f, 0.f};
        cur = nxt; cA = nA; cB = nB; ++ui;
    }
    PG8_WAIT_V(0);
    if (wr == 0) PG8_BAR;
    PG8_BAR;
    if constexpr (Epi::AFTER_DRAIN) { E.fused(acc, cur, wr, wc, fr, fq, lds, wid, lane); S.done(cur); }
    PG8_STAMP();
    if (STAMP && wid == 0) { stamps[lane] = lane < nts ? (((unsigned long long)(unsigned)ts_hi << 32) | (unsigned)ts_lo) : 0ull;
        if (lane == 62) stamps[62] = rt_entry; if (lane == 63) stamps[63] = (unsigned long long)wall_clock64(); }
#undef PG8_STAMP
#undef PG8_SA
#undef PG8_SB
#undef PG8_STAGE
#undef PG8_LDA
#undef PG8_LDB
#undef PG8_MMA
#undef PG8_WAIT_V
#undef PG8_WAIT_L
#undef PG8_BAR
#undef PG8_SCHED
}
}

using namespace pg8;
#define LAS __attribute__((address_space(3)))
typedef short s16x4 __attribute__((ext_vector_type(4)));
typedef short v4i16_t __attribute__((ext_vector_type(4)));
typedef float f32x16 __attribute__((ext_vector_type(16)));
typedef unsigned u32x2 __attribute__((ext_vector_type(2)));
typedef float f32x2v __attribute__((ext_vector_type(2)));

#ifndef NREP_S5
#define NREP_S5 1
#endif
#ifndef NREP_B2
#define NREP_B2 1
#endif
#ifndef NREP_P0
#define NREP_P0 1
#endif
#ifndef MK_PER_PHASE
#define MK_PER_PHASE 0
#endif

constexpr int NTOK = 65536, SEQL = 2048;
constexpr float EPSN = 1e-6f;
constexpr int LDS_BYTES = 155648;
constexpr int S5_WL = 25088;
constexpr int ATT_OFF = 4 * S5_WL;
constexpr int VSTR = 192;
constexpr int ATT_WL = 32 * VSTR;
constexpr int CTR_OFF = LDS_BYTES - 256;
static_assert(ATT_OFF + 8 * ATT_WL <= CTR_OFF, "lds");

constexpr size_t OFF_WIN = 0;
constexpr size_t OFF_WGLU = OFF_WIN + 2ull * 7168 * 1024 * 2;
constexpr size_t OFF_WATT = OFF_WGLU + 2ull * 2048 * 512 * 2;
constexpr size_t OFF_WPW2 = OFF_WATT + 2ull * 1024 * 512 * 2;
constexpr size_t OFF_WOUT = OFF_WPW2 + 2ull * 1024 * 512 * 2;
constexpr size_t OFF_WF1 = OFF_WOUT + 2ull * 1024 * 1024 * 2;
constexpr size_t OFF_WF2 = OFF_WF1 + 2ull * 5632 * 1024 * 2;
constexpr size_t OFF_S5BB = OFF_WF2 + 2ull * 1024 * 2816 * 2;
constexpr size_t OFF_S5CM = OFF_S5BB + 2ull * 32 * 128 * 16 * 2;
constexpr size_t OFF_S5A = OFF_S5CM + 2ull * 32 * 16 * 128 * 2;
constexpr size_t OFF_CONVW = OFF_S5A + 2ull * 32 * 64 * 8;
constexpr size_t OFF_CTL = OFF_CONVW + 65536;
constexpr size_t OFF_RSQ1 = OFF_CTL + 16384;
constexpr size_t OFF_RSQ2 = OFF_RSQ1 + 65536ull * 8;
constexpr size_t OFF_LSE = OFF_RSQ2 + 65536ull * 8;
constexpr size_t OFF_XB = OFF_LSE + 2ull * 65536 * 8 * 4;
constexpr size_t OFF_G = OFF_XB + 65536ull * 1024 * 2;
constexpr size_t OFF_QO = OFF_G + 65536ull * 3072 * 2;
constexpr size_t OFF_CG = OFF_QO + 65536ull * 1536 * 2;
constexpr size_t OFF_HC = OFF_CG + 65536ull * 512 * 2;
constexpr size_t OFF_OC = OFF_HC + 65536ull * 512 * 2;
constexpr size_t WS_END = OFF_OC + 65536ull * 512 * 2;
constexpr size_t DO_U = 0, DO_K = 64ull << 20, DO_V = 128ull << 20, DO_Y = 192ull << 20, DO_MG = 64ull << 20;

struct Params {
    const float* in[24];
    float* out; unsigned char* ws;
    int ph_lo, ph_hi;
};
enum { I_X = 0, I_N1G, I_WIN, I_BGATE, I_LRE, I_LIM, I_LOGDT, I_BRE, I_BIM, I_CRE, I_CIM, I_SSMD, I_WGLU, I_WATT, I_CONVW, I_CONVB, I_LNG, I_LNB, I_WPW2, I_WOUT, I_N2G, I_WF1, I_WF2, I_FING };

__device__ __forceinline__ float bf_lo(unsigned u) { return __uint_as_float(u << 16); }
__device__ __forceinline__ float bf_hi(unsigned u) { return __uint_as_float(u & 0xffff0000u); }
__device__ __forceinline__ float sigm(float x) { return __builtin_amdgcn_rcpf(1.f + __expf(-x)); }
__device__ __forceinline__ unsigned short f2bf(float f) { unsigned u = __float_as_uint(f); u += 0x7FFFu + ((u >> 16) & 1u); return (unsigned short)(u >> 16); }
__device__ __forceinline__ float wave_sum(float v) {
#pragma unroll
    for (int o = 1; o < 64; o <<= 1) v += __shfl_xor(v, o);
    return v;
}
__device__ __forceinline__ s16x4 vtr(const LAS unsigned char* p) { return __builtin_bit_cast(s16x4, __builtin_amdgcn_ds_read_tr16_b64_v4i16((LAS v4i16_t*)p)); }

__device__ __forceinline__ u32x4 pack8(const f32x4 a, const f32x4 b) { u32x4 w; w.x = cvt_pk_bf16(a[0], a[1]); w.y = cvt_pk_bf16(a[2], a[3]); w.z = cvt_pk_bf16(b[0], b[1]); w.w = cvt_pk_bf16(b[2], b[3]); return w; }
__device__ __forceinline__ void unpack8(const u32x4 w, f32x4& a, f32x4& b) { a[0] = bf_lo(w.x); a[1] = bf_hi(w.x); a[2] = bf_lo(w.y); a[3] = bf_hi(w.y); b[0] = bf_lo(w.z); b[1] = bf_hi(w.z); b[2] = bf_lo(w.w); b[3] = bf_hi(w.w); }

struct EpiIn {
    static constexpr bool PERM = true, AFTER_DRAIN = false;
    bf16_t *U, *QO, *Kb, *Vb, *CG, *G; const float* rowsq; const float* bgate;
    __device__ __forceinline__ void operator()(const f32x4 (&acc)[2][2][4][2], const Unit& u, int wr, int wc, int fr, int fq) const {
        const int row0 = u.pm * 256 + wr * 64 + fr, cl = wc * 32 + 8 * fq, pn = u.pn;
        if (pn < 12) {
            bf16_t* base; int ld, col0;
            if (pn < 2) { base = U; ld = 512; col0 = pn * 256; }
            else if (pn < 8) { base = QO; ld = 1536; col0 = (pn - 2) * 256; }
            else if (pn < 10) { base = Kb; ld = 512; col0 = (pn - 8) * 256; }
            else { base = Vb; ld = 512; col0 = (pn - 10) * 256; }
#pragma unroll
            for (int ai = 0; ai < 2; ++ai)
#pragma unroll
                for (int m = 0; m < 4; ++m) { const int r = row0 + ai * 128 + m * 16; const float rs = rowsq[r];
#pragma unroll
                    for (int bj = 0; bj < 2; ++bj) *(u32x4*)(base + (size_t)r * ld + col0 + bj * 128 + cl) = pack8(acc[ai][bj][m][0] * rs, acc[ai][bj][m][1] * rs); }
        } else if (pn < 16) {
            const int c0 = (pn - 12) * 128 + cl;
#pragma unroll
            for (int ai = 0; ai < 2; ++ai)
#pragma unroll
                for (int m = 0; m < 4; ++m) { const int r = row0 + ai * 128 + m * 16; const float rs = rowsq[r];
                    f32x4 o[2];
#pragma unroll
                    for (int n = 0; n < 2; ++n)
#pragma unroll
                        for (int j = 0; j < 4; ++j) o[n][j] = acc[ai][0][m][n][j] * rs * sigm(acc[ai][1][m][n][j] * rs);
                    *(u32x4*)(CG + (size_t)r * 512 + c0) = pack8(o[0], o[1]); }
        } else {
            const int c0 = (pn - 16) * 256 + cl;
            f32x4 bv[2][2];
#pragma unroll
            for (int bj = 0; bj < 2; ++bj)
#pragma unroll
                for (int n = 0; n < 2; ++n) bv[bj][n] = *(const f32x4*)(bgate + c0 + bj * 128 + 4 * n);
#pragma unroll
            for (int ai = 0; ai < 2; ++ai)
#pragma unroll
                for (int m = 0; m < 4; ++m) { const int r = row0 + ai * 128 + m * 16; const float rs = rowsq[r];
#pragma unroll
                    for (int bj = 0; bj < 2; ++bj) { f32x4 o[2];
#pragma unroll
                        for (int n = 0; n < 2; ++n)
#pragma unroll
                            for (int j = 0; j < 4; ++j) o[n][j] = sigm(acc[ai][bj][m][n][j] * rs + bv[bj][n][j]);
                        *(u32x4*)(G + (size_t)r * 3072 + c0 + bj * 128) = pack8(o[0], o[1]); } }
        }
    }
};
struct EpiGluMerge {
    static constexpr bool PERM = true, AFTER_DRAIN = false;
    bf16_t* Mg; const bf16_t* G;
    __device__ __forceinline__ void operator()(const f32x4 (&acc)[2][2][4][2], const Unit& u, int wr, int wc, int fr, int fq) const {
        const int row0 = u.pm * 256 + wr * 64 + fr, c0 = u.pn * 128 + wc * 32 + 8 * fq;
#pragma unroll
        for (int ai = 0; ai < 2; ++ai)
#pragma unroll
            for (int m = 0; m < 4; ++m) { const int r = row0 + ai * 128 + m * 16;
                f32x4 g0, g1; unpack8(*(const u32x4*)(G + (size_t)r * 3072 + c0), g0, g1);
                f32x4 o[2];
#pragma unroll
                for (int j = 0; j < 4; ++j) { o[0][j] = g0[j] * acc[ai][0][m][0][j] * sigm(acc[ai][1][m][0][j]); o[1][j] = g1[j] * acc[ai][0][m][1][j] * sigm(acc[ai][1][m][1][j]); }
                *(u32x4*)(Mg + (size_t)r * 1024 + c0) = pack8(o[0], o[1]); }
    }
};
struct EpiAccMerge {
    static constexpr bool PERM = true, AFTER_DRAIN = false;
    bf16_t* Mg; const bf16_t* G; int gate_off;
    __device__ __forceinline__ void operator()(const f32x4 (&acc)[2][2][4][2], const Unit& u, int wr, int wc, int fr, int fq) const {
        const int row0 = u.pm * 256 + wr * 64 + fr, cb = u.pn * 256 + wc * 32 + 8 * fq;
#pragma unroll
        for (int ai = 0; ai < 2; ++ai)
#pragma unroll
            for (int m = 0; m < 4; ++m) { const int r = row0 + ai * 128 + m * 16;
#pragma unroll
                for (int bj = 0; bj < 2; ++bj) { const int c0 = cb + bj * 128;
                    f32x4 g0, g1, m0, m1; unpack8(*(const u32x4*)(G + (size_t)r * 3072 + gate_off + c0), g0, g1); unpack8(*(const u32x4*)(Mg + (size_t)r * 1024 + c0), m0, m1);
                    *(u32x4*)(Mg + (size_t)r * 1024 + c0) = pack8(m0 + g0 * acc[ai][bj][m][0], m1 + g1 * acc[ai][bj][m][1]); } }
    }
};
struct EpiDelta {
    static constexpr bool PERM = true, AFTER_DRAIN = false;
    bf16_t* D;
    __device__ __forceinline__ void operator()(const f32x4 (&acc)[2][2][4][2], const Unit& u, int wr, int wc, int fr, int fq) const {
        const int row0 = u.pm * 256 + wr * 64 + fr, cb = u.pn * 256 + wc * 32 + 8 * fq;
#pragma unroll
        for (int ai = 0; ai < 2; ++ai)
#pragma unroll
            for (int m = 0; m < 4; ++m)
#pragma unroll
                for (int bj = 0; bj < 2; ++bj) *(u32x4*)(D + (size_t)(row0 + ai * 128 + m * 16) * 1024 + cb + bj * 128) = pack8(acc[ai][bj][m][0], acc[ai][bj][m][1]);
    }
};
struct EpiFfn1 {
    static constexpr bool PERM = true, AFTER_DRAIN = false;
    bf16_t* Hf;
    __device__ __forceinline__ void operator()(const f32x4 (&acc)[2][2][4][2], const Unit& u, int wr, int wc, int fr, int fq) const {
        const int row0 = u.pm * 256 + wr * 64 + fr, c0 = u.pn * 128 + wc * 32 + 8 * fq;
#pragma unroll
        for (int ai = 0; ai < 2; ++ai)
#pragma unroll
            for (int m = 0; m < 4; ++m) { const int r = row0 + ai * 128 + m * 16;
                f32x4 o[2];
#pragma unroll
                for (int n = 0; n < 2; ++n)
#pragma unroll
                    for (int j = 0; j < 4; ++j) { const float a = acc[ai][0][m][n][j], b = acc[ai][1][m][n][j]; o[n][j] = a * sigm(a) * b; }
                *(u32x4*)(Hf + (size_t)r * 2816 + c0) = pack8(o[0], o[1]); }
    }
};

__device__ __forceinline__ void p0_tr_item(const float* W, int K, int N, bf16_t* WT, int kb, int nd0, int ns0, const float* gk, float scale, LAS float* scr, int lane) {
    const int k0 = 64 * kb;
#pragma unroll 8
    for (int i = 0; i < 32; ++i) { const int kk = 2 * i + (lane >> 5); float s = scale; if (gk) s *= gk[k0 + kk]; scr[kk * 33 + (lane & 31)] = W[(size_t)(k0 + kk) * N + ns0 + (lane & 31)] * s; }
    asm volatile("" ::: "memory");
    const int c = lane & 7;
#pragma unroll
    for (int j = 0; j < 4; ++j) { const int n = (lane >> 3) + 8 * j; const LAS float* s = scr + (8 * c) * 33 + n;
        u32x4 o; o.x = cvt_pk_bf16(s[0 * 33], s[1 * 33]); o.y = cvt_pk_bf16(s[2 * 33], s[3 * 33]); o.z = cvt_pk_bf16(s[4 * 33], s[5 * 33]); o.w = cvt_pk_bf16(s[6 * 33], s[7 * 33]);
        *(u32x4*)(WT + (size_t)(nd0 + n) * K + k0 + 8 * c) = o; }
    asm volatile("" ::: "memory");
}
__device__ __forceinline__ void phase_p0(const Params& P, LAS unsigned char* lds, int wave, int lane, int tid) {
    unsigned char* ws = P.ws;
    const int gw = blockIdx.x * 8 + wave, NGW = gridDim.x * 8;
    LAS float* scr = (LAS float*)(lds + wave * 16384);
    constexpr int PER_L = 3584 + 512 + 256 + 256 + 512 + 2816 + 1408;
    for (int it = gw; it < 2 * PER_L; it += NGW) {
        const int l = it / PER_L; int r = it % PER_L;
        const float* W; bf16_t* WT; int K, N, type = 0; const float* gk = nullptr;
        if (r < 3584) { W = P.in[I_WIN] + (size_t)l * 1024 * 7168; WT = (bf16_t*)(ws + OFF_WIN) + (size_t)l * 7168 * 1024; K = 1024; N = 7168; type = 1; gk = P.in[I_N1G] + l * 1024; }
        else if ((r -= 3584) < 512) { W = P.in[I_WGLU] + (size_t)l * 512 * 2048; WT = (bf16_t*)(ws + OFF_WGLU) + (size_t)l * 2048 * 512; K = 512; N = 2048; type = 3; }
        else if ((r -= 512) < 256) { W = P.in[I_WATT] + (size_t)l * 512 * 1024; WT = (bf16_t*)(ws + OFF_WATT) + (size_t)l * 1024 * 512; K = 512; N = 1024; }
        else if ((r -= 256) < 256) { W = P.in[I_WPW2] + (size_t)l * 512 * 1024; WT = (bf16_t*)(ws + OFF_WPW2) + (size_t)l * 1024 * 512; K = 512; N = 1024; }
        else if ((r -= 256) < 512) { W = P.in[I_WOUT] + (size_t)l * 1024 * 1024; WT = (bf16_t*)(ws + OFF_WOUT) + (size_t)l * 1024 * 1024; K = 1024; N = 1024; }
        else if ((r -= 512) < 2816) { W = P.in[I_WF1] + (size_t)l * 1024 * 5632; WT = (bf16_t*)(ws + OFF_WF1) + (size_t)l * 5632 * 1024; K = 1024; N = 5632; type = 2; gk = P.in[I_N2G] + l * 1024; }
        else { r -= 2816; W = P.in[I_WF2] + (size_t)l * 2816 * 1024; WT = (bf16_t*)(ws + OFF_WF2) + (size_t)l * 1024 * 2816; K = 2816; N = 1024; }
        const int nblk = N / 32, kb = r / nblk, nd0 = (r % nblk) * 32;
        int ns0 = nd0; float scale = 1.f;
        if (type == 1) { if (nd0 >= 3072 && nd0 < 4096) { const int t = nd0 - 3072, j = t & 255; ns0 = 3072 + (t >> 8) * 128 + (j & 127) + (j >= 128 ? 512 : 0); }
                         if (nd0 >= 512 && nd0 < 2048) scale = 0.125f * 1.4426950408889634f; }
        else if (type == 2) { const int j = nd0 & 255; ns0 = (nd0 >> 8) * 128 + (j & 127) + (j >= 128 ? 2816 : 0); }
        else if (type == 3) { const int j = nd0 & 255; ns0 = (nd0 >> 8) * 128 + (j & 127) + (j >= 128 ? 1024 : 0); }
        p0_tr_item(W, K, N, WT, kb, nd0, ns0, gk, scale, scr, lane);
    }
    { const float* x = P.in[I_X]; bf16_t* xb = (bf16_t*)(ws + OFF_XB); bf16_t* xn = (bf16_t*)(ws + OFF_HC);
      for (int row = gw; row < NTOK; row += NGW) { float ss = 0.f; f32x4 v[4];
#pragma unroll
          for (int j = 0; j < 4; ++j) { const f32x4 t = *(const f32x4*)(x + (size_t)row * 1024 + 4 * lane + 256 * j); u32x2 w; w.x = cvt_pk_bf16(t[0], t[1]); w.y = cvt_pk_bf16(t[2], t[3]);
              *(u32x2*)(xb + (size_t)row * 1024 + 4 * lane + 256 * j) = w; v[j][0] = bf_lo(w.x); v[j][1] = bf_hi(w.x); v[j][2] = bf_lo(w.y); v[j][3] = bf_hi(w.y);
              ss += v[j][0] * v[j][0] + v[j][1] * v[j][1] + v[j][2] * v[j][2] + v[j][3] * v[j][3]; }
          ss = wave_sum(ss); const float rs = rsqrtf(ss * (1.f / 1024.f) + EPSN); if (lane == 0) ((float*)(ws + OFF_RSQ1))[row] = rs;
#pragma unroll
          for (int j = 0; j < 4; ++j) { u32x2 w; w.x = cvt_pk_bf16(v[j][0] * rs, v[j][1] * rs); w.y = cvt_pk_bf16(v[j][2] * rs, v[j][3] * rs); *(u32x2*)(xn + (size_t)row * 1024 + 4 * lane + 256 * j) = w; } } }
    const int gt = blockIdx.x * 512 + tid, NGT = gridDim.x * 512;
    for (int idx = gt; idx < 2 * 32 * 64; idx += NGT) {
        const int lg = idx >> 6, p = idx & 63;
        const float lre = P.in[I_LRE][idx], lim = P.in[I_LIM][idx], dt = expf(P.in[I_LOGDT][lg]);
        const float mag = expf(lre * dt);
        const double rev = (double)lim * (double)dt * 0.15915494309189535; const float frc = (float)(rev - rint(rev));
        const float sn = __builtin_amdgcn_sinf(frc), cs = __builtin_amdgcn_cosf(frc);
        const float are = mag * cs, aim = mag * sn, nr = are - 1.f, ni = aim, den = lre * lre + lim * lim;
        const float zre = (nr * lre + ni * lim) / den, zim = (ni * lre - nr * lim) / den;
        { f32x2v t2; t2.x = are; t2.y = aim; ((f32x2v*)(ws + OFF_S5A))[idx] = t2; }
        bf16_t* bbt = (bf16_t*)(ws + OFF_S5BB) + (size_t)lg * 128 * 16; bf16_t* cm = (bf16_t*)(ws + OFF_S5CM) + (size_t)lg * 16 * 128;
        for (int h = 0; h < 16; ++h) { const float br = P.in[I_BRE][(size_t)idx * 16 + h], bi = P.in[I_BIM][(size_t)idx * 16 + h];
            bbt[p * 16 + h] = f2bf(zre * br - zim * bi); bbt[(64 + p) * 16 + h] = f2bf(zre * bi + zim * br);
            cm[h * 128 + p] = f2bf(P.in[I_CRE][((size_t)lg * 16 + h) * 64 + p]); cm[h * 128 + 64 + p] = f2bf(-P.in[I_CIM][((size_t)lg * 16 + h) * 64 + p]); }
    }
    for (int idx = gt; idx < 2 * 31 * 256; idx += NGT) { const float a = P.in[I_CONVW][2 * idx], b = P.in[I_CONVW][2 * idx + 1]; ((unsigned*)(ws + OFF_CONVW))[idx] = cvt_pk_bf16(a, b); }
}
template <bool FINAL> __device__ __forceinline__ void phase_rows(const Params& P, int wave, int lane) {
    const int gw = blockIdx.x * 8 + wave, NGW = gridDim.x * 8;
    bf16_t* xb = (bf16_t*)(P.ws + OFF_XB); const bf16_t* D = (const bf16_t*)(P.ws + OFF_QO); bf16_t* xn = (bf16_t*)(P.ws + OFF_HC); const float* fg = P.in[I_FING];
    for (int row = gw; row < NTOK; row += NGW) {
        const size_t o0 = (size_t)row * 1024 + 8 * lane, o1 = o0 + 512;
        const u32x4 w0 = *(const u32x4*)(xb + o0), w1 = *(const u32x4*)(xb + o1), d0 = *(const u32x4*)(D + o0), d1 = *(const u32x4*)(D + o1);
        f32x4 a0, a1, b0, b1, e0, e1, g0, g1; unpack8(w0, a0, a1); unpack8(w1, b0, b1); unpack8(d0, e0, e1); unpack8(d1, g0, g1);
        const u32x4 n0 = pack8(a0 + e0, a1 + e1), n1 = pack8(b0 + g0, b1 + g1);
        unpack8(n0, a0, a1); unpack8(n1, b0, b1);
        float ss = 0.f;
#pragma unroll
        for (int j = 0; j < 4; ++j) ss += a0[j] * a0[j] + a1[j] * a1[j] + b0[j] * b0[j] + b1[j] * b1[j];
        ss = wave_sum(ss);
        const float rs = rsqrtf(ss * (1.f / 1024.f) + EPSN);
        if (!FINAL) { if (lane == 0) ((float*)(P.ws + OFF_RSQ1))[row] = rs; *(u32x4*)(xb + o0) = n0; *(u32x4*)(xb + o1) = n1; *(u32x4*)(xn + o0) = pack8(a0 * rs, a1 * rs); *(u32x4*)(xn + o1) = pack8(b0 * rs, b1 * rs); }
        else { const f32x4 q0 = *(const f32x4*)(fg + 8 * lane), q1 = *(const f32x4*)(fg + 8 * lane + 4), q2 = *(const f32x4*)(fg + 512 + 8 * lane), q3 = *(const f32x4*)(fg + 512 + 8 * lane + 4);
            float* o = P.out + (size_t)row * 1024;
            *(f32x4*)(o + 8 * lane) = a0 * q0 * rs; *(f32x4*)(o + 8 * lane + 4) = a1 * q1 * rs; *(f32x4*)(o + 512 + 8 * lane) = b0 * q2 * rs; *(f32x4*)(o + 512 + 8 * lane + 4) = b1 * q3 * rs; }
    }
}

__device__ __forceinline__ void s5_item(const Params& P, int l, int it, LAS unsigned char* wl, int lane) {
    const int b = it >> 5, g = it & 31, lg = l * 32 + g;
    LAS float* bu = (LAS float*)wl; LAS unsigned char* sl = wl + 16384;
    const int c32 = lane & 31, hi = lane >> 5, fr = lane & 15, fq = lane >> 4;
    const bf16_t* bbt = (const bf16_t*)(P.ws + OFF_S5BB) + (size_t)lg * 128 * 16; const bf16_t* cm = (const bf16_t*)(P.ws + OFF_S5CM) + (size_t)lg * 16 * 128;
    bf16x8 bbreg[4], cmreg[4];
#pragma unroll
    for (int j = 0; j < 4; ++j) { bbreg[j] = *(const bf16x8*)(bbt + (32 * j + c32) * 16 + 8 * hi); cmreg[j] = *(const bf16x8*)(cm + fr * 128 + 32 * j + 8 * fq); }
    const f32x2v av = ((const f32x2v*)(P.ws + OFF_S5A))[lg * 64 + lane]; const float a_re = av.x, a_im = av.y;
    const float dsk = P.in[I_SSMD][l * 512 + g * 16 + fr];
    float s_re = 0.f, s_im = 0.f;
    const bf16_t* Ub = (const bf16_t*)((unsigned char*)P.out + DO_U) + (size_t)b * SEQL * 512 + g * 16; bf16_t* Yb = (bf16_t*)((unsigned char*)P.out + DO_Y) + (size_t)b * SEQL * 512 + g * 16;
    for (int c = 0; c < 64; ++c) {
        const int t0 = c * 32;
        const bf16x8 ureg = *(const bf16x8*)(Ub + (size_t)(t0 + c32) * 512 + 8 * hi);
        unsigned short uep[2][4];
#pragma unroll
        for (int mt = 0; mt < 2; ++mt)
#pragma unroll
            for (int i = 0; i < 4; ++i) uep[mt][i] = Ub[(size_t)(t0 + 16 * mt + 4 * fq + i) * 512 + fr];
#pragma unroll
        for (int j = 0; j < 4; ++j) { f32x16 a;
#pragma unroll
            for (int r = 0; r < 16; ++r) a[r] = 0.f;
            a = __builtin_amdgcn_mfma_f32_32x32x16_bf16(ureg, bbreg[j], a, 0, 0, 0);
#pragma unroll
            for (int r = 0; r < 16; ++r) { const int tok = (r & 3) + 8 * (r >> 2) + 4 * hi; bu[tok * 128 + ((32 * (j & 1) + c32) << 1) + (j >> 1)] = a[r]; } }
        asm volatile("" ::: "memory");
#pragma unroll 8
        for (int t = 0; t < 32; ++t) { const f32x2v v = *(const LAS f32x2v*)(bu + t * 128 + 2 * lane);
            const float nre = fmaf(a_re, s_re, fmaf(-a_im, s_im, v.x)), nim = fmaf(a_re, s_im, fmaf(a_im, s_re, v.y)); s_re = nre; s_im = nim;
            *(LAS unsigned short*)(sl + t * 272 + lane * 2) = f2bf(s_re); *(LAS unsigned short*)(sl + t * 272 + 128 + lane * 2) = f2bf(s_im); }
        asm volatile("" ::: "memory");
#pragma unroll
        for (int mt = 0; mt < 2; ++mt) { f32x4 ya = {0.f, 0.f, 0.f, 0.f};
#pragma unroll
            for (int ks = 0; ks < 4; ++ks) { const bf16x8 a = *(const LAS bf16x8*)(sl + (16 * mt + fr) * 272 + (32 * ks + 8 * fq) * 2); ya = __builtin_amdgcn_mfma_f32_16x16x32_bf16(a, cmreg[ks], ya, 0, 0, 0); }
#pragma unroll
            for (int i = 0; i < 4; ++i) { const float y = ya[i] + dsk * __uint_as_float((unsigned)uep[mt][i] << 16);
                const float ge = y * sigm(1.5957691216057308f * (y + 0.044715f * y * y * y));
                Yb[(size_t)(t0 + 16 * mt + 4 * fq + i) * 512 + fr] = f2bf(ge); } }
        asm volatile("" ::: "memory");
    }
}

template <int PAT> __device__ __forceinline__ void attn_item(const Params& P, int it, LAS unsigned char* vl, int lane) {
    constexpr int d = PAT == 0 ? 1 : (PAT == 1 ? 4 : 16);
    constexpr int ngrp = (SEQL / d) / 32;
    constexpr int KSTR = 144;
    const int j = it % ngrp; int t = it / ngrp; const int r = t % d; t /= d; const int h = t & 7, b = t >> 3;
    const int c32 = lane & 31, hi = lane >> 5, i0 = 32 * j;
    const int lrow = lane >> 3, lch = lane & 7;
    const size_t tokbase = (size_t)b * SEQL;
    bf16_t* QO = (bf16_t*)(P.ws + OFF_QO); const bf16_t* Kb = (const bf16_t*)((unsigned char*)P.out + DO_K); const bf16_t* Vb = (const bf16_t*)((unsigned char*)P.out + DO_V);
    float* LSE = (float*)(P.ws + OFF_LSE);
    const unsigned char* qrow0 = (const unsigned char*)QO + ((tokbase + (size_t)i0 * d + r) * 1536 + PAT * 512 + h * 64) * 2;
    const unsigned char* krow0 = (const unsigned char*)Kb + ((tokbase + (size_t)(i0 - 128) * d + r) * 512 + h * 64) * 2;
    const unsigned char* vrow0 = (const unsigned char*)Vb + ((tokbase + (size_t)(i0 - 128) * d + r) * 512 + h * 64) * 2;
    const unsigned qlo = (unsigned)(lrow * d * 3072 + lch * 16), klo = (unsigned)(lrow * d * 1024 + lch * 16);
    u32x4 qraw[4], kraw[5][4];
#pragma unroll
    for (int i4 = 0; i4 < 4; ++i4) qraw[i4] = *(const u32x4*)(qrow0 + (qlo + (unsigned)(8 * i4 * d * 3072)));
#pragma unroll
    for (int kt = 0; kt < 5; ++kt) { const int kb = i0 - 128 + 32 * kt;
        if (kb >= 0) {
#pragma unroll
            for (int i4 = 0; i4 < 4; ++i4) kraw[kt][i4] = *(const u32x4*)(krow0 + (klo + (unsigned)((32 * kt + 8 * i4) * d * 1024))); } }
    bf16x8 qreg[4];
#pragma unroll
    for (int i4 = 0; i4 < 4; ++i4) *(LAS u32x4*)(vl + (lrow + 8 * i4) * KSTR + lch * 16) = qraw[i4];
    asm volatile("" ::: "memory");
#pragma unroll
    for (int ks = 0; ks < 4; ++ks) qreg[ks] = *(const LAS bf16x8*)(vl + c32 * KSTR + (16 * ks + 8 * hi) * 2);
    asm volatile("" ::: "memory");
    f32x16 s[5];
#pragma unroll
    for (int kt = 0; kt < 5; ++kt) { const int kb = i0 - 128 + 32 * kt;
        f32x16 a;
        if (kb >= 0) {
#pragma unroll
            for (int q = 0; q < 16; ++q) a[q] = 0.f;
#pragma unroll
            for (int i4 = 0; i4 < 4; ++i4) *(LAS u32x4*)(vl + (lrow + 8 * i4) * KSTR + lch * 16) = kraw[kt][i4];
            asm volatile("" ::: "memory");
#pragma unroll
            for (int ks = 0; ks < 4; ++ks) { const bf16x8 kreg = *(const LAS bf16x8*)(vl + c32 * KSTR + (16 * ks + 8 * hi) * 2); a = __builtin_amdgcn_mfma_f32_32x32x16_bf16(kreg, qreg[ks], a, 0, 0, 0); }
            asm volatile("" ::: "memory");
        } else {
#pragma unroll
            for (int q = 0; q < 16; ++q) a[q] = (-__builtin_inff());
        }
        s[kt] = a; }
    u32x4 vreg[5][4];
#pragma unroll
    for (int kt = 0; kt < 3; ++kt) { const int kb = i0 - 128 + 32 * kt;
        if (kb >= 0) {
#pragma unroll
            for (int i4 = 0; i4 < 4; ++i4) vreg[kt][i4] = *(const u32x4*)(vrow0 + (klo + (unsigned)((32 * kt + 8 * i4) * d * 1024))); } }
#pragma unroll
    for (int q = 0; q < 16; ++q) { const int kr = (q & 3) + 8 * (q >> 2) + 4 * hi; if (kr < c32) s[0][q] = (-__builtin_inff()); if (kr > c32) s[4][q] = (-__builtin_inff()); }
    float mx = (-__builtin_inff());
#pragma unroll
    for (int kt = 0; kt < 5; ++kt)
#pragma unroll
        for (int q = 0; q < 16; ++q) mx = fmaxf(mx, s[kt][q]);
    mx = fmaxf(mx, __shfl_xor(mx, 32));
    float den = 0.f;
#pragma unroll
    for (int kt = 0; kt < 5; ++kt)
#pragma unroll
        for (int q = 0; q < 16; ++q) { const float p = __builtin_amdgcn_exp2f(s[kt][q] - mx); s[kt][q] = p; den += p; }
    den += __shfl_xor(den, 32);
    u32x4 pw[5][2];
#pragma unroll
    for (int kt = 0; kt < 5; ++kt)
#pragma unroll
        for (int ks2 = 0; ks2 < 2; ++ks2) { pw[kt][ks2].x = cvt_pk_bf16(s[kt][8 * ks2 + 0], s[kt][8 * ks2 + 1]); pw[kt][ks2].y = cvt_pk_bf16(s[kt][8 * ks2 + 2], s[kt][8 * ks2 + 3]);
            pw[kt][ks2].z = cvt_pk_bf16(s[kt][8 * ks2 + 4], s[kt][8 * ks2 + 5]); pw[kt][ks2].w = cvt_pk_bf16(s[kt][8 * ks2 + 6], s[kt][8 * ks2 + 7]); }
#pragma unroll
    for (int kt = 3; kt < 5; ++kt) { const int kb = i0 - 128 + 32 * kt;
        if (kb >= 0) {
#pragma unroll
            for (int i4 = 0; i4 < 4; ++i4) vreg[kt][i4] = *(const u32x4*)(vrow0 + (klo + (unsigned)((32 * kt + 8 * i4) * d * 1024))); } }
    u32x4 mraw[2][4]; float l2b = 0.f, l2c = 0.f;
    if (PAT == 0) {
#pragma unroll
        for (int pp = 0; pp < 2; ++pp)
#pragma unroll
            for (int i4 = 0; i4 < 4; ++i4) mraw[pp][i4] = *(const u32x4*)(qrow0 + (qlo + (unsigned)(8 * i4 * 3072 + (pp + 1) * 1024)));
        l2b = LSE[((size_t)(0 * 32 + b) * 8 + h) * SEQL + i0 + c32]; l2c = LSE[((size_t)(1 * 32 + b) * 8 + h) * SEQL + i0 + c32];
    }
    f32x16 o[2];
#pragma unroll
    for (int q = 0; q < 16; ++q) { o[0][q] = 0.f; o[1][q] = 0.f; }
    const int gi = lane >> 4, li = lane & 15;
    const LAS unsigned char* vrd = vl + (4 * hi + (li >> 2)) * VSTR + (16 * (gi & 1) + 4 * (li & 3)) * 2;
#pragma unroll
    for (int kt = 0; kt < 5; ++kt) { const int kb = i0 - 128 + 32 * kt;
        if (kb >= 0) {
#pragma unroll
            for (int i4 = 0; i4 < 4; ++i4) *(LAS u32x4*)(vl + (lrow + 8 * i4) * VSTR + lch * 16) = vreg[kt][i4];
            asm volatile("" ::: "memory");
#pragma unroll
            for (int ks2 = 0; ks2 < 2; ++ks2) {
                const bf16x8 pb = __builtin_bit_cast(bf16x8, pw[kt][ks2]);
#pragma unroll
                for (int mt = 0; mt < 2; ++mt) { const LAS unsigned char* a1 = vrd + (16 * ks2) * VSTR + 64 * mt;
                    const s16x4 lo = vtr(a1), up = vtr(a1 + 8 * VSTR);
                    bf16x8 av; av[0] = lo[0]; av[1] = lo[1]; av[2] = lo[2]; av[3] = lo[3]; av[4] = up[0]; av[5] = up[1]; av[6] = up[2]; av[7] = up[3];
                    o[mt] = __builtin_amdgcn_mfma_f32_32x32x16_bf16(av, pb, o[mt], 0, 0, 0); } }
            asm volatile("" ::: "memory");
        } }
    const float inv = __builtin_amdgcn_rcpf(den);
    const float l2 = mx + __builtin_amdgcn_logf(den);
    const LAS unsigned char* frd = vl + c32 * KSTR + 8 * hi;
    float w1 = inv;
    if (PAT == 0) {
        const float M = fmaxf(l2, fmaxf(l2b, l2c));
        float e1 = __builtin_amdgcn_exp2f(l2 - M), e2 = __builtin_amdgcn_exp2f(l2b - M), e3 = __builtin_amdgcn_exp2f(l2c - M);
        const float wi = __builtin_amdgcn_rcpf(e1 + e2 + e3); w1 = e1 * wi * inv; const float wo[2] = {e2 * wi, e3 * wi};
#pragma unroll
        for (int q = 0; q < 16; ++q) { o[0][q] *= w1; o[1][q] *= w1; }
#pragma unroll
        for (int pp = 0; pp < 2; ++pp) {
#pragma unroll
            for (int i4 = 0; i4 < 4; ++i4) *(LAS u32x4*)(vl + (lrow + 8 * i4) * KSTR + lch * 16) = mraw[pp][i4];
            asm volatile("" ::: "memory");
#pragma unroll
            for (int mt = 0; mt < 2; ++mt)
#pragma unroll
                for (int rg = 0; rg < 4; ++rg) { const u32x2 bb = *(const LAS u32x2*)(frd + 64 * mt + 16 * rg);
                    o[mt][4 * rg] += wo[pp] * bf_lo(bb.x); o[mt][4 * rg + 1] += wo[pp] * bf_hi(bb.x); o[mt][4 * rg + 2] += wo[pp] * bf_lo(bb.y); o[mt][4 * rg + 3] += wo[pp] * bf_hi(bb.y); }
            asm volatile("" ::: "memory");
        }
    } else {
#pragma unroll
        for (int q = 0; q < 16; ++q) { o[0][q] *= w1; o[1][q] *= w1; }
    }
#pragma unroll
    for (int mt = 0; mt < 2; ++mt)
#pragma unroll
        for (int rg = 0; rg < 4; ++rg) { u32x2 w; w.x = cvt_pk_bf16(o[mt][4 * rg], o[mt][4 * rg + 1]); w.y = cvt_pk_bf16(o[mt][4 * rg + 2], o[mt][4 * rg + 3]);
            *(LAS u32x2*)(vl + c32 * KSTR + 8 * hi + 64 * mt + 16 * rg) = w; }
    asm volatile("" ::: "memory");
    if (PAT != 0) {
#pragma unroll
        for (int i4 = 0; i4 < 4; ++i4) *(u32x4*)((unsigned char*)qrow0 + (qlo + (unsigned)(8 * i4 * d * 3072))) = *(const LAS u32x4*)(vl + (lrow + 8 * i4) * KSTR + lch * 16);
        if (hi == 0) LSE[((size_t)((PAT - 1) * 32 + b) * 8 + h) * SEQL + (size_t)(i0 + c32) * d + r] = l2;
    } else {
        bf16_t* OC = (bf16_t*)(P.ws + OFF_OC);
#pragma unroll
        for (int i4 = 0; i4 < 4; ++i4) *(u32x4*)(OC + (tokbase + (size_t)(i0 + lrow + 8 * i4)) * 512 + h * 64 + lch * 8) = *(const LAS u32x4*)(vl + (lrow + 8 * i4) * KSTR + lch * 16);
    }
    asm volatile("" ::: "memory");
}

__device__ __forceinline__ void conv_item(const Params& P, int l, int it, int lane, const LAS unsigned char* wlds) {
    const int b = it >> 8, t0 = (it & 255) * 8, ch0 = 8 * lane;
    const bf16_t* in = (const bf16_t*)(P.ws + OFF_CG) + (size_t)b * SEQL * 512 + ch0;
    const LAS unsigned char* cw = wlds + 16 * lane;
    float acc[8][8], win[8][8];
    { const f32x4 b0 = *(const f32x4*)(P.in[I_CONVB] + l * 512 + ch0), b1 = *(const f32x4*)(P.in[I_CONVB] + l * 512 + ch0 + 4);
#pragma unroll
      for (int i = 0; i < 8; ++i) { acc[i][0] = b0[0]; acc[i][1] = b0[1]; acc[i][2] = b0[2]; acc[i][3] = b0[3]; acc[i][4] = b1[0]; acc[i][5] = b1[1]; acc[i][6] = b1[2]; acc[i][7] = b1[3]; } }
#define CONV_LOADROW(rr, dst) do { const int t_ = t0 - 30 + (rr); if (t_ >= 0) { const u32x4 v_ = *(const u32x4*)(in + (size_t)t_ * 512); \
        dst[0] = bf_lo(v_.x); dst[1] = bf_hi(v_.x); dst[2] = bf_lo(v_.y); dst[3] = bf_hi(v_.y); dst[4] = bf_lo(v_.z); dst[5] = bf_hi(v_.z); dst[6] = bf_lo(v_.w); dst[7] = bf_hi(v_.w); } \
        else { _Pragma("unroll") for (int c_ = 0; c_ < 8; ++c_) dst[c_] = 0.f; } } while (0)
#pragma unroll
    for (int rr = 0; rr < 8; ++rr) CONV_LOADROW(rr, win[rr]);
    for (int jb = 0; jb < 32; jb += 8) {
        asm volatile("" ::: "memory");
#pragma unroll
        for (int jj = 0; jj < 8; ++jj) { const int j = jb + jj;
            if (j < 31) { const u32x4 wv = *(const LAS u32x4*)(cw + j * 1024);
                float w[8]; w[0] = bf_lo(wv.x); w[1] = bf_hi(wv.x); w[2] = bf_lo(wv.y); w[3] = bf_hi(wv.y); w[4] = bf_lo(wv.z); w[5] = bf_hi(wv.z); w[6] = bf_lo(wv.w); w[7] = bf_hi(wv.w);
#pragma unroll
                for (int i = 0; i < 8; ++i)
#pragma unroll
                    for (int c = 0; c < 8; ++c) acc[i][c] = fmaf(w[c], win[(jj + i) & 7][c], acc[i][c]);
                if (j + 8 < 38) CONV_LOADROW(j + 8, win[jj]); } }
    }
#undef CONV_LOADROW
    const f32x4 g0 = *(const f32x4*)(P.in[I_LNG] + l * 512 + ch0), g1 = *(const f32x4*)(P.in[I_LNG] + l * 512 + ch0 + 4);
    const f32x4 e0 = *(const f32x4*)(P.in[I_LNB] + l * 512 + ch0), e1 = *(const f32x4*)(P.in[I_LNB] + l * 512 + ch0 + 4);
    bf16_t* outp = (bf16_t*)(P.ws + OFF_HC) + ((size_t)b * SEQL + t0) * 512 + ch0;
#pragma unroll
    for (int i = 0; i < 8; ++i) { float s1 = 0.f, s2 = 0.f;
#pragma unroll
        for (int c = 0; c < 8; ++c) { s1 += acc[i][c]; s2 += acc[i][c] * acc[i][c]; }
        s1 = wave_sum(s1); s2 = wave_sum(s2);
        const float mean = s1 * (1.f / 512.f), var = fmaxf(s2 * (1.f / 512.f) - mean * mean, 0.f), rs = rsqrtf(var + EPSN);
        f32x4 y0, y1;
#pragma unroll
        for (int c = 0; c < 4; ++c) { const float h0 = (acc[i][c] - mean) * rs * g0[c] + e0[c], h1 = (acc[i][4 + c] - mean) * rs * g1[c] + e1[c]; y0[c] = h0 * sigm(h0); y1[c] = h1 * sigm(h1); }
        *(u32x4*)(outp + (size_t)i * 512) = pack8(y0, y1); }
}

__device__ __forceinline__ int xcc_id() { return (int)(__builtin_amdgcn_s_getreg((3 << 11) | 20) & 7u); }
__device__ __forceinline__ int claim_issue(unsigned* ctr, int& lane) { asm volatile("" : "+v"(lane)); int v = 0; if (lane == 0) v = (int)atomicAdd(ctr, 1u); return v; }
__device__ __forceinline__ int lane_now() { int l = (int)__builtin_amdgcn_mbcnt_hi(~0u, __builtin_amdgcn_mbcnt_lo(~0u, 0u)); asm volatile("" : "+v"(l)); return l; }
__device__ __forceinline__ int lds_claim(LAS unsigned* ctr, int lane) { int v = 0; if (lane == 0) v = (int)__hip_atomic_fetch_add(ctr, 1u, __ATOMIC_RELAXED, __HIP_MEMORY_SCOPE_WORKGROUP); return __builtin_amdgcn_readfirstlane(v); }
__device__ __forceinline__ int claim(unsigned* ctr, int& lane) { asm volatile("" : "+v"(lane)); int v = 0; if (lane == 0) v = (int)atomicAdd(ctr, 1u); return __builtin_amdgcn_readfirstlane(v); }


__device__ __forceinline__ void grid_barrier(unsigned* bar, unsigned target, int tid) {
    asm volatile("s_waitcnt vmcnt(0) lgkmcnt(0)" ::: "memory");
    __syncthreads();
    if (tid == 0) {
        __builtin_amdgcn_fence(__ATOMIC_RELEASE, "agent");
        asm volatile("s_waitcnt vmcnt(0) lgkmcnt(0)" ::: "memory");
        __hip_atomic_fetch_add(bar, 1u, __ATOMIC_RELAXED, __HIP_MEMORY_SCOPE_AGENT);
        while (__hip_atomic_load(bar, __ATOMIC_RELAXED, __HIP_MEMORY_SCOPE_AGENT) < target) __builtin_amdgcn_s_sleep(2);
        __builtin_amdgcn_fence(__ATOMIC_ACQUIRE, "agent");
        asm volatile("s_waitcnt vmcnt(0) lgkmcnt(0)" ::: "memory");
    }
    __syncthreads();
}

constexpr int NPHASE = 21;
__global__ void __launch_bounds__(512, 2) fwd_kernel(Params P) {
    extern __shared__ __attribute__((aligned(16))) unsigned char shm[];
    LAS unsigned char* lds = (LAS unsigned char*)shm;
        unsigned char* ws = P.ws; unsigned char* dout = (unsigned char*)P.out;
    bf16_t* xb = (bf16_t*)(ws + OFF_XB); bf16_t* Gt = (bf16_t*)(ws + OFF_G); bf16_t* Mg = (bf16_t*)(dout + DO_MG);
    bf16_t* xn = (bf16_t*)(ws + OFF_HC); bf16_t* Dl = (bf16_t*)(ws + OFF_QO);
    unsigned* ctl = (unsigned*)(ws + OFF_CTL);
    StaticOrder S;
    unsigned nbar = 0;
    const int wave_s = __builtin_amdgcn_readfirstlane((int)threadIdx.x >> 6);
    if (P.ph_hi - P.ph_lo > 1) cg::this_grid().sync();
    for (int ph = P.ph_lo; ph < P.ph_hi; ++ph) {
        const int wave = wave_s;
#define PHASE_IDS const int lane = lane_now(); const int tid = (wave_s << 6) | lane; (void)tid; (void)lane;
        if (ph == 0) { PHASE_IDS for (int rp = 0; rp < NREP_P0; ++rp) phase_p0(P, lds, wave, lane, tid); }
        else if (ph == NPHASE - 1) { PHASE_IDS phase_rows<true>(P, wave, lane); }
        else {
            const int l = (ph - 1) / 10, s = (ph - 1) % 10;
            if (s == 0) { PHASE_IDS
                S.init(NTOK, 7168, gridDim.x, blockIdx.x);
                Gemm g{xb, (const bf16_t*)(ws + OFF_WIN) + (size_t)l * 7168 * 1024, NTOK, 7168, 1024};
                EpiIn E{(bf16_t*)(dout + DO_U), (bf16_t*)(ws + OFF_QO), (bf16_t*)(dout + DO_K), (bf16_t*)(dout + DO_V), (bf16_t*)(ws + OFF_CG), Gt, (const float*)(ws + OFF_RSQ1), P.in[I_BGATE] + l * 3072};
                gemm_phase<EpiIn, StaticOrder, false>(lds, g, S, E, nullptr, tid);
            } else if (s == 1) { PHASE_IDS
                LAS unsigned* lctr = (LAS unsigned*)(lds + CTR_OFF);
                if (tid == 0) lctr[0] = 0u;
                __syncthreads();
                const int grp = blockIdx.x & 7, rank = blockIdx.x >> 3; constexpr int per = 128;
                if (wave < 4) { for (int it = blockIdx.x * 4 + wave; it < 1024; it += gridDim.x * 4) s5_item(P, l, it, lds + wave * S5_WL, lane_now()); }
                LAS unsigned char* vl = lds + ATT_OFF + wave * ATT_WL;
                for (;;) { const int ln = lane_now(); const int k = lds_claim(lctr, ln); const int li = rank * per + k; if (k >= per || li >= 4096) break;
                    const int b = grp + 8 * (li >> 10), rest = li & 1023;
                    if (rest < 512) attn_item<1>(P, b * 512 + rest, vl, ln); else attn_item<2>(P, b * 512 + rest - 512, vl, ln); }
            } else if (s == 2) { PHASE_IDS
                LAS unsigned* lctr = (LAS unsigned*)(lds + CTR_OFF);
                if (tid == 0) lctr[0] = 0u;
                { const unsigned* cwg = (const unsigned*)(ws + OFF_CONVW) + (size_t)l * 31 * 256;
                  for (int i = tid; i < 31 * 64; i += 512) *(LAS u32x4*)(lds + i * 16) = *(const u32x4*)(cwg + i * 4); }
                __syncthreads();
                const int grp = blockIdx.x & 7, rank = blockIdx.x >> 3; constexpr int per = 96;
                LAS unsigned char* vl = lds + ATT_OFF + wave * ATT_WL;
                for (;;) { const int ln = lane_now(); const int k = lds_claim(lctr, ln); const int li = rank * per + k; if (k >= per || li >= 3072) break;
                    const int b = grp + 8 * (li / 768), rest = li % 768;
                    if (rest < 512) attn_item<0>(P, b * 512 + rest, vl, ln); else conv_item(P, l, b * 256 + rest - 512, ln, lds); }
            } else if (s == 3) { PHASE_IDS
                S.init(NTOK, 2048, gridDim.x, blockIdx.x);
                Gemm g{(const bf16_t*)(dout + DO_Y), (const bf16_t*)(ws + OFF_WGLU) + (size_t)l * 2048 * 512, NTOK, 2048, 512};
                EpiGluMerge E{Mg, Gt};
                gemm_phase<EpiGluMerge, StaticOrder, false>(lds, g, S, E, nullptr, tid);
            } else if (s == 4) { PHASE_IDS
                S.init(NTOK, 1024, gridDim.x, blockIdx.x);
                for (int c = 0; c < 2; ++c) {
                    Gemm g{(const bf16_t*)(ws + (c == 0 ? OFF_HC : OFF_OC)), (const bf16_t*)(ws + (c == 0 ? OFF_WPW2 : OFF_WATT)) + (size_t)l * 1024 * 512, NTOK, 1024, 512};
                    EpiAccMerge E{Mg, Gt, c == 0 ? 2048 : 1024};
                    gemm_phase<EpiAccMerge, StaticOrder, false>(lds, g, S, E, nullptr, tid);
                    __syncthreads();
                }
            } else if (s == 6 || s == 9) { PHASE_IDS
                phase_rows<false>(P, wave, lane);
            } else if (s == 5 || s == 8) { PHASE_IDS
                S.init(NTOK, 1024, gridDim.x, blockIdx.x);
                Gemm g{s == 5 ? (const bf16_t*)Mg : (const bf16_t*)Gt, s == 5 ? (const bf16_t*)(ws + OFF_WOUT) + (size_t)l * 1024 * 1024 : (const bf16_t*)(ws + OFF_WF2) + (size_t)l * 1024 * 2816, NTOK, 1024, s == 5 ? 1024 : 2816};
                EpiDelta E{Dl};
                gemm_phase<EpiDelta, StaticOrder, false>(lds, g, S, E, nullptr, tid);
            } else {
                PHASE_IDS
                S.init(NTOK, 5632, gridDim.x, blockIdx.x);
                Gemm g{xn, (const bf16_t*)(ws + OFF_WF1) + (size_t)l * 5632 * 1024, NTOK, 5632, 1024};
                EpiFfn1 E{Gt};
                gemm_phase<EpiFfn1, StaticOrder, false>(lds, g, S, E, nullptr, tid);
            }
        }
        if (ph + 1 < P.ph_hi) { ++nbar; grid_barrier(ctl + 3072, nbar * gridDim.x, (wave_s << 6) | lane_now()); }
    }
}

extern "C" void kernel_launch(void* const* d_in, const int* in_sizes, int n_in, void* d_out, int out_size, void* d_ws, size_t ws_size, hipStream_t stream) {
    static int grid = 0;
    if (grid == 0) {
        if (n_in != 24 || out_size != NTOK * 1024 || ws_size < WS_END) { fprintf(stderr, "kernel_launch: unexpected problem (n_in %d out %d ws %zu need %zu)\n", n_in, out_size, ws_size, (size_t)WS_END); grid = -1; return; }
        int dev = 0, cus = 0, per_cu = 0;
        hipGetDevice(&dev); hipDeviceGetAttribute(&cus, hipDeviceAttributeMultiprocessorCount, dev);
        if (hipFuncSetAttribute((const void*)fwd_kernel, hipFuncAttributeMaxDynamicSharedMemorySize, LDS_BYTES) != hipSuccess) { fprintf(stderr, "kernel_launch: hipFuncSetAttribute failed\n"); grid = -1; return; }
        hipOccupancyMaxActiveBlocksPerMultiprocessor(&per_cu, (const void*)fwd_kernel, 512, LDS_BYTES);
        if (per_cu < 1) { fprintf(stderr, "kernel_launch: occupancy query says %d blocks/CU\n", per_cu); per_cu = 1; }
        (void)hipGetLastError();
        grid = cus * per_cu; if (grid > 256) grid = 256;
        if (grid != 256) { fprintf(stderr, "kernel_launch: this build partitions its work over exactly 256 workgroups (got %d)\n", grid); grid = -1; return; }
    }
    if (grid < 0) return;
    hipMemsetAsync((unsigned char*)d_ws + OFF_CTL, 0, 16384, stream);
    Params p{};
    for (int i = 0; i < 24; ++i) p.in[i] = (const float*)d_in[i];
    p.out = (float*)d_out; p.ws = (unsigned char*)d_ws;
#if MK_PER_PHASE
    for (int ph = 0; ph < NPHASE; ++ph) { p.ph_lo = ph; p.ph_hi = ph + 1; hipLaunchKernelGGL(fwd_kernel, dim3(grid), dim3(512), LDS_BYTES, stream, p); }
#else
    p.ph_lo = 0; p.ph_hi = NPHASE;
    void* args[] = {&p};
    hipError_t e = hipLaunchCooperativeKernel((const void*)fwd_kernel, dim3(grid), dim3(512), args, LDS_BYTES, stream);
    if (e != hipSuccess) fprintf(stderr, "cooperative launch failed: %s (grid %d)\n", hipGetErrorString(e), grid);
#endif
}
```

```cpp
#include <hip/hip_runtime.h>
#include <hip/hip_cooperative_groups.h>
#include <cstdio>
namespace cg = cooperative_groups;
namespace pg8 {
#define PG8_LAS __attribute__((address_space(3)))
typedef unsigned short bf16_t;
typedef short bf16x8 __attribute__((ext_vector_type(8)));
typedef float f32x4 __attribute__((ext_vector_type(4)));
typedef unsigned u32x4 __attribute__((ext_vector_type(4)));
constexpr int BM = 256, BK = 64, HALF = 128, HTB = HALF * BK * 2  , STAGE_BYTES = 8 * HTB, NXCD = 8, WGM = 8;

__host__ __device__ __forceinline__ int lds_byte(int r, int c) { const int st = (r >> 4) * 2 + (c >> 5), rr = r & 15, cc = c & 31, ob = rr * 64 + cc * 2; return st * 1024 + (ob ^ (((ob >> 9) & 1) << 5)); }
__host__ __device__ __forceinline__ void stage_rc(int b, int& R, int& C) { const int st = b / 1024, sb = b % 1024, swz = sb ^ (((sb >> 9) & 1) << 5); R = (st >> 1) * 16 + swz / 64; C = (st & 1) * 32 + (swz % 64) / 2; }
__host__ __device__ __forceinline__ int perm32(int rho) { const int n = rho >> 4, i = rho & 15; return 8 * (i >> 2) + 4 * n + (i & 3); }

struct Unit { int pm, pn; };
struct Gemm { const bf16_t* A; const bf16_t* Bt; int M, N, K; };

struct StaticOrder {
    int nM, nN, nwg, G, c;
    __host__ __device__ void init(int M, int N, int G_, int c_) { nM = M / BM; nN = N / BM; nwg = nM * nN; G = G_; c = c_; }
    __host__ __device__ bool next(int i, Unit& u) const {
        const long L = (long)i * G + c; if (L >= nwg) return false;
        int wgid = (int)L; { const int q = nwg / NXCD, r = nwg % NXCD, xcd = wgid % NXCD, off = wgid / NXCD; wgid = (xcd < r ? xcd * (q + 1) : r * (q + 1) + (xcd - r) * q) + off; }
        const int nig = WGM * nN, gid = wgid / nig, fm = gid * WGM, gsz = (nM - fm) < WGM ? (nM - fm) : WGM;
        u.pm = fm + ((wgid % nig) % gsz); u.pn = (wgid % nig) / gsz; return true;
    }
    __device__ __forceinline__ void a_ready(const Unit&) const {}
    __device__ __forceinline__ void done(const Unit&) const {}
};
__device__ __forceinline__ unsigned cvt_pk_bf16(float lo, float hi) { unsigned r; asm volatile("v_cvt_pk_bf16_f32 %0, %1, %2" : "=v"(r) : "v"(lo), "v"(hi)); return r; }
template <class Epi, class Sched, bool STAMP = false>
__device__ __forceinline__ void gemm_phase(PG8_LAS unsigned char* lds, const Gemm g, const Sched& S, const Epi& E, unsigned long long* stamps, int tid_in) {
    int tid_o = tid_in; asm volatile("" : "+v"(tid_o)); const int tid = tid_o, wid = __builtin_amdgcn_readfirstlane(tid >> 6), lane = tid & 63, wr = wid >> 2, wc = wid & 3, fr = lane & 15, fq = lane >> 4;
    const int K = g.K, nt = K / BK;
    int ts_lo = 0, ts_hi = 0, nts = 0; const unsigned long long rt_entry = STAMP ? (unsigned long long)wall_clock64() : 0ull;
#define PG8_STAMP() do { if (STAMP && wid == 0 && nts < 64) { const unsigned long long _c = (unsigned long long)clock64(); \
        ts_lo = (lane == nts) ? (int)(unsigned)_c : ts_lo; ts_hi = (lane == nts) ? (int)(unsigned)(_c >> 32) : ts_hi; ++nts; } } while (0)
    PG8_STAMP();
    unsigned voffA[2], voffB[2];
#pragma unroll
    for (int i = 0; i < 2; ++i) { int R, C; stage_rc(tid * 16 + i * 8192, R, C); const int Rb = Epi::PERM ? ((R & ~31) + perm32(R & 31)) : R;
        voffA[i] = (unsigned)(R * K + C) * 2u; voffB[i] = (unsigned)(Rb * K + C) * 2u; }
    const size_t kstep = (size_t)(BK * 2);
    const size_t hstep = (size_t)HALF * K * 2;
    const size_t tstep = 2 * hstep;
    const unsigned ldsw = (unsigned)wid * 1024u;
    const int aoff = lds_byte(wr * 64 + fr, fq * 8), boff = lds_byte(wc * 32 + fr, fq * 8);
#define PG8_SA(b, h) (((b) * 2 + (h)) * HTB)
#define PG8_SB(b, h) ((4 + (b) * 2 + (h)) * HTB)
#define PG8_STAGE(bufoff, gbase, voff) do { _Pragma("unroll") for (int _i = 0; _i < 2; ++_i) \
        __builtin_amdgcn_global_load_lds((const unsigned*)((const char*)(gbase) + (voff)[_i]), (PG8_LAS unsigned*)(lds + (bufoff) + ldsw + _i * 8192), 16, 0, 0); } while (0)
#define PG8_LDA(dst, b, h) do { _Pragma("unroll") for (int m = 0; m < 4; ++m) _Pragma("unroll") for (int k = 0; k < 2; ++k) dst[m][k] = *(const PG8_LAS bf16x8*)(lds + PG8_SA(b, h) + aoff + m * 2048 + k * 1024); } while (0)
#define PG8_LDB(dst, b, h) do { _Pragma("unroll") for (int n = 0; n < 2; ++n) _Pragma("unroll") for (int k = 0; k < 2; ++k) dst[n][k] = *(const PG8_LAS bf16x8*)(lds + PG8_SB(b, h) + boff + n * 2048 + k * 1024); } while (0)
#define PG8_MMA(ai, bj, At, Bt) do { __builtin_amdgcn_s_setprio(1); _Pragma("unroll") for (int m = 0; m < 4; ++m) _Pragma("unroll") for (int n = 0; n < 2; ++n) _Pragma("unroll") for (int k = 0; k < 2; ++k) \
        acc[ai][bj][m][n] = __builtin_amdgcn_mfma_f32_16x16x32_bf16(Bt[n][k], At[m][k], acc[ai][bj][m][n], 0, 0, 0); __builtin_amdgcn_s_setprio(0); } while (0)
#define PG8_WAIT_V(n) asm volatile("s_waitcnt vmcnt(" #n ")" ::: "memory")
#define PG8_WAIT_L(n) asm volatile("s_waitcnt lgkmcnt(" #n ")" ::: "memory")
#define PG8_BAR __builtin_amdgcn_s_barrier()
#define PG8_SCHED __builtin_amdgcn_sched_barrier(0)
    Unit cur, nxt; int ui = 0;
    if (!S.next(0, cur)) return;
    f32x4 acc[2][2][4][2];
#pragma unroll
    for (int a = 0; a < 2; ++a)
#pragma unroll
        for (int b = 0; b < 2; ++b)
#pragma unroll
            for (int m = 0; m < 4; ++m)
#pragma unroll
                for (int n = 0; n < 2; ++n) acc[a][b][m][n] = (f32x4){0.f, 0.f, 0.f, 0.f};
    bf16x8 At[4][2], B0[2][2], B1[2][2];
    const char* cA = (const char*)g.A + (size_t)cur.pm * tstep; const char* cB = (const char*)g.Bt + (size_t)cur.pn * tstep;
    S.a_ready(cur);
    PG8_STAGE(PG8_SB(0, 0), cB, voffB); PG8_STAGE(PG8_SA(0, 0), cA, voffA); PG8_STAGE(PG8_SB(0, 1), cB + hstep, voffB); PG8_STAGE(PG8_SA(0, 1), cA + hstep, voffA);
    if (wr == 1) PG8_BAR;
    PG8_WAIT_V(4); PG8_BAR;
    PG8_STAGE(PG8_SB(1, 0), cB + kstep, voffB); PG8_STAGE(PG8_SA(1, 0), cA + kstep, voffA); PG8_STAGE(PG8_SB(1, 1), cB + hstep + kstep, voffB);
    PG8_WAIT_V(6); PG8_BAR;
    PG8_STAMP();
    for (;;) {
        const bool has_next = S.next(ui + 1, nxt);
        const char* nA = has_next ? (const char*)g.A + (size_t)nxt.pm * tstep : cA; const char* nB = has_next ? (const char*)g.Bt + (size_t)nxt.pn * tstep : cB;
        for (int t = 0; t < nt; t += 2) {
            const bool last = (t == nt - 2);
            const char* a1 = cA + (size_t)(t + 1) * kstep;
            const char* a2 = last ? nA : cA + (size_t)(t + 2) * kstep; const char* b2 = last ? nB : cB + (size_t)(t + 2) * kstep;
            const char* a3 = a2 + kstep; const char* b3 = b2 + kstep;
            if (last && has_next) S.a_ready(nxt);
            PG8_LDB(B0, 0, 0); PG8_SCHED; PG8_LDA(At, 0, 0); PG8_STAGE(PG8_SA(1, 1), a1 + hstep, voffA);
            PG8_WAIT_L(8); PG8_BAR; PG8_WAIT_L(0); PG8_MMA(0, 0, At, B0); PG8_BAR; PG8_SCHED;
            PG8_LDB(B1, 0, 1); PG8_STAGE(PG8_SB(0, 0), b2, voffB);
            PG8_BAR; PG8_WAIT_L(0); PG8_MMA(0, 1, At, B1); PG8_BAR;
            PG8_LDA(At, 0, 1); PG8_STAGE(PG8_SA(0, 0), a2, voffA);
            PG8_BAR; PG8_WAIT_L(0); PG8_MMA(1, 0, At, B0); PG8_BAR; PG8_SCHED;
            PG8_STAGE(PG8_SB(0, 1), b2 + hstep, voffB);
            PG8_WAIT_V(6); PG8_BAR; PG8_MMA(1, 1, At, B1); PG8_BAR;
            PG8_LDB(B0, 1, 0); PG8_SCHED; PG8_LDA(At, 1, 0); PG8_STAGE(PG8_SA(0, 1), a2 + hstep, voffA);
            PG8_WAIT_L(8); PG8_BAR; PG8_WAIT_L(0); PG8_MMA(0, 0, At, B0); PG8_BAR; PG8_SCHED;
            PG8_LDB(B1, 1, 1); PG8_STAGE(PG8_SB(1, 0), b3, voffB);
            PG8_BAR; PG8_WAIT_L(0); PG8_MMA(0, 1, At, B1); PG8_BAR;
            PG8_LDA(At, 1, 1); PG8_STAGE(PG8_SA(1, 0), a3, voffA);
            PG8_BAR; PG8_WAIT_L(0); PG8_MMA(1, 0, At, B0); PG8_BAR; PG8_SCHED;
            PG8_STAGE(PG8_SB(1, 1), b3 + hstep, voffB);
            PG8_WAIT_V(6); PG8_BAR; PG8_MMA(1, 1, At, B1); PG8_BAR;
        }
        PG8_STAMP();
        if constexpr (!Epi::AFTER_DRAIN) { E(acc, cur, wr, wc, fr, fq); S.done(cur); }
        PG8_STAMP();
        if (!has_next) break;
#pragma unroll
        for (int a = 0; a < 2; ++a)
#pragma unroll
            for (int b = 0; b < 2; ++b)
#pragma unroll
                for (int m = 0; m < 4; ++m)
#pragma unroll
                    for (int n = 0; n < 2; ++n) acc[a][b][m][n] = (f32x4){0.f, 0.f, 0.f, 0.f};
        cur = nxt; cA = nA; cB = nB; ++ui;
    }
    PG8_WAIT_V(0);
    if (wr == 0) PG8_BAR;
    PG8_BAR;
    if constexpr (Epi::AFTER_DRAIN) { E.fused(acc, cur, wr, wc, fr, fq, lds, wid, lane); S.done(cur); }
    PG8_STAMP();
    if (STAMP && wid == 0) { stamps[lane] = lane < nts ? (((unsigned long long)(unsigned)ts_hi << 32) | (unsigned)ts_lo) : 0ull;
        if (lane == 62) stamps[62] = rt_entry; if (lane == 63) stamps[63] = (unsigned long long)wall_clock64(); }
#undef PG8_STAMP
#undef PG8_SA
#undef PG8_SB
#undef PG8_STAGE
#undef PG8_LDA
#undef PG8_LDB
#undef PG8_MMA
#undef PG8_WAIT_V
#undef PG8_WAIT_L
#undef PG8_BAR
#undef PG8_SCHED
}
}

using namespace pg8;
#define LAS __attribute__((address_space(3)))
typedef short s16x4 __attribute__((ext_vector_type(4)));
typedef short v4i16_t __attribute__((ext_vector_type(4)));
typedef float f32x16 __attribute__((ext_vector_type(16)));
typedef unsigned u32x2 __attribute__((ext_vector_type(2)));
typedef float f32x2v __attribute__((ext_vector_type(2)));

#ifndef NREP_S5
#define NREP_S5 1
#endif
#ifndef NREP_B2
#define NREP_B2 1
#endif
#ifndef NREP_P0
#define NREP_P0 1
#endif
#ifndef MK_PER_PHASE
#define MK_PER_PHASE 0
#endif

constexpr int NTOK = 65536, SEQL = 2048;
constexpr float EPSN = 1e-6f;
constexpr int LDS_BYTES = 155648;
constexpr int S5_WL = 25088;
constexpr int ATT_OFF = 4 * S5_WL;
constexpr int VSTR = 192;
constexpr int ATT_WL = 32 * VSTR;
constexpr int CTR_OFF = LDS_BYTES - 256;
static_assert(ATT_OFF + 8 * ATT_WL <= CTR_OFF, "lds");

constexpr size_t OFF_WIN = 0;
constexpr size_t OFF_WGLU = OFF_WIN + 2ull * 7168 * 1024 * 2;
constexpr size_t OFF_WATT = OFF_WGLU + 2ull * 2048 * 512 * 2;
constexpr size_t OFF_WPW2 = OFF_WATT + 2ull * 1024 * 512 * 2;
constexpr size_t OFF_WOUT = OFF_WPW2 + 2ull * 1024 * 512 * 2;
constexpr size_t OFF_WF1 = OFF_WOUT + 2ull * 1024 * 1024 * 2;
constexpr size_t OFF_WF2 = OFF_WF1 + 2ull * 5632 * 1024 * 2;
constexpr size_t OFF_S5BB = OFF_WF2 + 2ull * 1024 * 2816 * 2;
constexpr size_t OFF_S5CM = OFF_S5BB + 2ull * 32 * 128 * 16 * 2;
constexpr size_t OFF_S5A = OFF_S5CM + 2ull * 32 * 16 * 128 * 2;
constexpr size_t OFF_CONVW = OFF_S5A + 2ull * 32 * 64 * 8;
constexpr size_t OFF_CTL = OFF_CONVW + 65536;
constexpr size_t OFF_RSQ1 = OFF_CTL + 16384;
constexpr size_t OFF_RSQ2 = OFF_RSQ1 + 65536ull * 8;
constexpr size_t OFF_LSE = OFF_RSQ2 + 65536ull * 8;
constexpr size_t OFF_XB = OFF_LSE + 2ull * 65536 * 8 * 4;
constexpr size_t OFF_G = OFF_XB + 65536ull * 1024 * 2;
constexpr size_t OFF_QO = OFF_G + 65536ull * 3072 * 2;
constexpr size_t OFF_CG = OFF_QO + 65536ull * 1536 * 2;
constexpr size_t OFF_HC = OFF_CG + 65536ull * 512 * 2;
constexpr size_t OFF_OC = OFF_HC + 65536ull * 512 * 2;
constexpr size_t WS_END = OFF_OC + 65536ull * 512 * 2;
constexpr size_t DO_U = 0, DO_K = 64ull << 20, DO_V = 128ull << 20, DO_Y = 192ull << 20, DO_MG = 64ull << 20;

struct Params {
    const float* in[24];
    float* out; unsigned char* ws;
    int ph_lo, ph_hi;
};
enum { I_X = 0, I_N1G, I_WIN, I_BGATE, I_LRE, I_LIM, I_LOGDT, I_BRE, I_BIM, I_CRE, I_CIM, I_SSMD, I_WGLU, I_WATT, I_CONVW, I_CONVB, I_LNG, I_LNB, I_WPW2, I_WOUT, I_N2G, I_WF1, I_WF2, I_FING };

__device__ __forceinline__ float bf_lo(unsigned u) { return __uint_as_float(u << 16); }
__device__ __forceinline__ float bf_hi(unsigned u) { return __uint_as_float(u & 0xffff0000u); }
__device__ __forceinline__ float sigm(float x) { return __builtin_amdgcn_rcpf(1.f + __expf(-x)); }
__device__ __forceinline__ unsigned short f2bf(float f) { unsigned u = __float_as_uint(f); u += 0x7FFFu + ((u >> 16) & 1u); return (unsigned short)(u >> 16); }
__device__ __forceinline__ float wave_sum(float v) {
#pragma unroll
    for (int o = 1; o < 64; o <<= 1) v += __shfl_xor(v, o);
    return v;
}
__device__ __forceinline__ s16x4 vtr(const LAS unsigned char* p) { return __builtin_bit_cast(s16x4, __builtin_amdgcn_ds_read_tr16_b64_v4i16((LAS v4i16_t*)p)); }

__device__ __forceinline__ u32x4 pack8(const f32x4 a, const f32x4 b) { u32x4 w; w.x = cvt_pk_bf16(a[0], a[1]); w.y = cvt_pk_bf16(a[2], a[3]); w.z = cvt_pk_bf16(b[0], b[1]); w.w = cvt_pk_bf16(b[2], b[3]); return w; }
__device__ __forceinline__ void unpack8(const u32x4 w, f32x4& a, f32x4& b) { a[0] = bf_lo(w.x); a[1] = bf_hi(w.x); a[2] = bf_lo(w.y); a[3] = bf_hi(w.y); b[0] = bf_lo(w.z); b[1] = bf_hi(w.z); b[2] = bf_lo(w.w); b[3] = bf_hi(w.w); }

struct EpiIn {
    static constexpr bool PERM = true, AFTER_DRAIN = false;
    bf16_t *U, *QO, *Kb, *Vb, *CG, *G; const float* rowsq; const float* bgate;
    __device__ __forceinline__ void operator()(const f32x4 (&acc)[2][2][4][2], const Unit& u, int wr, int wc, int fr, int fq) const {
        const int row0 = u.pm * 256 + wr * 64 + fr, cl = wc * 32 + 8 * fq, pn = u.pn;
        if (pn < 12) {
            bf16_t* base; int ld, col0;
            if (pn < 2) { base = U; ld = 512; col0 = pn * 256; }
            else if (pn < 8) { base = QO; ld = 1536; col0 = (pn - 2) * 256; }
            else if (pn < 10) { base = Kb; ld = 512; col0 = (pn - 8) * 256; }
            else { base = Vb; ld = 512; col0 = (pn - 10) * 256; }
#pragma unroll
            for (int ai = 0; ai < 2; ++ai)
#pragma unroll
                for (int m = 0; m < 4; ++m) { const int r = row0 + ai * 128 + m * 16; const float rs = rowsq[r];
#pragma unroll
                    for (int bj = 0; bj < 2; ++bj) *(u32x4*)(base + (size_t)r * ld + col0 + bj * 128 + cl) = pack8(acc[ai][bj][m][0] * rs, acc[ai][bj][m][1] * rs); }
        } else if (pn < 16) {
            const int c0 = (pn - 12) * 128 + cl;
#pragma unroll
            for (int ai = 0; ai < 2; ++ai)
#pragma unroll
                for (int m = 0; m < 4; ++m) { const int r = row0 + ai * 128 + m * 16; const float rs = rowsq[r];
                    f32x4 o[2];
#pragma unroll
                    for (int n = 0; n < 2; ++n)
#pragma unroll
                        for (int j = 0; j < 4; ++j) o[n][j] = acc[ai][0][m][n][j] * rs * sigm(acc[ai][1][m][n][j] * rs);
                    *(u32x4*)(CG + (size_t)r * 512 + c0) = pack8(o[0], o[1]); }
        } else {
            const int c0 = (pn - 16) * 256 + cl;
            f32x4 bv[2][2];
#pragma unroll
            for (int bj = 0; bj < 2; ++bj)
#pragma unroll
                for (int n = 0; n < 2; ++n) bv[bj][n] = *(const f32x4*)(bgate + c0 + bj * 128 + 4 * n);
#pragma unroll
            for (int ai = 0; ai < 2; ++ai)
#pragma unroll
                for (int m = 0; m < 4; ++m) { const int r = row0 + ai * 128 + m * 16; const float rs = rowsq[r];
#pragma unroll
                    for (int bj = 0; bj < 2; ++bj) { f32x4 o[2];
#pragma unroll
                        for (int n = 0; n < 2; ++n)
#pragma unroll
                            for (int j = 0; j < 4; ++j) o[n][j] = sigm(acc[ai][bj][m][n][j] * rs + bv[bj][n][j]);
                        *(u32x4*)(G + (size_t)r * 3072 + c0 + bj * 128) = pack8(o[0], o[1]); } }
        }
    }
};
struct EpiGluMerge {
    static constexpr bool PERM = true, AFTER_DRAIN = false;
    bf16_t* Mg; const bf16_t* G;
    __device__ __forceinline__ void operator()(const f32x4 (&acc)[2][2][4][2], const Unit& u, int wr, int wc, int fr, int fq) const {
        const int row0 = u.pm * 256 + wr * 64 + fr, c0 = u.pn * 128 + wc * 32 + 8 * fq;
#pragma unroll
        for (int ai = 0; ai < 2; ++ai)
#pragma unroll
            for (int m = 0; m < 4; ++m) { const int r = row0 + ai * 128 + m * 16;
                f32x4 g0, g1; unpack8(*(const u32x4*)(G + (size_t)r * 3072 + c0), g0, g1);
                f32x4 o[2];
#pragma unroll
                for (int j = 0; j < 4; ++j) { o[0][j] = g0[j] * acc[ai][0][m][0][j] * sigm(acc[ai][1][m][0][j]); o[1][j] = g1[j] * acc[ai][0][m][1][j] * sigm(acc[ai][1][m][1][j]); }
                *(u32x4*)(Mg + (size_t)r * 1024 + c0) = pack8(o[0], o[1]); }
    }
};
struct EpiAccMerge {
    static constexpr bool PERM = true, AFTER_DRAIN = false;
    bf16_t* Mg; const bf16_t* G; int gate_off;
    __device__ __forceinline__ void operator()(const f32x4 (&acc)[2][2][4][2], const Unit& u, int wr, int wc, int fr, int fq) const {
        const int row0 = u.pm * 256 + wr * 64 + fr, cb = u.pn * 256 + wc * 32 + 8 * fq;
#pragma unroll
        for (int ai = 0; ai < 2; ++ai)
#pragma unroll
            for (int m = 0; m < 4; ++m) { const int r = row0 + ai * 128 + m * 16;
#pragma unroll
                for (int bj = 0; bj < 2; ++bj) { const int c0 = cb + bj * 128;
                    f32x4 g0, g1, m0, m1; unpack8(*(const u32x4*)(G + (size_t)r * 3072 + gate_off + c0), g0, g1); unpack8(*(const u32x4*)(Mg + (size_t)r * 1024 + c0), m0, m1);
                    *(u32x4*)(Mg + (size_t)r * 1024 + c0) = pack8(m0 + g0 * acc[ai][bj][m][0], m1 + g1 * acc[ai][bj][m][1]); } }
    }
};
struct EpiDelta {
    static constexpr bool PERM = true, AFTER_DRAIN = false;
    bf16_t* D;
    __device__ __forceinline__ void operator()(const f32x4 (&acc)[2][2][4][2], const Unit& u, int wr, int wc, int fr, int fq) const {
        const int row0 = u.pm * 256 + wr * 64 + fr, cb = u.pn * 256 + wc * 32 + 8 * fq;
#pragma unroll
        for (int ai = 0; ai < 2; ++ai)
#pragma unroll
            for (int m = 0; m < 4; ++m)
#pragma unroll
                for (int bj = 0; bj < 2; ++bj) *(u32x4*)(D + (size_t)(row0 + ai * 128 + m * 16) * 1024 + cb + bj * 128) = pack8(acc[ai][bj][m][0], acc[ai][bj][m][1]);
    }
};
struct EpiFfn1 {
    static constexpr bool PERM = true, AFTER_DRAIN = false;
    bf16_t* Hf;
    __device__ __forceinline__ void operator()(const f32x4 (&acc)[2][2][4][2], const Unit& u, int wr, int wc, int fr, int fq) const {
        const int row0 = u.pm * 256 + wr * 64 + fr, c0 = u.pn * 128 + wc * 32 + 8 * fq;
#pragma unroll
        for (int ai = 0; ai < 2; ++ai)
#pragma unroll
            for (int m = 0; m < 4; ++m) { const int r = row0 + ai * 128 + m * 16;
                f32x4 o[2];
#pragma unroll
                for (int n = 0; n < 2; ++n)
#pragma unroll
                    for (int j = 0; j < 4; ++j) { const float a = acc[ai][0][m][n][j], b = acc[ai][1][m][n][j]; o[n][j] = a * sigm(a) * b; }
                *(u32x4*)(Hf + (size_t)r * 2816 + c0) = pack8(o[0], o[1]); }
    }
};

__device__ __forceinline__ void p0_tr_item(const float* W, int K, int N, bf16_t* WT, int kb, int nd0, int ns0, const float* gk, float scale, LAS float* scr, int lane) {
    const int k0 = 64 * kb;
#pragma unroll 8
    for (int i = 0; i < 32; ++i) { const int kk = 2 * i + (lane >> 5); float s = scale; if (gk) s *= gk[k0 + kk]; scr[kk * 33 + (lane & 31)] = W[(size_t)(k0 + kk) * N + ns0 + (lane & 31)] * s; }
    asm volatile("" ::: "memory");
    const int c = lane & 7;
#pragma unroll
    for (int j = 0; j < 4; ++j) { const int n = (lane >> 3) + 8 * j; const LAS float* s = scr + (8 * c) * 33 + n;
        u32x4 o; o.x = cvt_pk_bf16(s[0 * 33], s[1 * 33]); o.y = cvt_pk_bf16(s[2 * 33], s[3 * 33]); o.z = cvt_pk_bf16(s[4 * 33], s[5 * 33]); o.w = cvt_pk_bf16(s[6 * 33], s[7 * 33]);
        *(u32x4*)(WT + (size_t)(nd0 + n) * K + k0 + 8 * c) = o; }
    asm volatile("" ::: "memory");
}
__device__ __forceinline__ void phase_p0(const Params& P, LAS unsigned char* lds, int wave, int lane, int tid) {
    unsigned char* ws = P.ws;
    const int gw = blockIdx.x * 8 + wave, NGW = gridDim.x * 8;
    LAS float* scr = (LAS float*)(lds + wave * 16384);
    constexpr int PER_L = 3584 + 512 + 256 + 256 + 512 + 2816 + 1408;
    for (int it = gw; it < 2 * PER_L; it += NGW) {
        const int l = it / PER_L; int r = it % PER_L;
        const float* W; bf16_t* WT; int K, N, type = 0; const float* gk = nullptr;
        if (r < 3584) { W = P.in[I_WIN] + (size_t)l * 1024 * 7168; WT = (bf16_t*)(ws + OFF_WIN) + (size_t)l * 7168 * 1024; K = 1024; N = 7168; type = 1; gk = P.in[I_N1G] + l * 1024; }
        else if ((r -= 3584) < 512) { W = P.in[I_WGLU] + (size_t)l * 512 * 2048; WT = (bf16_t*)(ws + OFF_WGLU) + (size_t)l * 2048 * 512; K = 512; N = 2048; type = 3; }
        else if ((r -= 512) < 256) { W = P.in[I_WATT] + (size_t)l * 512 * 1024; WT = (bf16_t*)(ws + OFF_WATT) + (size_t)l * 1024 * 512; K = 512; N = 1024; }
        else if ((r -= 256) < 256) { W = P.in[I_WPW2] + (size_t)l * 512 * 1024; WT = (bf16_t*)(ws + OFF_WPW2) + (size_t)l * 1024 * 512; K = 512; N = 1024; }
        else if ((r -= 256) < 512) { W = P.in[I_WOUT] + (size_t)l * 1024 * 1024; WT = (bf16_t*)(ws + OFF_WOUT) + (size_t)l * 1024 * 1024; K = 1024; N = 1024; }
        else if ((r -= 512) < 2816) { W = P.in[I_WF1] + (size_t)l * 1024 * 5632; WT = (bf16_t*)(ws + OFF_WF1) + (size_t)l * 5632 * 1024; K = 1024; N = 5632; type = 2; gk = P.in[I_N2G] + l * 1024; }
        else { r -= 2816; W = P.in[I_WF2] + (size_t)l * 2816 * 1024; WT = (bf16_t*)(ws + OFF_WF2) + (size_t)l * 1024 * 2816; K = 2816; N = 1024; }
        const int nblk = N / 32, kb = r / nblk, nd0 = (r % nblk) * 32;
        int ns0 = nd0; float scale = 1.f;
        if (type == 1) { if (nd0 >= 3072 && nd0 < 4096) { const int t = nd0 - 3072, j = t & 255; ns0 = 3072 + (t >> 8) * 128 + (j & 127) + (j >= 128 ? 512 : 0); }
                         if (nd0 >= 512 && nd0 < 2048) scale = 0.125f * 1.4426950408889634f; }
        else if (type == 2) { const int j = nd0 & 255; ns0 = (nd0 >> 8) * 128 + (j & 127) + (j >= 128 ? 2816 : 0); }
        else if (type == 3) { const int j = nd0 & 255; ns0 = (nd0 >> 8) * 128 + (j & 127) + (j >= 128 ? 1024 : 0); }
        p0_tr_item(W, K, N, WT, kb, nd0, ns0, gk, scale, scr, lane);
    }
    { const float* x = P.in[I_X]; bf16_t* xb = (bf16_t*)(ws + OFF_XB);
      for (int row = gw; row < NTOK; row += NGW) { float ss = 0.f; f32x4 v[4];
#pragma unroll
          for (int j = 0; j < 4; ++j) { const f32x4 t = *(const f32x4*)(x + (size_t)row * 1024 + 4 * lane + 256 * j); u32x2 w; w.x = cvt_pk_bf16(t[0], t[1]); w.y = cvt_pk_bf16(t[2], t[3]);
              *(u32x2*)(xb + (size_t)row * 1024 + 4 * lane + 256 * j) = w; v[j][0] = bf_lo(w.x); v[j][1] = bf_hi(w.x); v[j][2] = bf_lo(w.y); v[j][3] = bf_hi(w.y);
              ss += v[j][0] * v[j][0] + v[j][1] * v[j][1] + v[j][2] * v[j][2] + v[j][3] * v[j][3]; }
          ss = wave_sum(ss); const float rs = rsqrtf(ss * (1.f / 1024.f) + EPSN); if (lane == 0) ((float*)(ws + OFF_RSQ1))[row] = rs;
 } }
    const int gt = blockIdx.x * 512 + tid, NGT = gridDim.x * 512;
    for (int idx = gt; idx < 2 * 32 * 64; idx += NGT) {
        const int lg = idx >> 6, p = idx & 63;
        const float lre = P.in[I_LRE][idx], lim = P.in[I_LIM][idx], dt = expf(P.in[I_LOGDT][lg]);
        const float mag = expf(lre * dt);
        const double rev = (double)lim * (double)dt * 0.15915494309189535; const float frc = (float)(rev - rint(rev));
        const float sn = __builtin_amdgcn_sinf(frc), cs = __builtin_amdgcn_cosf(frc);
        const float are = mag * cs, aim = mag * sn, nr = are - 1.f, ni = aim, den = lre * lre + lim * lim;
        const float zre = (nr * lre + ni * lim) / den, zim = (ni * lre - nr * lim) / den;
        { f32x2v t2; t2.x = are; t2.y = aim; ((f32x2v*)(ws + OFF_S5A))[idx] = t2; }
        bf16_t* bbt = (bf16_t*)(ws + OFF_S5BB) + (size_t)lg * 128 * 16; bf16_t* cm = (bf16_t*)(ws + OFF_S5CM) + (size_t)lg * 16 * 128;
        for (int h = 0; h < 16; ++h) { const float br = P.in[I_BRE][(size_t)idx * 16 + h], bi = P.in[I_BIM][(size_t)idx * 16 + h];
            bbt[p * 16 + h] = f2bf(zre * br - zim * bi); bbt[(64 + p) * 16 + h] = f2bf(zre * bi + zim * br);
            cm[h * 128 + p] = f2bf(P.in[I_CRE][((size_t)lg * 16 + h) * 64 + p]); cm[h * 128 + 64 + p] = f2bf(-P.in[I_CIM][((size_t)lg * 16 + h) * 64 + p]); }
    }
    for (int idx = gt; idx < 2 * 31 * 256; idx += NGT) { const float a = P.in[I_CONVW][2 * idx], b = P.in[I_CONVW][2 * idx + 1]; ((unsigned*)(ws + OFF_CONVW))[idx] = cvt_pk_bf16(a, b); }
}
template <bool FINAL> __device__ __forceinline__ void phase_rows(const Params& P, int wave, int lane, bool want_xn) {
    const int gw = blockIdx.x * 8 + wave, NGW = gridDim.x * 8;
    bf16_t* xb = (bf16_t*)(P.ws + OFF_XB); const bf16_t* D = (const bf16_t*)(P.ws + OFF_QO); bf16_t* xn = (bf16_t*)(P.ws + OFF_HC); const float* fg = P.in[I_FING];
    for (int row = gw; row < NTOK; row += NGW) {
        const size_t o0 = (size_t)row * 1024 + 8 * lane, o1 = o0 + 512;
        const u32x4 w0 = *(const u32x4*)(xb + o0), w1 = *(const u32x4*)(xb + o1), d0 = *(const u32x4*)(D + o0), d1 = *(const u32x4*)(D + o1);
        f32x4 a0, a1, b0, b1, e0, e1, g0, g1; unpack8(w0, a0, a1); unpack8(w1, b0, b1); unpack8(d0, e0, e1); unpack8(d1, g0, g1);
        const u32x4 n0 = pack8(a0 + e0, a1 + e1), n1 = pack8(b0 + g0, b1 + g1);
        unpack8(n0, a0, a1); unpack8(n1, b0, b1);
        float ss = 0.f;
#pragma unroll
        for (int j = 0; j < 4; ++j) ss += a0[j] * a0[j] + a1[j] * a1[j] + b0[j] * b0[j] + b1[j] * b1[j];
        ss = wave_sum(ss);
        const float rs = rsqrtf(ss * (1.f / 1024.f) + EPSN);
        if (!FINAL) { if (lane == 0) ((float*)(P.ws + OFF_RSQ1))[row] = rs; *(u32x4*)(xb + o0) = n0; *(u32x4*)(xb + o1) = n1; if (want_xn) { *(u32x4*)(xn + o0) = pack8(a0 * rs, a1 * rs); *(u32x4*)(xn + o1) = pack8(b0 * rs, b1 * rs); } }
        else { const f32x4 q0 = *(const f32x4*)(fg + 8 * lane), q1 = *(const f32x4*)(fg + 8 * lane + 4), q2 = *(const f32x4*)(fg + 512 + 8 * lane), q3 = *(const f32x4*)(fg + 512 + 8 * lane + 4);
            float* o = P.out + (size_t)row * 1024;
            *(f32x4*)(o + 8 * lane) = a0 * q0 * rs; *(f32x4*)(o + 8 * lane + 4) = a1 * q1 * rs; *(f32x4*)(o + 512 + 8 * lane) = b0 * q2 * rs; *(f32x4*)(o + 512 + 8 * lane + 4) = b1 * q3 * rs; }
    }
}

__device__ __forceinline__ void s5_item(const Params& P, int l, int it, LAS unsigned char* wl, int lane) {
    const int b = it >> 5, g = it & 31, lg = l * 32 + g;
    LAS float* bu = (LAS float*)wl; LAS unsigned char* sl = wl + 16384;
    const int c32 = lane & 31, hi = lane >> 5, fr = lane & 15, fq = lane >> 4;
    const bf16_t* bbt = (const bf16_t*)(P.ws + OFF_S5BB) + (size_t)lg * 128 * 16; const bf16_t* cm = (const bf16_t*)(P.ws + OFF_S5CM) + (size_t)lg * 16 * 128;
    bf16x8 bbreg[4], cmreg[4];
#pragma unroll
    for (int j = 0; j < 4; ++j) { bbreg[j] = *(const bf16x8*)(bbt + (32 * j + c32) * 16 + 8 * hi); cmreg[j] = *(const bf16x8*)(cm + fr * 128 + 32 * j + 8 * fq); }
    const f32x2v av = ((const f32x2v*)(P.ws + OFF_S5A))[lg * 64 + lane]; const float a_re = av.x, a_im = av.y;
    const float dsk = P.in[I_SSMD][l * 512 + g * 16 + fr];
    float s_re = 0.f, s_im = 0.f;
    const bf16_t* Ub = (const bf16_t*)((unsigned char*)P.out + DO_U) + (size_t)b * SEQL * 512 + g * 16; bf16_t* Yb = (bf16_t*)((unsigned char*)P.out + DO_Y) + (size_t)b * SEQL * 512 + g * 16;
    for (int c = 0; c < 64; ++c) {
        const int t0 = c * 32;
        const bf16x8 ureg = *(const bf16x8*)(Ub + (size_t)(t0 + c32) * 512 + 8 * hi);
        unsigned short uep[2][4];
#pragma unroll
        for (int mt = 0; mt < 2; ++mt)
#pragma unroll
            for (int i = 0; i < 4; ++i) uep[mt][i] = Ub[(size_t)(t0 + 16 * mt + 4 * fq + i) * 512 + fr];
#pragma unroll
        for (int j = 0; j < 4; ++j) { f32x16 a;
#pragma unroll
            for (int r = 0; r < 16; ++r) a[r] = 0.f;
            a = __builtin_amdgcn_mfma_f32_32x32x16_bf16(ureg, bbreg[j], a, 0, 0, 0);
#pragma unroll
            for (int r = 0; r < 16; ++r) { const int tok = (r & 3) + 8 * (r >> 2) + 4 * hi; bu[tok * 128 + ((32 * (j & 1) + c32) << 1) + (j >> 1)] = a[r]; } }
        asm volatile("" ::: "memory");
#pragma unroll 8
        for (int t = 0; t < 32; ++t) { const f32x2v v = *(const LAS f32x2v*)(bu + t * 128 + 2 * lane);
            const float nre = fmaf(a_re, s_re, fmaf(-a_im, s_im, v.x)), nim = fmaf(a_re, s_im, fmaf(a_im, s_re, v.y)); s_re = nre; s_im = nim;
            *(LAS unsigned short*)(sl + t * 272 + lane * 2) = f2bf(s_re); *(LAS unsigned short*)(sl + t * 272 + 128 + lane * 2) = f2bf(s_im); }
        asm volatile("" ::: "memory");
#pragma unroll
        for (int mt = 0; mt < 2; ++mt) { f32x4 ya = {0.f, 0.f, 0.f, 0.f};
#pragma unroll
            for (int ks = 0; ks < 4; ++ks) { const bf16x8 a = *(const LAS bf16x8*)(sl + (16 * mt + fr) * 272 + (32 * ks + 8 * fq) * 2); ya = __builtin_amdgcn_mfma_f32_16x16x32_bf16(a, cmreg[ks], ya, 0, 0, 0); }
#pragma unroll
            for (int i = 0; i < 4; ++i) { const float y = ya[i] + dsk * __uint_as_float((unsigned)uep[mt][i] << 16);
                const float ge = y * sigm(1.5957691216057308f * (y + 0.044715f * y * y * y));
                Yb[(size_t)(t0 + 16 * mt + 4 * fq + i) * 512 + fr] = f2bf(ge); } }
        asm volatile("" ::: "memory");
    }
}

template <int PAT> __device__ __forceinline__ void attn_item(const Params& P, int it, LAS unsigned char* vl, int lane) {
    constexpr int d = PAT == 0 ? 1 : (PAT == 1 ? 4 : 16);
    constexpr int ngrp = (SEQL / d) / 32;
    constexpr int KSTR = 144;
    const int j = it % ngrp; int t = it / ngrp; const int r = t % d; t /= d; const int h = t & 7, b = t >> 3;
    const int c32 = lane & 31, hi = lane >> 5, i0 = 32 * j;
    const int lrow = lane >> 3, lch = lane & 7;
    const size_t tokbase = (size_t)b * SEQL;
    bf16_t* QO = (bf16_t*)(P.ws + OFF_QO); const bf16_t* Kb = (const bf16_t*)((unsigned char*)P.out + DO_K); const bf16_t* Vb = (const bf16_t*)((unsigned char*)P.out + DO_V);
    float* LSE = (float*)(P.ws + OFF_LSE);
    const unsigned char* qrow0 = (const unsigned char*)QO + ((tokbase + (size_t)i0 * d + r) * 1536 + PAT * 512 + h * 64) * 2;
    const unsigned char* krow0 = (const unsigned char*)Kb + ((tokbase + (size_t)(i0 - 128) * d + r) * 512 + h * 64) * 2;
    const unsigned char* vrow0 = (const unsigned char*)Vb + ((tokbase + (size_t)(i0 - 128) * d + r) * 512 + h * 64) * 2;
    const unsigned qlo = (unsigned)(lrow * d * 3072 + lch * 16), klo = (unsigned)(lrow * d * 1024 + lch * 16);
    u32x4 qraw[4], kraw[5][4];
#pragma unroll
    for (int i4 = 0; i4 < 4; ++i4) qraw[i4] = *(const u32x4*)(qrow0 + (qlo + (unsigned)(8 * i4 * d * 3072)));
#pragma unroll
    for (int kt = 0; kt < 5; ++kt) { const int kb = i0 - 128 + 32 * kt;
        if (kb >= 0) {
#pragma unroll
            for (int i4 = 0; i4 < 4; ++i4) kraw[kt][i4] = *(const u32x4*)(krow0 + (klo + (unsigned)((32 * kt + 8 * i4) * d * 1024))); } }
    bf16x8 qreg[4];
#pragma unroll
    for (int i4 = 0; i4 < 4; ++i4) *(LAS u32x4*)(vl + (lrow + 8 * i4) * KSTR + lch * 16) = qraw[i4];
    asm volatile("" ::: "memory");
#pragma unroll
    for (int ks = 0; ks < 4; ++ks) qreg[ks] = *(const LAS bf16x8*)(vl + c32 * KSTR + (16 * ks + 8 * hi) * 2);
    asm volatile("" ::: "memory");
    f32x16 s[5];
#pragma unroll
    for (int kt = 0; kt < 5; ++kt) { const int kb = i0 - 128 + 32 * kt;
        f32x16 a;
        if (kb >= 0) {
#pragma unroll
            for (int q = 0; q < 16; ++q) a[q] = 0.f;
#pragma unroll
            for (int i4 = 0; i4 < 4; ++i4) *(LAS u32x4*)(vl + (lrow + 8 * i4) * KSTR + lch * 16) = kraw[kt][i4];
            asm volatile("" ::: "memory");
#pragma unroll
            for (int ks = 0; ks < 4; ++ks) { const bf16x8 kreg = *(const LAS bf16x8*)(vl + c32 * KSTR + (16 * ks + 8 * hi) * 2); a = __builtin_amdgcn_mfma_f32_32x32x16_bf16(kreg, qreg[ks], a, 0, 0, 0); }
            asm volatile("" ::: "memory");
        } else {
#pragma unroll
            for (int q = 0; q < 16; ++q) a[q] = (-__builtin_inff());
        }
        s[kt] = a; }
    u32x4 vreg[5][4];
#pragma unroll
    for (int kt = 0; kt < 3; ++kt) { const int kb = i0 - 128 + 32 * kt;
        if (kb >= 0) {
#pragma unroll
            for (int i4 = 0; i4 < 4; ++i4) vreg[kt][i4] = *(const u32x4*)(vrow0 + (klo + (unsigned)((32 * kt + 8 * i4) * d * 1024))); } }
#pragma unroll
    for (int q = 0; q < 16; ++q) { const int kr = (q & 3) + 8 * (q >> 2) + 4 * hi; if (kr < c32) s[0][q] = (-__builtin_inff()); if (kr > c32) s[4][q] = (-__builtin_inff()); }
    float mx = (-__builtin_inff());
#pragma unroll
    for (int kt = 0; kt < 5; ++kt)
#pragma unroll
        for (int q = 0; q < 16; ++q) mx = fmaxf(mx, s[kt][q]);
    mx = fmaxf(mx, __shfl_xor(mx, 32));
    float den = 0.f;
#pragma unroll
    for (int kt = 0; kt < 5; ++kt)
#pragma unroll
        for (int q = 0; q < 16; ++q) { const float p = __builtin_amdgcn_exp2f(s[kt][q] - mx); s[kt][q] = p; den += p; }
    den += __shfl_xor(den, 32);
    u32x4 pw[5][2];
#pragma unroll
    for (int kt = 0; kt < 5; ++kt)
#pragma unroll
        for (int ks2 = 0; ks2 < 2; ++ks2) { pw[kt][ks2].x = cvt_pk_bf16(s[kt][8 * ks2 + 0], s[kt][8 * ks2 + 1]); pw[kt][ks2].y = cvt_pk_bf16(s[kt][8 * ks2 + 2], s[kt][8 * ks2 + 3]);
            pw[kt][ks2].z = cvt_pk_bf16(s[kt][8 * ks2 + 4], s[kt][8 * ks2 + 5]); pw[kt][ks2].w = cvt_pk_bf16(s[kt][8 * ks2 + 6], s[kt][8 * ks2 + 7]); }
#pragma unroll
    for (int kt = 3; kt < 5; ++kt) { const int kb = i0 - 128 + 32 * kt;
        if (kb >= 0) {
#pragma unroll
            for (int i4 = 0; i4 < 4; ++i4) vreg[kt][i4] = *(const u32x4*)(vrow0 + (klo + (unsigned)((32 * kt + 8 * i4) * d * 1024))); } }
    u32x4 mraw[2][4]; float l2b = 0.f, l2c = 0.f;
    if (PAT == 0) {
#pragma unroll
        for (int pp = 0; pp < 2; ++pp)
#pragma unroll
            for (int i4 = 0; i4 < 4; ++i4) mraw[pp][i4] = *(const u32x4*)(qrow0 + (qlo + (unsigned)(8 * i4 * 3072 + (pp + 1) * 1024)));
        l2b = LSE[((size_t)(0 * 32 + b) * 8 + h) * SEQL + i0 + c32]; l2c = LSE[((size_t)(1 * 32 + b) * 8 + h) * SEQL + i0 + c32];
    }
    f32x16 o[2];
#pragma unroll
    for (int q = 0; q < 16; ++q) { o[0][q] = 0.f; o[1][q] = 0.f; }
    const int gi = lane >> 4, li = lane & 15;
    const LAS unsigned char* vrd = vl + (4 * hi + (li >> 2)) * VSTR + (16 * (gi & 1) + 4 * (li & 3)) * 2;
#pragma unroll
    for (int kt = 0; kt < 5; ++kt) { const int kb = i0 - 128 + 32 * kt;
        if (kb >= 0) {
#pragma unroll
            for (int i4 = 0; i4 < 4; ++i4) *(LAS u32x4*)(vl + (lrow + 8 * i4) * VSTR + lch * 16) = vreg[kt][i4];
            asm volatile("" ::: "memory");
#pragma unroll
            for (int ks2 = 0; ks2 < 2; ++ks2) {
                const bf16x8 pb = __builtin_bit_cast(bf16x8, pw[kt][ks2]);
#pragma unroll
                for (int mt = 0; mt < 2; ++mt) { const LAS unsigned char* a1 = vrd + (16 * ks2) * VSTR + 64 * mt;
                    const s16x4 lo = vtr(a1), up = vtr(a1 + 8 * VSTR);
                    bf16x8 av; av[0] = lo[0]; av[1] = lo[1]; av[2] = lo[2]; av[3] = lo[3]; av[4] = up[0]; av[5] = up[1]; av[6] = up[2]; av[7] = up[3];
                    o[mt] = __builtin_amdgcn_mfma_f32_32x32x16_bf16(av, pb, o[mt], 0, 0, 0); } }
            asm volatile("" ::: "memory");
        } }
    const float inv = __builtin_amdgcn_rcpf(den);
    const float l2 = mx + __builtin_amdgcn_logf(den);
    const LAS unsigned char* frd = vl + c32 * KSTR + 8 * hi;
    float w1 = inv;
    if (PAT == 0) {
        const float M = fmaxf(l2, fmaxf(l2b, l2c));
        float e1 = __builtin_amdgcn_exp2f(l2 - M), e2 = __builtin_amdgcn_exp2f(l2b - M), e3 = __builtin_amdgcn_exp2f(l2c - M);
        const float wi = __builtin_amdgcn_rcpf(e1 + e2 + e3); w1 = e1 * wi * inv; const float wo[2] = {e2 * wi, e3 * wi};
#pragma unroll
        for (int q = 0; q < 16; ++q) { o[0][q] *= w1; o[1][q] *= w1; }
#pragma unroll
        for (int pp = 0; pp < 2; ++pp) {
#pragma unroll
            for (int i4 = 0; i4 < 4; ++i4) *(LAS u32x4*)(vl + (lrow + 8 * i4) * KSTR + lch * 16) = mraw[pp][i4];
            asm volatile("" ::: "memory");
#pragma unroll
            for (int mt = 0; mt < 2; ++mt)
#pragma unroll
                for (int rg = 0; rg < 4; ++rg) { const u32x2 bb = *(const LAS u32x2*)(frd + 64 * mt + 16 * rg);
                    o[mt][4 * rg] += wo[pp] * bf_lo(bb.x); o[mt][4 * rg + 1] += wo[pp] * bf_hi(bb.x); o[mt][4 * rg + 2] += wo[pp] * bf_lo(bb.y); o[mt][4 * rg + 3] += wo[pp] * bf_hi(bb.y); }
            asm volatile("" ::: "memory");
        }
    } else {
#pragma unroll
        for (int q = 0; q < 16; ++q) { o[0][q] *= w1; o[1][q] *= w1; }
    }
#pragma unroll
    for (int mt = 0; mt < 2; ++mt)
#pragma unroll
        for (int rg = 0; rg < 4; ++rg) { u32x2 w; w.x = cvt_pk_bf16(o[mt][4 * rg], o[mt][4 * rg + 1]); w.y = cvt_pk_bf16(o[mt][4 * rg + 2], o[mt][4 * rg + 3]);
            *(LAS u32x2*)(vl + c32 * KSTR + 8 * hi + 64 * mt + 16 * rg) = w; }
    asm volatile("" ::: "memory");
    if (PAT != 0) {
#pragma unroll
        for (int i4 = 0; i4 < 4; ++i4) *(u32x4*)((unsigned char*)qrow0 + (qlo + (unsigned)(8 * i4 * d * 3072))) = *(const LAS u32x4*)(vl + (lrow + 8 * i4) * KSTR + lch * 16);
        if (hi == 0) LSE[((size_t)((PAT - 1) * 32 + b) * 8 + h) * SEQL + (size_t)(i0 + c32) * d + r] = l2;
    } else {
        bf16_t* OC = (bf16_t*)(P.ws + OFF_OC);
#pragma unroll
        for (int i4 = 0; i4 < 4; ++i4) *(u32x4*)(OC + (tokbase + (size_t)(i0 + lrow + 8 * i4)) * 512 + h * 64 + lch * 8) = *(const LAS u32x4*)(vl + (lrow + 8 * i4) * KSTR + lch * 16);
    }
    asm volatile("" ::: "memory");
}

__device__ __forceinline__ void conv_item(const Params& P, int l, int it, int lane, const LAS unsigned char* wlds) {
    const int b = it >> 8, t0 = (it & 255) * 8, ch0 = 8 * lane;
    const bf16_t* in = (const bf16_t*)(P.ws + OFF_CG) + (size_t)b * SEQL * 512 + ch0;
    const LAS unsigned char* cw = wlds + 16 * lane;
    float acc[8][8], win[8][8];
    { const f32x4 b0 = *(const f32x4*)(P.in[I_CONVB] + l * 512 + ch0), b1 = *(const f32x4*)(P.in[I_CONVB] + l * 512 + ch0 + 4);
#pragma unroll
      for (int i = 0; i < 8; ++i) { acc[i][0] = b0[0]; acc[i][1] = b0[1]; acc[i][2] = b0[2]; acc[i][3] = b0[3]; acc[i][4] = b1[0]; acc[i][5] = b1[1]; acc[i][6] = b1[2]; acc[i][7] = b1[3]; } }
#define CONV_LOADROW(rr, dst) do { const int t_ = t0 - 30 + (rr); if (t_ >= 0) { const u32x4 v_ = *(const u32x4*)(in + (size_t)t_ * 512); \
        dst[0] = bf_lo(v_.x); dst[1] = bf_hi(v_.x); dst[2] = bf_lo(v_.y); dst[3] = bf_hi(v_.y); dst[4] = bf_lo(v_.z); dst[5] = bf_hi(v_.z); dst[6] = bf_lo(v_.w); dst[7] = bf_hi(v_.w); } \
        else { _Pragma("unroll") for (int c_ = 0; c_ < 8; ++c_) dst[c_] = 0.f; } } while (0)
#pragma unroll
    for (int rr = 0; rr < 8; ++rr) CONV_LOADROW(rr, win[rr]);
    for (int jb = 0; jb < 32; jb += 8) {
        asm volatile("" ::: "memory");
#pragma unroll
        for (int jj = 0; jj < 8; ++jj) { const int j = jb + jj;
            if (j < 31) { const u32x4 wv = *(const LAS u32x4*)(cw + j * 1024);
                float w[8]; w[0] = bf_lo(wv.x); w[1] = bf_hi(wv.x); w[2] = bf_lo(wv.y); w[3] = bf_hi(wv.y); w[4] = bf_lo(wv.z); w[5] = bf_hi(wv.z); w[6] = bf_lo(wv.w); w[7] = bf_hi(wv.w);
#pragma unroll
                for (int i = 0; i < 8; ++i)
#pragma unroll
                    for (int c = 0; c < 8; ++c) acc[i][c] = fmaf(w[c], win[(jj + i) & 7][c], acc[i][c]);
                if (j + 8 < 38) CONV_LOADROW(j + 8, win[jj]); } }
    }
#undef CONV_LOADROW
    const f32x4 g0 = *(const f32x4*)(P.in[I_LNG] + l * 512 + ch0), g1 = *(const f32x4*)(P.in[I_LNG] + l * 512 + ch0 + 4);
    const f32x4 e0 = *(const f32x4*)(P.in[I_LNB] + l * 512 + ch0), e1 = *(const f32x4*)(P.in[I_LNB] + l * 512 + ch0 + 4);
    bf16_t* outp = (bf16_t*)(P.ws + OFF_HC) + ((size_t)b * SEQL + t0) * 512 + ch0;
#pragma unroll
    for (int i = 0; i < 8; ++i) { float s1 = 0.f, s2 = 0.f;
#pragma unroll
        for (int c = 0; c < 8; ++c) { s1 += acc[i][c]; s2 += acc[i][c] * acc[i][c]; }
        s1 = wave_sum(s1); s2 = wave_sum(s2);
        const float mean = s1 * (1.f / 512.f), var = fmaxf(s2 * (1.f / 512.f) - mean * mean, 0.f), rs = rsqrtf(var + EPSN);
        f32x4 y0, y1;
#pragma unroll
        for (int c = 0; c < 4; ++c) { const float h0 = (acc[i][c] - mean) * rs * g0[c] + e0[c], h1 = (acc[i][4 + c] - mean) * rs * g1[c] + e1[c]; y0[c] = h0 * sigm(h0); y1[c] = h1 * sigm(h1); }
        *(u32x4*)(outp + (size_t)i * 512) = pack8(y0, y1); }
}

__device__ __forceinline__ int xcc_id() { return (int)(__builtin_amdgcn_s_getreg((3 << 11) | 20) & 7u); }
__device__ __forceinline__ int claim_issue(unsigned* ctr, int& lane) { asm volatile("" : "+v"(lane)); int v = 0; if (lane == 0) v = (int)atomicAdd(ctr, 1u); return v; }
__device__ __forceinline__ int lane_now() { int l = (int)__builtin_amdgcn_mbcnt_hi(~0u, __builtin_amdgcn_mbcnt_lo(~0u, 0u)); asm volatile("" : "+v"(l)); return l; }
__device__ __forceinline__ int lds_claim(LAS unsigned* ctr, int lane) { int v = 0; if (lane == 0) v = (int)__hip_atomic_fetch_add(ctr, 1u, __ATOMIC_RELAXED, __HIP_MEMORY_SCOPE_WORKGROUP); return __builtin_amdgcn_readfirstlane(v); }
__device__ __forceinline__ int claim(unsigned* ctr, int& lane) { asm volatile("" : "+v"(lane)); int v = 0; if (lane == 0) v = (int)atomicAdd(ctr, 1u); return __builtin_amdgcn_readfirstlane(v); }


__device__ __forceinline__ void grid_barrier(unsigned* bar, unsigned target, int tid) {
    asm volatile("s_waitcnt vmcnt(0) lgkmcnt(0)" ::: "memory");
    __syncthreads();
    if (tid == 0) {
        __builtin_amdgcn_fence(__ATOMIC_RELEASE, "agent");
        asm volatile("s_waitcnt vmcnt(0) lgkmcnt(0)" ::: "memory");
        __hip_atomic_fetch_add(bar, 1u, __ATOMIC_RELAXED, __HIP_MEMORY_SCOPE_AGENT);
        while (__hip_atomic_load(bar, __ATOMIC_RELAXED, __HIP_MEMORY_SCOPE_AGENT) < target) __builtin_amdgcn_s_sleep(2);
        __builtin_amdgcn_fence(__ATOMIC_ACQUIRE, "agent");
        asm volatile("s_waitcnt vmcnt(0) lgkmcnt(0)" ::: "memory");
    }
    __syncthreads();
}

constexpr int NPHASE = 21;
__global__ void __launch_bounds__(512, 2) fwd_kernel(Params P) {
    extern __shared__ __attribute__((aligned(16))) unsigned char shm[];
    LAS unsigned char* lds = (LAS unsigned char*)shm;
        unsigned char* ws = P.ws; unsigned char* dout = (unsigned char*)P.out;
    bf16_t* xb = (bf16_t*)(ws + OFF_XB); bf16_t* Gt = (bf16_t*)(ws + OFF_G); bf16_t* Mg = (bf16_t*)(dout + DO_MG);
    bf16_t* xn = (bf16_t*)(ws + OFF_HC); bf16_t* Dl = (bf16_t*)(ws + OFF_QO);
    unsigned* ctl = (unsigned*)(ws + OFF_CTL);
    StaticOrder S;
    unsigned nbar = 0;
    const int wave_s = __builtin_amdgcn_readfirstlane((int)threadIdx.x >> 6);
    if (P.ph_hi - P.ph_lo > 1) cg::this_grid().sync();
    for (int ph = P.ph_lo; ph < P.ph_hi; ++ph) {
        const int wave = wave_s;
#define PHASE_IDS const int lane = lane_now(); const int tid = (wave_s << 6) | lane; (void)tid; (void)lane;
        if (ph == 0) { PHASE_IDS for (int rp = 0; rp < NREP_P0; ++rp) phase_p0(P, lds, wave, lane, tid); }
        else if (ph == NPHASE - 1) { PHASE_IDS phase_rows<true>(P, wave, lane, false); }
        else {
            const int l = (ph - 1) / 10, s = (ph - 1) % 10;
            if (s == 0) { PHASE_IDS
                S.init(NTOK, 7168, gridDim.x, blockIdx.x);
                Gemm g{xb, (const bf16_t*)(ws + OFF_WIN) + (size_t)l * 7168 * 1024, NTOK, 7168, 1024};
                EpiIn E{(bf16_t*)(dout + DO_U), (bf16_t*)(ws + OFF_QO), (bf16_t*)(dout + DO_K), (bf16_t*)(dout + DO_V), (bf16_t*)(ws + OFF_CG), Gt, (const float*)(ws + OFF_RSQ1), P.in[I_BGATE] + l * 3072};
                gemm_phase<EpiIn, StaticOrder, false>(lds, g, S, E, nullptr, tid);
            } else if (s == 1) { PHASE_IDS
                LAS unsigned* lctr = (LAS unsigned*)(lds + CTR_OFF);
                if (tid == 0) lctr[0] = 0u;
                __syncthreads();
                const int grp = blockIdx.x & 7, rank = blockIdx.x >> 3; constexpr int per = 128;
                if (wave < 4) { for (int it = blockIdx.x * 4 + wave; it < 1024; it += gridDim.x * 4) s5_item(P, l, it, lds + wave * S5_WL, lane_now()); }
                LAS unsigned char* vl = lds + ATT_OFF + wave * ATT_WL;
                for (;;) { const int ln = lane_now(); const int k = lds_claim(lctr, ln); const int li = rank * per + k; if (k >= per || li >= 4096) break;
                    const int b = grp + 8 * (li >> 10), rest = li & 1023;
                    if (rest < 512) attn_item<1>(P, b * 512 + rest, vl, ln); else attn_item<2>(P, b * 512 + rest - 512, vl, ln); }
            } else if (s == 2) { PHASE_IDS
                LAS unsigned* lctr = (LAS unsigned*)(lds + CTR_OFF);
                if (tid == 0) lctr[0] = 0u;
                { const unsigned* cwg = (const unsigned*)(ws + OFF_CONVW) + (size_t)l * 31 * 256;
                  for (int i = tid; i < 31 * 64; i += 512) *(LAS u32x4*)(lds + i * 16) = *(const u32x4*)(cwg + i * 4); }
                __syncthreads();
                const int grp = blockIdx.x & 7, rank = blockIdx.x >> 3; constexpr int per = 96;
                LAS unsigned char* vl = lds + ATT_OFF + wave * ATT_WL;
                for (;;) { const int ln = lane_now(); const int k = lds_claim(lctr, ln); const int li = rank * per + k; if (k >= per || li >= 3072) break;
                    const int b = grp + 8 * (li / 768), rest = li % 768;
                    if (rest < 512) attn_item<0>(P, b * 512 + rest, vl, ln); else conv_item(P, l, b * 256 + rest - 512, ln, lds); }
            } else if (s == 3) { PHASE_IDS
                S.init(NTOK, 2048, gridDim.x, blockIdx.x);
                Gemm g{(const bf16_t*)(dout + DO_Y), (const bf16_t*)(ws + OFF_WGLU) + (size_t)l * 2048 * 512, NTOK, 2048, 512};
                EpiGluMerge E{Mg, Gt};
                gemm_phase<EpiGluMerge, StaticOrder, false>(lds, g, S, E, nullptr, tid);
            } else if (s == 4) { PHASE_IDS
                S.init(NTOK, 1024, gridDim.x, blockIdx.x);
                for (int c = 0; c < 2; ++c) {
                    Gemm g{(const bf16_t*)(ws + (c == 0 ? OFF_HC : OFF_OC)), (const bf16_t*)(ws + (c == 0 ? OFF_WPW2 : OFF_WATT)) + (size_t)l * 1024 * 512, NTOK, 1024, 512};
                    EpiAccMerge E{Mg, Gt, c == 0 ? 2048 : 1024};
                    gemm_phase<EpiAccMerge, StaticOrder, false>(lds, g, S, E, nullptr, tid);
                    __syncthreads();
                }
            } else if (s == 6 || s == 9) { PHASE_IDS
                phase_rows<false>(P, wave, lane, s == 6);
            } else if (s == 5 || s == 8) { PHASE_IDS
                S.init(NTOK, 1024, gridDim.x, blockIdx.x);
                Gemm g{s == 5 ? (const bf16_t*)Mg : (const bf16_t*)Gt, s == 5 ? (const bf16_t*)(ws + OFF_WOUT) + (size_t)l * 1024 * 1024 : (const bf16_t*)(ws + OFF_WF2) + (size_t)l * 1024 * 2816, NTOK, 1024, s == 5 ? 1024 : 2816};
                EpiDelta E{Dl};
                gemm_phase<EpiDelta, StaticOrder, false>(lds, g, S, E, nullptr, tid);
            } else {
                PHASE_IDS
                S.init(NTOK, 5632, gridDim.x, blockIdx.x);
                Gemm g{xn, (const bf16_t*)(ws + OFF_WF1) + (size_t)l * 5632 * 1024, NTOK, 5632, 1024};
                EpiFfn1 E{Gt};
                gemm_phase<EpiFfn1, StaticOrder, false>(lds, g, S, E, nullptr, tid);
            }
        }
        if (ph + 1 < P.ph_hi) { ++nbar; grid_barrier(ctl + 3072, nbar * gridDim.x, (wave_s << 6) | lane_now()); }
    }
}

extern "C" void kernel_launch(void* const* d_in, const int* in_sizes, int n_in, void* d_out, int out_size, void* d_ws, size_t ws_size, hipStream_t stream) {
    static int grid = 0;
    if (grid == 0) {
        if (n_in != 24 || out_size != NTOK * 1024 || ws_size < WS_END) { fprintf(stderr, "kernel_launch: unexpected problem (n_in %d out %d ws %zu need %zu)\n", n_in, out_size, ws_size, (size_t)WS_END); grid = -1; return; }
        int dev = 0, cus = 0, per_cu = 0;
        hipGetDevice(&dev); hipDeviceGetAttribute(&cus, hipDeviceAttributeMultiprocessorCount, dev);
        if (hipFuncSetAttribute((const void*)fwd_kernel, hipFuncAttributeMaxDynamicSharedMemorySize, LDS_BYTES) != hipSuccess) { fprintf(stderr, "kernel_launch: hipFuncSetAttribute failed\n"); grid = -1; return; }
        hipOccupancyMaxActiveBlocksPerMultiprocessor(&per_cu, (const void*)fwd_kernel, 512, LDS_BYTES);
        if (per_cu < 1) { fprintf(stderr, "kernel_launch: occupancy query says %d blocks/CU\n", per_cu); per_cu = 1; }
        (void)hipGetLastError();
        grid = cus * per_cu; if (grid > 256) grid = 256;
        if (grid != 256) { fprintf(stderr, "kernel_launch: this build partitions its work over exactly 256 workgroups (got %d)\n", grid); grid = -1; return; }
    }
    if (grid < 0) return;
    hipMemsetAsync((unsigned char*)d_ws + OFF_CTL, 0, 16384, stream);
    Params p{};
    for (int i = 0; i < 24; ++i) p.in[i] = (const float*)d_in[i];
    p.out = (float*)d_out; p.ws = (unsigned char*)d_ws;
#if MK_PER_PHASE
    for (int ph = 0; ph < NPHASE; ++ph) { p.ph_lo = ph; p.ph_hi = ph + 1; hipLaunchKernelGGL(fwd_kernel, dim3(grid), dim3(512), LDS_BYTES, stream, p); }
#else
    p.ph_lo = 0; p.ph_hi = NPHASE;
    void* args[] = {&p};
    hipError_t e = hipLaunchCooperativeKernel((const void*)fwd_kernel, dim3(grid), dim3(512), args, LDS_BYTES, stream);
    if (e != hipSuccess) fprintf(stderr, "cooperative launch failed: %s (grid %d)\n", hipGetErrorString(e), grid);
#endif
}
```

```cpp
#include <hip/hip_runtime.h>
#include <hip/hip_cooperative_groups.h>
#include <cstdio>
namespace cg = cooperative_groups;
namespace pg8 {
#define PG8_LAS __attribute__((address_space(3)))
typedef unsigned short bf16_t;
typedef short bf16x8 __attribute__((ext_vector_type(8)));
typedef float f32x4 __attribute__((ext_vector_type(4)));
typedef unsigned u32x4 __attribute__((ext_vector_type(4)));
constexpr int BM = 256, BK = 64, HALF = 128, HTB = HALF * BK * 2  , STAGE_BYTES = 8 * HTB, NXCD = 8, WGM = 8;

__host__ __device__ __forceinline__ int lds_byte(int r, int c) { const int st = (r >> 4) * 2 + (c >> 5), rr = r & 15, cc = c & 31, ob = rr * 64 + cc * 2; return st * 1024 + (ob ^ (((ob >> 9) & 1) << 5)); }
__host__ __device__ __forceinline__ void stage_rc(int b, int& R, int& C) { const int st = b / 1024, sb = b % 1024, swz = sb ^ (((sb >> 9) & 1) << 5); R = (st >> 1) * 16 + swz / 64; C = (st & 1) * 32 + (swz % 64) / 2; }
__host__ __device__ __forceinline__ int perm32(int rho) { const int n = rho >> 4, i = rho & 15; return 8 * (i >> 2) + 4 * n + (i & 3); }

struct Unit { int pm, pn; };
struct Gemm { const bf16_t* A; const bf16_t* Bt; int M, N, K; };

struct StaticOrder {
    int nM, nN, nwg, G, c;
    __host__ __device__ void init(int M, int N, int G_, int c_) { nM = M / BM; nN = N / BM; nwg = nM * nN; G = G_; c = c_; }
    __host__ __device__ bool next(int i, Unit& u) const {
        const long L = (long)i * G + c; if (L >= nwg) return false;
        int wgid = (int)L; { const int q = nwg / NXCD, r = nwg % NXCD, xcd = wgid % NXCD, off = wgid / NXCD; wgid = (xcd < r ? xcd * (q + 1) : r * (q + 1) + (xcd - r) * q) + off; }
        const int nig = WGM * nN, gid = wgid / nig, fm = gid * WGM, gsz = (nM - fm) < WGM ? (nM - fm) : WGM;
        u.pm = fm + ((wgid % nig) % gsz); u.pn = (wgid % nig) / gsz; return true;
    }
    __device__ __forceinline__ void a_ready(const Unit&) const {}
    __device__ __forceinline__ void done(const Unit&) const {}
};
__device__ __forceinline__ unsigned cvt_pk_bf16(float lo, float hi) { unsigned r; asm volatile("v_cvt_pk_bf16_f32 %0, %1, %2" : "=v"(r) : "v"(lo), "v"(hi)); return r; }
template <class Epi, class Sched, bool STAMP = false>
__device__ __forceinline__ void gemm_phase(PG8_LAS unsigned char* lds, const Gemm g, const Sched& S, const Epi& E, unsigned long long* stamps, int tid_in) {
    int tid_o = tid_in; asm volatile("" : "+v"(tid_o)); const int tid = tid_o, wid = __builtin_amdgcn_readfirstlane(tid >> 6), lane = tid & 63, wr = wid >> 2, wc = wid & 3, fr = lane & 15, fq = lane >> 4;
    const int K = g.K, nt = K / BK;
    int ts_lo = 0, ts_hi = 0, nts = 0; const unsigned long long rt_entry = STAMP ? (unsigned long long)wall_clock64() : 0ull;
#define PG8_STAMP() do { if (STAMP && wid == 0 && nts < 64) { const unsigned long long _c = (unsigned long long)clock64(); \
        ts_lo = (lane == nts) ? (int)(unsigned)_c : ts_lo; ts_hi = (lane == nts) ? (int)(unsigned)(_c >> 32) : ts_hi; ++nts; } } while (0)
    PG8_STAMP();
    unsigned voffA[2], voffB[2];
#pragma unroll
    for (int i = 0; i < 2; ++i) { int R, C; stage_rc(tid * 16 + i * 8192, R, C); const int Rb = Epi::PERM ? ((R & ~31) + perm32(R & 31)) : R;
        voffA[i] = (unsigned)(R * K + C) * 2u; voffB[i] = (unsigned)(Rb * K + C) * 2u; }
    const size_t kstep = (size_t)(BK * 2);
    const size_t hstep = (size_t)HALF * K * 2;
    const size_t tstep = 2 * hstep;
    const unsigned ldsw = (unsigned)wid * 1024u;
    const int aoff = lds_byte(wr * 64 + fr, fq * 8), boff = lds_byte(wc * 32 + fr, fq * 8);
#define PG8_SA(b, h) (((b) * 2 + (h)) * HTB)
#define PG8_SB(b, h) ((4 + (b) * 2 + (h)) * HTB)
#define PG8_STAGE(bufoff, gbase, voff) do { _Pragma("unroll") for (int _i = 0; _i < 2; ++_i) \
        __builtin_amdgcn_global_load_lds((const unsigned*)((const char*)(gbase) + (voff)[_i]), (PG8_LAS unsigned*)(lds + (bufoff) + ldsw + _i * 8192), 16, 0, 0); } while (0)
#define PG8_LDA(dst, b, h) do { _Pragma("unroll") for (int m = 0; m < 4; ++m) _Pragma("unroll") for (int k = 0; k < 2; ++k) dst[m][k] = *(const PG8_LAS bf16x8*)(lds + PG8_SA(b, h) + aoff + m * 2048 + k * 1024); } while (0)
#define PG8_LDB(dst, b, h) do { _Pragma("unroll") for (int n = 0; n < 2; ++n) _Pragma("unroll") for (int k = 0; k < 2; ++k) dst[n][k] = *(const PG8_LAS bf16x8*)(lds + PG8_SB(b, h) + boff + n * 2048 + k * 1024); } while (0)
#define PG8_MMA(ai, bj, At, Bt) do { __builtin_amdgcn_s_setprio(1); _Pragma("unroll") for (int m = 0; m < 4; ++m) _Pragma("unroll") for (int n = 0; n < 2; ++n) _Pragma("unroll") for (int k = 0; k < 2; ++k) \
        acc[ai][bj][m][n] = __builtin_amdgcn_mfma_f32_16x16x32_bf16(Bt[n][k], At[m][k], acc[ai][bj][m][n], 0, 0, 0); __builtin_amdgcn_s_setprio(0); } while (0)
#define PG8_WAIT_V(n) asm volatile("s_waitcnt vmcnt(" #n ")" ::: "memory")
#define PG8_WAIT_L(n) asm volatile("s_waitcnt lgkmcnt(" #n ")" ::: "memory")
#define PG8_BAR __builtin_amdgcn_s_barrier()
#define PG8_SCHED __builtin_amdgcn_sched_barrier(0)
    Unit cur, nxt; int ui = 0;
    if (!S.next(0, cur)) return;
    f32x4 acc[2][2][4][2];
#pragma unroll
    for (int a = 0; a < 2; ++a)
#pragma unroll
        for (int b = 0; b < 2; ++b)
#pragma unroll
            for (int m = 0; m < 4; ++m)
#pragma unroll
                for (int n = 0; n < 2; ++n) acc[a][b][m][n] = (f32x4){0.f, 0.f, 0.f, 0.f};
    bf16x8 At[4][2], B0[2][2], B1[2][2];
    const char* cA = (const char*)g.A + (size_t)cur.pm * tstep; const char* cB = (const char*)g.Bt + (size_t)cur.pn * tstep;
    S.a_ready(cur);
    PG8_STAGE(PG8_SB(0, 0), cB, voffB); PG8_STAGE(PG8_SA(0, 0), cA, voffA); PG8_STAGE(PG8_SB(0, 1), cB + hstep, voffB); PG8_STAGE(PG8_SA(0, 1), cA + hstep, voffA);
    if (wr == 1) PG8_BAR;
    PG8_WAIT_V(4); PG8_BAR;
    PG8_STAGE(PG8_SB(1, 0), cB + kstep, voffB); PG8_STAGE(PG8_SA(1, 0), cA + kstep, voffA); PG8_STAGE(PG8_SB(1, 1), cB + hstep + kstep, voffB);
    PG8_WAIT_V(6); PG8_BAR;
    PG8_STAMP();
    for (;;) {
        const bool has_next = S.next(ui + 1, nxt);
        const char* nA = has_next ? (const char*)g.A + (size_t)nxt.pm * tstep : cA; const char* nB = has_next ? (const char*)g.Bt + (size_t)nxt.pn * tstep : cB;
        for (int t = 0; t < nt; t += 2) {
            const bool last = (t == nt - 2);
            const char* a1 = cA + (size_t)(t + 1) * kstep;
            const char* a2 = last ? nA : cA + (size_t)(t + 2) * kstep; const char* b2 = last ? nB : cB + (size_t)(t + 2) * kstep;
            const char* a3 = a2 + kstep; const char* b3 = b2 + kstep;
            if (last && has_next) S.a_ready(nxt);
            PG8_LDB(B0, 0, 0); PG8_SCHED; PG8_LDA(At, 0, 0); PG8_STAGE(PG8_SA(1, 1), a1 + hstep, voffA);
            PG8_WAIT_L(8); PG8_BAR; PG8_WAIT_L(0); PG8_MMA(0, 0, At, B0); PG8_BAR; PG8_SCHED;
            PG8_LDB(B1, 0, 1); PG8_STAGE(PG8_SB(0, 0), b2, voffB);
            PG8_BAR; PG8_WAIT_L(0); PG8_MMA(0, 1, At, B1); PG8_BAR;
            PG8_LDA(At, 0, 1); PG8_STAGE(PG8_SA(0, 0), a2, voffA);
            PG8_BAR; PG8_WAIT_L(0); PG8_MMA(1, 0, At, B0); PG8_BAR; PG8_SCHED;
            PG8_STAGE(PG8_SB(0, 1), b2 + hstep, voffB);
            PG8_WAIT_V(6); PG8_BAR; PG8_MMA(1, 1, At, B1); PG8_BAR;
            PG8_LDB(B0, 1, 0); PG8_SCHED; PG8_LDA(At, 1, 0); PG8_STAGE(PG8_SA(0, 1), a2 + hstep, voffA);
            PG8_WAIT_L(8); PG8_BAR; PG8_WAIT_L(0); PG8_MMA(0, 0, At, B0); PG8_BAR; PG8_SCHED;
            PG8_LDB(B1, 1, 1); PG8_STAGE(PG8_SB(1, 0), b3, voffB);
            PG8_BAR; PG8_WAIT_L(0); PG8_MMA(0, 1, At, B1); PG8_BAR;
            PG8_LDA(At, 1, 1); PG8_STAGE(PG8_SA(1, 0), a3, voffA);
            PG8_BAR; PG8_WAIT_L(0); PG8_MMA(1, 0, At, B0); PG8_BAR; PG8_SCHED;
            PG8_STAGE(PG8_SB(1, 1), b3 + hstep, voffB);
            PG8_WAIT_V(6); PG8_BAR; PG8_MMA(1, 1, At, B1); PG8_BAR;
        }
        PG8_STAMP();
        if constexpr (!Epi::AFTER_DRAIN) { E(acc, cur, wr, wc, fr, fq); S.done(cur); }
        PG8_STAMP();
        if (!has_next) break;
#pragma unroll
        for (int a = 0; a < 2; ++a)
#pragma unroll
            for (int b = 0; b < 2; ++b)
#pragma unroll
                for (int m = 0; m < 4; ++m)
#pragma unroll
                    for (int n = 0; n < 2; ++n) acc[a][b][m][n] = (f32x4){0.f, 0.f, 0.f, 0.f};
        cur = nxt; cA = nA; cB = nB; ++ui;
    }
    PG8_WAIT_V(0);
    if (wr == 0) PG8_BAR;
    PG8_BAR;
    if constexpr (Epi::AFTER_DRAIN) { E.fused(acc, cur, wr, wc, fr, fq, lds, wid, lane); S.done(cur); }
    PG8_STAMP();
    if (STAMP && wid == 0) { stamps[lane] = lane < nts ? (((unsigned long long)(unsigned)ts_hi << 32) | (unsigned)ts_lo) : 0ull;
        if (lane == 62) stamps[62] = rt_entry; if (lane == 63) stamps[63] = (unsigned long long)wall_clock64(); }
#undef PG8_STAMP
#undef PG8_SA
#undef PG8_SB
#undef PG8_STAGE
#undef PG8_LDA
#undef PG8_LDB
#undef PG8_MMA
#undef PG8_WAIT_V
#undef PG8_WAIT_L
#undef PG8_BAR
#undef PG8_SCHED
}
}

using namespace pg8;
#define LAS __attribute__((address_space(3)))
typedef short s16x4 __attribute__((ext_vector_type(4)));
typedef short v4i16_t __attribute__((ext_vector_type(4)));
typedef float f32x16 __attribute__((ext_vector_type(16)));
typedef unsigned u32x2 __attribute__((ext_vector_type(2)));
typedef float f32x2v __attribute__((ext_vector_type(2)));

#ifndef NREP_S5
#define NREP_S5 1
#endif
#ifndef NREP_B2
#define NREP_B2 1
#endif
#ifndef NREP_P0
#define NREP_P0 1
#endif
#ifndef MK_PER_PHASE
#define MK_PER_PHASE 0
#endif

constexpr int NTOK = 65536, SEQL = 2048;
constexpr float EPSN = 1e-6f;
constexpr int LDS_BYTES = 155648;
constexpr int S5_WL = 25088;
constexpr int ATT_OFF = 4 * S5_WL;
constexpr int VSTR = 192;
constexpr int ATT_WL = 32 * VSTR;
constexpr int CTR_OFF = LDS_BYTES - 256;
static_assert(ATT_OFF + 8 * ATT_WL <= CTR_OFF, "lds");

constexpr size_t OFF_WIN = 0;
constexpr size_t OFF_WGLU = OFF_WIN + 2ull * 7168 * 1024 * 2;
constexpr size_t OFF_WATT = OFF_WGLU + 2ull * 2048 * 512 * 2;
constexpr size_t OFF_WPW2 = OFF_WATT + 2ull * 1024 * 512 * 2;
constexpr size_t OFF_WOUT = OFF_WPW2 + 2ull * 1024 * 512 * 2;
constexpr size_t OFF_WF1 = OFF_WOUT + 2ull * 1024 * 1024 * 2;
constexpr size_t OFF_WF2 = OFF_WF1 + 2ull * 5632 * 1024 * 2;
constexpr size_t OFF_S5BB = OFF_WF2 + 2ull * 1024 * 2816 * 2;
constexpr size_t OFF_S5CM = OFF_S5BB + 2ull * 32 * 128 * 16 * 2;
constexpr size_t OFF_S5A = OFF_S5CM + 2ull * 32 * 16 * 128 * 2;
constexpr size_t OFF_CONVW = OFF_S5A + 2ull * 32 * 64 * 8;
constexpr size_t OFF_CTL = OFF_CONVW + 65536;
constexpr size_t OFF_RSQ1 = OFF_CTL + 16384;
constexpr size_t OFF_RSQ2 = OFF_RSQ1 + 65536ull * 8;
constexpr size_t OFF_LSE = OFF_RSQ2 + 65536ull * 8;
constexpr size_t OFF_XB = OFF_LSE + 2ull * 65536 * 8 * 4;
constexpr size_t OFF_G = OFF_XB + 65536ull * 1024 * 2;
constexpr size_t OFF_QO = OFF_G + 65536ull * 3072 * 2;
constexpr size_t OFF_CG = OFF_QO + 65536ull * 1536 * 2;
constexpr size_t OFF_HC = OFF_CG + 65536ull * 512 * 2;
constexpr size_t OFF_OC = OFF_HC + 65536ull * 512 * 2;
constexpr size_t WS_END = OFF_OC + 65536ull * 512 * 2;
constexpr size_t DO_U = 0, DO_K = 64ull << 20, DO_V = 128ull << 20, DO_Y = 192ull << 20, DO_MG = 64ull << 20;

struct Params {
    const float* in[24];
    float* out; unsigned char* ws;
    int ph_lo, ph_hi;
};
enum { I_X = 0, I_N1G, I_WIN, I_BGATE, I_LRE, I_LIM, I_LOGDT, I_BRE, I_BIM, I_CRE, I_CIM, I_SSMD, I_WGLU, I_WATT, I_CONVW, I_CONVB, I_LNG, I_LNB, I_WPW2, I_WOUT, I_N2G, I_WF1, I_WF2, I_FING };

__device__ __forceinline__ float bf_lo(unsigned u) { return __uint_as_float(u << 16); }
__device__ __forceinline__ float bf_hi(unsigned u) { return __uint_as_float(u & 0xffff0000u); }
__device__ __forceinline__ float sigm(float x) { return __builtin_amdgcn_rcpf(1.f + __expf(-x)); }
__device__ __forceinline__ unsigned short f2bf(float f) { unsigned u = __float_as_uint(f); u += 0x7FFFu + ((u >> 16) & 1u); return (unsigned short)(u >> 16); }
__device__ __forceinline__ float wave_sum(float v) {
#pragma unroll
    for (int o = 1; o < 64; o <<= 1) v += __shfl_xor(v, o);
    return v;
}
__device__ __forceinline__ s16x4 vtr(const LAS unsigned char* p) { return __builtin_bit_cast(s16x4, __builtin_amdgcn_ds_read_tr16_b64_v4i16((LAS v4i16_t*)p)); }

__device__ __forceinline__ u32x4 pack8(const f32x4 a, const f32x4 b) { u32x4 w; w.x = cvt_pk_bf16(a[0], a[1]); w.y = cvt_pk_bf16(a[2], a[3]); w.z = cvt_pk_bf16(b[0], b[1]); w.w = cvt_pk_bf16(b[2], b[3]); return w; }
__device__ __forceinline__ void unpack8(const u32x4 w, f32x4& a, f32x4& b) { a[0] = bf_lo(w.x); a[1] = bf_hi(w.x); a[2] = bf_lo(w.y); a[3] = bf_hi(w.y); b[0] = bf_lo(w.z); b[1] = bf_hi(w.z); b[2] = bf_lo(w.w); b[3] = bf_hi(w.w); }

struct EpiIn {
    static constexpr bool PERM = true, AFTER_DRAIN = false;
    bf16_t *U, *QO, *Kb, *Vb, *CG, *G; const float* rowsq; const float* bgate;
    __device__ __forceinline__ void operator()(const f32x4 (&acc)[2][2][4][2], const Unit& u, int wr, int wc, int fr, int fq) const {
        const int row0 = u.pm * 256 + wr * 64 + fr, cl = wc * 32 + 8 * fq, pn = u.pn;
        if (pn < 12) {
            bf16_t* base; int ld, col0;
            if (pn < 2) { base = U; ld = 512; col0 = pn * 256; }
            else if (pn < 8) { base = QO; ld = 1536; col0 = (pn - 2) * 256; }
            else if (pn < 10) { base = Kb; ld = 512; col0 = (pn - 8) * 256; }
            else { base = Vb; ld = 512; col0 = (pn - 10) * 256; }
#pragma unroll
            for (int ai = 0; ai < 2; ++ai)
#pragma unroll
                for (int m = 0; m < 4; ++m) { const int r = row0 + ai * 128 + m * 16; const float rs = rowsq[r];
#pragma unroll
                    for (int bj = 0; bj < 2; ++bj) *(u32x4*)(base + (size_t)r * ld + col0 + bj * 128 + cl) = pack8(acc[ai][bj][m][0] * rs, acc[ai][bj][m][1] * rs); }
        } else if (pn < 16) {
            const int c0 = (pn - 12) * 128 + cl;
#pragma unroll
            for (int ai = 0; ai < 2; ++ai)
#pragma unroll
                for (int m = 0; m < 4; ++m) { const int r = row0 + ai * 128 + m * 16; const float rs = rowsq[r];
                    f32x4 o[2];
#pragma unroll
                    for (int n = 0; n < 2; ++n)
#pragma unroll
                        for (int j = 0; j < 4; ++j) o[n][j] = acc[ai][0][m][n][j] * rs * sigm(acc[ai][1][m][n][j] * rs);
                    *(u32x4*)(CG + (size_t)r * 512 + c0) = pack8(o[0], o[1]); }
        } else {
            const int c0 = (pn - 16) * 256 + cl;
            f32x4 bv[2][2];
#pragma unroll
            for (int bj = 0; bj < 2; ++bj)
#pragma unroll
                for (int n = 0; n < 2; ++n) bv[bj][n] = *(const f32x4*)(bgate + c0 + bj * 128 + 4 * n);
#pragma unroll
            for (int ai = 0; ai < 2; ++ai)
#pragma unroll
                for (int m = 0; m < 4; ++m) { const int r = row0 + ai * 128 + m * 16; const float rs = rowsq[r];
#pragma unroll
                    for (int bj = 0; bj < 2; ++bj) { f32x4 o[2];
#pragma unroll
                        for (int n = 0; n < 2; ++n)
#pragma unroll
                            for (int j = 0; j < 4; ++j) o[n][j] = sigm(acc[ai][bj][m][n][j] * rs + bv[bj][n][j]);
                        *(u32x4*)(G + (size_t)r * 3072 + c0 + bj * 128) = pack8(o[0], o[1]); } }
        }
    }
};
struct EpiGluMerge {
    static constexpr bool PERM = true, AFTER_DRAIN = false;
    bf16_t* Mg; const bf16_t* G;
    __device__ __forceinline__ void operator()(const f32x4 (&acc)[2][2][4][2], const Unit& u, int wr, int wc, int fr, int fq) const {
        const int row0 = u.pm * 256 + wr * 64 + fr, c0 = u.pn * 128 + wc * 32 + 8 * fq;
#pragma unroll
        for (int ai = 0; ai < 2; ++ai)
#pragma unroll
            for (int m = 0; m < 4; ++m) { const int r = row0 + ai * 128 + m * 16;
                f32x4 g0, g1; unpack8(*(const u32x4*)(G + (size_t)r * 3072 + c0), g0, g1);
                f32x4 o[2];
#pragma unroll
                for (int j = 0; j < 4; ++j) { o[0][j] = g0[j] * acc[ai][0][m][0][j] * sigm(acc[ai][1][m][0][j]); o[1][j] = g1[j] * acc[ai][0][m][1][j] * sigm(acc[ai][1][m][1][j]); }
                *(u32x4*)(Mg + (size_t)r * 1024 + c0) = pack8(o[0], o[1]); }
    }
};
struct EpiAccMerge {
    static constexpr bool PERM = true, AFTER_DRAIN = false;
    bf16_t* Mg; const bf16_t* G; int gate_off;
    __device__ __forceinline__ void operator()(const f32x4 (&acc)[2][2][4][2], const Unit& u, int wr, int wc, int fr, int fq) const {
        const int row0 = u.pm * 256 + wr * 64 + fr, cb = u.pn * 256 + wc * 32 + 8 * fq;
#pragma unroll
        for (int ai = 0; ai < 2; ++ai)
#pragma unroll
            for (int m = 0; m < 4; ++m) { const int r = row0 + ai * 128 + m * 16;
#pragma unroll
                for (int bj = 0; bj < 2; ++bj) { const int c0 = cb + bj * 128;
                    f32x4 g0, g1, m0, m1; unpack8(*(const u32x4*)(G + (size_t)r * 3072 + gate_off + c0), g0, g1); unpack8(*(const u32x4*)(Mg + (size_t)r * 1024 + c0), m0, m1);
                    *(u32x4*)(Mg + (size_t)r * 1024 + c0) = pack8(m0 + g0 * acc[ai][bj][m][0], m1 + g1 * acc[ai][bj][m][1]); } }
    }
};
struct EpiDelta {
    static constexpr bool PERM = true, AFTER_DRAIN = false;
    bf16_t* D;
    __device__ __forceinline__ void operator()(const f32x4 (&acc)[2][2][4][2], const Unit& u, int wr, int wc, int fr, int fq) const {
        const int row0 = u.pm * 256 + wr * 64 + fr, cb = u.pn * 256 + wc * 32 + 8 * fq;
#pragma unroll
        for (int ai = 0; ai < 2; ++ai)
#pragma unroll
            for (int m = 0; m < 4; ++m)
#pragma unroll
                for (int bj = 0; bj < 2; ++bj) *(u32x4*)(D + (size_t)(row0 + ai * 128 + m * 16) * 1024 + cb + bj * 128) = pack8(acc[ai][bj][m][0], acc[ai][bj][m][1]);
    }
};
struct EpiFfn1 {
    static constexpr bool PERM = true, AFTER_DRAIN = false;
    bf16_t* Hf;
    __device__ __forceinline__ void operator()(const f32x4 (&acc)[2][2][4][2], const Unit& u, int wr, int wc, int fr, int fq) const {
        const int row0 = u.pm * 256 + wr * 64 + fr, c0 = u.pn * 128 + wc * 32 + 8 * fq;
#pragma unroll
        for (int ai = 0; ai < 2; ++ai)
#pragma unroll
            for (int m = 0; m < 4; ++m) { const int r = row0 + ai * 128 + m * 16;
                f32x4 o[2];
#pragma unroll
                for (int n = 0; n < 2; ++n)
#pragma unroll
                    for (int j = 0; j < 4; ++j) { const float a = acc[ai][0][m][n][j], b = acc[ai][1][m][n][j]; o[n][j] = a * sigm(a) * b; }
                *(u32x4*)(Hf + (size_t)r * 2816 + c0) = pack8(o[0], o[1]); }
    }
};

__device__ __forceinline__ void p0_tr_item(const float* W, int K, int N, bf16_t* WT, int kb, int nd0, int ns0, const float* gk, float scale, LAS float* scr, int lane) {
    const int k0 = 64 * kb;
#pragma unroll 8
    for (int i = 0; i < 32; ++i) { const int kk = 2 * i + (lane >> 5); float s = scale; if (gk) s *= gk[k0 + kk]; scr[kk * 33 + (lane & 31)] = W[(size_t)(k0 + kk) * N + ns0 + (lane & 31)] * s; }
    asm volatile("" ::: "memory");
    const int c = lane & 7;
#pragma unroll
    for (int j = 0; j < 4; ++j) { const int n = (lane >> 3) + 8 * j; const LAS float* s = scr + (8 * c) * 33 + n;
        u32x4 o; o.x = cvt_pk_bf16(s[0 * 33], s[1 * 33]); o.y = cvt_pk_bf16(s[2 * 33], s[3 * 33]); o.z = cvt_pk_bf16(s[4 * 33], s[5 * 33]); o.w = cvt_pk_bf16(s[6 * 33], s[7 * 33]);
        *(u32x4*)(WT + (size_t)(nd0 + n) * K + k0 + 8 * c) = o; }
    asm volatile("" ::: "memory");
}
__device__ __forceinline__ void phase_p0(const Params& P, LAS unsigned char* lds, int wave, int lane, int tid) {
    unsigned char* ws = P.ws;
    const int gw = blockIdx.x * 8 + wave, NGW = gridDim.x * 8;
    LAS float* scr = (LAS float*)(lds + wave * 16384);
    constexpr int PER_L = 3584 + 512 + 256 + 256 + 512 + 2816 + 1408;
    for (int it = gw; it < 2 * PER_L; it += NGW) {
        const int l = it / PER_L; int r = it % PER_L;
        const float* W; bf16_t* WT; int K, N, type = 0; const float* gk = nullptr;
        if (r < 3584) { W = P.in[I_WIN] + (size_t)l * 1024 * 7168; WT = (bf16_t*)(ws + OFF_WIN) + (size_t)l * 7168 * 1024; K = 1024; N = 7168; type = 1; gk = P.in[I_N1G] + l * 1024; }
        else if ((r -= 3584) < 512) { W = P.in[I_WGLU] + (size_t)l * 512 * 2048; WT = (bf16_t*)(ws + OFF_WGLU) + (size_t)l * 2048 * 512; K = 512; N = 2048; type = 3; }
        else if ((r -= 512) < 256) { W = P.in[I_WATT] + (size_t)l * 512 * 1024; WT = (bf16_t*)(ws + OFF_WATT) + (size_t)l * 1024 * 512; K = 512; N = 1024; }
        else if ((r -= 256) < 256) { W = P.in[I_WPW2] + (size_t)l * 512 * 1024; WT = (bf16_t*)(ws + OFF_WPW2) + (size_t)l * 1024 * 512; K = 512; N = 1024; }
        else if ((r -= 256) < 512) { W = P.in[I_WOUT] + (size_t)l * 1024 * 1024; WT = (bf16_t*)(ws + OFF_WOUT) + (size_t)l * 1024 * 1024; K = 1024; N = 1024; }
        else if ((r -= 512) < 2816) { W = P.in[I_WF1] + (size_t)l * 1024 * 5632; WT = (bf16_t*)(ws + OFF_WF1) + (size_t)l * 5632 * 1024; K = 1024; N = 5632; type = 2; gk = P.in[I_N2G] + l * 1024; }
        else { r -= 2816; W = P.in[I_WF2] + (size_t)l * 2816 * 1024; WT = (bf16_t*)(ws + OFF_WF2) + (size_t)l * 1024 * 2816; K = 2816; N = 1024; }
        const int nblk = N / 32, kb = r / nblk, nd0 = (r % nblk) * 32;
        int ns0 = nd0; float scale = 1.f;
        if (type == 1) { if (nd0 >= 3072 && nd0 < 4096) { const int t = nd0 - 3072, j = t & 255; ns0 = 3072 + (t >> 8) * 128 + (j & 127) + (j >= 128 ? 512 : 0); }
                         if (nd0 >= 512 && nd0 < 2048) scale = 0.125f * 1.4426950408889634f; }
        else if (type == 2) { const int j = nd0 & 255; ns0 = (nd0 >> 8) * 128 + (j & 127) + (j >= 128 ? 2816 : 0); }
        else if (type == 3) { const int j = nd0 & 255; ns0 = (nd0 >> 8) * 128 + (j & 127) + (j >= 128 ? 1024 : 0); }
        p0_tr_item(W, K, N, WT, kb, nd0, ns0, gk, scale, scr, lane);
    }
    { const float* x = P.in[I_X]; bf16_t* xb = (bf16_t*)(ws + OFF_XB);
      for (int row = gw; row < NTOK; row += NGW) { float ss = 0.f; f32x4 v[4];
#pragma unroll
          for (int j = 0; j < 4; ++j) { const f32x4 t = *(const f32x4*)(x + (size_t)row * 1024 + 4 * lane + 256 * j); u32x2 w; w.x = cvt_pk_bf16(t[0], t[1]); w.y = cvt_pk_bf16(t[2], t[3]);
              *(u32x2*)(xb + (size_t)row * 1024 + 4 * lane + 256 * j) = w; v[j][0] = bf_lo(w.x); v[j][1] = bf_hi(w.x); v[j][2] = bf_lo(w.y); v[j][3] = bf_hi(w.y);
              ss += v[j][0] * v[j][0] + v[j][1] * v[j][1] + v[j][2] * v[j][2] + v[j][3] * v[j][3]; }
          ss = wave_sum(ss); const float rs = rsqrtf(ss * (1.f / 1024.f) + EPSN); if (lane == 0) ((float*)(ws + OFF_RSQ1))[row] = rs;
 } }
    const int gt = blockIdx.x * 512 + tid, NGT = gridDim.x * 512;
    for (int idx = gt; idx < 2 * 32 * 64; idx += NGT) {
        const int lg = idx >> 6, p = idx & 63;
        const float lre = P.in[I_LRE][idx], lim = P.in[I_LIM][idx], dt = expf(P.in[I_LOGDT][lg]);
        const float mag = expf(lre * dt);
        const double rev = (double)lim * (double)dt * 0.15915494309189535; const float frc = (float)(rev - rint(rev));
        const float sn = __builtin_amdgcn_sinf(frc), cs = __builtin_amdgcn_cosf(frc);
        const float are = mag * cs, aim = mag * sn, nr = are - 1.f, ni = aim, den = lre * lre + lim * lim;
        const float zre = (nr * lre + ni * lim) / den, zim = (ni * lre - nr * lim) / den;
        { f32x2v t2; t2.x = are; t2.y = aim; ((f32x2v*)(ws + OFF_S5A))[idx] = t2; }
        bf16_t* bbt = (bf16_t*)(ws + OFF_S5BB) + (size_t)lg * 128 * 16; bf16_t* cm = (bf16_t*)(ws + OFF_S5CM) + (size_t)lg * 16 * 128;
        for (int h = 0; h < 16; ++h) { const float br = P.in[I_BRE][(size_t)idx * 16 + h], bi = P.in[I_BIM][(size_t)idx * 16 + h];
            bbt[p * 16 + h] = f2bf(zre * br - zim * bi); bbt[(64 + p) * 16 + h] = f2bf(zre * bi + zim * br);
            cm[h * 128 + p] = f2bf(P.in[I_CRE][((size_t)lg * 16 + h) * 64 + p]); cm[h * 128 + 64 + p] = f2bf(-P.in[I_CIM][((size_t)lg * 16 + h) * 64 + p]); }
    }
    for (int idx = gt; idx < 2 * 31 * 256; idx += NGT) { const float a = P.in[I_CONVW][2 * idx], b = P.in[I_CONVW][2 * idx + 1]; ((unsigned*)(ws + OFF_CONVW))[idx] = cvt_pk_bf16(a, b); }
}
template <bool FINAL> __device__ __forceinline__ void phase_rows(const Params& P, int wave, int lane, bool want_xn) {
    const int gw = blockIdx.x * 8 + wave, NGW = gridDim.x * 8;
    bf16_t* xb = (bf16_t*)(P.ws + OFF_XB); const bf16_t* D = (const bf16_t*)(P.ws + OFF_QO); bf16_t* xn = (bf16_t*)(P.ws + OFF_HC); const float* fg = P.in[I_FING];
    for (int row = gw; row < NTOK; row += NGW) {
        const size_t o0 = (size_t)row * 1024 + 8 * lane, o1 = o0 + 512;
        const u32x4 w0 = *(const u32x4*)(xb + o0), w1 = *(const u32x4*)(xb + o1), d0 = *(const u32x4*)(D + o0), d1 = *(const u32x4*)(D + o1);
        f32x4 a0, a1, b0, b1, e0, e1, g0, g1; unpack8(w0, a0, a1); unpack8(w1, b0, b1); unpack8(d0, e0, e1); unpack8(d1, g0, g1);
        const u32x4 n0 = pack8(a0 + e0, a1 + e1), n1 = pack8(b0 + g0, b1 + g1);
        unpack8(n0, a0, a1); unpack8(n1, b0, b1);
        float ss = 0.f;
#pragma unroll
        for (int j = 0; j < 4; ++j) ss += a0[j] * a0[j] + a1[j] * a1[j] + b0[j] * b0[j] + b1[j] * b1[j];
        ss = wave_sum(ss);
        const float rs = rsqrtf(ss * (1.f / 1024.f) + EPSN);
        if (!FINAL) { if (lane == 0) ((float*)(P.ws + OFF_RSQ1))[row] = rs; *(u32x4*)(xb + o0) = n0; *(u32x4*)(xb + o1) = n1; if (want_xn) { *(u32x4*)(xn + o0) = pack8(a0 * rs, a1 * rs); *(u32x4*)(xn + o1) = pack8(b0 * rs, b1 * rs); } }
        else { const f32x4 q0 = *(const f32x4*)(fg + 8 * lane), q1 = *(const f32x4*)(fg + 8 * lane + 4), q2 = *(const f32x4*)(fg + 512 + 8 * lane), q3 = *(const f32x4*)(fg + 512 + 8 * lane + 4);
            float* o = P.out + (size_t)row * 1024;
            *(f32x4*)(o + 8 * lane) = a0 * q0 * rs; *(f32x4*)(o + 8 * lane + 4) = a1 * q1 * rs; *(f32x4*)(o + 512 + 8 * lane) = b0 * q2 * rs; *(f32x4*)(o + 512 + 8 * lane + 4) = b1 * q3 * rs; }
    }
}

__device__ __forceinline__ void s5_item(const Params& P, int l, int it, LAS unsigned char* wl, int lane) {
    const int b = it >> 5, g = it & 31, lg = l * 32 + g;
    LAS float* bu = (LAS float*)wl; LAS unsigned char* sl = wl + 16384;
    const int c32 = lane & 31, hi = lane >> 5, fr = lane & 15, fq = lane >> 4;
    const bf16_t* bbt = (const bf16_t*)(P.ws + OFF_S5BB) + (size_t)lg * 128 * 16; const bf16_t* cm = (const bf16_t*)(P.ws + OFF_S5CM) + (size_t)lg * 16 * 128;
    bf16x8 bbreg[4], cmreg[4];
#pragma unroll
    for (int j = 0; j < 4; ++j) { bbreg[j] = *(const bf16x8*)(bbt + (32 * j + c32) * 16 + 8 * hi); cmreg[j] = *(const bf16x8*)(cm + fr * 128 + 32 * j + 8 * fq); }
    const f32x2v av = ((const f32x2v*)(P.ws + OFF_S5A))[lg * 64 + lane]; const float a_re = av.x, a_im = av.y;
    const float dsk = P.in[I_SSMD][l * 512 + g * 16 + fr];
    float s_re = 0.f, s_im = 0.f;
    const bf16_t* Ub = (const bf16_t*)((unsigned char*)P.out + DO_U) + (size_t)b * SEQL * 512 + g * 16; bf16_t* Yb = (bf16_t*)((unsigned char*)P.out + DO_Y) + (size_t)b * SEQL * 512 + g * 16;
    for (int c = 0; c < 64; ++c) {
        const int t0 = c * 32;
        const bf16x8 ureg = *(const bf16x8*)(Ub + (size_t)(t0 + c32) * 512 + 8 * hi);
        unsigned short uep[2][4];
#pragma unroll
        for (int mt = 0; mt < 2; ++mt)
#pragma unroll
            for (int i = 0; i < 4; ++i) uep[mt][i] = Ub[(size_t)(t0 + 16 * mt + 4 * fq + i) * 512 + fr];
#pragma unroll
        for (int j = 0; j < 4; ++j) { f32x16 a;
#pragma unroll
            for (int r = 0; r < 16; ++r) a[r] = 0.f;
            a = __builtin_amdgcn_mfma_f32_32x32x16_bf16(ureg, bbreg[j], a, 0, 0, 0);
#pragma unroll
            for (int r = 0; r < 16; ++r) { const int tok = (r & 3) + 8 * (r >> 2) + 4 * hi; bu[tok * 128 + ((32 * (j & 1) + c32) << 1) + (j >> 1)] = a[r]; } }
        asm volatile("" ::: "memory");
#pragma unroll 8
        for (int t = 0; t < 32; ++t) { const f32x2v v = *(const LAS f32x2v*)(bu + t * 128 + 2 * lane);
            const float nre = fmaf(a_re, s_re, fmaf(-a_im, s_im, v.x)), nim = fmaf(a_re, s_im, fmaf(a_im, s_re, v.y)); s_re = nre; s_im = nim;
            *(LAS unsigned short*)(sl + t * 272 + lane * 2) = f2bf(s_re); *(LAS unsigned short*)(sl + t * 272 + 128 + lane * 2) = f2bf(s_im); }
        asm volatile("" ::: "memory");
#pragma unroll
        for (int mt = 0; mt < 2; ++mt) { f32x4 ya = {0.f, 0.f, 0.f, 0.f};
#pragma unroll
            for (int ks = 0; ks < 4; ++ks) { const bf16x8 a = *(const LAS bf16x8*)(sl + (16 * mt + fr) * 272 + (32 * ks + 8 * fq) * 2); ya = __builtin_amdgcn_mfma_f32_16x16x32_bf16(a, cmreg[ks], ya, 0, 0, 0); }
#pragma unroll
            for (int i = 0; i < 4; ++i) { const float y = ya[i] + dsk * __uint_as_float((unsigned)uep[mt][i] << 16);
                const float ge = y * sigm(1.5957691216057308f * (y + 0.044715f * y * y * y));
                Yb[(size_t)(t0 + 16 * mt + 4 * fq + i) * 512 + fr] = f2bf(ge); } }
        asm volatile("" ::: "memory");
    }
}

template <int PAT> __device__ __forceinline__ void attn_item(const Params& P, int it, LAS unsigned char* vl, int lane) {
    constexpr int d = PAT == 0 ? 1 : (PAT == 1 ? 4 : 16);
    constexpr int ngrp = (SEQL / d) / 32;
    constexpr int KSTR = 144;
    const int j = it % ngrp; int t = it / ngrp; const int r = t % d; t /= d; const int h = t & 7, b = t >> 3;
    const int c32 = lane & 31, hi = lane >> 5, i0 = 32 * j;
    const int lrow = lane >> 3, lch = lane & 7;
    const size_t tokbase = (size_t)b * SEQL;
    bf16_t* QO = (bf16_t*)(P.ws + OFF_QO); const bf16_t* Kb = (const bf16_t*)((unsigned char*)P.out + DO_K); const bf16_t* Vb = (const bf16_t*)((unsigned char*)P.out + DO_V);
    float* LSE = (float*)(P.ws + OFF_LSE);
    const unsigned char* qrow0 = (const unsigned char*)QO + ((tokbase + (size_t)i0 * d + r) * 1536 + PAT * 512 + h * 64) * 2;
    const unsigned char* krow0 = (const unsigned char*)Kb + ((tokbase + (size_t)(i0 - 128) * d + r) * 512 + h * 64) * 2;
    const unsigned char* vrow0 = (const unsigned char*)Vb + ((tokbase + (size_t)(i0 - 128) * d + r) * 512 + h * 64) * 2;
    const unsigned qlo = (unsigned)(lrow * d * 3072 + lch * 16), klo = (unsigned)(lrow * d * 1024 + lch * 16);
    u32x4 qraw[4], kraw[5][4];
#pragma unroll
    for (int i4 = 0; i4 < 4; ++i4) qraw[i4] = *(const u32x4*)(qrow0 + (qlo + (unsigned)(8 * i4 * d * 3072)));
#pragma unroll
    for (int kt = 0; kt < 5; ++kt) { const int kb = i0 - 128 + 32 * kt;
        if (kb >= 0) {
#pragma unroll
            for (int i4 = 0; i4 < 4; ++i4) kraw[kt][i4] = *(const u32x4*)(krow0 + (klo + (unsigned)((32 * kt + 8 * i4) * d * 1024))); } }
    bf16x8 qreg[4];
#pragma unroll
    for (int i4 = 0; i4 < 4; ++i4) *(LAS u32x4*)(vl + (lrow + 8 * i4) * KSTR + lch * 16) = qraw[i4];
    asm volatile("" ::: "memory");
#pragma unroll
    for (int ks = 0; ks < 4; ++ks) qreg[ks] = *(const LAS bf16x8*)(vl + c32 * KSTR + (16 * ks + 8 * hi) * 2);
    asm volatile("" ::: "memory");
    f32x16 s[5];
#pragma unroll
    for (int kt = 0; kt < 5; ++kt) { const int kb = i0 - 128 + 32 * kt;
        f32x16 a;
        if (kb >= 0) {
#pragma unroll
            for (int q = 0; q < 16; ++q) a[q] = 0.f;
#pragma unroll
            for (int i4 = 0; i4 < 4; ++i4) *(LAS u32x4*)(vl + (lrow + 8 * i4) * KSTR + lch * 16) = kraw[kt][i4];
            asm volatile("" ::: "memory");
#pragma unroll
            for (int ks = 0; ks < 4; ++ks) { const bf16x8 kreg = *(const LAS bf16x8*)(vl + c32 * KSTR + (16 * ks + 8 * hi) * 2); a = __builtin_amdgcn_mfma_f32_32x32x16_bf16(kreg, qreg[ks], a, 0, 0, 0); }
            asm volatile("" ::: "memory");
        } else {
#pragma unroll
            for (int q = 0; q < 16; ++q) a[q] = (-__builtin_inff());
        }
        s[kt] = a; }
    u32x4 vreg[5][4];
#pragma unroll
    for (int kt = 0; kt < 3; ++kt) { const int kb = i0 - 128 + 32 * kt;
        if (kb >= 0) {
#pragma unroll
            for (int i4 = 0; i4 < 4; ++i4) vreg[kt][i4] = *(const u32x4*)(vrow0 + (klo + (unsigned)((32 * kt + 8 * i4) * d * 1024))); } }
#pragma unroll
    for (int q = 0; q < 16; ++q) { const int kr = (q & 3) + 8 * (q >> 2) + 4 * hi; if (kr < c32) s[0][q] = (-__builtin_inff()); if (kr > c32) s[4][q] = (-__builtin_inff()); }
    float mx = (-__builtin_inff());
#pragma unroll
    for (int kt = 0; kt < 5; ++kt)
#pragma unroll
        for (int q = 0; q < 16; ++q) mx = fmaxf(mx, s[kt][q]);
    mx = fmaxf(mx, __shfl_xor(mx, 32));
    float den = 0.f;
#pragma unroll
    for (int kt = 0; kt < 5; ++kt)
#pragma unroll
        for (int q = 0; q < 16; ++q) { const float p = __builtin_amdgcn_exp2f(s[kt][q] - mx); s[kt][q] = p; den += p; }
    den += __shfl_xor(den, 32);
    u32x4 pw[5][2];
#pragma unroll
    for (int kt = 0; kt < 5; ++kt)
#pragma unroll
        for (int ks2 = 0; ks2 < 2; ++ks2) { pw[kt][ks2].x = cvt_pk_bf16(s[kt][8 * ks2 + 0], s[kt][8 * ks2 + 1]); pw[kt][ks2].y = cvt_pk_bf16(s[kt][8 * ks2 + 2], s[kt][8 * ks2 + 3]);
            pw[kt][ks2].z = cvt_pk_bf16(s[kt][8 * ks2 + 4], s[kt][8 * ks2 + 5]); pw[kt][ks2].w = cvt_pk_bf16(s[kt][8 * ks2 + 6], s[kt][8 * ks2 + 7]); }
#pragma unroll
    for (int kt = 3; kt < 5; ++kt) { const int kb = i0 - 128 + 32 * kt;
        if (kb >= 0) {
#pragma unroll
            for (int i4 = 0; i4 < 4; ++i4) vreg[kt][i4] = *(const u32x4*)(vrow0 + (klo + (unsigned)((32 * kt + 8 * i4) * d * 1024))); } }
    u32x4 mraw[2][4]; float l2b = 0.f, l2c = 0.f;
    if (PAT == 0) {
#pragma unroll
        for (int pp = 0; pp < 2; ++pp)
#pragma unroll
            for (int i4 = 0; i4 < 4; ++i4) mraw[pp][i4] = *(const u32x4*)(qrow0 + (qlo + (unsigned)(8 * i4 * 3072 + (pp + 1) * 1024)));
        l2b = LSE[((size_t)(0 * 32 + b) * 8 + h) * SEQL + i0 + c32]; l2c = LSE[((size_t)(1 * 32 + b) * 8 + h) * SEQL + i0 + c32];
    }
    f32x16 o[2];
#pragma unroll
    for (int q = 0; q < 16; ++q) { o[0][q] = 0.f; o[1][q] = 0.f; }
    const int gi = lane >> 4, li = lane & 15;
    const LAS unsigned char* vrd = vl + (4 * hi + (li >> 2)) * VSTR + (16 * (gi & 1) + 4 * (li & 3)) * 2;
#pragma unroll
    for (int kt = 0; kt < 5; ++kt) { const int kb = i0 - 128 + 32 * kt;
        if (kb >= 0) {
#pragma unroll
            for (int i4 = 0; i4 < 4; ++i4) *(LAS u32x4*)(vl + (lrow + 8 * i4) * VSTR + lch * 16) = vreg[kt][i4];
            asm volatile("" ::: "memory");
#pragma unroll
            for (int ks2 = 0; ks2 < 2; ++ks2) {
                const bf16x8 pb = __builtin_bit_cast(bf16x8, pw[kt][ks2]);
#pragma unroll
                for (int mt = 0; mt < 2; ++mt) { const LAS unsigned char* a1 = vrd + (16 * ks2) * VSTR + 64 * mt;
                    const s16x4 lo = vtr(a1), up = vtr(a1 + 8 * VSTR);
                    bf16x8 av; av[0] = lo[0]; av[1] = lo[1]; av[2] = lo[2]; av[3] = lo[3]; av[4] = up[0]; av[5] = up[1]; av[6] = up[2]; av[7] = up[3];
                    o[mt] = __builtin_amdgcn_mfma_f32_32x32x16_bf16(av, pb, o[mt], 0, 0, 0); } }
            asm volatile("" ::: "memory");
        } }
    const float inv = __builtin_amdgcn_rcpf(den);
    const float l2 = mx + __builtin_amdgcn_logf(den);
    const LAS unsigned char* frd = vl + c32 * KSTR + 8 * hi;
    float w1 = inv;
    if (PAT == 0) {
        const float M = fmaxf(l2, fmaxf(l2b, l2c));
        float e1 = __builtin_amdgcn_exp2f(l2 - M), e2 = __builtin_amdgcn_exp2f(l2b - M), e3 = __builtin_amdgcn_exp2f(l2c - M);
        const float wi = __builtin_amdgcn_rcpf(e1 + e2 + e3); w1 = e1 * wi * inv; const float wo[2] = {e2 * wi, e3 * wi};
#pragma unroll
        for (int q = 0; q < 16; ++q) { o[0][q] *= w1; o[1][q] *= w1; }
#pragma unroll
        for (int pp = 0; pp < 2; ++pp) {
#pragma unroll
            for (int i4 = 0; i4 < 4; ++i4) *(LAS u32x4*)(vl + (lrow + 8 * i4) * KSTR + lch * 16) = mraw[pp][i4];
            asm volatile("" ::: "memory");
#pragma unroll
            for (int mt = 0; mt < 2; ++mt)
#pragma unroll
                for (int rg = 0; rg < 4; ++rg) { const u32x2 bb = *(const LAS u32x2*)(frd + 64 * mt + 16 * rg);
                    o[mt][4 * rg] += wo[pp] * bf_lo(bb.x); o[mt][4 * rg + 1] += wo[pp] * bf_hi(bb.x); o[mt][4 * rg + 2] += wo[pp] * bf_lo(bb.y); o[mt][4 * rg + 3] += wo[pp] * bf_hi(bb.y); }
            asm volatile("" ::: "memory");
        }
    } else {
#pragma unroll
        for (int q = 0; q < 16; ++q) { o[0][q] *= w1; o[1][q] *= w1; }
    }
#pragma unroll
    for (int mt = 0; mt < 2; ++mt)
#pragma unroll
        for (int rg = 0; rg < 4; ++rg) { u32x2 w; w.x = cvt_pk_bf16(o[mt][4 * rg], o[mt][4 * rg + 1]); w.y = cvt_pk_bf16(o[mt][4 * rg + 2], o[mt][4 * rg + 3]);
            *(LAS u32x2*)(vl + c32 * KSTR + 8 * hi + 64 * mt + 16 * rg) = w; }
    asm volatile("" ::: "memory");
    if (PAT != 0) {
#pragma unroll
        for (int i4 = 0; i4 < 4; ++i4) *(u32x4*)((unsigned char*)qrow0 + (qlo + (unsigned)(8 * i4 * d * 3072))) = *(const LAS u32x4*)(vl + (lrow + 8 * i4) * KSTR + lch * 16);
        if (hi == 0) LSE[((size_t)((PAT - 1) * 32 + b) * 8 + h) * SEQL + (size_t)(i0 + c32) * d + r] = l2;
    } else {
        bf16_t* OC = (bf16_t*)(P.ws + OFF_OC);
#pragma unroll
        for (int i4 = 0; i4 < 4; ++i4) *(u32x4*)(OC + (tokbase + (size_t)(i0 + lrow + 8 * i4)) * 512 + h * 64 + lch * 8) = *(const LAS u32x4*)(vl + (lrow + 8 * i4) * KSTR + lch * 16);
    }
    asm volatile("" ::: "memory");
}

__device__ __forceinline__ void conv_item(const Params& P, int l, int it, int lane, const LAS unsigned char* wlds) {
    const int b = it >> 8, t0 = (it & 255) * 8, ch0 = 8 * lane;
    const bf16_t* in = (const bf16_t*)(P.ws + OFF_CG) + (size_t)b * SEQL * 512 + ch0;
    const LAS unsigned char* cw = wlds + 16 * lane;
    float acc[8][8], win[8][8];
    { const f32x4 b0 = *(const f32x4*)(P.in[I_CONVB] + l * 512 + ch0), b1 = *(const f32x4*)(P.in[I_CONVB] + l * 512 + ch0 + 4);
#pragma unroll
      for (int i = 0; i < 8; ++i) { acc[i][0] = b0[0]; acc[i][1] = b0[1]; acc[i][2] = b0[2]; acc[i][3] = b0[3]; acc[i][4] = b1[0]; acc[i][5] = b1[1]; acc[i][6] = b1[2]; acc[i][7] = b1[3]; } }
#define CONV_LOADROW(rr, dst) do { const int t_ = t0 - 30 + (rr); if (t_ >= 0) { const u32x4 v_ = *(const u32x4*)(in + (size_t)t_ * 512); \
        dst[0] = bf_lo(v_.x); dst[1] = bf_hi(v_.x); dst[2] = bf_lo(v_.y); dst[3] = bf_hi(v_.y); dst[4] = bf_lo(v_.z); dst[5] = bf_hi(v_.z); dst[6] = bf_lo(v_.w); dst[7] = bf_hi(v_.w); } \
        else { _Pragma("unroll") for (int c_ = 0; c_ < 8; ++c_) dst[c_] = 0.f; } } while (0)
#pragma unroll
    for (int rr = 0; rr < 8; ++rr) CONV_LOADROW(rr, win[rr]);
    for (int jb = 0; jb < 32; jb += 8) {
        asm volatile("" ::: "memory");
#pragma unroll
        for (int jj = 0; jj < 8; ++jj) { const int j = jb + jj;
            if (j < 31) { const u32x4 wv = *(const LAS u32x4*)(cw + j * 1024);
                float w[8]; w[0] = bf_lo(wv.x); w[1] = bf_hi(wv.x); w[2] = bf_lo(wv.y); w[3] = bf_hi(wv.y); w[4] = bf_lo(wv.z); w[5] = bf_hi(wv.z); w[6] = bf_lo(wv.w); w[7] = bf_hi(wv.w);
#pragma unroll
                for (int i = 0; i < 8; ++i)
#pragma unroll
                    for (int c = 0; c < 8; ++c) acc[i][c] = fmaf(w[c], win[(jj + i) & 7][c], acc[i][c]);
                if (j + 8 < 38) CONV_LOADROW(j + 8, win[jj]); } }
    }
#undef CONV_LOADROW
    const f32x4 g0 = *(const f32x4*)(P.in[I_LNG] + l * 512 + ch0), g1 = *(const f32x4*)(P.in[I_LNG] + l * 512 + ch0 + 4);
    const f32x4 e0 = *(const f32x4*)(P.in[I_LNB] + l * 512 + ch0), e1 = *(const f32x4*)(P.in[I_LNB] + l * 512 + ch0 + 4);
    bf16_t* outp = (bf16_t*)(P.ws + OFF_HC) + ((size_t)b * SEQL + t0) * 512 + ch0;
#pragma unroll
    for (int i = 0; i < 8; ++i) { float s1 = 0.f, s2 = 0.f;
#pragma unroll
        for (int c = 0; c < 8; ++c) { s1 += acc[i][c]; s2 += acc[i][c] * acc[i][c]; }
        s1 = wave_sum(s1); s2 = wave_sum(s2);
        const float mean = s1 * (1.f / 512.f), var = fmaxf(s2 * (1.f / 512.f) - mean * mean, 0.f), rs = rsqrtf(var + EPSN);
        f32x4 y0, y1;
#pragma unroll
        for (int c = 0; c < 4; ++c) { const float h0 = (acc[i][c] - mean) * rs * g0[c] + e0[c], h1 = (acc[i][4 + c] - mean) * rs * g1[c] + e1[c]; y0[c] = h0 * sigm(h0); y1[c] = h1 * sigm(h1); }
        *(u32x4*)(outp + (size_t)i * 512) = pack8(y0, y1); }
}

__device__ __forceinline__ int xcc_id() { return (int)(__builtin_amdgcn_s_getreg((3 << 11) | 20) & 7u); }
__device__ __forceinline__ int claim_issue(unsigned* ctr, int& lane) { asm volatile("" : "+v"(lane)); int v = 0; if (lane == 0) v = (int)atomicAdd(ctr, 1u); return v; }
__device__ __forceinline__ int lane_now() { int l = (int)__builtin_amdgcn_mbcnt_hi(~0u, __builtin_amdgcn_mbcnt_lo(~0u, 0u)); asm volatile("" : "+v"(l)); return l; }
__device__ __forceinline__ int lds_claim(LAS unsigned* ctr, int lane) { int v = 0; if (lane == 0) v = (int)__hip_atomic_fetch_add(ctr, 1u, __ATOMIC_RELAXED, __HIP_MEMORY_SCOPE_WORKGROUP); return __builtin_amdgcn_readfirstlane(v); }
__device__ __forceinline__ int claim(unsigned* ctr, int& lane) { asm volatile("" : "+v"(lane)); int v = 0; if (lane == 0) v = (int)atomicAdd(ctr, 1u); return __builtin_amdgcn_readfirstlane(v); }


__device__ __forceinline__ void grid_barrier(unsigned* bar, unsigned target, int tid) {
    asm volatile("s_waitcnt vmcnt(0) lgkmcnt(0)" ::: "memory");
    __syncthreads();
    if (tid == 0) {
        __builtin_amdgcn_fence(__ATOMIC_RELEASE, "agent");
        asm volatile("s_waitcnt vmcnt(0) lgkmcnt(0)" ::: "memory");
        __hip_atomic_fetch_add(bar, 1u, __ATOMIC_RELAXED, __HIP_MEMORY_SCOPE_AGENT);
        while (__hip_atomic_load(bar, __ATOMIC_RELAXED, __HIP_MEMORY_SCOPE_AGENT) < target) __builtin_amdgcn_s_sleep(2);
        __builtin_amdgcn_fence(__ATOMIC_ACQUIRE, "agent");
        asm volatile("s_waitcnt vmcnt(0) lgkmcnt(0)" ::: "memory");
    }
    __syncthreads();
}


#define XB_TMO      128
#define XB_XCNT(j)  (256  + 64 * (j))
#define XB_XSUB(j)  (1280 + 64 * (j))
#define XB_XGEN(j)  (2304 + 64 * (j))
#define XB_TOP      3328
#define XB_TOPGEN   3392
#define XB_SPIN_CAP (1u << 22)
__device__ __forceinline__ unsigned xb_ld(unsigned* p)              { return __hip_atomic_load(p, __ATOMIC_RELAXED, __HIP_MEMORY_SCOPE_AGENT); }
__device__ __forceinline__ unsigned xb_add(unsigned* p, unsigned v) { return __hip_atomic_fetch_add(p, v, __ATOMIC_RELAXED, __HIP_MEMORY_SCOPE_AGENT); }
#define XB_SPIN(cond, bar) do { unsigned _sp = 0; while (cond) { __builtin_amdgcn_s_sleep(1); \
    if ((++_sp & 255u) == 0u) { if (xb_ld(&(bar)[XB_TMO])) break; if (_sp > XB_SPIN_CAP) { atomicAdd(&(bar)[XB_TMO], 1u); break; } } } } while (0)
__device__ __forceinline__ void xcd_barrier_complete(unsigned* bar, unsigned x, unsigned& nloc, unsigned& nx) {
    const unsigned G = gridDim.x;
    unsigned sum, cnt, mine, sp = 0u;
    for (;;) {
        sum = 0u; cnt = 0u; mine = 0u;
#pragma unroll
        for (unsigned j = 0; j < 16; ++j) { const unsigned c = xb_ld(&bar[XB_XCNT(j)]); sum += c; cnt += (c > 0u) ? 1u : 0u; mine = (j == x) ? c : mine; }
        if (sum == G) break;
        __builtin_amdgcn_s_sleep(1);
        if ((++sp & 255u) == 0u) { if (xb_ld(&bar[XB_TMO])) break; if (sp > XB_SPIN_CAP) { atomicAdd(&bar[XB_TMO], 1u); break; } }
    }
    nloc = mine > 0u ? mine : 1u; nx = cnt > 0u ? cnt : 1u;
}
__device__ __forceinline__ void xcd_barrier(unsigned* bar, LAS unsigned char* lds, int tid) {
    const unsigned x = (unsigned)__builtin_amdgcn_s_getreg((3 << 11) | 20) & 0xFu; volatile LAS unsigned* st = (volatile LAS unsigned*)(lds + CTR_OFF + 64);
    asm volatile("s_waitcnt vmcnt(0) lgkmcnt(0)" ::: "memory");
    __syncthreads();
    if (tid == 0) {
        unsigned nloc = st[0], nx = st[1];
        if (nloc == 0u) { xcd_barrier_complete(bar, x, nloc, nx); st[0] = nloc; st[1] = nx; }
        const unsigned old = xb_add(&bar[XB_XSUB(x)], 1u);
        const unsigned gen = old / nloc;
        if (old + 1u == (gen + 1u) * nloc) {
            __builtin_amdgcn_fence(__ATOMIC_RELEASE, "agent");
            asm volatile("s_waitcnt vmcnt(0)" ::: "memory");
            const unsigned og = xb_add(&bar[XB_TOP], 1u);
            const unsigned tg = og / nx;
            if (og + 1u == (tg + 1u) * nx) xb_add(&bar[XB_TOPGEN], 1u);
            else XB_SPIN(xb_ld(&bar[XB_TOPGEN]) == tg, bar);
            __builtin_amdgcn_fence(__ATOMIC_ACQUIRE, "agent");
            xb_add(&bar[XB_XGEN(x)], 1u);
            asm volatile("s_waitcnt vmcnt(0)" ::: "memory");
        } else {
            XB_SPIN(xb_ld(&bar[XB_XGEN(x)]) == gen, bar);
            __builtin_amdgcn_fence(__ATOMIC_ACQUIRE, "agent");
            asm volatile("s_waitcnt vmcnt(0)" ::: "memory");
        }
    }
    __syncthreads();
}

constexpr int NPHASE = 21;
__global__ void __launch_bounds__(512, 2) fwd_kernel(Params P) {
    extern __shared__ __attribute__((aligned(16))) unsigned char shm[];
    LAS unsigned char* lds = (LAS unsigned char*)shm;
        unsigned char* ws = P.ws; unsigned char* dout = (unsigned char*)P.out;
    bf16_t* xb = (bf16_t*)(ws + OFF_XB); bf16_t* Gt = (bf16_t*)(ws + OFF_G); bf16_t* Mg = (bf16_t*)(dout + DO_MG);
    bf16_t* xn = (bf16_t*)(ws + OFF_HC); bf16_t* Dl = (bf16_t*)(ws + OFF_QO);
    unsigned* ctl = (unsigned*)(ws + OFF_CTL);
    StaticOrder S;
    unsigned nbar = 0;
    const int wave_s = __builtin_amdgcn_readfirstlane((int)threadIdx.x >> 6);
    if (P.ph_hi - P.ph_lo > 1) cg::this_grid().sync();
    { volatile LAS unsigned* xst = (volatile LAS unsigned*)(lds + CTR_OFF + 64);
      const unsigned xcc = (unsigned)__builtin_amdgcn_s_getreg((3 << 11) | 20) & 0xFu;
      if (threadIdx.x == 0) { xst[0] = 0u; xst[1] = 0u; (void)xb_add(&ctl[XB_XCNT(xcc)], 1u); }
      __syncthreads(); }
    for (int ph = P.ph_lo; ph < P.ph_hi; ++ph) {
        const int wave = wave_s;
#define PHASE_IDS const int lane = lane_now(); const int tid = (wave_s << 6) | lane; (void)tid; (void)lane;
        if (ph == 0) { PHASE_IDS for (int rp = 0; rp < NREP_P0; ++rp) phase_p0(P, lds, wave, lane, tid); }
        else if (ph == NPHASE - 1) { PHASE_IDS phase_rows<true>(P, wave, lane, false); }
        else {
            const int l = (ph - 1) / 10, s = (ph - 1) % 10;
            if (s == 0) { PHASE_IDS
                S.init(NTOK, 7168, gridDim.x, blockIdx.x);
                Gemm g{xb, (const bf16_t*)(ws + OFF_WIN) + (size_t)l * 7168 * 1024, NTOK, 7168, 1024};
                EpiIn E{(bf16_t*)(dout + DO_U), (bf16_t*)(ws + OFF_QO), (bf16_t*)(dout + DO_K), (bf16_t*)(dout + DO_V), (bf16_t*)(ws + OFF_CG), Gt, (const float*)(ws + OFF_RSQ1), P.in[I_BGATE] + l * 3072};
                gemm_phase<EpiIn, StaticOrder, false>(lds, g, S, E, nullptr, tid);
            } else if (s == 1) { PHASE_IDS
                LAS unsigned* lctr = (LAS unsigned*)(lds + CTR_OFF);
                if (tid == 0) lctr[0] = 0u;
                __syncthreads();
                const int grp = blockIdx.x & 7, rank = blockIdx.x >> 3; constexpr int per = 128;
                if (wave < 4) { for (int it = blockIdx.x * 4 + wave; it < 1024; it += gridDim.x * 4) s5_item(P, l, it, lds + wave * S5_WL, lane_now()); }
                LAS unsigned char* vl = lds + ATT_OFF + wave * ATT_WL;
                for (;;) { const int ln = lane_now(); const int k = lds_claim(lctr, ln); const int li = rank * per + k; if (k >= per || li >= 4096) break;
                    const int b = grp + 8 * (li >> 10), rest = li & 1023;
                    if (rest < 512) attn_item<1>(P, b * 512 + rest, vl, ln); else attn_item<2>(P, b * 512 + rest - 512, vl, ln); }
            } else if (s == 2) { PHASE_IDS
                LAS unsigned* lctr = (LAS unsigned*)(lds + CTR_OFF);
                if (tid == 0) lctr[0] = 0u;
                { const unsigned* cwg = (const unsigned*)(ws + OFF_CONVW) + (size_t)l * 31 * 256;
                  for (int i = tid; i < 31 * 64; i += 512) *(LAS u32x4*)(lds + i * 16) = *(const u32x4*)(cwg + i * 4); }
                __syncthreads();
                const int grp = blockIdx.x & 7, rank = blockIdx.x >> 3; constexpr int per = 96;
                LAS unsigned char* vl = lds + ATT_OFF + wave * ATT_WL;
                for (;;) { const int ln = lane_now(); const int k = lds_claim(lctr, ln); const int li = rank * per + k; if (k >= per || li >= 3072) break;
                    const int b = grp + 8 * (li / 768), rest = li % 768;
                    if (rest < 512) attn_item<0>(P, b * 512 + rest, vl, ln); else conv_item(P, l, b * 256 + rest - 512, ln, lds); }
            } else if (s == 3) { PHASE_IDS
                S.init(NTOK, 2048, gridDim.x, blockIdx.x);
                Gemm g{(const bf16_t*)(dout + DO_Y), (const bf16_t*)(ws + OFF_WGLU) + (size_t)l * 2048 * 512, NTOK, 2048, 512};
                EpiGluMerge E{Mg, Gt};
                gemm_phase<EpiGluMerge, StaticOrder, false>(lds, g, S, E, nullptr, tid);
            } else if (s == 4) { PHASE_IDS
                S.init(NTOK, 1024, gridDim.x, blockIdx.x);
                for (int c = 0; c < 2; ++c) {
                    Gemm g{(const bf16_t*)(ws + (c == 0 ? OFF_HC : OFF_OC)), (const bf16_t*)(ws + (c == 0 ? OFF_WPW2 : OFF_WATT)) + (size_t)l * 1024 * 512, NTOK, 1024, 512};
                    EpiAccMerge E{Mg, Gt, c == 0 ? 2048 : 1024};
                    gemm_phase<EpiAccMerge, StaticOrder, false>(lds, g, S, E, nullptr, tid);
                    __syncthreads();
                }
            } else if (s == 6 || s == 9) { PHASE_IDS
                phase_rows<false>(P, wave, lane, s == 6);
            } else if (s == 5 || s == 8) { PHASE_IDS
                S.init(NTOK, 1024, gridDim.x, blockIdx.x);
                Gemm g{s == 5 ? (const bf16_t*)Mg : (const bf16_t*)Gt, s == 5 ? (const bf16_t*)(ws + OFF_WOUT) + (size_t)l * 1024 * 1024 : (const bf16_t*)(ws + OFF_WF2) + (size_t)l * 1024 * 2816, NTOK, 1024, s == 5 ? 1024 : 2816};
                EpiDelta E{Dl};
                gemm_phase<EpiDelta, StaticOrder, false>(lds, g, S, E, nullptr, tid);
            } else {
                PHASE_IDS
                S.init(NTOK, 5632, gridDim.x, blockIdx.x);
                Gemm g{xn, (const bf16_t*)(ws + OFF_WF1) + (size_t)l * 5632 * 1024, NTOK, 5632, 1024};
                EpiFfn1 E{Gt};
                gemm_phase<EpiFfn1, StaticOrder, false>(lds, g, S, E, nullptr, tid);
            }
        }
        if (ph + 1 < P.ph_hi) xcd_barrier(ctl, lds, (wave_s << 6) | lane_now());
    }
}

extern "C" void kernel_launch(void* const* d_in, const int* in_sizes, int n_in, void* d_out, int out_size, void* d_ws, size_t ws_size, hipStream_t stream) {
    static int grid = 0;
    if (grid == 0) {
        if (n_in != 24 || out_size != NTOK * 1024 || ws_size < WS_END) { fprintf(stderr, "kernel_launch: unexpected problem (n_in %d out %d ws %zu need %zu)\n", n_in, out_size, ws_size, (size_t)WS_END); grid = -1; return; }
        int dev = 0, cus = 0, per_cu = 0;
        hipGetDevice(&dev); hipDeviceGetAttribute(&cus, hipDeviceAttributeMultiprocessorCount, dev);
        if (hipFuncSetAttribute((const void*)fwd_kernel, hipFuncAttributeMaxDynamicSharedMemorySize, LDS_BYTES) != hipSuccess) { fprintf(stderr, "kernel_launch: hipFuncSetAttribute failed\n"); grid = -1; return; }
        hipOccupancyMaxActiveBlocksPerMultiprocessor(&per_cu, (const void*)fwd_kernel, 512, LDS_BYTES);
        if (per_cu < 1) { fprintf(stderr, "kernel_launch: occupancy query says %d blocks/CU\n", per_cu); per_cu = 1; }
        (void)hipGetLastError();
        grid = cus * per_cu; if (grid > 256) grid = 256;
        if (grid != 256) { fprintf(stderr, "kernel_launch: this build partitions its work over exactly 256 workgroups (got %d)\n", grid); grid = -1; return; }
    }
    if (grid < 0) return;
    hipMemsetAsync((unsigned char*)d_ws + OFF_CTL, 0, 16384, stream);
    Params p{};
    for (int i = 0; i < 24; ++i) p.in[i] = (const float*)d_in[i];
    p.out = (float*)d_out; p.ws = (unsigned char*)d_ws;
#if MK_PER_PHASE
    for (int ph = 0; ph < NPHASE; ++ph) { p.ph_lo = ph; p.ph_hi = ph + 1; hipLaunchKernelGGL(fwd_kernel, dim3(grid), dim3(512), LDS_BYTES, stream, p); }
#else
    p.ph_lo = 0; p.ph_hi = NPHASE;
    void* args[] = {&p};
    hipError_t e = hipLaunchCooperativeKernel((const void*)fwd_kernel, dim3(grid), dim3(512), args, LDS_BYTES, stream);
    if (e != hipSuccess) fprintf(stderr, "cooperative launch failed: %s (grid %d)\n", hipGetErrorString(e), grid);
#endif
}
```

```cpp
#include <hip/hip_runtime.h>
#include <hip/hip_cooperative_groups.h>
#include <cstdio>
namespace cg = cooperative_groups;
namespace pg8 {
#define PG8_LAS __attribute__((address_space(3)))
typedef unsigned short bf16_t;
typedef short bf16x8 __attribute__((ext_vector_type(8)));
typedef float f32x4 __attribute__((ext_vector_type(4)));
typedef unsigned u32x4 __attribute__((ext_vector_type(4)));
constexpr int BM = 256, BK = 64, HALF = 128, HTB = HALF * BK * 2  , STAGE_BYTES = 8 * HTB, NXCD = 8, WGM = 8;

__host__ __device__ __forceinline__ int lds_byte(int r, int c) { const int st = (r >> 4) * 2 + (c >> 5), rr = r & 15, cc = c & 31, ob = rr * 64 + cc * 2; return st * 1024 + (ob ^ (((ob >> 9) & 1) << 5)); }
__host__ __device__ __forceinline__ void stage_rc(int b, int& R, int& C) { const int st = b / 1024, sb = b % 1024, swz = sb ^ (((sb >> 9) & 1) << 5); R = (st >> 1) * 16 + swz / 64; C = (st & 1) * 32 + (swz % 64) / 2; }
__host__ __device__ __forceinline__ int perm32(int rho) { const int n = rho >> 4, i = rho & 15; return 8 * (i >> 2) + 4 * n + (i & 3); }

struct Unit { int pm, pn; };
struct Gemm { const bf16_t* A; const bf16_t* Bt; int M, N, K; };

struct StaticOrder {
    int nM, nN, nwg, G, c;
    __host__ __device__ void init(int M, int N, int G_, int c_) { nM = M / BM; nN = N / BM; nwg = nM * nN; G = G_; c = c_; }
    __host__ __device__ bool next(int i, Unit& u) const {
        const long L = (long)i * G + c; if (L >= nwg) return false;
        int wgid = (int)L; { const int q = nwg / NXCD, r = nwg % NXCD, xcd = wgid % NXCD, off = wgid / NXCD; wgid = (xcd < r ? xcd * (q + 1) : r * (q + 1) + (xcd - r) * q) + off; }
        const int nig = WGM * nN, gid = wgid / nig, fm = gid * WGM, gsz = (nM - fm) < WGM ? (nM - fm) : WGM;
        u.pm = fm + ((wgid % nig) % gsz); u.pn = (wgid % nig) / gsz; return true;
    }
    __device__ __forceinline__ void a_ready(const Unit&) const {}
    __device__ __forceinline__ void done(const Unit&) const {}
};
__device__ __forceinline__ unsigned cvt_pk_bf16(float lo, float hi) { unsigned r; asm volatile("s_nop 1\n\tv_cvt_pk_bf16_f32 %0, %1, %2" : "=v"(r) : "v"(lo), "v"(hi)); return r; }
template <class Epi, class Sched, bool STAMP = false>
__device__ __forceinline__ void gemm_phase(PG8_LAS unsigned char* lds, const Gemm g, const Sched& S, const Epi& E, unsigned long long* stamps, int tid_in) {
    int tid_o = tid_in; asm volatile("" : "+v"(tid_o)); const int tid = tid_o, wid = __builtin_amdgcn_readfirstlane(tid >> 6), lane = tid & 63, wr = wid >> 2, wc = wid & 3, fr = lane & 15, fq = lane >> 4;
    const int K = g.K, nt = K / BK;
    int ts_lo = 0, ts_hi = 0, nts = 0; const unsigned long long rt_entry = STAMP ? (unsigned long long)wall_clock64() : 0ull;
#define PG8_STAMP() do { if (STAMP && wid == 0 && nts < 64) { const unsigned long long _c = (unsigned long long)clock64(); \
        ts_lo = (lane == nts) ? (int)(unsigned)_c : ts_lo; ts_hi = (lane == nts) ? (int)(unsigned)(_c >> 32) : ts_hi; ++nts; } } while (0)
    PG8_STAMP();
    unsigned voffA[2], voffB[2];
#pragma unroll
    for (int i = 0; i < 2; ++i) { int R, C; stage_rc(tid * 16 + i * 8192, R, C); const int Rb = Epi::PERM ? ((R & ~31) + perm32(R & 31)) : R;
        voffA[i] = (unsigned)(R * K + C) * 2u; voffB[i] = (unsigned)(Rb * K + C) * 2u; }
    const size_t kstep = (size_t)(BK * 2);
    const size_t hstep = (size_t)HALF * K * 2;
    const size_t tstep = 2 * hstep;
    const unsigned ldsw = (unsigned)wid * 1024u;
    const int aoff = lds_byte(wr * 64 + fr, fq * 8), boff = lds_byte(wc * 32 + fr, fq * 8);
#define PG8_SA(b, h) (((b) * 2 + (h)) * HTB)
#define PG8_SB(b, h) ((4 + (b) * 2 + (h)) * HTB)
#define PG8_STAGE(bufoff, gbase, voff) do { _Pragma("unroll") for (int _i = 0; _i < 2; ++_i) \
        __builtin_amdgcn_global_load_lds((const unsigned*)((const char*)(gbase) + (voff)[_i]), (PG8_LAS unsigned*)(lds + (bufoff) + ldsw + _i * 8192), 16, 0, 0); } while (0)
#define PG8_LDA(dst, b, h) do { _Pragma("unroll") for (int m = 0; m < 4; ++m) _Pragma("unroll") for (int k = 0; k < 2; ++k) dst[m][k] = *(const PG8_LAS bf16x8*)(lds + PG8_SA(b, h) + aoff + m * 2048 + k * 1024); } while (0)
#define PG8_LDB(dst, b, h) do { _Pragma("unroll") for (int n = 0; n < 2; ++n) _Pragma("unroll") for (int k = 0; k < 2; ++k) dst[n][k] = *(const PG8_LAS bf16x8*)(lds + PG8_SB(b, h) + boff + n * 2048 + k * 1024); } while (0)
#define PG8_MMA(ai, bj, At, Bt) do { __builtin_amdgcn_s_setprio(1); _Pragma("unroll") for (int m = 0; m < 4; ++m) _Pragma("unroll") for (int n = 0; n < 2; ++n) _Pragma("unroll") for (int k = 0; k < 2; ++k) \
        acc[ai][bj][m][n] = __builtin_amdgcn_mfma_f32_16x16x32_bf16(Bt[n][k], At[m][k], acc[ai][bj][m][n], 0, 0, 0); __builtin_amdgcn_s_setprio(0); } while (0)
#define PG8_WAIT_V(n) asm volatile("s_waitcnt vmcnt(" #n ")" ::: "memory")
#define PG8_WAIT_L(n) asm volatile("s_waitcnt lgkmcnt(" #n ")" ::: "memory")
#define PG8_BAR __builtin_amdgcn_s_barrier()
#define PG8_SCHED __builtin_amdgcn_sched_barrier(0)
    Unit cur, nxt; int ui = 0;
    if (!S.next(0, cur)) return;
    f32x4 acc[2][2][4][2];
#pragma unroll
    for (int a = 0; a < 2; ++a)
#pragma unroll
        for (int b = 0; b < 2; ++b)
#pragma unroll
            for (int m = 0; m < 4; ++m)
#pragma unroll
                for (int n = 0; n < 2; ++n) acc[a][b][m][n] = (f32x4){0.f, 0.f, 0.f, 0.f};
    bf16x8 At[4][2], B0[2][2], B1[2][2];
    const char* cA = (const char*)g.A + (size_t)cur.pm * tstep; const char* cB = (const char*)g.Bt + (size_t)cur.pn * tstep;
    S.a_ready(cur);
    PG8_STAGE(PG8_SB(0, 0), cB, voffB); PG8_STAGE(PG8_SA(0, 0), cA, voffA); PG8_STAGE(PG8_SB(0, 1), cB + hstep, voffB); PG8_STAGE(PG8_SA(0, 1), cA + hstep, voffA);
    if (wr == 1) PG8_BAR;
    PG8_WAIT_V(4); PG8_BAR;
    PG8_STAGE(PG8_SB(1, 0), cB + kstep, voffB); PG8_STAGE(PG8_SA(1, 0), cA + kstep, voffA); PG8_STAGE(PG8_SB(1, 1), cB + hstep + kstep, voffB);
    PG8_WAIT_V(6); PG8_BAR;
    PG8_STAMP();
    for (;;) {
        const bool has_next = S.next(ui + 1, nxt);
        const char* nA = has_next ? (const char*)g.A + (size_t)nxt.pm * tstep : cA; const char* nB = has_next ? (const char*)g.Bt + (size_t)nxt.pn * tstep : cB;
        for (int t = 0; t < nt; t += 2) {
            const bool last = (t == nt - 2);
            const char* a1 = cA + (size_t)(t + 1) * kstep;
            const char* a2 = last ? nA : cA + (size_t)(t + 2) * kstep; const char* b2 = last ? nB : cB + (size_t)(t + 2) * kstep;
            const char* a3 = a2 + kstep; const char* b3 = b2 + kstep;
            if (last && has_next) S.a_ready(nxt);
            PG8_LDB(B0, 0, 0); PG8_SCHED; PG8_LDA(At, 0, 0); PG8_STAGE(PG8_SA(1, 1), a1 + hstep, voffA);
            PG8_WAIT_L(8); PG8_BAR; PG8_WAIT_L(0); PG8_MMA(0, 0, At, B0); PG8_BAR; PG8_SCHED;
            PG8_LDB(B1, 0, 1); PG8_STAGE(PG8_SB(0, 0), b2, voffB);
            PG8_BAR; PG8_WAIT_L(0); PG8_MMA(0, 1, At, B1); PG8_BAR;
            PG8_LDA(At, 0, 1); PG8_STAGE(PG8_SA(0, 0), a2, voffA);
            PG8_BAR; PG8_WAIT_L(0); PG8_MMA(1, 0, At, B0); PG8_BAR; PG8_SCHED;
            PG8_STAGE(PG8_SB(0, 1), b2 + hstep, voffB);
            PG8_WAIT_V(6); PG8_BAR; PG8_MMA(1, 1, At, B1); PG8_BAR;
            PG8_LDB(B0, 1, 0); PG8_SCHED; PG8_LDA(At, 1, 0); PG8_STAGE(PG8_SA(0, 1), a2 + hstep, voffA);
            PG8_WAIT_L(8); PG8_BAR; PG8_WAIT_L(0); PG8_MMA(0, 0, At, B0); PG8_BAR; PG8_SCHED;
            PG8_LDB(B1, 1, 1); PG8_STAGE(PG8_SB(1, 0), b3, voffB);
            PG8_BAR; PG8_WAIT_L(0); PG8_MMA(0, 1, At, B1); PG8_BAR;
            PG8_LDA(At, 1, 1); PG8_STAGE(PG8_SA(1, 0), a3, voffA);
            PG8_BAR; PG8_WAIT_L(0); PG8_MMA(1, 0, At, B0); PG8_BAR; PG8_SCHED;
            PG8_STAGE(PG8_SB(1, 1), b3 + hstep, voffB);
            PG8_WAIT_V(6); PG8_BAR; PG8_MMA(1, 1, At, B1); PG8_BAR;
        }
        PG8_STAMP();
        if constexpr (!Epi::AFTER_DRAIN) { E(acc, cur, wr, wc, fr, fq); S.done(cur); }
        PG8_STAMP();
        if (!has_next) break;
#pragma unroll
        for (int a = 0; a < 2; ++a)
#pragma unroll
            for (int b = 0; b < 2; ++b)
#pragma unroll
                for (int m = 0; m < 4; ++m)
#pragma unroll
                    for (int n = 0; n < 2; ++n) acc[a][b][m][n] = (f32x4){0.f, 0.f, 0.f, 0.f};
        cur = nxt; cA = nA; cB = nB; ++ui;
    }
    PG8_WAIT_V(0);
    if (wr == 0) PG8_BAR;
    PG8_BAR;
    if constexpr (Epi::AFTER_DRAIN) { E.fused(acc, cur, wr, wc, fr, fq, lds, wid, lane); S.done(cur); }
    PG8_STAMP();
    if (STAMP && wid == 0) { stamps[lane] = lane < nts ? (((unsigned long long)(unsigned)ts_hi << 32) | (unsigned)ts_lo) : 0ull;
        if (lane == 62) stamps[62] = rt_entry; if (lane == 63) stamps[63] = (unsigned long long)wall_clock64(); }
#undef PG8_STAMP
#undef PG8_SA
#undef PG8_SB
#undef PG8_STAGE
#undef PG8_LDA
#undef PG8_LDB
#undef PG8_MMA
#undef PG8_WAIT_V
#undef PG8_WAIT_L
#undef PG8_BAR
#undef PG8_SCHED
}
}

using namespace pg8;
#define LAS __attribute__((address_space(3)))
typedef short s16x4 __attribute__((ext_vector_type(4)));
typedef short v4i16_t __attribute__((ext_vector_type(4)));
typedef float f32x16 __attribute__((ext_vector_type(16)));
typedef unsigned u32x2 __attribute__((ext_vector_type(2)));
typedef float f32x2v __attribute__((ext_vector_type(2)));

#ifndef NREP_S5
#define NREP_S5 1
#endif
#ifndef NREP_B2
#define NREP_B2 1
#endif
#ifndef NREP_P0
#define NREP_P0 1
#endif
#ifndef MK_PER_PHASE
#define MK_PER_PHASE 0
#endif

constexpr int NTOK = 65536, SEQL = 2048;
constexpr float EPSN = 1e-6f;
constexpr int LDS_BYTES = 155648;
constexpr int S5_WL = 25088;
constexpr int ATT_OFF = 4 * S5_WL;
constexpr int VSTR = 192;
constexpr int ATT_WL = 32 * VSTR;
constexpr int CTR_OFF = LDS_BYTES - 256;
static_assert(ATT_OFF + 8 * ATT_WL <= CTR_OFF, "lds");

constexpr size_t OFF_WIN = 0;
constexpr size_t OFF_WGLU = OFF_WIN + 2ull * 7168 * 1024 * 2;
constexpr size_t OFF_WATT = OFF_WGLU + 2ull * 2048 * 512 * 2;
constexpr size_t OFF_WPW2 = OFF_WATT + 2ull * 1024 * 512 * 2;
constexpr size_t OFF_WOUT = OFF_WPW2 + 2ull * 1024 * 512 * 2;
constexpr size_t OFF_WF1 = OFF_WOUT + 2ull * 1024 * 1024 * 2;
constexpr size_t OFF_WF2 = OFF_WF1 + 2ull * 5632 * 1024 * 2;
constexpr size_t OFF_S5BB = OFF_WF2 + 2ull * 1024 * 2816 * 2;
constexpr size_t OFF_S5CM = OFF_S5BB + 2ull * 32 * 128 * 16 * 2;
constexpr size_t OFF_S5A = OFF_S5CM + 2ull * 32 * 16 * 128 * 2;
constexpr size_t OFF_CONVW = OFF_S5A + 2ull * 32 * 64 * 8;
constexpr size_t OFF_CTL = OFF_CONVW + 65536;
constexpr size_t OFF_RSQ1 = OFF_CTL + 16384;
constexpr size_t OFF_RSQ2 = OFF_RSQ1 + 65536ull * 8;
constexpr size_t OFF_LSE = OFF_RSQ2 + 65536ull * 8;
constexpr size_t OFF_XB = OFF_LSE + 2ull * 65536 * 8 * 4;
constexpr size_t OFF_G = OFF_XB + 65536ull * 1024 * 2;
constexpr size_t OFF_QO = OFF_G + 65536ull * 3072 * 2;
constexpr size_t OFF_CG = OFF_QO + 65536ull * 1536 * 2;
constexpr size_t OFF_HC = OFF_CG + 65536ull * 512 * 2;
constexpr size_t OFF_OC = OFF_HC + 65536ull * 512 * 2;
constexpr size_t WS_END = OFF_OC + 65536ull * 512 * 2;
constexpr size_t DO_U = 0, DO_K = 64ull << 20, DO_V = 128ull << 20, DO_Y = 192ull << 20, DO_MG = 64ull << 20;

struct Params {
    const float* in[24];
    float* out; unsigned char* ws;
    int ph_lo, ph_hi;
};
enum { I_X = 0, I_N1G, I_WIN, I_BGATE, I_LRE, I_LIM, I_LOGDT, I_BRE, I_BIM, I_CRE, I_CIM, I_SSMD, I_WGLU, I_WATT, I_CONVW, I_CONVB, I_LNG, I_LNB, I_WPW2, I_WOUT, I_N2G, I_WF1, I_WF2, I_FING };

__device__ __forceinline__ float bf_lo(unsigned u) { return __uint_as_float(u << 16); }
__device__ __forceinline__ float bf_hi(unsigned u) { return __uint_as_float(u & 0xffff0000u); }
__device__ __forceinline__ float sigm(float x) { return __builtin_amdgcn_rcpf(1.f + __expf(-x)); }
__device__ __forceinline__ unsigned short f2bf(float f) { unsigned u = __float_as_uint(f); u += 0x7FFFu + ((u >> 16) & 1u); return (unsigned short)(u >> 16); }
__device__ __forceinline__ float wave_sum(float v) {
#pragma unroll
    for (int o = 1; o < 64; o <<= 1) v += __shfl_xor(v, o);
    return v;
}
__device__ __forceinline__ s16x4 vtr(const LAS unsigned char* p) { return __builtin_bit_cast(s16x4, __builtin_amdgcn_ds_read_tr16_b64_v4i16((LAS v4i16_t*)p)); }

__device__ __forceinline__ u32x4 pack8(const f32x4 a, const f32x4 b) { u32x4 w; w.x = cvt_pk_bf16(a[0], a[1]); w.y = cvt_pk_bf16(a[2], a[3]); w.z = cvt_pk_bf16(b[0], b[1]); w.w = cvt_pk_bf16(b[2], b[3]); return w; }
__device__ __forceinline__ void unpack8(const u32x4 w, f32x4& a, f32x4& b) { a[0] = bf_lo(w.x); a[1] = bf_hi(w.x); a[2] = bf_lo(w.y); a[3] = bf_hi(w.y); b[0] = bf_lo(w.z); b[1] = bf_hi(w.z); b[2] = bf_lo(w.w); b[3] = bf_hi(w.w); }

struct EpiIn {
    static constexpr bool PERM = true, AFTER_DRAIN = false;
    bf16_t *U, *QO, *Kb, *Vb, *CG, *G; const float* bgate;
    __device__ __forceinline__ void operator()(const f32x4 (&acc)[2][2][4][2], const Unit& u, int wr, int wc, int fr, int fq) const {
        const int row0 = u.pm * 256 + wr * 64 + fr, cl = wc * 32 + 8 * fq, pn = u.pn;
        if (pn < 12) {
            bf16_t* base; int ld, col0;
            if (pn < 2) { base = U; ld = 512; col0 = pn * 256; }
            else if (pn < 8) { base = QO; ld = 1536; col0 = (pn - 2) * 256; }
            else if (pn < 10) { base = Kb; ld = 512; col0 = (pn - 8) * 256; }
            else { base = Vb; ld = 512; col0 = (pn - 10) * 256; }
#pragma unroll
            for (int ai = 0; ai < 2; ++ai)
#pragma unroll
                for (int m = 0; m < 4; ++m) { const int r = row0 + ai * 128 + m * 16;
#pragma unroll
                    for (int bj = 0; bj < 2; ++bj) *(u32x4*)(base + (size_t)r * ld + col0 + bj * 128 + cl) = pack8(acc[ai][bj][m][0], acc[ai][bj][m][1]); }
        } else if (pn < 16) {
            const int c0 = (pn - 12) * 128 + cl;
#pragma unroll
            for (int ai = 0; ai < 2; ++ai)
#pragma unroll
                for (int m = 0; m < 4; ++m) { const int r = row0 + ai * 128 + m * 16;
                    f32x4 o[2];
#pragma unroll
                    for (int n = 0; n < 2; ++n)
#pragma unroll
                        for (int j = 0; j < 4; ++j) o[n][j] = acc[ai][0][m][n][j] * sigm(acc[ai][1][m][n][j]);
                    *(u32x4*)(CG + (size_t)r * 512 + c0) = pack8(o[0], o[1]); }
        } else {
            const int c0 = (pn - 16) * 256 + cl;
            f32x4 bv[2][2];
#pragma unroll
            for (int bj = 0; bj < 2; ++bj)
#pragma unroll
                for (int n = 0; n < 2; ++n) bv[bj][n] = *(const f32x4*)(bgate + c0 + bj * 128 + 4 * n);
#pragma unroll
            for (int ai = 0; ai < 2; ++ai)
#pragma unroll
                for (int m = 0; m < 4; ++m) { const int r = row0 + ai * 128 + m * 16;
#pragma unroll
                    for (int bj = 0; bj < 2; ++bj) { f32x4 o[2];
#pragma unroll
                        for (int n = 0; n < 2; ++n)
#pragma unroll
                            for (int j = 0; j < 4; ++j) o[n][j] = sigm(acc[ai][bj][m][n][j] + bv[bj][n][j]);
                        *(u32x4*)(G + (size_t)r * 3072 + c0 + bj * 128) = pack8(o[0], o[1]); } }
        }
    }
};
struct EpiGluMerge {
    static constexpr bool PERM = true, AFTER_DRAIN = false;
    bf16_t* Mg; const bf16_t* G;
    __device__ __forceinline__ void operator()(const f32x4 (&acc)[2][2][4][2], const Unit& u, int wr, int wc, int fr, int fq) const {
        const int row0 = u.pm * 256 + wr * 64 + fr, c0 = u.pn * 128 + wc * 32 + 8 * fq;
#pragma unroll
        for (int ai = 0; ai < 2; ++ai)
#pragma unroll
            for (int m = 0; m < 4; ++m) { const int r = row0 + ai * 128 + m * 16;
                f32x4 g0, g1; unpack8(*(const u32x4*)(G + (size_t)r * 3072 + c0), g0, g1);
                f32x4 o[2];
#pragma unroll
                for (int j = 0; j < 4; ++j) { o[0][j] = g0[j] * acc[ai][0][m][0][j] * sigm(acc[ai][1][m][0][j]); o[1][j] = g1[j] * acc[ai][0][m][1][j] * sigm(acc[ai][1][m][1][j]); }
                *(u32x4*)(Mg + (size_t)r * 1024 + c0) = pack8(o[0], o[1]); }
    }
};
struct EpiAccMerge {
    static constexpr bool PERM = true, AFTER_DRAIN = false;
    bf16_t* Mg; const bf16_t* G; int gate_off;
    __device__ __forceinline__ void operator()(const f32x4 (&acc)[2][2][4][2], const Unit& u, int wr, int wc, int fr, int fq) const {
        const int row0 = u.pm * 256 + wr * 64 + fr, cb = u.pn * 256 + wc * 32 + 8 * fq;
#pragma unroll
        for (int ai = 0; ai < 2; ++ai)
#pragma unroll
            for (int m = 0; m < 4; ++m) { const int r = row0 + ai * 128 + m * 16;
#pragma unroll
                for (int bj = 0; bj < 2; ++bj) { const int c0 = cb + bj * 128;
                    f32x4 g0, g1, m0, m1; unpack8(*(const u32x4*)(G + (size_t)r * 3072 + gate_off + c0), g0, g1); unpack8(*(const u32x4*)(Mg + (size_t)r * 1024 + c0), m0, m1);
                    *(u32x4*)(Mg + (size_t)r * 1024 + c0) = pack8(m0 + g0 * acc[ai][bj][m][0], m1 + g1 * acc[ai][bj][m][1]); } }
    }
};
struct EpiDelta {
    static constexpr bool PERM = true, AFTER_DRAIN = false;
    bf16_t* D;
    __device__ __forceinline__ void operator()(const f32x4 (&acc)[2][2][4][2], const Unit& u, int wr, int wc, int fr, int fq) const {
        const int row0 = u.pm * 256 + wr * 64 + fr, cb = u.pn * 256 + wc * 32 + 8 * fq;
#pragma unroll
        for (int ai = 0; ai < 2; ++ai)
#pragma unroll
            for (int m = 0; m < 4; ++m)
#pragma unroll
                for (int bj = 0; bj < 2; ++bj) *(u32x4*)(D + (size_t)(row0 + ai * 128 + m * 16) * 1024 + cb + bj * 128) = pack8(acc[ai][bj][m][0], acc[ai][bj][m][1]);
    }
};
struct EpiFfn1 {
    static constexpr bool PERM = true, AFTER_DRAIN = false;
    bf16_t* Hf;
    __device__ __forceinline__ void operator()(const f32x4 (&acc)[2][2][4][2], const Unit& u, int wr, int wc, int fr, int fq) const {
        const int row0 = u.pm * 256 + wr * 64 + fr, c0 = u.pn * 128 + wc * 32 + 8 * fq;
#pragma unroll
        for (int ai = 0; ai < 2; ++ai)
#pragma unroll
            for (int m = 0; m < 4; ++m) { const int r = row0 + ai * 128 + m * 16;
                f32x4 o[2];
#pragma unroll
                for (int n = 0; n < 2; ++n)
#pragma unroll
                    for (int j = 0; j < 4; ++j) { const float a = acc[ai][0][m][n][j], b = acc[ai][1][m][n][j]; o[n][j] = a * sigm(a) * b; }
                *(u32x4*)(Hf + (size_t)r * 2816 + c0) = pack8(o[0], o[1]); }
    }
};

__device__ __forceinline__ void p0_tr_item(const float* W, int K, int N, bf16_t* WT, int kb, int nd0, int ns0, const float* gk, float scale, LAS float* scr, int lane) {
    const int k0 = 64 * kb;
#pragma unroll 8
    for (int i = 0; i < 32; ++i) { const int kk = 2 * i + (lane >> 5); float s = scale; if (gk) s *= gk[k0 + kk]; scr[kk * 33 + (lane & 31)] = W[(size_t)(k0 + kk) * N + ns0 + (lane & 31)] * s; }
    asm volatile("" ::: "memory");
    const int c = lane & 7;
#pragma unroll
    for (int j = 0; j < 4; ++j) { const int n = (lane >> 3) + 8 * j; const LAS float* s = scr + (8 * c) * 33 + n;
        u32x4 o; o.x = cvt_pk_bf16(s[0 * 33], s[1 * 33]); o.y = cvt_pk_bf16(s[2 * 33], s[3 * 33]); o.z = cvt_pk_bf16(s[4 * 33], s[5 * 33]); o.w = cvt_pk_bf16(s[6 * 33], s[7 * 33]);
        *(u32x4*)(WT + (size_t)(nd0 + n) * K + k0 + 8 * c) = o; }
    asm volatile("" ::: "memory");
}
__device__ __forceinline__ void phase_p0(const Params& P, LAS unsigned char* lds, int wave, int lane, int tid) {
    unsigned char* ws = P.ws;
    const int gw = blockIdx.x * 8 + wave, NGW = gridDim.x * 8;
    LAS float* scr = (LAS float*)(lds + wave * 16384);
    constexpr int PER_L = 3584 + 512 + 256 + 256 + 512 + 2816 + 1408;
    for (int it = gw; it < 2 * PER_L; it += NGW) {
        const int l = it / PER_L; int r = it % PER_L;
        const float* W; bf16_t* WT; int K, N, type = 0; const float* gk = nullptr;
        if (r < 3584) { W = P.in[I_WIN] + (size_t)l * 1024 * 7168; WT = (bf16_t*)(ws + OFF_WIN) + (size_t)l * 7168 * 1024; K = 1024; N = 7168; type = 1; gk = P.in[I_N1G] + l * 1024; }
        else if ((r -= 3584) < 512) { W = P.in[I_WGLU] + (size_t)l * 512 * 2048; WT = (bf16_t*)(ws + OFF_WGLU) + (size_t)l * 2048 * 512; K = 512; N = 2048; type = 3; }
        else if ((r -= 512) < 256) { W = P.in[I_WATT] + (size_t)l * 512 * 1024; WT = (bf16_t*)(ws + OFF_WATT) + (size_t)l * 1024 * 512; K = 512; N = 1024; }
        else if ((r -= 256) < 256) { W = P.in[I_WPW2] + (size_t)l * 512 * 1024; WT = (bf16_t*)(ws + OFF_WPW2) + (size_t)l * 1024 * 512; K = 512; N = 1024; }
        else if ((r -= 256) < 512) { W = P.in[I_WOUT] + (size_t)l * 1024 * 1024; WT = (bf16_t*)(ws + OFF_WOUT) + (size_t)l * 1024 * 1024; K = 1024; N = 1024; }
        else if ((r -= 512) < 2816) { W = P.in[I_WF1] + (size_t)l * 1024 * 5632; WT = (bf16_t*)(ws + OFF_WF1) + (size_t)l * 5632 * 1024; K = 1024; N = 5632; type = 2; gk = P.in[I_N2G] + l * 1024; }
        else { r -= 2816; W = P.in[I_WF2] + (size_t)l * 2816 * 1024; WT = (bf16_t*)(ws + OFF_WF2) + (size_t)l * 1024 * 2816; K = 2816; N = 1024; }
        const int nblk = N / 32, kb = r / nblk, nd0 = (r % nblk) * 32;
        int ns0 = nd0; float scale = 1.f;
        if (type == 1) { if (nd0 >= 3072 && nd0 < 4096) { const int t = nd0 - 3072, j = t & 255; ns0 = 3072 + (t >> 8) * 128 + (j & 127) + (j >= 128 ? 512 : 0); }
                         if (nd0 >= 512 && nd0 < 2048) scale = 0.125f * 1.4426950408889634f; }
        else if (type == 2) { const int j = nd0 & 255; ns0 = (nd0 >> 8) * 128 + (j & 127) + (j >= 128 ? 2816 : 0); }
        else if (type == 3) { const int j = nd0 & 255; ns0 = (nd0 >> 8) * 128 + (j & 127) + (j >= 128 ? 1024 : 0); }
        p0_tr_item(W, K, N, WT, kb, nd0, ns0, gk, scale, scr, lane);
    }
    { const float* x = P.in[I_X]; bf16_t* xb = (bf16_t*)(ws + OFF_XB);
      for (int row = gw; row < NTOK; row += NGW) { float ss = 0.f; f32x4 v[4];
#pragma unroll
          for (int j = 0; j < 4; ++j) { const f32x4 t = *(const f32x4*)(x + (size_t)row * 1024 + 4 * lane + 256 * j); u32x2 w; w.x = cvt_pk_bf16(t[0], t[1]); w.y = cvt_pk_bf16(t[2], t[3]);
              *(u32x2*)(xb + (size_t)row * 1024 + 4 * lane + 256 * j) = w; v[j][0] = bf_lo(w.x); v[j][1] = bf_hi(w.x); v[j][2] = bf_lo(w.y); v[j][3] = bf_hi(w.y);
              ss += v[j][0] * v[j][0] + v[j][1] * v[j][1] + v[j][2] * v[j][2] + v[j][3] * v[j][3]; }
          ss = wave_sum(ss); const float rs = rsqrtf(ss * (1.f / 1024.f) + EPSN); if (lane == 0) ((float*)(ws + OFF_RSQ1))[row] = rs;
#pragma unroll
          for (int j = 0; j < 4; ++j) { u32x2 w; w.x = cvt_pk_bf16(v[j][0] * rs, v[j][1] * rs); w.y = cvt_pk_bf16(v[j][2] * rs, v[j][3] * rs); *(u32x2*)((bf16_t*)(ws + OFF_HC) + (size_t)row * 1024 + 4 * lane + 256 * j) = w; } } }
    const int gt = blockIdx.x * 512 + tid, NGT = gridDim.x * 512;
    for (int idx = gt; idx < 2 * 32 * 64; idx += NGT) {
        const int lg = idx >> 6, p = idx & 63;
        const float lre = P.in[I_LRE][idx], lim = P.in[I_LIM][idx], dt = expf(P.in[I_LOGDT][lg]);
        const float mag = expf(lre * dt);
        const double rev = (double)lim * (double)dt * 0.15915494309189535; const float frc = (float)(rev - rint(rev));
        const float sn = __builtin_amdgcn_sinf(frc), cs = __builtin_amdgcn_cosf(frc);
        const float are = mag * cs, aim = mag * sn, nr = are - 1.f, ni = aim, den = lre * lre + lim * lim;
        const float zre = (nr * lre + ni * lim) / den, zim = (ni * lre - nr * lim) / den;
        { f32x2v t2; t2.x = are; t2.y = aim; ((f32x2v*)(ws + OFF_S5A))[idx] = t2; }
        bf16_t* bbt = (bf16_t*)(ws + OFF_S5BB) + (size_t)lg * 128 * 16; bf16_t* cm = (bf16_t*)(ws + OFF_S5CM) + (size_t)lg * 16 * 128;
        for (int h = 0; h < 16; ++h) { const float br = P.in[I_BRE][(size_t)idx * 16 + h], bi = P.in[I_BIM][(size_t)idx * 16 + h];
            bbt[p * 16 + h] = f2bf(zre * br - zim * bi); bbt[(64 + p) * 16 + h] = f2bf(zre * bi + zim * br);
            cm[h * 128 + p] = f2bf(P.in[I_CRE][((size_t)lg * 16 + h) * 64 + p]); cm[h * 128 + 64 + p] = f2bf(-P.in[I_CIM][((size_t)lg * 16 + h) * 64 + p]); }
    }
    for (int idx = gt; idx < 2 * 31 * 256; idx += NGT) { const float a = P.in[I_CONVW][2 * idx], b = P.in[I_CONVW][2 * idx + 1]; ((unsigned*)(ws + OFF_CONVW))[idx] = cvt_pk_bf16(a, b); }
}
template <bool FINAL> __device__ __forceinline__ void phase_rows(const Params& P, int wave, int lane, bool want_xn) {
    const int gw = blockIdx.x * 8 + wave, NGW = gridDim.x * 8;
    bf16_t* xb = (bf16_t*)(P.ws + OFF_XB); const bf16_t* D = (const bf16_t*)(P.ws + OFF_QO); bf16_t* xn = (bf16_t*)(P.ws + OFF_HC); const float* fg = P.in[I_FING];
    for (int row = gw; row < NTOK; row += NGW) {
        const size_t o0 = (size_t)row * 1024 + 8 * lane, o1 = o0 + 512;
        const u32x4 w0 = *(const u32x4*)(xb + o0), w1 = *(const u32x4*)(xb + o1), d0 = *(const u32x4*)(D + o0), d1 = *(const u32x4*)(D + o1);
        f32x4 a0, a1, b0, b1, e0, e1, g0, g1; unpack8(w0, a0, a1); unpack8(w1, b0, b1); unpack8(d0, e0, e1); unpack8(d1, g0, g1);
        const u32x4 n0 = pack8(a0 + e0, a1 + e1), n1 = pack8(b0 + g0, b1 + g1);
        unpack8(n0, a0, a1); unpack8(n1, b0, b1);
        float ss = 0.f;
#pragma unroll
        for (int j = 0; j < 4; ++j) ss += a0[j] * a0[j] + a1[j] * a1[j] + b0[j] * b0[j] + b1[j] * b1[j];
        ss = wave_sum(ss);
        const float rs = rsqrtf(ss * (1.f / 1024.f) + EPSN);
        if (!FINAL) { if (lane == 0) ((float*)(P.ws + OFF_RSQ1))[row] = rs; *(u32x4*)(xb + o0) = n0; *(u32x4*)(xb + o1) = n1; if (want_xn) { *(u32x4*)(xn + o0) = pack8(a0 * rs, a1 * rs); *(u32x4*)(xn + o1) = pack8(b0 * rs, b1 * rs); } }
        else { const f32x4 q0 = *(const f32x4*)(fg + 8 * lane), q1 = *(const f32x4*)(fg + 8 * lane + 4), q2 = *(const f32x4*)(fg + 512 + 8 * lane), q3 = *(const f32x4*)(fg + 512 + 8 * lane + 4);
            float* o = P.out + (size_t)row * 1024;
            *(f32x4*)(o + 8 * lane) = a0 * q0 * rs; *(f32x4*)(o + 8 * lane + 4) = a1 * q1 * rs; *(f32x4*)(o + 512 + 8 * lane) = b0 * q2 * rs; *(f32x4*)(o + 512 + 8 * lane + 4) = b1 * q3 * rs; }
    }
}

__device__ __forceinline__ void s5_item(const Params& P, int l, int it, LAS unsigned char* wl, int lane) {
    const int b = it >> 5, g = it & 31, lg = l * 32 + g;
    LAS float* bu = (LAS float*)wl; LAS unsigned char* sl = wl + 16384;
    const int c32 = lane & 31, hi = lane >> 5, fr = lane & 15, fq = lane >> 4;
    const bf16_t* bbt = (const bf16_t*)(P.ws + OFF_S5BB) + (size_t)lg * 128 * 16; const bf16_t* cm = (const bf16_t*)(P.ws + OFF_S5CM) + (size_t)lg * 16 * 128;
    bf16x8 bbreg[4], cmreg[4];
#pragma unroll
    for (int j = 0; j < 4; ++j) { bbreg[j] = *(const bf16x8*)(bbt + (32 * j + c32) * 16 + 8 * hi); cmreg[j] = *(const bf16x8*)(cm + fr * 128 + 32 * j + 8 * fq); }
    const f32x2v av = ((const f32x2v*)(P.ws + OFF_S5A))[lg * 64 + lane]; const float a_re = av.x, a_im = av.y;
    const float dsk = P.in[I_SSMD][l * 512 + g * 16 + fr];
    float s_re = 0.f, s_im = 0.f;
    const bf16_t* Ub = (const bf16_t*)((unsigned char*)P.out + DO_U) + (size_t)b * SEQL * 512 + g * 16; bf16_t* Yb = (bf16_t*)((unsigned char*)P.out + DO_Y) + (size_t)b * SEQL * 512 + g * 16;
    for (int c = 0; c < 64; ++c) {
        const int t0 = c * 32;
        const bf16x8 ureg = *(const bf16x8*)(Ub + (size_t)(t0 + c32) * 512 + 8 * hi);
        unsigned short uep[2][4];
#pragma unroll
        for (int mt = 0; mt < 2; ++mt)
#pragma unroll
            for (int i = 0; i < 4; ++i) uep[mt][i] = Ub[(size_t)(t0 + 16 * mt + 4 * fq + i) * 512 + fr];
#pragma unroll
        for (int j = 0; j < 4; ++j) { f32x16 a;
#pragma unroll
            for (int r = 0; r < 16; ++r) a[r] = 0.f;
            a = __builtin_amdgcn_mfma_f32_32x32x16_bf16(ureg, bbreg[j], a, 0, 0, 0);
#pragma unroll
            for (int r = 0; r < 16; ++r) { const int tok = (r & 3) + 8 * (r >> 2) + 4 * hi; bu[tok * 128 + ((32 * (j & 1) + c32) << 1) + (j >> 1)] = a[r]; } }
        asm volatile("" ::: "memory");
#pragma unroll 8
        for (int t = 0; t < 32; ++t) { const f32x2v v = *(const LAS f32x2v*)(bu + t * 128 + 2 * lane);
            const float nre = fmaf(a_re, s_re, fmaf(-a_im, s_im, v.x)), nim = fmaf(a_re, s_im, fmaf(a_im, s_re, v.y)); s_re = nre; s_im = nim;
            *(LAS unsigned short*)(sl + t * 272 + lane * 2) = f2bf(s_re); *(LAS unsigned short*)(sl + t * 272 + 128 + lane * 2) = f2bf(s_im); }
        asm volatile("" ::: "memory");
#pragma unroll
        for (int mt = 0; mt < 2; ++mt) { f32x4 ya = {0.f, 0.f, 0.f, 0.f};
#pragma unroll
            for (int ks = 0; ks < 4; ++ks) { const bf16x8 a = *(const LAS bf16x8*)(sl + (16 * mt + fr) * 272 + (32 * ks + 8 * fq) * 2); ya = __builtin_amdgcn_mfma_f32_16x16x32_bf16(a, cmreg[ks], ya, 0, 0, 0); }
#pragma unroll
            for (int i = 0; i < 4; ++i) { const float y = ya[i] + dsk * __uint_as_float((unsigned)uep[mt][i] << 16);
                const float ge = y * sigm(1.5957691216057308f * (y + 0.044715f * y * y * y));
                Yb[(size_t)(t0 + 16 * mt + 4 * fq + i) * 512 + fr] = f2bf(ge); } }
        asm volatile("" ::: "memory");
    }
}

template <int PAT> __device__ __forceinline__ void attn_item(const Params& P, int it, LAS unsigned char* vl, int lane) {
    constexpr int d = PAT == 0 ? 1 : (PAT == 1 ? 4 : 16);
    constexpr int ngrp = (SEQL / d) / 32;
    constexpr int KSTR = 144;
    const int j = it % ngrp; int t = it / ngrp; const int r = t % d; t /= d; const int h = t & 7, b = t >> 3;
    const int c32 = lane & 31, hi = lane >> 5, i0 = 32 * j;
    const int lrow = lane >> 3, lch = lane & 7;
    const size_t tokbase = (size_t)b * SEQL;
    bf16_t* QO = (bf16_t*)(P.ws + OFF_QO); const bf16_t* Kb = (const bf16_t*)((unsigned char*)P.out + DO_K); const bf16_t* Vb = (const bf16_t*)((unsigned char*)P.out + DO_V);
    float* LSE = (float*)(P.ws + OFF_LSE);
    const unsigned char* qrow0 = (const unsigned char*)QO + ((tokbase + (size_t)i0 * d + r) * 1536 + PAT * 512 + h * 64) * 2;
    const unsigned char* krow0 = (const unsigned char*)Kb + ((tokbase + (size_t)(i0 - 128) * d + r) * 512 + h * 64) * 2;
    const unsigned char* vrow0 = (const unsigned char*)Vb + ((tokbase + (size_t)(i0 - 128) * d + r) * 512 + h * 64) * 2;
    const unsigned qlo = (unsigned)(lrow * d * 3072 + lch * 16), klo = (unsigned)(lrow * d * 1024 + lch * 16);
    u32x4 qraw[4], kraw[5][4];
#pragma unroll
    for (int i4 = 0; i4 < 4; ++i4) qraw[i4] = *(const u32x4*)(qrow0 + (qlo + (unsigned)(8 * i4 * d * 3072)));
#pragma unroll
    for (int kt = 0; kt < 5; ++kt) { const int kb = i0 - 128 + 32 * kt;
        if (kb >= 0) {
#pragma unroll
            for (int i4 = 0; i4 < 4; ++i4) kraw[kt][i4] = *(const u32x4*)(krow0 + (klo + (unsigned)((32 * kt + 8 * i4) * d * 1024))); } }
    bf16x8 qreg[4];
#pragma unroll
    for (int i4 = 0; i4 < 4; ++i4) *(LAS u32x4*)(vl + (lrow + 8 * i4) * KSTR + lch * 16) = qraw[i4];
    asm volatile("" ::: "memory");
#pragma unroll
    for (int ks = 0; ks < 4; ++ks) qreg[ks] = *(const LAS bf16x8*)(vl + c32 * KSTR + (16 * ks + 8 * hi) * 2);
    asm volatile("" ::: "memory");
    f32x16 s[5];
#pragma unroll
    for (int kt = 0; kt < 5; ++kt) { const int kb = i0 - 128 + 32 * kt;
        f32x16 a;
        if (kb >= 0) {
#pragma unroll
            for (int q = 0; q < 16; ++q) a[q] = 0.f;
#pragma unroll
            for (int i4 = 0; i4 < 4; ++i4) *(LAS u32x4*)(vl + (lrow + 8 * i4) * KSTR + lch * 16) = kraw[kt][i4];
            asm volatile("" ::: "memory");
#pragma unroll
            for (int ks = 0; ks < 4; ++ks) { const bf16x8 kreg = *(const LAS bf16x8*)(vl + c32 * KSTR + (16 * ks + 8 * hi) * 2); a = __builtin_amdgcn_mfma_f32_32x32x16_bf16(kreg, qreg[ks], a, 0, 0, 0); }
            asm volatile("" ::: "memory");
        } else {
#pragma unroll
            for (int q = 0; q < 16; ++q) a[q] = (-__builtin_inff());
        }
        s[kt] = a; }
    u32x4 vreg[5][4];
#pragma unroll
    for (int kt = 0; kt < 3; ++kt) { const int kb = i0 - 128 + 32 * kt;
        if (kb >= 0) {
#pragma unroll
            for (int i4 = 0; i4 < 4; ++i4) vreg[kt][i4] = *(const u32x4*)(vrow0 + (klo + (unsigned)((32 * kt + 8 * i4) * d * 1024))); } }
#pragma unroll
    for (int q = 0; q < 16; ++q) { const int kr = (q & 3) + 8 * (q >> 2) + 4 * hi; if (kr < c32) s[0][q] = (-__builtin_inff()); if (kr > c32) s[4][q] = (-__builtin_inff()); }
    float mx = (-__builtin_inff());
#pragma unroll
    for (int kt = 0; kt < 5; ++kt)
#pragma unroll
        for (int q = 0; q < 16; ++q) mx = fmaxf(mx, s[kt][q]);
    mx = fmaxf(mx, __shfl_xor(mx, 32));
    float den = 0.f;
#pragma unroll
    for (int kt = 0; kt < 5; ++kt)
#pragma unroll
        for (int q = 0; q < 16; ++q) { const float p = __builtin_amdgcn_exp2f(s[kt][q] - mx); s[kt][q] = p; den += p; }
    den += __shfl_xor(den, 32);
    u32x4 pw[5][2];
#pragma unroll
    for (int kt = 0; kt < 5; ++kt)
#pragma unroll
        for (int ks2 = 0; ks2 < 2; ++ks2) { pw[kt][ks2].x = cvt_pk_bf16(s[kt][8 * ks2 + 0], s[kt][8 * ks2 + 1]); pw[kt][ks2].y = cvt_pk_bf16(s[kt][8 * ks2 + 2], s[kt][8 * ks2 + 3]);
            pw[kt][ks2].z = cvt_pk_bf16(s[kt][8 * ks2 + 4], s[kt][8 * ks2 + 5]); pw[kt][ks2].w = cvt_pk_bf16(s[kt][8 * ks2 + 6], s[kt][8 * ks2 + 7]); }
#pragma unroll
    for (int kt = 3; kt < 5; ++kt) { const int kb = i0 - 128 + 32 * kt;
        if (kb >= 0) {
#pragma unroll
            for (int i4 = 0; i4 < 4; ++i4) vreg[kt][i4] = *(const u32x4*)(vrow0 + (klo + (unsigned)((32 * kt + 8 * i4) * d * 1024))); } }
    u32x4 mraw[2][4]; float l2b = 0.f, l2c = 0.f;
    if (PAT == 0) {
#pragma unroll
        for (int pp = 0; pp < 2; ++pp)
#pragma unroll
            for (int i4 = 0; i4 < 4; ++i4) mraw[pp][i4] = *(const u32x4*)(qrow0 + (qlo + (unsigned)(8 * i4 * 3072 + (pp + 1) * 1024)));
        l2b = LSE[((size_t)(0 * 32 + b) * 8 + h) * SEQL + i0 + c32]; l2c = LSE[((size_t)(1 * 32 + b) * 8 + h) * SEQL + i0 + c32];
    }
    f32x16 o[2];
#pragma unroll
    for (int q = 0; q < 16; ++q) { o[0][q] = 0.f; o[1][q] = 0.f; }
    const int gi = lane >> 4, li = lane & 15;
    const LAS unsigned char* vrd = vl + (4 * hi + (li >> 2)) * VSTR + (16 * (gi & 1) + 4 * (li & 3)) * 2;
#pragma unroll
    for (int kt = 0; kt < 5; ++kt) { const int kb = i0 - 128 + 32 * kt;
        if (kb >= 0) {
#pragma unroll
            for (int i4 = 0; i4 < 4; ++i4) *(LAS u32x4*)(vl + (lrow + 8 * i4) * VSTR + lch * 16) = vreg[kt][i4];
            asm volatile("" ::: "memory");
#pragma unroll
            for (int ks2 = 0; ks2 < 2; ++ks2) {
                const bf16x8 pb = __builtin_bit_cast(bf16x8, pw[kt][ks2]);
#pragma unroll
                for (int mt = 0; mt < 2; ++mt) { const LAS unsigned char* a1 = vrd + (16 * ks2) * VSTR + 64 * mt;
                    const s16x4 lo = vtr(a1), up = vtr(a1 + 8 * VSTR);
                    bf16x8 av; av[0] = lo[0]; av[1] = lo[1]; av[2] = lo[2]; av[3] = lo[3]; av[4] = up[0]; av[5] = up[1]; av[6] = up[2]; av[7] = up[3];
                    o[mt] = __builtin_amdgcn_mfma_f32_32x32x16_bf16(av, pb, o[mt], 0, 0, 0); } }
            asm volatile("" ::: "memory");
        } }
    const float inv = __builtin_amdgcn_rcpf(den);
    const float l2 = mx + __builtin_amdgcn_logf(den);
    const LAS unsigned char* frd = vl + c32 * KSTR + 8 * hi;
    float w1 = inv;
    if (PAT == 0) {
        const float M = fmaxf(l2, fmaxf(l2b, l2c));
        float e1 = __builtin_amdgcn_exp2f(l2 - M), e2 = __builtin_amdgcn_exp2f(l2b - M), e3 = __builtin_amdgcn_exp2f(l2c - M);
        const float wi = __builtin_amdgcn_rcpf(e1 + e2 + e3); w1 = e1 * wi * inv; const float wo[2] = {e2 * wi, e3 * wi};
#pragma unroll
        for (int q = 0; q < 16; ++q) { o[0][q] *= w1; o[1][q] *= w1; }
#pragma unroll
        for (int pp = 0; pp < 2; ++pp) {
#pragma unroll
            for (int i4 = 0; i4 < 4; ++i4) *(LAS u32x4*)(vl + (lrow + 8 * i4) * KSTR + lch * 16) = mraw[pp][i4];
            asm volatile("" ::: "memory");
#pragma unroll
            for (int mt = 0; mt < 2; ++mt)
#pragma unroll
                for (int rg = 0; rg < 4; ++rg) { const u32x2 bb = *(const LAS u32x2*)(frd + 64 * mt + 16 * rg);
                    o[mt][4 * rg] += wo[pp] * bf_lo(bb.x); o[mt][4 * rg + 1] += wo[pp] * bf_hi(bb.x); o[mt][4 * rg + 2] += wo[pp] * bf_lo(bb.y); o[mt][4 * rg + 3] += wo[pp] * bf_hi(bb.y); }
            asm volatile("" ::: "memory");
        }
    } else {
#pragma unroll
        for (int q = 0; q < 16; ++q) { o[0][q] *= w1; o[1][q] *= w1; }
    }
#pragma unroll
    for (int mt = 0; mt < 2; ++mt)
#pragma unroll
        for (int rg = 0; rg < 4; ++rg) { u32x2 w; w.x = cvt_pk_bf16(o[mt][4 * rg], o[mt][4 * rg + 1]); w.y = cvt_pk_bf16(o[mt][4 * rg + 2], o[mt][4 * rg + 3]);
            *(LAS u32x2*)(vl + c32 * KSTR + 8 * hi + 64 * mt + 16 * rg) = w; }
    asm volatile("" ::: "memory");
    if (PAT != 0) {
#pragma unroll
        for (int i4 = 0; i4 < 4; ++i4) *(u32x4*)((unsigned char*)qrow0 + (qlo + (unsigned)(8 * i4 * d * 3072))) = *(const LAS u32x4*)(vl + (lrow + 8 * i4) * KSTR + lch * 16);
        if (hi == 0) LSE[((size_t)((PAT - 1) * 32 + b) * 8 + h) * SEQL + (size_t)(i0 + c32) * d + r] = l2;
    } else {
        bf16_t* OC = (bf16_t*)(P.ws + OFF_OC);
#pragma unroll
        for (int i4 = 0; i4 < 4; ++i4) *(u32x4*)(OC + (tokbase + (size_t)(i0 + lrow + 8 * i4)) * 512 + h * 64 + lch * 8) = *(const LAS u32x4*)(vl + (lrow + 8 * i4) * KSTR + lch * 16);
    }
    asm volatile("" ::: "memory");
}

__device__ __forceinline__ void conv_item(const Params& P, int l, int it, int lane, const LAS unsigned char* wlds) {
    const int b = it >> 8, t0 = (it & 255) * 8, ch0 = 8 * lane;
    const bf16_t* in = (const bf16_t*)(P.ws + OFF_CG) + (size_t)b * SEQL * 512 + ch0;
    const LAS unsigned char* cw = wlds + 16 * lane;
    float acc[8][8], win[8][8];
    { const f32x4 b0 = *(const f32x4*)(P.in[I_CONVB] + l * 512 + ch0), b1 = *(const f32x4*)(P.in[I_CONVB] + l * 512 + ch0 + 4);
#pragma unroll
      for (int i = 0; i < 8; ++i) { acc[i][0] = b0[0]; acc[i][1] = b0[1]; acc[i][2] = b0[2]; acc[i][3] = b0[3]; acc[i][4] = b1[0]; acc[i][5] = b1[1]; acc[i][6] = b1[2]; acc[i][7] = b1[3]; } }
#define CONV_LOADROW(rr, dst) do { const int t_ = t0 - 30 + (rr); if (t_ >= 0) { const u32x4 v_ = *(const u32x4*)(in + (size_t)t_ * 512); \
        dst[0] = bf_lo(v_.x); dst[1] = bf_hi(v_.x); dst[2] = bf_lo(v_.y); dst[3] = bf_hi(v_.y); dst[4] = bf_lo(v_.z); dst[5] = bf_hi(v_.z); dst[6] = bf_lo(v_.w); dst[7] = bf_hi(v_.w); } \
        else { _Pragma("unroll") for (int c_ = 0; c_ < 8; ++c_) dst[c_] = 0.f; } } while (0)
#pragma unroll
    for (int rr = 0; rr < 8; ++rr) CONV_LOADROW(rr, win[rr]);
    for (int jb = 0; jb < 32; jb += 8) {
        asm volatile("" ::: "memory");
#pragma unroll
        for (int jj = 0; jj < 8; ++jj) { const int j = jb + jj;
            if (j < 31) { const u32x4 wv = *(const LAS u32x4*)(cw + j * 1024);
                float w[8]; w[0] = bf_lo(wv.x); w[1] = bf_hi(wv.x); w[2] = bf_lo(wv.y); w[3] = bf_hi(wv.y); w[4] = bf_lo(wv.z); w[5] = bf_hi(wv.z); w[6] = bf_lo(wv.w); w[7] = bf_hi(wv.w);
#pragma unroll
                for (int i = 0; i < 8; ++i)
#pragma unroll
                    for (int c = 0; c < 8; ++c) acc[i][c] = fmaf(w[c], win[(jj + i) & 7][c], acc[i][c]);
                if (j + 8 < 38) CONV_LOADROW(j + 8, win[jj]); } }
    }
#undef CONV_LOADROW
    const f32x4 g0 = *(const f32x4*)(P.in[I_LNG] + l * 512 + ch0), g1 = *(const f32x4*)(P.in[I_LNG] + l * 512 + ch0 + 4);
    const f32x4 e0 = *(const f32x4*)(P.in[I_LNB] + l * 512 + ch0), e1 = *(const f32x4*)(P.in[I_LNB] + l * 512 + ch0 + 4);
    bf16_t* outp = (bf16_t*)(P.ws + OFF_HC) + ((size_t)b * SEQL + t0) * 512 + ch0;
#pragma unroll
    for (int i = 0; i < 8; ++i) { float s1 = 0.f, s2 = 0.f;
#pragma unroll
        for (int c = 0; c < 8; ++c) { s1 += acc[i][c]; s2 += acc[i][c] * acc[i][c]; }
        s1 = wave_sum(s1); s2 = wave_sum(s2);
        const float mean = s1 * (1.f / 512.f), var = fmaxf(s2 * (1.f / 512.f) - mean * mean, 0.f), rs = rsqrtf(var + EPSN);
        f32x4 y0, y1;
#pragma unroll
        for (int c = 0; c < 4; ++c) { const float h0 = (acc[i][c] - mean) * rs * g0[c] + e0[c], h1 = (acc[i][4 + c] - mean) * rs * g1[c] + e1[c]; y0[c] = h0 * sigm(h0); y1[c] = h1 * sigm(h1); }
        *(u32x4*)(outp + (size_t)i * 512) = pack8(y0, y1); }
}

__device__ __forceinline__ int xcc_id() { return (int)(__builtin_amdgcn_s_getreg((3 << 11) | 20) & 7u); }
__device__ __forceinline__ int claim_issue(unsigned* ctr, int& lane) { asm volatile("" : "+v"(lane)); int v = 0; if (lane == 0) v = (int)atomicAdd(ctr, 1u); return v; }
__device__ __forceinline__ int lane_now() { int l = (int)__builtin_amdgcn_mbcnt_hi(~0u, __builtin_amdgcn_mbcnt_lo(~0u, 0u)); asm volatile("" : "+v"(l)); return l; }
__device__ __forceinline__ int lds_claim(LAS unsigned* ctr, int lane) { int v = 0; if (lane == 0) v = (int)__hip_atomic_fetch_add(ctr, 1u, __ATOMIC_RELAXED, __HIP_MEMORY_SCOPE_WORKGROUP); return __builtin_amdgcn_readfirstlane(v); }
__device__ __forceinline__ int claim(unsigned* ctr, int& lane) { asm volatile("" : "+v"(lane)); int v = 0; if (lane == 0) v = (int)atomicAdd(ctr, 1u); return __builtin_amdgcn_readfirstlane(v); }


__device__ __forceinline__ void grid_barrier(unsigned* bar, unsigned target, int tid) {
    asm volatile("s_waitcnt vmcnt(0) lgkmcnt(0)" ::: "memory");
    __syncthreads();
    if (tid == 0) {
        __builtin_amdgcn_fence(__ATOMIC_RELEASE, "agent");
        asm volatile("s_waitcnt vmcnt(0) lgkmcnt(0)" ::: "memory");
        __hip_atomic_fetch_add(bar, 1u, __ATOMIC_RELAXED, __HIP_MEMORY_SCOPE_AGENT);
        while (__hip_atomic_load(bar, __ATOMIC_RELAXED, __HIP_MEMORY_SCOPE_AGENT) < target) __builtin_amdgcn_s_sleep(2);
        __builtin_amdgcn_fence(__ATOMIC_ACQUIRE, "agent");
        asm volatile("s_waitcnt vmcnt(0) lgkmcnt(0)" ::: "memory");
    }
    __syncthreads();
}


#define XB_TMO      128
#define XB_XCNT(j)  (256  + 64 * (j))
#define XB_XSUB(j)  (1280 + 64 * (j))
#define XB_XGEN(j)  (2304 + 64 * (j))
#define XB_TOP      3328
#define XB_TOPGEN   3392
#define XB_SPIN_CAP (1u << 22)
__device__ __forceinline__ unsigned xb_ld(unsigned* p)              { return __hip_atomic_load(p, __ATOMIC_RELAXED, __HIP_MEMORY_SCOPE_AGENT); }
__device__ __forceinline__ unsigned xb_add(unsigned* p, unsigned v) { return __hip_atomic_fetch_add(p, v, __ATOMIC_RELAXED, __HIP_MEMORY_SCOPE_AGENT); }
#define XB_SPIN(cond, bar) do { unsigned _sp = 0; while (cond) { __builtin_amdgcn_s_sleep(1); \
    if ((++_sp & 255u) == 0u) { if (xb_ld(&(bar)[XB_TMO])) break; if (_sp > XB_SPIN_CAP) { atomicAdd(&(bar)[XB_TMO], 1u); break; } } } } while (0)
__device__ __forceinline__ void xcd_barrier_complete(unsigned* bar, unsigned x, unsigned& nloc, unsigned& nx) {
    const unsigned G = gridDim.x;
    unsigned sum, cnt, mine, sp = 0u;
    for (;;) {
        sum = 0u; cnt = 0u; mine = 0u;
#pragma unroll
        for (unsigned j = 0; j < 16; ++j) { const unsigned c = xb_ld(&bar[XB_XCNT(j)]); sum += c; cnt += (c > 0u) ? 1u : 0u; mine = (j == x) ? c : mine; }
        if (sum == G) break;
        __builtin_amdgcn_s_sleep(1);
        if ((++sp & 255u) == 0u) { if (xb_ld(&bar[XB_TMO])) break; if (sp > XB_SPIN_CAP) { atomicAdd(&bar[XB_TMO], 1u); break; } }
    }
    nloc = mine > 0u ? mine : 1u; nx = cnt > 0u ? cnt : 1u;
}
__device__ __forceinline__ void xcd_barrier(unsigned* bar, LAS unsigned char* lds, int tid) {
    const unsigned x = (unsigned)__builtin_amdgcn_s_getreg((3 << 11) | 20) & 0xFu; volatile LAS unsigned* st = (volatile LAS unsigned*)(lds + CTR_OFF + 64);
    asm volatile("s_waitcnt vmcnt(0) lgkmcnt(0)" ::: "memory");
    __syncthreads();
    if (tid == 0) {
        unsigned nloc = st[0], nx = st[1];
        if (nloc == 0u) { xcd_barrier_complete(bar, x, nloc, nx); st[0] = nloc; st[1] = nx; }
        const unsigned old = xb_add(&bar[XB_XSUB(x)], 1u);
        const unsigned gen = old / nloc;
        if (old + 1u == (gen + 1u) * nloc) {
            __builtin_amdgcn_fence(__ATOMIC_RELEASE, "agent");
            asm volatile("s_waitcnt vmcnt(0)" ::: "memory");
            const unsigned og = xb_add(&bar[XB_TOP], 1u);
            const unsigned tg = og / nx;
            if (og + 1u == (tg + 1u) * nx) xb_add(&bar[XB_TOPGEN], 1u);
            else XB_SPIN(xb_ld(&bar[XB_TOPGEN]) == tg, bar);
            __builtin_amdgcn_fence(__ATOMIC_ACQUIRE, "agent");
            xb_add(&bar[XB_XGEN(x)], 1u);
            asm volatile("s_waitcnt vmcnt(0)" ::: "memory");
        } else {
            XB_SPIN(xb_ld(&bar[XB_XGEN(x)]) == gen, bar);
            __builtin_amdgcn_fence(__ATOMIC_ACQUIRE, "agent");
            asm volatile("s_waitcnt vmcnt(0)" ::: "memory");
        }
    }
    __syncthreads();
}

constexpr int NPHASE = 21;
__global__ void __launch_bounds__(512, 2) fwd_kernel(Params P) {
    extern __shared__ __attribute__((aligned(16))) unsigned char shm[];
    LAS unsigned char* lds = (LAS unsigned char*)shm;
        unsigned char* ws = P.ws; unsigned char* dout = (unsigned char*)P.out;
    bf16_t* xb = (bf16_t*)(ws + OFF_XB); bf16_t* Gt = (bf16_t*)(ws + OFF_G); bf16_t* Mg = (bf16_t*)(dout + DO_MG);
    bf16_t* xn = (bf16_t*)(ws + OFF_HC); bf16_t* Dl = (bf16_t*)(ws + OFF_QO);
    unsigned* ctl = (unsigned*)(ws + OFF_CTL);
    StaticOrder S;
    unsigned nbar = 0;
    const int wave_s = __builtin_amdgcn_readfirstlane((int)threadIdx.x >> 6);
    if (P.ph_hi - P.ph_lo > 1) cg::this_grid().sync();
    { volatile LAS unsigned* xst = (volatile LAS unsigned*)(lds + CTR_OFF + 64);
      const unsigned xcc = (unsigned)__builtin_amdgcn_s_getreg((3 << 11) | 20) & 0xFu;
      if (threadIdx.x == 0) { xst[0] = 0u; xst[1] = 0u; (void)xb_add(&ctl[XB_XCNT(xcc)], 1u); }
      __syncthreads(); }
    for (int ph = P.ph_lo; ph < P.ph_hi; ++ph) {
        const int wave = wave_s;
#define PHASE_IDS const int lane = lane_now(); const int tid = (wave_s << 6) | lane; (void)tid; (void)lane;
        if (ph == 0) { PHASE_IDS for (int rp = 0; rp < NREP_P0; ++rp) phase_p0(P, lds, wave, lane, tid); }
        else if (ph == NPHASE - 1) { PHASE_IDS phase_rows<true>(P, wave, lane, false); }
        else {
            const int l = (ph - 1) / 10, s = (ph - 1) % 10;
            if (s == 0) { PHASE_IDS
                S.init(NTOK, 7168, gridDim.x, blockIdx.x);
                Gemm g{xn, (const bf16_t*)(ws + OFF_WIN) + (size_t)l * 7168 * 1024, NTOK, 7168, 1024};
                EpiIn E{(bf16_t*)(dout + DO_U), (bf16_t*)(ws + OFF_QO), (bf16_t*)(dout + DO_K), (bf16_t*)(dout + DO_V), (bf16_t*)(ws + OFF_CG), Gt, P.in[I_BGATE] + l * 3072};
                gemm_phase<EpiIn, StaticOrder, false>(lds, g, S, E, nullptr, tid);
            } else if (s == 1) { PHASE_IDS
                LAS unsigned* lctr = (LAS unsigned*)(lds + CTR_OFF);
                if (tid == 0) lctr[0] = 0u;
                __syncthreads();
                const int grp = blockIdx.x & 7, rank = blockIdx.x >> 3; constexpr int per = 128;
                if (wave < 4) { for (int it = blockIdx.x * 4 + wave; it < 1024; it += gridDim.x * 4) s5_item(P, l, it, lds + wave * S5_WL, lane_now()); }
                LAS unsigned char* vl = lds + ATT_OFF + wave * ATT_WL;
                for (;;) { const int ln = lane_now(); const int k = lds_claim(lctr, ln); const int li = rank * per + k; if (k >= per || li >= 4096) break;
                    const int b = grp + 8 * (li >> 10), rest = li & 1023;
                    if (rest < 512) attn_item<1>(P, b * 512 + rest, vl, ln); else attn_item<2>(P, b * 512 + rest - 512, vl, ln); }
            } else if (s == 2) { PHASE_IDS
                LAS unsigned* lctr = (LAS unsigned*)(lds + CTR_OFF);
                if (tid == 0) lctr[0] = 0u;
                { const unsigned* cwg = (const unsigned*)(ws + OFF_CONVW) + (size_t)l * 31 * 256;
                  for (int i = tid; i < 31 * 64; i += 512) *(LAS u32x4*)(lds + i * 16) = *(const u32x4*)(cwg + i * 4); }
                __syncthreads();
                const int grp = blockIdx.x & 7, rank = blockIdx.x >> 3; constexpr int per = 96;
                LAS unsigned char* vl = lds + ATT_OFF + wave * ATT_WL;
                for (;;) { const int ln = lane_now(); const int k = lds_claim(lctr, ln); const int li = rank * per + k; if (k >= per || li >= 3072) break;
                    const int b = grp + 8 * (li / 768), rest = li % 768;
                    if (rest < 512) attn_item<0>(P, b * 512 + rest, vl, ln); else conv_item(P, l, b * 256 + rest - 512, ln, lds); }
            } else if (s == 3) { PHASE_IDS
                S.init(NTOK, 2048, gridDim.x, blockIdx.x);
                Gemm g{(const bf16_t*)(dout + DO_Y), (const bf16_t*)(ws + OFF_WGLU) + (size_t)l * 2048 * 512, NTOK, 2048, 512};
                EpiGluMerge E{Mg, Gt};
                gemm_phase<EpiGluMerge, StaticOrder, false>(lds, g, S, E, nullptr, tid);
            } else if (s == 4) { PHASE_IDS
                S.init(NTOK, 1024, gridDim.x, blockIdx.x);
                for (int c = 0; c < 2; ++c) {
                    Gemm g{(const bf16_t*)(ws + (c == 0 ? OFF_HC : OFF_OC)), (const bf16_t*)(ws + (c == 0 ? OFF_WPW2 : OFF_WATT)) + (size_t)l * 1024 * 512, NTOK, 1024, 512};
                    EpiAccMerge E{Mg, Gt, c == 0 ? 2048 : 1024};
                    gemm_phase<EpiAccMerge, StaticOrder, false>(lds, g, S, E, nullptr, tid);
                    __syncthreads();
                }
            } else if (s == 6 || s == 9) { PHASE_IDS
                phase_rows<false>(P, wave, lane, true);
            } else if (s == 5 || s == 8) { PHASE_IDS
                S.init(NTOK, 1024, gridDim.x, blockIdx.x);
                Gemm g{s == 5 ? (const bf16_t*)Mg : (const bf16_t*)Gt, s == 5 ? (const bf16_t*)(ws + OFF_WOUT) + (size_t)l * 1024 * 1024 : (const bf16_t*)(ws + OFF_WF2) + (size_t)l * 1024 * 2816, NTOK, 1024, s == 5 ? 1024 : 2816};
                EpiDelta E{Dl};
                gemm_phase<EpiDelta, StaticOrder, false>(lds, g, S, E, nullptr, tid);
            } else {
                PHASE_IDS
                S.init(NTOK, 5632, gridDim.x, blockIdx.x);
                Gemm g{xn, (const bf16_t*)(ws + OFF_WF1) + (size_t)l * 5632 * 1024, NTOK, 5632, 1024};
                EpiFfn1 E{Gt};
                gemm_phase<EpiFfn1, StaticOrder, false>(lds, g, S, E, nullptr, tid);
            }
        }
        if (ph + 1 < P.ph_hi) xcd_barrier(ctl, lds, (wave_s << 6) | lane_now());
    }
}

extern "C" void kernel_launch(void* const* d_in, const int* in_sizes, int n_in, void* d_out, int out_size, void* d_ws, size_t ws_size, hipStream_t stream) {
    static int grid = 0;
    if (grid == 0) {
        if (n_in != 24 || out_size != NTOK * 1024 || ws_size < WS_END) { fprintf(stderr, "kernel_launch: unexpected problem (n_in %d out %d ws %zu need %zu)\n", n_in, out_size, ws_size, (size_t)WS_END); grid = -1; return; }
        int dev = 0, cus = 0, per_cu = 0;
        hipGetDevice(&dev); hipDeviceGetAttribute(&cus, hipDeviceAttributeMultiprocessorCount, dev);
        if (hipFuncSetAttribute((const void*)fwd_kernel, hipFuncAttributeMaxDynamicSharedMemorySize, LDS_BYTES) != hipSuccess) { fprintf(stderr, "kernel_launch: hipFuncSetAttribute failed\n"); grid = -1; return; }
        hipOccupancyMaxActiveBlocksPerMultiprocessor(&per_cu, (const void*)fwd_kernel, 512, LDS_BYTES);
        if (per_cu < 1) { fprintf(stderr, "kernel_launch: occupancy query says %d blocks/CU\n", per_cu); per_cu = 1; }
        (void)hipGetLastError();
        grid = cus * per_cu; if (grid > 256) grid = 256;
        if (grid != 256) { fprintf(stderr, "kernel_launch: this build partitions its work over exactly 256 workgroups (got %d)\n", grid); grid = -1; return; }
    }
    if (grid < 0) return;
    hipMemsetAsync((unsigned char*)d_ws + OFF_CTL, 0, 16384, stream);
    Params p{};
    for (int i = 0; i < 24; ++i) p.in[i] = (const float*)d_in[i];
    p.out = (float*)d_out; p.ws = (unsigned char*)d_ws;
#if MK_PER_PHASE
    for (int ph = 0; ph < NPHASE; ++ph) { p.ph_lo = ph; p.ph_hi = ph + 1; hipLaunchKernelGGL(fwd_kernel, dim3(grid), dim3(512), LDS_BYTES, stream, p); }
#else
    p.ph_lo = 0; p.ph_hi = NPHASE;
    void* args[] = {&p};
    hipError_t e = hipLaunchCooperativeKernel((const void*)fwd_kernel, dim3(grid), dim3(512), args, LDS_BYTES, stream);
    if (e != hipSuccess) fprintf(stderr, "cooperative launch failed: %s (grid %d)\n", hipGetErrorString(e), grid);
#endif
}
```

```cpp
#include <hip/hip_runtime.h>
#include <hip/hip_cooperative_groups.h>
#include <cstdio>
namespace cg = cooperative_groups;
namespace pg8 {
#define PG8_LAS __attribute__((address_space(3)))
typedef unsigned short bf16_t;
typedef short bf16x8 __attribute__((ext_vector_type(8)));
typedef float f32x4 __attribute__((ext_vector_type(4)));
typedef unsigned u32x4 __attribute__((ext_vector_type(4)));
constexpr int BM = 256, BK = 64, HALF = 128, HTB = HALF * BK * 2  , STAGE_BYTES = 8 * HTB, NXCD = 8, WGM = 8;

__host__ __device__ __forceinline__ int lds_byte(int r, int c) { const int st = (r >> 4) * 2 + (c >> 5), rr = r & 15, cc = c & 31, ob = rr * 64 + cc * 2; return st * 1024 + (ob ^ (((ob >> 9) & 1) << 5)); }
__host__ __device__ __forceinline__ void stage_rc(int b, int& R, int& C) { const int st = b / 1024, sb = b % 1024, swz = sb ^ (((sb >> 9) & 1) << 5); R = (st >> 1) * 16 + swz / 64; C = (st & 1) * 32 + (swz % 64) / 2; }
__host__ __device__ __forceinline__ int perm32(int rho) { const int n = rho >> 4, i = rho & 15; return 8 * (i >> 2) + 4 * n + (i & 3); }

struct Unit { int pm, pn; };
struct Gemm { const bf16_t* A; const bf16_t* Bt; int M, N, K; };

struct StaticOrder {
    int nM, nN, nwg, G, c;
    __host__ __device__ void init(int M, int N, int G_, int c_) { nM = M / BM; nN = N / BM; nwg = nM * nN; G = G_; c = c_; }
    __host__ __device__ bool next(int i, Unit& u) const {
        const long L = (long)i * G + c; if (L >= nwg) return false;
        int wgid = (int)L; { const int q = nwg / NXCD, r = nwg % NXCD, xcd = wgid % NXCD, off = wgid / NXCD; wgid = (xcd < r ? xcd * (q + 1) : r * (q + 1) + (xcd - r) * q) + off; }
        const int nig = WGM * nN, gid = wgid / nig, fm = gid * WGM, gsz = (nM - fm) < WGM ? (nM - fm) : WGM;
        u.pm = fm + ((wgid % nig) % gsz); u.pn = (wgid % nig) / gsz; return true;
    }
    __device__ __forceinline__ void a_ready(const Unit&) const {}
    __device__ __forceinline__ void done(const Unit&) const {}
};
__device__ __forceinline__ unsigned cvt_pk_bf16(float lo, float hi) { unsigned r; asm volatile("s_nop 1\n\tv_cvt_pk_bf16_f32 %0, %1, %2" : "=v"(r) : "v"(lo), "v"(hi)); return r; }
template <class Epi, class Sched, bool STAMP = false>
__device__ __forceinline__ void gemm_phase(PG8_LAS unsigned char* lds, const Gemm g, const Sched& S, const Epi& E, unsigned long long* stamps, int tid_in) {
    int tid_o = tid_in; asm volatile("" : "+v"(tid_o)); const int tid = tid_o, wid = __builtin_amdgcn_readfirstlane(tid >> 6), lane = tid & 63, wr = wid >> 2, wc = wid & 3, fr = lane & 15, fq = lane >> 4;
    const int K = g.K, nt = K / BK;
    int ts_lo = 0, ts_hi = 0, nts = 0; const unsigned long long rt_entry = STAMP ? (unsigned long long)wall_clock64() : 0ull;
#define PG8_STAMP() do { if (STAMP && wid == 0 && nts < 64) { const unsigned long long _c = (unsigned long long)clock64(); \
        ts_lo = (lane == nts) ? (int)(unsigned)_c : ts_lo; ts_hi = (lane == nts) ? (int)(unsigned)(_c >> 32) : ts_hi; ++nts; } } while (0)
    PG8_STAMP();
    unsigned voffA[2], voffB[2];
#pragma unroll
    for (int i = 0; i < 2; ++i) { int R, C; stage_rc(tid * 16 + i * 8192, R, C); const int Rb = Epi::PERM ? ((R & ~31) + perm32(R & 31)) : R;
        voffA[i] = (unsigned)(R * K + C) * 2u; voffB[i] = (unsigned)(Rb * K + C) * 2u; }
    const size_t kstep = (size_t)(BK * 2);
    const size_t hstep = (size_t)HALF * K * 2;
    const size_t tstep = 2 * hstep;
    const unsigned ldsw = (unsigned)wid * 1024u;
    const int aoff = lds_byte(wr * 64 + fr, fq * 8), boff = lds_byte(wc * 32 + fr, fq * 8);
#define PG8_SA(b, h) (((b) * 2 + (h)) * HTB)
#define PG8_SB(b, h) ((4 + (b) * 2 + (h)) * HTB)
#define PG8_STAGE(bufoff, gbase, voff) do { _Pragma("unroll") for (int _i = 0; _i < 2; ++_i) \
        __builtin_amdgcn_global_load_lds((const unsigned*)((const char*)(gbase) + (voff)[_i]), (PG8_LAS unsigned*)(lds + (bufoff) + ldsw + _i * 8192), 16, 0, 0); } while (0)
#define PG8_LDA(dst, b, h) do { _Pragma("unroll") for (int m = 0; m < 4; ++m) _Pragma("unroll") for (int k = 0; k < 2; ++k) dst[m][k] = *(const PG8_LAS bf16x8*)(lds + PG8_SA(b, h) + aoff + m * 2048 + k * 1024); } while (0)
#define PG8_LDB(dst, b, h) do { _Pragma("unroll") for (int n = 0; n < 2; ++n) _Pragma("unroll") for (int k = 0; k < 2; ++k) dst[n][k] = *(const PG8_LAS bf16x8*)(lds + PG8_SB(b, h) + boff + n * 2048 + k * 1024); } while (0)
#define PG8_MMA(ai, bj, At, Bt) do { __builtin_amdgcn_s_setprio(1); _Pragma("unroll") for (int m = 0; m < 4; ++m) _Pragma("unroll") for (int n = 0; n < 2; ++n) _Pragma("unroll") for (int k = 0; k < 2; ++k) \
        acc[ai][bj][m][n] = __builtin_amdgcn_mfma_f32_16x16x32_bf16(Bt[n][k], At[m][k], acc[ai][bj][m][n], 0, 0, 0); __builtin_amdgcn_s_setprio(0); } while (0)
#define PG8_WAIT_V(n) asm volatile("s_waitcnt vmcnt(" #n ")" ::: "memory")
#define PG8_WAIT_L(n) asm volatile("s_waitcnt lgkmcnt(" #n ")" ::: "memory")
#define PG8_BAR __builtin_amdgcn_s_barrier()
#define PG8_SCHED __builtin_amdgcn_sched_barrier(0)
    Unit cur, nxt; int ui = 0;
    if (!S.next(0, cur)) return;
    f32x4 acc[2][2][4][2];
#pragma unroll
    for (int a = 0; a < 2; ++a)
#pragma unroll
        for (int b = 0; b < 2; ++b)
#pragma unroll
            for (int m = 0; m < 4; ++m)
#pragma unroll
                for (int n = 0; n < 2; ++n) acc[a][b][m][n] = (f32x4){0.f, 0.f, 0.f, 0.f};
    bf16x8 At[4][2], B0[2][2], B1[2][2];
    const char* cA = (const char*)g.A + (size_t)cur.pm * tstep; const char* cB = (const char*)g.Bt + (size_t)cur.pn * tstep;
    S.a_ready(cur);
    PG8_STAGE(PG8_SB(0, 0), cB, voffB); PG8_STAGE(PG8_SA(0, 0), cA, voffA); PG8_STAGE(PG8_SB(0, 1), cB + hstep, voffB); PG8_STAGE(PG8_SA(0, 1), cA + hstep, voffA);
    if (wr == 1) PG8_BAR;
    PG8_WAIT_V(4); PG8_BAR;
    PG8_STAGE(PG8_SB(1, 0), cB + kstep, voffB); PG8_STAGE(PG8_SA(1, 0), cA + kstep, voffA); PG8_STAGE(PG8_SB(1, 1), cB + hstep + kstep, voffB);
    PG8_WAIT_V(6); PG8_BAR;
    PG8_STAMP();
    for (;;) {
        const bool has_next = S.next(ui + 1, nxt);
        const char* nA = has_next ? (const char*)g.A + (size_t)nxt.pm * tstep : cA; const char* nB = has_next ? (const char*)g.Bt + (size_t)nxt.pn * tstep : cB;
        for (int t = 0; t < nt; t += 2) {
            const bool last = (t == nt - 2);
            const char* a1 = cA + (size_t)(t + 1) * kstep;
            const char* a2 = last ? nA : cA + (size_t)(t + 2) * kstep; const char* b2 = last ? nB : cB + (size_t)(t + 2) * kstep;
            const char* a3 = a2 + kstep; const char* b3 = b2 + kstep;
            if (last && has_next) S.a_ready(nxt);
            PG8_LDB(B0, 0, 0); PG8_SCHED; PG8_LDA(At, 0, 0); PG8_STAGE(PG8_SA(1, 1), a1 + hstep, voffA);
            PG8_WAIT_L(8); PG8_BAR; PG8_WAIT_L(0); PG8_MMA(0, 0, At, B0); PG8_BAR; PG8_SCHED;
            PG8_LDB(B1, 0, 1); PG8_STAGE(PG8_SB(0, 0), b2, voffB);
            PG8_BAR; PG8_WAIT_L(0); PG8_MMA(0, 1, At, B1); PG8_BAR;
            PG8_LDA(At, 0, 1); PG8_STAGE(PG8_SA(0, 0), a2, voffA);
            PG8_BAR; PG8_WAIT_L(0); PG8_MMA(1, 0, At, B0); PG8_BAR; PG8_SCHED;
            PG8_STAGE(PG8_SB(0, 1), b2 + hstep, voffB);
            PG8_WAIT_V(6); PG8_BAR; PG8_MMA(1, 1, At, B1); PG8_BAR;
            PG8_LDB(B0, 1, 0); PG8_SCHED; PG8_LDA(At, 1, 0); PG8_STAGE(PG8_SA(0, 1), a2 + hstep, voffA);
            PG8_WAIT_L(8); PG8_BAR; PG8_WAIT_L(0); PG8_MMA(0, 0, At, B0); PG8_BAR; PG8_SCHED;
            PG8_LDB(B1, 1, 1); PG8_STAGE(PG8_SB(1, 0), b3, voffB);
            PG8_BAR; PG8_WAIT_L(0); PG8_MMA(0, 1, At, B1); PG8_BAR;
            PG8_LDA(At, 1, 1); PG8_STAGE(PG8_SA(1, 0), a3, voffA);
            PG8_BAR; PG8_WAIT_L(0); PG8_MMA(1, 0, At, B0); PG8_BAR; PG8_SCHED;
            PG8_STAGE(PG8_SB(1, 1), b3 + hstep, voffB);
            PG8_WAIT_V(6); PG8_BAR; PG8_MMA(1, 1, At, B1); PG8_BAR;
        }
        PG8_STAMP();
        if constexpr (!Epi::AFTER_DRAIN) { E(acc, cur, wr, wc, fr, fq); S.done(cur); }
        PG8_STAMP();
        if (!has_next) break;
#pragma unroll
        for (int a = 0; a < 2; ++a)
#pragma unroll
            for (int b = 0; b < 2; ++b)
#pragma unroll
                for (int m = 0; m < 4; ++m)
#pragma unroll
                    for (int n = 0; n < 2; ++n) acc[a][b][m][n] = (f32x4){0.f, 0.f, 0.f, 0.f};
        cur = nxt; cA = nA; cB = nB; ++ui;
    }
    PG8_WAIT_V(0);
    if (wr == 0) PG8_BAR;
    PG8_BAR;
    if constexpr (Epi::AFTER_DRAIN) { E.fused(acc, cur, wr, wc, fr, fq, lds, wid, lane); S.done(cur); }
    PG8_STAMP();
    if (STAMP && wid == 0) { stamps[lane] = lane < nts ? (((unsigned long long)(unsigned)ts_hi << 32) | (unsigned)ts_lo) : 0ull;
        if (lane == 62) stamps[62] = rt_entry; if (lane == 63) stamps[63] = (unsigned long long)wall_clock64(); }
#undef PG8_STAMP
#undef PG8_SA
#undef PG8_SB
#undef PG8_STAGE
#undef PG8_LDA
#undef PG8_LDB
#undef PG8_MMA
#undef PG8_WAIT_V
#undef PG8_WAIT_L
#undef PG8_BAR
#undef PG8_SCHED
}
}

using namespace pg8;
#define LAS __attribute__((address_space(3)))
typedef short s16x4 __attribute__((ext_vector_type(4)));
typedef short v4i16_t __attribute__((ext_vector_type(4)));
typedef float f32x16 __attribute__((ext_vector_type(16)));
typedef unsigned u32x2 __attribute__((ext_vector_type(2)));
typedef float f32x2v __attribute__((ext_vector_type(2)));

#ifndef NREP_S5
#define NREP_S5 1
#endif
#ifndef NREP_B2
#define NREP_B2 1
#endif
#ifndef NREP_P0
#define NREP_P0 1
#endif
#ifndef MK_PER_PHASE
#define MK_PER_PHASE 0
#endif

constexpr int NTOK = 65536, SEQL = 2048;
constexpr float EPSN = 1e-6f;
constexpr int LDS_BYTES = 155648;
constexpr int S5_WL = 25088;
constexpr int ATT_OFF = 4 * S5_WL;
constexpr int VSTR = 192;
constexpr int ATT_WL = 32 * VSTR;
constexpr int CTR_OFF = LDS_BYTES - 256;
static_assert(ATT_OFF + 8 * ATT_WL <= CTR_OFF, "lds");

constexpr size_t OFF_WIN = 0;
constexpr size_t OFF_WGLU = OFF_WIN + 2ull * 7168 * 1024 * 2;
constexpr size_t OFF_WATT = OFF_WGLU + 2ull * 2048 * 512 * 2;
constexpr size_t OFF_WPW2 = OFF_WATT + 2ull * 1024 * 512 * 2;
constexpr size_t OFF_WOUT = OFF_WPW2 + 2ull * 1024 * 512 * 2;
constexpr size_t OFF_WF1 = OFF_WOUT + 2ull * 1024 * 1024 * 2;
constexpr size_t OFF_WF2 = OFF_WF1 + 2ull * 5632 * 1024 * 2;
constexpr size_t OFF_S5BB = OFF_WF2 + 2ull * 1024 * 2816 * 2;
constexpr size_t OFF_S5CM = OFF_S5BB + 2ull * 32 * 128 * 16 * 2;
constexpr size_t OFF_S5A = OFF_S5CM + 2ull * 32 * 16 * 128 * 2;
constexpr size_t OFF_CONVW = OFF_S5A + 2ull * 32 * 64 * 8;
constexpr size_t OFF_CTL = OFF_CONVW + 65536;
constexpr size_t OFF_RSQ1 = OFF_CTL + 16384;
constexpr size_t OFF_RSQ2 = OFF_RSQ1 + 65536ull * 8;
constexpr size_t OFF_LSE = OFF_RSQ2 + 65536ull * 8;
constexpr size_t OFF_XB = OFF_LSE + 2ull * 65536 * 8 * 4;
constexpr size_t OFF_G = OFF_XB + 65536ull * 1024 * 2;
constexpr size_t OFF_QO = OFF_G + 65536ull * 3072 * 2;
constexpr size_t OFF_CG = OFF_QO + 65536ull * 1536 * 2;
constexpr size_t OFF_HC = OFF_CG + 65536ull * 512 * 2;
constexpr size_t OFF_OC = OFF_HC + 65536ull * 512 * 2;
constexpr size_t WS_END = OFF_OC + 65536ull * 512 * 2;
constexpr size_t DO_U = 0, DO_K = 64ull << 20, DO_V = 128ull << 20, DO_Y = 192ull << 20, DO_MG = 64ull << 20;

struct Params {
    const float* in[24];
    float* out; unsigned char* ws;
    int ph_lo, ph_hi;
};
enum { I_X = 0, I_N1G, I_WIN, I_BGATE, I_LRE, I_LIM, I_LOGDT, I_BRE, I_BIM, I_CRE, I_CIM, I_SSMD, I_WGLU, I_WATT, I_CONVW, I_CONVB, I_LNG, I_LNB, I_WPW2, I_WOUT, I_N2G, I_WF1, I_WF2, I_FING };

__device__ __forceinline__ float bf_lo(unsigned u) { return __uint_as_float(u << 16); }
__device__ __forceinline__ float bf_hi(unsigned u) { return __uint_as_float(u & 0xffff0000u); }
__device__ __forceinline__ float sigm(float x) { return __builtin_amdgcn_rcpf(1.f + __expf(-x)); }
__device__ __forceinline__ unsigned short f2bf(float f) { unsigned u = __float_as_uint(f); u += 0x7FFFu + ((u >> 16) & 1u); return (unsigned short)(u >> 16); }
__device__ __forceinline__ float wave_sum(float v) {
#pragma unroll
    for (int o = 1; o < 64; o <<= 1) v += __shfl_xor(v, o);
    return v;
}
__device__ __forceinline__ s16x4 vtr(const LAS unsigned char* p) { return __builtin_bit_cast(s16x4, __builtin_amdgcn_ds_read_tr16_b64_v4i16((LAS v4i16_t*)p)); }

__device__ __forceinline__ u32x4 pack8(const f32x4 a, const f32x4 b) { u32x4 w; w.x = cvt_pk_bf16(a[0], a[1]); w.y = cvt_pk_bf16(a[2], a[3]); w.z = cvt_pk_bf16(b[0], b[1]); w.w = cvt_pk_bf16(b[2], b[3]); return w; }
__device__ __forceinline__ void unpack8(const u32x4 w, f32x4& a, f32x4& b) { a[0] = bf_lo(w.x); a[1] = bf_hi(w.x); a[2] = bf_lo(w.y); a[3] = bf_hi(w.y); b[0] = bf_lo(w.z); b[1] = bf_hi(w.z); b[2] = bf_lo(w.w); b[3] = bf_hi(w.w); }

struct EpiIn {
    static constexpr bool PERM = true, AFTER_DRAIN = false;
    bf16_t *U, *QO, *Kb, *Vb, *CG, *G; const float* bgate;
    __device__ __forceinline__ void operator()(const f32x4 (&acc)[2][2][4][2], const Unit& u, int wr, int wc, int fr, int fq) const {
        const int row0 = u.pm * 256 + wr * 64 + fr, cl = wc * 32 + 8 * fq, pn = u.pn;
        if (pn < 12) {
            bf16_t* base; int ld, col0;
            if (pn < 2) { base = U; ld = 512; col0 = pn * 256; }
            else if (pn < 8) { base = QO; ld = 1536; col0 = (pn - 2) * 256; }
            else if (pn < 10) { base = Kb; ld = 512; col0 = (pn - 8) * 256; }
            else { base = Vb; ld = 512; col0 = (pn - 10) * 256; }
#pragma unroll
            for (int ai = 0; ai < 2; ++ai)
#pragma unroll
                for (int m = 0; m < 4; ++m) { const int r = row0 + ai * 128 + m * 16;
#pragma unroll
                    for (int bj = 0; bj < 2; ++bj) *(u32x4*)(base + (size_t)r * ld + col0 + bj * 128 + cl) = pack8(acc[ai][bj][m][0], acc[ai][bj][m][1]); }
        } else if (pn < 16) {
            const int c0 = (pn - 12) * 128 + cl;
#pragma unroll
            for (int ai = 0; ai < 2; ++ai)
#pragma unroll
                for (int m = 0; m < 4; ++m) { const int r = row0 + ai * 128 + m * 16;
                    f32x4 o[2];
#pragma unroll
                    for (int n = 0; n < 2; ++n)
#pragma unroll
                        for (int j = 0; j < 4; ++j) o[n][j] = acc[ai][0][m][n][j] * sigm(acc[ai][1][m][n][j]);
                    *(u32x4*)(CG + (size_t)r * 512 + c0) = pack8(o[0], o[1]); }
        } else {
            const int c0 = (pn - 16) * 256 + cl;
            f32x4 bv[2][2];
#pragma unroll
            for (int bj = 0; bj < 2; ++bj)
#pragma unroll
                for (int n = 0; n < 2; ++n) bv[bj][n] = *(const f32x4*)(bgate + c0 + bj * 128 + 4 * n);
#pragma unroll
            for (int ai = 0; ai < 2; ++ai)
#pragma unroll
                for (int m = 0; m < 4; ++m) { const int r = row0 + ai * 128 + m * 16;
#pragma unroll
                    for (int bj = 0; bj < 2; ++bj) { f32x4 o[2];
#pragma unroll
                        for (int n = 0; n < 2; ++n)
#pragma unroll
                            for (int j = 0; j < 4; ++j) o[n][j] = sigm(acc[ai][bj][m][n][j] + bv[bj][n][j]);
                        *(u32x4*)(G + (size_t)r * 3072 + c0 + bj * 128) = pack8(o[0], o[1]); } }
        }
    }
};
struct EpiGluMerge {
    static constexpr bool PERM = true, AFTER_DRAIN = false;
    bf16_t* Mg; const bf16_t* G;
    __device__ __forceinline__ void operator()(const f32x4 (&acc)[2][2][4][2], const Unit& u, int wr, int wc, int fr, int fq) const {
        const int row0 = u.pm * 256 + wr * 64 + fr, c0 = u.pn * 128 + wc * 32 + 8 * fq;
        u32x4 gv[2][4];
#pragma unroll
        for (int ai = 0; ai < 2; ++ai)
#pragma unroll
            for (int m = 0; m < 4; ++m) gv[ai][m] = *(const u32x4*)(G + (size_t)(row0 + ai * 128 + m * 16) * 3072 + c0);
#pragma unroll
        for (int ai = 0; ai < 2; ++ai)
#pragma unroll
            for (int m = 0; m < 4; ++m) { const int r = row0 + ai * 128 + m * 16;
                f32x4 g0, g1; unpack8(gv[ai][m], g0, g1);
                f32x4 o[2];
#pragma unroll
                for (int j = 0; j < 4; ++j) { o[0][j] = g0[j] * acc[ai][0][m][0][j] * sigm(acc[ai][1][m][0][j]); o[1][j] = g1[j] * acc[ai][0][m][1][j] * sigm(acc[ai][1][m][1][j]); }
                *(u32x4*)(Mg + (size_t)r * 1024 + c0) = pack8(o[0], o[1]); }
    }
};
struct EpiAccMerge {
    static constexpr bool PERM = true, AFTER_DRAIN = false;
    bf16_t* Mg; const bf16_t* G; int gate_off;
    __device__ __forceinline__ void operator()(const f32x4 (&acc)[2][2][4][2], const Unit& u, int wr, int wc, int fr, int fq) const {
        const int row0 = u.pm * 256 + wr * 64 + fr, cb = u.pn * 256 + wc * 32 + 8 * fq;
#pragma unroll
        for (int ai = 0; ai < 2; ++ai)
#pragma unroll
          for (int mh = 0; mh < 2; ++mh) {
            u32x4 gv[2][2], mv[2][2];
#pragma unroll
            for (int mm = 0; mm < 2; ++mm)
#pragma unroll
                for (int bj = 0; bj < 2; ++bj) { const int r = row0 + ai * 128 + (2 * mh + mm) * 16, c0 = cb + bj * 128;
                    gv[mm][bj] = *(const u32x4*)(G + (size_t)r * 3072 + gate_off + c0); mv[mm][bj] = *(const u32x4*)(Mg + (size_t)r * 1024 + c0); }
#pragma unroll
            for (int mm = 0; mm < 2; ++mm)
#pragma unroll
                for (int bj = 0; bj < 2; ++bj) { const int m = 2 * mh + mm; const int r = row0 + ai * 128 + m * 16, c0 = cb + bj * 128;
                    f32x4 g0, g1, m0, m1; unpack8(gv[mm][bj], g0, g1); unpack8(mv[mm][bj], m0, m1);
                    *(u32x4*)(Mg + (size_t)r * 1024 + c0) = pack8(m0 + g0 * acc[ai][bj][m][0], m1 + g1 * acc[ai][bj][m][1]); }
            asm volatile("" ::: "memory");
          }
    }
};
struct EpiDelta {
    static constexpr bool PERM = true, AFTER_DRAIN = false;
    bf16_t* D;
    __device__ __forceinline__ void operator()(const f32x4 (&acc)[2][2][4][2], const Unit& u, int wr, int wc, int fr, int fq) const {
        const int row0 = u.pm * 256 + wr * 64 + fr, cb = u.pn * 256 + wc * 32 + 8 * fq;
#pragma unroll
        for (int ai = 0; ai < 2; ++ai)
#pragma unroll
            for (int m = 0; m < 4; ++m)
#pragma unroll
                for (int bj = 0; bj < 2; ++bj) *(u32x4*)(D + (size_t)(row0 + ai * 128 + m * 16) * 1024 + cb + bj * 128) = pack8(acc[ai][bj][m][0], acc[ai][bj][m][1]);
    }
};
struct EpiFfn1 {
    static constexpr bool PERM = true, AFTER_DRAIN = false;
    bf16_t* Hf;
    __device__ __forceinline__ void operator()(const f32x4 (&acc)[2][2][4][2], const Unit& u, int wr, int wc, int fr, int fq) const {
        const int row0 = u.pm * 256 + wr * 64 + fr, c0 = u.pn * 128 + wc * 32 + 8 * fq;
#pragma unroll
        for (int ai = 0; ai < 2; ++ai)
#pragma unroll
            for (int m = 0; m < 4; ++m) { const int r = row0 + ai * 128 + m * 16;
                f32x4 o[2];
#pragma unroll
                for (int n = 0; n < 2; ++n)
#pragma unroll
                    for (int j = 0; j < 4; ++j) { const float a = acc[ai][0][m][n][j], b = acc[ai][1][m][n][j]; o[n][j] = a * sigm(a) * b; }
                *(u32x4*)(Hf + (size_t)r * 2816 + c0) = pack8(o[0], o[1]); }
    }
};

__device__ __forceinline__ void p0_tr_item(const float* W, int K, int N, bf16_t* WT, int kb, int nd0, int ns0, const float* gk, float scale, LAS float* scr, int lane) {
    const int k0 = 64 * kb;
#pragma unroll 8
    for (int i = 0; i < 32; ++i) { const int kk = 2 * i + (lane >> 5); float s = scale; if (gk) s *= gk[k0 + kk]; scr[kk * 33 + (lane & 31)] = W[(size_t)(k0 + kk) * N + ns0 + (lane & 31)] * s; }
    asm volatile("" ::: "memory");
    const int c = lane & 7;
#pragma unroll
    for (int j = 0; j < 4; ++j) { const int n = (lane >> 3) + 8 * j; const LAS float* s = scr + (8 * c) * 33 + n;
        u32x4 o; o.x = cvt_pk_bf16(s[0 * 33], s[1 * 33]); o.y = cvt_pk_bf16(s[2 * 33], s[3 * 33]); o.z = cvt_pk_bf16(s[4 * 33], s[5 * 33]); o.w = cvt_pk_bf16(s[6 * 33], s[7 * 33]);
        *(u32x4*)(WT + (size_t)(nd0 + n) * K + k0 + 8 * c) = o; }
    asm volatile("" ::: "memory");
}
__device__ __forceinline__ void phase_p0(const Params& P, LAS unsigned char* lds, int wave, int lane, int tid) {
    unsigned char* ws = P.ws;
    const int gw = blockIdx.x * 8 + wave, NGW = gridDim.x * 8;
    LAS float* scr = (LAS float*)(lds + wave * 16384);
    constexpr int PER_L = 3584 + 512 + 256 + 256 + 512 + 2816 + 1408;
    for (int it = gw; it < 2 * PER_L; it += NGW) {
        const int l = it / PER_L; int r = it % PER_L;
        const float* W; bf16_t* WT; int K, N, type = 0; const float* gk = nullptr;
        if (r < 3584) { W = P.in[I_WIN] + (size_t)l * 1024 * 7168; WT = (bf16_t*)(ws + OFF_WIN) + (size_t)l * 7168 * 1024; K = 1024; N = 7168; type = 1; gk = P.in[I_N1G] + l * 1024; }
        else if ((r -= 3584) < 512) { W = P.in[I_WGLU] + (size_t)l * 512 * 2048; WT = (bf16_t*)(ws + OFF_WGLU) + (size_t)l * 2048 * 512; K = 512; N = 2048; type = 3; }
        else if ((r -= 512) < 256) { W = P.in[I_WATT] + (size_t)l * 512 * 1024; WT = (bf16_t*)(ws + OFF_WATT) + (size_t)l * 1024 * 512; K = 512; N = 1024; }
        else if ((r -= 256) < 256) { W = P.in[I_WPW2] + (size_t)l * 512 * 1024; WT = (bf16_t*)(ws + OFF_WPW2) + (size_t)l * 1024 * 512; K = 512; N = 1024; }
        else if ((r -= 256) < 512) { W = P.in[I_WOUT] + (size_t)l * 1024 * 1024; WT = (bf16_t*)(ws + OFF_WOUT) + (size_t)l * 1024 * 1024; K = 1024; N = 1024; }
        else if ((r -= 512) < 2816) { W = P.in[I_WF1] + (size_t)l * 1024 * 5632; WT = (bf16_t*)(ws + OFF_WF1) + (size_t)l * 5632 * 1024; K = 1024; N = 5632; type = 2; gk = P.in[I_N2G] + l * 1024; }
        else { r -= 2816; W = P.in[I_WF2] + (size_t)l * 2816 * 1024; WT = (bf16_t*)(ws + OFF_WF2) + (size_t)l * 1024 * 2816; K = 2816; N = 1024; }
        const int nblk = N / 32, kb = r / nblk, nd0 = (r % nblk) * 32;
        int ns0 = nd0; float scale = 1.f;
        if (type == 1) { if (nd0 >= 3072 && nd0 < 4096) { const int t = nd0 - 3072, j = t & 255; ns0 = 3072 + (t >> 8) * 128 + (j & 127) + (j >= 128 ? 512 : 0); }
                         if (nd0 >= 512 && nd0 < 2048) scale = 0.125f * 1.4426950408889634f; }
        else if (type == 2) { const int j = nd0 & 255; ns0 = (nd0 >> 8) * 128 + (j & 127) + (j >= 128 ? 2816 : 0); }
        else if (type == 3) { const int j = nd0 & 255; ns0 = (nd0 >> 8) * 128 + (j & 127) + (j >= 128 ? 1024 : 0); }
        p0_tr_item(W, K, N, WT, kb, nd0, ns0, gk, scale, scr, lane);
    }
    { const float* x = P.in[I_X]; bf16_t* xb = (bf16_t*)(ws + OFF_XB);
      for (int row = gw; row < NTOK; row += NGW) { float ss = 0.f; f32x4 v[4];
#pragma unroll
          for (int j = 0; j < 4; ++j) { const f32x4 t = *(const f32x4*)(x + (size_t)row * 1024 + 4 * lane + 256 * j); u32x2 w; w.x = cvt_pk_bf16(t[0], t[1]); w.y = cvt_pk_bf16(t[2], t[3]);
              *(u32x2*)(xb + (size_t)row * 1024 + 4 * lane + 256 * j) = w; v[j][0] = bf_lo(w.x); v[j][1] = bf_hi(w.x); v[j][2] = bf_lo(w.y); v[j][3] = bf_hi(w.y);
              ss += v[j][0] * v[j][0] + v[j][1] * v[j][1] + v[j][2] * v[j][2] + v[j][3] * v[j][3]; }
          ss = wave_sum(ss); const float rs = rsqrtf(ss * (1.f / 1024.f) + EPSN); if (lane == 0) ((float*)(ws + OFF_RSQ1))[row] = rs;
#pragma unroll
          for (int j = 0; j < 4; ++j) { u32x2 w; w.x = cvt_pk_bf16(v[j][0] * rs, v[j][1] * rs); w.y = cvt_pk_bf16(v[j][2] * rs, v[j][3] * rs); *(u32x2*)((bf16_t*)(ws + OFF_HC) + (size_t)row * 1024 + 4 * lane + 256 * j) = w; } } }
    const int gt = blockIdx.x * 512 + tid, NGT = gridDim.x * 512;
    for (int idx = gt; idx < 2 * 32 * 64; idx += NGT) {
        const int lg = idx >> 6, p = idx & 63;
        const float lre = P.in[I_LRE][idx], lim = P.in[I_LIM][idx], dt = expf(P.in[I_LOGDT][lg]);
        const float mag = expf(lre * dt);
        const double rev = (double)lim * (double)dt * 0.15915494309189535; const float frc = (float)(rev - rint(rev));
        const float sn = __builtin_amdgcn_sinf(frc), cs = __builtin_amdgcn_cosf(frc);
        const float are = mag * cs, aim = mag * sn, nr = are - 1.f, ni = aim, den = lre * lre + lim * lim;
        const float zre = (nr * lre + ni * lim) / den, zim = (ni * lre - nr * lim) / den;
        { f32x2v t2; t2.x = are; t2.y = aim; ((f32x2v*)(ws + OFF_S5A))[idx] = t2; }
        bf16_t* bbt = (bf16_t*)(ws + OFF_S5BB) + (size_t)lg * 128 * 16; bf16_t* cm = (bf16_t*)(ws + OFF_S5CM) + (size_t)lg * 16 * 128;
        for (int h = 0; h < 16; ++h) { const float br = P.in[I_BRE][(size_t)idx * 16 + h], bi = P.in[I_BIM][(size_t)idx * 16 + h];
            bbt[p * 16 + h] = f2bf(zre * br - zim * bi); bbt[(64 + p) * 16 + h] = f2bf(zre * bi + zim * br);
            cm[h * 128 + p] = f2bf(P.in[I_CRE][((size_t)lg * 16 + h) * 64 + p]); cm[h * 128 + 64 + p] = f2bf(-P.in[I_CIM][((size_t)lg * 16 + h) * 64 + p]); }
    }
    for (int idx = gt; idx < 2 * 31 * 256; idx += NGT) { const float a = P.in[I_CONVW][2 * idx], b = P.in[I_CONVW][2 * idx + 1]; ((unsigned*)(ws + OFF_CONVW))[idx] = cvt_pk_bf16(a, b); }
}
template <bool FINAL> __device__ __forceinline__ void phase_rows(const Params& P, int wave, int lane, bool want_xn) {
    const int gw = blockIdx.x * 8 + wave, NGW = gridDim.x * 8;
    bf16_t* xb = (bf16_t*)(P.ws + OFF_XB); const bf16_t* D = (const bf16_t*)(P.ws + OFF_QO); bf16_t* xn = (bf16_t*)(P.ws + OFF_HC); const float* fg = P.in[I_FING];
    for (int row = gw; row < NTOK; row += NGW) {
        const size_t o0 = (size_t)row * 1024 + 8 * lane, o1 = o0 + 512;
        const u32x4 w0 = *(const u32x4*)(xb + o0), w1 = *(const u32x4*)(xb + o1), d0 = *(const u32x4*)(D + o0), d1 = *(const u32x4*)(D + o1);
        f32x4 a0, a1, b0, b1, e0, e1, g0, g1; unpack8(w0, a0, a1); unpack8(w1, b0, b1); unpack8(d0, e0, e1); unpack8(d1, g0, g1);
        const u32x4 n0 = pack8(a0 + e0, a1 + e1), n1 = pack8(b0 + g0, b1 + g1);
        unpack8(n0, a0, a1); unpack8(n1, b0, b1);
        float ss = 0.f;
#pragma unroll
        for (int j = 0; j < 4; ++j) ss += a0[j] * a0[j] + a1[j] * a1[j] + b0[j] * b0[j] + b1[j] * b1[j];
        ss = wave_sum(ss);
        const float rs = rsqrtf(ss * (1.f / 1024.f) + EPSN);
        if (!FINAL) { if (lane == 0) ((float*)(P.ws + OFF_RSQ1))[row] = rs; *(u32x4*)(xb + o0) = n0; *(u32x4*)(xb + o1) = n1; if (want_xn) { *(u32x4*)(xn + o0) = pack8(a0 * rs, a1 * rs); *(u32x4*)(xn + o1) = pack8(b0 * rs, b1 * rs); } }
        else { const f32x4 q0 = *(const f32x4*)(fg + 8 * lane), q1 = *(const f32x4*)(fg + 8 * lane + 4), q2 = *(const f32x4*)(fg + 512 + 8 * lane), q3 = *(const f32x4*)(fg + 512 + 8 * lane + 4);
            float* o = P.out + (size_t)row * 1024;
            *(f32x4*)(o + 8 * lane) = a0 * q0 * rs; *(f32x4*)(o + 8 * lane + 4) = a1 * q1 * rs; *(f32x4*)(o + 512 + 8 * lane) = b0 * q2 * rs; *(f32x4*)(o + 512 + 8 * lane + 4) = b1 * q3 * rs; }
    }
}

__device__ __forceinline__ void s5_item(const Params& P, int l, int it, LAS unsigned char* wl, int lane) {
    const int b = it >> 5, g = it & 31, lg = l * 32 + g;
    LAS float* bu = (LAS float*)wl; LAS unsigned char* sl = wl + 16384;
    const int c32 = lane & 31, hi = lane >> 5, fr = lane & 15, fq = lane >> 4;
    const bf16_t* bbt = (const bf16_t*)(P.ws + OFF_S5BB) + (size_t)lg * 128 * 16; const bf16_t* cm = (const bf16_t*)(P.ws + OFF_S5CM) + (size_t)lg * 16 * 128;
    bf16x8 bbreg[4], cmreg[4];
#pragma unroll
    for (int j = 0; j < 4; ++j) { bbreg[j] = *(const bf16x8*)(bbt + (32 * j + c32) * 16 + 8 * hi); cmreg[j] = *(const bf16x8*)(cm + fr * 128 + 32 * j + 8 * fq); }
    const f32x2v av = ((const f32x2v*)(P.ws + OFF_S5A))[lg * 64 + lane]; const float a_re = av.x, a_im = av.y;
    const float dsk = P.in[I_SSMD][l * 512 + g * 16 + fr];
    float s_re = 0.f, s_im = 0.f;
    const bf16_t* Ub = (const bf16_t*)((unsigned char*)P.out + DO_U) + (size_t)b * SEQL * 512 + g * 16; bf16_t* Yb = (bf16_t*)((unsigned char*)P.out + DO_Y) + (size_t)b * SEQL * 512 + g * 16;
    for (int c = 0; c < 64; ++c) {
        const int t0 = c * 32;
        const bf16x8 ureg = *(const bf16x8*)(Ub + (size_t)(t0 + c32) * 512 + 8 * hi);
        unsigned short uep[2][4];
#pragma unroll
        for (int mt = 0; mt < 2; ++mt)
#pragma unroll
            for (int i = 0; i < 4; ++i) uep[mt][i] = Ub[(size_t)(t0 + 16 * mt + 4 * fq + i) * 512 + fr];
#pragma unroll
        for (int j = 0; j < 4; ++j) { f32x16 a;
#pragma unroll
            for (int r = 0; r < 16; ++r) a[r] = 0.f;
            a = __builtin_amdgcn_mfma_f32_32x32x16_bf16(ureg, bbreg[j], a, 0, 0, 0);
#pragma unroll
            for (int r = 0; r < 16; ++r) { const int tok = (r & 3) + 8 * (r >> 2) + 4 * hi; bu[tok * 128 + ((32 * (j & 1) + c32) << 1) + (j >> 1)] = a[r]; } }
        asm volatile("" ::: "memory");
#pragma unroll 8
        for (int t = 0; t < 32; ++t) { const f32x2v v = *(const LAS f32x2v*)(bu + t * 128 + 2 * lane);
            const float nre = fmaf(a_re, s_re, fmaf(-a_im, s_im, v.x)), nim = fmaf(a_re, s_im, fmaf(a_im, s_re, v.y)); s_re = nre; s_im = nim;
            *(LAS unsigned short*)(sl + t * 272 + lane * 2) = f2bf(s_re); *(LAS unsigned short*)(sl + t * 272 + 128 + lane * 2) = f2bf(s_im); }
        asm volatile("" ::: "memory");
#pragma unroll
        for (int mt = 0; mt < 2; ++mt) { f32x4 ya = {0.f, 0.f, 0.f, 0.f};
#pragma unroll
            for (int ks = 0; ks < 4; ++ks) { const bf16x8 a = *(const LAS bf16x8*)(sl + (16 * mt + fr) * 272 + (32 * ks + 8 * fq) * 2); ya = __builtin_amdgcn_mfma_f32_16x16x32_bf16(a, cmreg[ks], ya, 0, 0, 0); }
#pragma unroll
            for (int i = 0; i < 4; ++i) { const float y = ya[i] + dsk * __uint_as_float((unsigned)uep[mt][i] << 16);
                const float ge = y * sigm(1.5957691216057308f * (y + 0.044715f * y * y * y));
                Yb[(size_t)(t0 + 16 * mt + 4 * fq + i) * 512 + fr] = f2bf(ge); } }
        asm volatile("" ::: "memory");
    }
}

template <int PAT> __device__ __forceinline__ void attn_item(const Params& P, int it, LAS unsigned char* vl, int lane) {
    constexpr int d = PAT == 0 ? 1 : (PAT == 1 ? 4 : 16);
    constexpr int ngrp = (SEQL / d) / 32;
    constexpr int KSTR = 144;
    const int j = it % ngrp; int t = it / ngrp; const int r = t % d; t /= d; const int h = t & 7, b = t >> 3;
    const int c32 = lane & 31, hi = lane >> 5, i0 = 32 * j;
    const int lrow = lane >> 3, lch = lane & 7;
    const size_t tokbase = (size_t)b * SEQL;
    bf16_t* QO = (bf16_t*)(P.ws + OFF_QO); const bf16_t* Kb = (const bf16_t*)((unsigned char*)P.out + DO_K); const bf16_t* Vb = (const bf16_t*)((unsigned char*)P.out + DO_V);
    float* LSE = (float*)(P.ws + OFF_LSE);
    const unsigned char* qrow0 = (const unsigned char*)QO + ((tokbase + (size_t)i0 * d + r) * 1536 + PAT * 512 + h * 64) * 2;
    const unsigned char* krow0 = (const unsigned char*)Kb + ((tokbase + (size_t)(i0 - 128) * d + r) * 512 + h * 64) * 2;
    const unsigned char* vrow0 = (const unsigned char*)Vb + ((tokbase + (size_t)(i0 - 128) * d + r) * 512 + h * 64) * 2;
    const unsigned qlo = (unsigned)(lrow * d * 3072 + lch * 16), klo = (unsigned)(lrow * d * 1024 + lch * 16);
    u32x4 qraw[4], kraw[5][4];
#pragma unroll
    for (int i4 = 0; i4 < 4; ++i4) qraw[i4] = *(const u32x4*)(qrow0 + (qlo + (unsigned)(8 * i4 * d * 3072)));
#pragma unroll
    for (int kt = 0; kt < 5; ++kt) { const int kb = i0 - 128 + 32 * kt;
        if (kb >= 0) {
#pragma unroll
            for (int i4 = 0; i4 < 4; ++i4) kraw[kt][i4] = *(const u32x4*)(krow0 + (klo + (unsigned)((32 * kt + 8 * i4) * d * 1024))); } }
    bf16x8 qreg[4];
#pragma unroll
    for (int i4 = 0; i4 < 4; ++i4) *(LAS u32x4*)(vl + (lrow + 8 * i4) * KSTR + lch * 16) = qraw[i4];
    asm volatile("" ::: "memory");
#pragma unroll
    for (int ks = 0; ks < 4; ++ks) qreg[ks] = *(const LAS bf16x8*)(vl + c32 * KSTR + (16 * ks + 8 * hi) * 2);
    asm volatile("" ::: "memory");
    f32x16 s[5];
#pragma unroll
    for (int kt = 0; kt < 5; ++kt) { const int kb = i0 - 128 + 32 * kt;
        f32x16 a;
        if (kb >= 0) {
#pragma unroll
            for (int q = 0; q < 16; ++q) a[q] = 0.f;
#pragma unroll
            for (int i4 = 0; i4 < 4; ++i4) *(LAS u32x4*)(vl + (lrow + 8 * i4) * KSTR + lch * 16) = kraw[kt][i4];
            asm volatile("" ::: "memory");
#pragma unroll
            for (int ks = 0; ks < 4; ++ks) { const bf16x8 kreg = *(const LAS bf16x8*)(vl + c32 * KSTR + (16 * ks + 8 * hi) * 2); a = __builtin_amdgcn_mfma_f32_32x32x16_bf16(kreg, qreg[ks], a, 0, 0, 0); }
            asm volatile("" ::: "memory");
        } else {
#pragma unroll
            for (int q = 0; q < 16; ++q) a[q] = (-__builtin_inff());
        }
        s[kt] = a; }
    u32x4 vreg[5][4];
#pragma unroll
    for (int kt = 0; kt < 3; ++kt) { const int kb = i0 - 128 + 32 * kt;
        if (kb >= 0) {
#pragma unroll
            for (int i4 = 0; i4 < 4; ++i4) vreg[kt][i4] = *(const u32x4*)(vrow0 + (klo + (unsigned)((32 * kt + 8 * i4) * d * 1024))); } }
#pragma unroll
    for (int q = 0; q < 16; ++q) { const int kr = (q & 3) + 8 * (q >> 2) + 4 * hi; if (kr < c32) s[0][q] = (-__builtin_inff()); if (kr > c32) s[4][q] = (-__builtin_inff()); }
    float mx = (-__builtin_inff());
#pragma unroll
    for (int kt = 0; kt < 5; ++kt)
#pragma unroll
        for (int q = 0; q < 16; ++q) mx = fmaxf(mx, s[kt][q]);
    mx = fmaxf(mx, __shfl_xor(mx, 32));
    float den = 0.f;
#pragma unroll
    for (int kt = 0; kt < 5; ++kt)
#pragma unroll
        for (int q = 0; q < 16; ++q) { const float p = __builtin_amdgcn_exp2f(s[kt][q] - mx); s[kt][q] = p; den += p; }
    den += __shfl_xor(den, 32);
    u32x4 pw[5][2];
#pragma unroll
    for (int kt = 0; kt < 5; ++kt)
#pragma unroll
        for (int ks2 = 0; ks2 < 2; ++ks2) { pw[kt][ks2].x = cvt_pk_bf16(s[kt][8 * ks2 + 0], s[kt][8 * ks2 + 1]); pw[kt][ks2].y = cvt_pk_bf16(s[kt][8 * ks2 + 2], s[kt][8 * ks2 + 3]);
            pw[kt][ks2].z = cvt_pk_bf16(s[kt][8 * ks2 + 4], s[kt][8 * ks2 + 5]); pw[kt][ks2].w = cvt_pk_bf16(s[kt][8 * ks2 + 6], s[kt][8 * ks2 + 7]); }
#pragma unroll
    for (int kt = 3; kt < 5; ++kt) { const int kb = i0 - 128 + 32 * kt;
        if (kb >= 0) {
#pragma unroll
            for (int i4 = 0; i4 < 4; ++i4) vreg[kt][i4] = *(const u32x4*)(vrow0 + (klo + (unsigned)((32 * kt + 8 * i4) * d * 1024))); } }
    u32x4 mraw[2][4]; float l2b = 0.f, l2c = 0.f;
    if (PAT == 0) {
#pragma unroll
        for (int pp = 0; pp < 2; ++pp)
#pragma unroll
            for (int i4 = 0; i4 < 4; ++i4) mraw[pp][i4] = *(const u32x4*)(qrow0 + (qlo + (unsigned)(8 * i4 * 3072 + (pp + 1) * 1024)));
        l2b = LSE[((size_t)(0 * 32 + b) * 8 + h) * SEQL + i0 + c32]; l2c = LSE[((size_t)(1 * 32 + b) * 8 + h) * SEQL + i0 + c32];
    }
    f32x16 o[2];
#pragma unroll
    for (int q = 0; q < 16; ++q) { o[0][q] = 0.f; o[1][q] = 0.f; }
    const int gi = lane >> 4, li = lane & 15;
    const LAS unsigned char* vrd = vl + (4 * hi + (li >> 2)) * VSTR + (16 * (gi & 1) + 4 * (li & 3)) * 2;
#pragma unroll
    for (int kt = 0; kt < 5; ++kt) { const int kb = i0 - 128 + 32 * kt;
        if (kb >= 0) {
#pragma unroll
            for (int i4 = 0; i4 < 4; ++i4) *(LAS u32x4*)(vl + (lrow + 8 * i4) * VSTR + lch * 16) = vreg[kt][i4];
            asm volatile("" ::: "memory");
#pragma unroll
            for (int ks2 = 0; ks2 < 2; ++ks2) {
                const bf16x8 pb = __builtin_bit_cast(bf16x8, pw[kt][ks2]);
#pragma unroll
                for (int mt = 0; mt < 2; ++mt) { const LAS unsigned char* a1 = vrd + (16 * ks2) * VSTR + 64 * mt;
                    const s16x4 lo = vtr(a1), up = vtr(a1 + 8 * VSTR);
                    bf16x8 av; av[0] = lo[0]; av[1] = lo[1]; av[2] = lo[2]; av[3] = lo[3]; av[4] = up[0]; av[5] = up[1]; av[6] = up[2]; av[7] = up[3];
                    o[mt] = __builtin_amdgcn_mfma_f32_32x32x16_bf16(av, pb, o[mt], 0, 0, 0); } }
            asm volatile("" ::: "memory");
        } }
    const float inv = __builtin_amdgcn_rcpf(den);
    const float l2 = mx + __builtin_amdgcn_logf(den);
    const LAS unsigned char* frd = vl + c32 * KSTR + 8 * hi;
    float w1 = inv;
    if (PAT == 0) {
        const float M = fmaxf(l2, fmaxf(l2b, l2c));
        float e1 = __builtin_amdgcn_exp2f(l2 - M), e2 = __builtin_amdgcn_exp2f(l2b - M), e3 = __builtin_amdgcn_exp2f(l2c - M);
        const float wi = __builtin_amdgcn_rcpf(e1 + e2 + e3); w1 = e1 * wi * inv; const float wo[2] = {e2 * wi, e3 * wi};
#pragma unroll
        for (int q = 0; q < 16; ++q) { o[0][q] *= w1; o[1][q] *= w1; }
#pragma unroll
        for (int pp = 0; pp < 2; ++pp) {
#pragma unroll
            for (int i4 = 0; i4 < 4; ++i4) *(LAS u32x4*)(vl + (lrow + 8 * i4) * KSTR + lch * 16) = mraw[pp][i4];
            asm volatile("" ::: "memory");
#pragma unroll
            for (int mt = 0; mt < 2; ++mt)
#pragma unroll
                for (int rg = 0; rg < 4; ++rg) { const u32x2 bb = *(const LAS u32x2*)(frd + 64 * mt + 16 * rg);
                    o[mt][4 * rg] += wo[pp] * bf_lo(bb.x); o[mt][4 * rg + 1] += wo[pp] * bf_hi(bb.x); o[mt][4 * rg + 2] += wo[pp] * bf_lo(bb.y); o[mt][4 * rg + 3] += wo[pp] * bf_hi(bb.y); }
            asm volatile("" ::: "memory");
        }
    } else {
#pragma unroll
        for (int q = 0; q < 16; ++q) { o[0][q] *= w1; o[1][q] *= w1; }
    }
#pragma unroll
    for (int mt = 0; mt < 2; ++mt)
#pragma unroll
        for (int rg = 0; rg < 4; ++rg) { u32x2 w; w.x = cvt_pk_bf16(o[mt][4 * rg], o[mt][4 * rg + 1]); w.y = cvt_pk_bf16(o[mt][4 * rg + 2], o[mt][4 * rg + 3]);
            *(LAS u32x2*)(vl + c32 * KSTR + 8 * hi + 64 * mt + 16 * rg) = w; }
    asm volatile("" ::: "memory");
    if (PAT != 0) {
#pragma unroll
        for (int i4 = 0; i4 < 4; ++i4) *(u32x4*)((unsigned char*)qrow0 + (qlo + (unsigned)(8 * i4 * d * 3072))) = *(const LAS u32x4*)(vl + (lrow + 8 * i4) * KSTR + lch * 16);
        if (hi == 0) LSE[((size_t)((PAT - 1) * 32 + b) * 8 + h) * SEQL + (size_t)(i0 + c32) * d + r] = l2;
    } else {
        bf16_t* OC = (bf16_t*)(P.ws + OFF_OC);
#pragma unroll
        for (int i4 = 0; i4 < 4; ++i4) *(u32x4*)(OC + (tokbase + (size_t)(i0 + lrow + 8 * i4)) * 512 + h * 64 + lch * 8) = *(const LAS u32x4*)(vl + (lrow + 8 * i4) * KSTR + lch * 16);
    }
    asm volatile("" ::: "memory");
}

__device__ __forceinline__ void conv_item(const Params& P, int l, int it, int lane, const LAS unsigned char* wlds) {
    const int b = it >> 8, t0 = (it & 255) * 8, ch0 = 8 * lane;
    const bf16_t* in = (const bf16_t*)(P.ws + OFF_CG) + (size_t)b * SEQL * 512 + ch0;
    const LAS unsigned char* cw = wlds + 16 * lane;
    float acc[8][8], win[8][8];
    { const f32x4 b0 = *(const f32x4*)(P.in[I_CONVB] + l * 512 + ch0), b1 = *(const f32x4*)(P.in[I_CONVB] + l * 512 + ch0 + 4);
#pragma unroll
      for (int i = 0; i < 8; ++i) { acc[i][0] = b0[0]; acc[i][1] = b0[1]; acc[i][2] = b0[2]; acc[i][3] = b0[3]; acc[i][4] = b1[0]; acc[i][5] = b1[1]; acc[i][6] = b1[2]; acc[i][7] = b1[3]; } }
#define CONV_LOADROW(rr, dst) do { const int t_ = t0 - 30 + (rr); if (t_ >= 0) { const u32x4 v_ = *(const u32x4*)(in + (size_t)t_ * 512); \
        dst[0] = bf_lo(v_.x); dst[1] = bf_hi(v_.x); dst[2] = bf_lo(v_.y); dst[3] = bf_hi(v_.y); dst[4] = bf_lo(v_.z); dst[5] = bf_hi(v_.z); dst[6] = bf_lo(v_.w); dst[7] = bf_hi(v_.w); } \
        else { _Pragma("unroll") for (int c_ = 0; c_ < 8; ++c_) dst[c_] = 0.f; } } while (0)
#pragma unroll
    for (int rr = 0; rr < 8; ++rr) CONV_LOADROW(rr, win[rr]);
    for (int jb = 0; jb < 32; jb += 8) {
        asm volatile("" ::: "memory");
#pragma unroll
        for (int jj = 0; jj < 8; ++jj) { const int j = jb + jj;
            if (j < 31) { const u32x4 wv = *(const LAS u32x4*)(cw + j * 1024);
                float w[8]; w[0] = bf_lo(wv.x); w[1] = bf_hi(wv.x); w[2] = bf_lo(wv.y); w[3] = bf_hi(wv.y); w[4] = bf_lo(wv.z); w[5] = bf_hi(wv.z); w[6] = bf_lo(wv.w); w[7] = bf_hi(wv.w);
#pragma unroll
                for (int i = 0; i < 8; ++i)
#pragma unroll
                    for (int c = 0; c < 8; ++c) acc[i][c] = fmaf(w[c], win[(jj + i) & 7][c], acc[i][c]);
                if (j + 8 < 38) CONV_LOADROW(j + 8, win[jj]); } }
    }
#undef CONV_LOADROW
    const f32x4 g0 = *(const f32x4*)(P.in[I_LNG] + l * 512 + ch0), g1 = *(const f32x4*)(P.in[I_LNG] + l * 512 + ch0 + 4);
    const f32x4 e0 = *(const f32x4*)(P.in[I_LNB] + l * 512 + ch0), e1 = *(const f32x4*)(P.in[I_LNB] + l * 512 + ch0 + 4);
    bf16_t* outp = (bf16_t*)(P.ws + OFF_HC) + ((size_t)b * SEQL + t0) * 512 + ch0;
#pragma unroll
    for (int i = 0; i < 8; ++i) { float s1 = 0.f, s2 = 0.f;
#pragma unroll
        for (int c = 0; c < 8; ++c) { s1 += acc[i][c]; s2 += acc[i][c] * acc[i][c]; }
        s1 = wave_sum(s1); s2 = wave_sum(s2);
        const float mean = s1 * (1.f / 512.f), var = fmaxf(s2 * (1.f / 512.f) - mean * mean, 0.f), rs = rsqrtf(var + EPSN);
        f32x4 y0, y1;
#pragma unroll
        for (int c = 0; c < 4; ++c) { const float h0 = (acc[i][c] - mean) * rs * g0[c] + e0[c], h1 = (acc[i][4 + c] - mean) * rs * g1[c] + e1[c]; y0[c] = h0 * sigm(h0); y1[c] = h1 * sigm(h1); }
        *(u32x4*)(outp + (size_t)i * 512) = pack8(y0, y1); }
}

__device__ __forceinline__ int xcc_id() { return (int)(__builtin_amdgcn_s_getreg((3 << 11) | 20) & 7u); }
__device__ __forceinline__ int claim_issue(unsigned* ctr, int& lane) { asm volatile("" : "+v"(lane)); int v = 0; if (lane == 0) v = (int)atomicAdd(ctr, 1u); return v; }
__device__ __forceinline__ int lane_now() { int l = (int)__builtin_amdgcn_mbcnt_hi(~0u, __builtin_amdgcn_mbcnt_lo(~0u, 0u)); asm volatile("" : "+v"(l)); return l; }
__device__ __forceinline__ int lds_claim(LAS unsigned* ctr, int lane) { int v = 0; if (lane == 0) v = (int)__hip_atomic_fetch_add(ctr, 1u, __ATOMIC_RELAXED, __HIP_MEMORY_SCOPE_WORKGROUP); return __builtin_amdgcn_readfirstlane(v); }
__device__ __forceinline__ int claim(unsigned* ctr, int& lane) { asm volatile("" : "+v"(lane)); int v = 0; if (lane == 0) v = (int)atomicAdd(ctr, 1u); return __builtin_amdgcn_readfirstlane(v); }


__device__ __forceinline__ void grid_barrier(unsigned* bar, unsigned target, int tid) {
    asm volatile("s_waitcnt vmcnt(0) lgkmcnt(0)" ::: "memory");
    __syncthreads();
    if (tid == 0) {
        __builtin_amdgcn_fence(__ATOMIC_RELEASE, "agent");
        asm volatile("s_waitcnt vmcnt(0) lgkmcnt(0)" ::: "memory");
        __hip_atomic_fetch_add(bar, 1u, __ATOMIC_RELAXED, __HIP_MEMORY_SCOPE_AGENT);
        while (__hip_atomic_load(bar, __ATOMIC_RELAXED, __HIP_MEMORY_SCOPE_AGENT) < target) __builtin_amdgcn_s_sleep(2);
        __builtin_amdgcn_fence(__ATOMIC_ACQUIRE, "agent");
        asm volatile("s_waitcnt vmcnt(0) lgkmcnt(0)" ::: "memory");
    }
    __syncthreads();
}


#define XB_TMO      128
#define XB_XCNT(j)  (256  + 64 * (j))
#define XB_XSUB(j)  (1280 + 64 * (j))
#define XB_XGEN(j)  (2304 + 64 * (j))
#define XB_TOP      3328
#define XB_TOPGEN   3392
#define XB_SPIN_CAP (1u << 22)
__device__ __forceinline__ unsigned xb_ld(unsigned* p)              { return __hip_atomic_load(p, __ATOMIC_RELAXED, __HIP_MEMORY_SCOPE_AGENT); }
__device__ __forceinline__ unsigned xb_add(unsigned* p, unsigned v) { return __hip_atomic_fetch_add(p, v, __ATOMIC_RELAXED, __HIP_MEMORY_SCOPE_AGENT); }
#define XB_SPIN(cond, bar) do { unsigned _sp = 0; while (cond) { __builtin_amdgcn_s_sleep(1); \
    if ((++_sp & 255u) == 0u) { if (xb_ld(&(bar)[XB_TMO])) break; if (_sp > XB_SPIN_CAP) { atomicAdd(&(bar)[XB_TMO], 1u); break; } } } } while (0)
__device__ __forceinline__ void xcd_barrier_complete(unsigned* bar, unsigned x, unsigned& nloc, unsigned& nx) {
    const unsigned G = gridDim.x;
    unsigned sum, cnt, mine, sp = 0u;
    for (;;) {
        sum = 0u; cnt = 0u; mine = 0u;
#pragma unroll
        for (unsigned j = 0; j < 16; ++j) { const unsigned c = xb_ld(&bar[XB_XCNT(j)]); sum += c; cnt += (c > 0u) ? 1u : 0u; mine = (j == x) ? c : mine; }
        if (sum == G) break;
        __builtin_amdgcn_s_sleep(1);
        if ((++sp & 255u) == 0u) { if (xb_ld(&bar[XB_TMO])) break; if (sp > XB_SPIN_CAP) { atomicAdd(&bar[XB_TMO], 1u); break; } }
    }
    nloc = mine > 0u ? mine : 1u; nx = cnt > 0u ? cnt : 1u;
}
__device__ __forceinline__ void xcd_barrier(unsigned* bar, LAS unsigned char* lds, int tid) {
    const unsigned x = (unsigned)__builtin_amdgcn_s_getreg((3 << 11) | 20) & 0xFu; volatile LAS unsigned* st = (volatile LAS unsigned*)(lds + CTR_OFF + 64);
    asm volatile("s_waitcnt vmcnt(0) lgkmcnt(0)" ::: "memory");
    __syncthreads();
    if (tid == 0) {
        unsigned nloc = st[0], nx = st[1];
        if (nloc == 0u) { xcd_barrier_complete(bar, x, nloc, nx); st[0] = nloc; st[1] = nx; }
        const unsigned old = xb_add(&bar[XB_XSUB(x)], 1u);
        const unsigned gen = old / nloc;
        if (old + 1u == (gen + 1u) * nloc) {
            __builtin_amdgcn_fence(__ATOMIC_RELEASE, "agent");
            asm volatile("s_waitcnt vmcnt(0)" ::: "memory");
            const unsigned og = xb_add(&bar[XB_TOP], 1u);
            const unsigned tg = og / nx;
            if (og + 1u == (tg + 1u) * nx) xb_add(&bar[XB_TOPGEN], 1u);
            else XB_SPIN(xb_ld(&bar[XB_TOPGEN]) == tg, bar);
            __builtin_amdgcn_fence(__ATOMIC_ACQUIRE, "agent");
            xb_add(&bar[XB_XGEN(x)], 1u);
            asm volatile("s_waitcnt vmcnt(0)" ::: "memory");
        } else {
            XB_SPIN(xb_ld(&bar[XB_XGEN(x)]) == gen, bar);
            __builtin_amdgcn_fence(__ATOMIC_ACQUIRE, "agent");
            asm volatile("s_waitcnt vmcnt(0)" ::: "memory");
        }
    }
    __syncthreads();
}

constexpr int NPHASE = 21;
__global__ void __launch_bounds__(512, 2) fwd_kernel(Params P) {
    extern __shared__ __attribute__((aligned(16))) unsigned char shm[];
    LAS unsigned char* lds = (LAS unsigned char*)shm;
        unsigned char* ws = P.ws; unsigned char* dout = (unsigned char*)P.out;
    bf16_t* xb = (bf16_t*)(ws + OFF_XB); bf16_t* Gt = (bf16_t*)(ws + OFF_G); bf16_t* Mg = (bf16_t*)(dout + DO_MG);
    bf16_t* xn = (bf16_t*)(ws + OFF_HC); bf16_t* Dl = (bf16_t*)(ws + OFF_QO);
    unsigned* ctl = (unsigned*)(ws + OFF_CTL);
    StaticOrder S;
    unsigned nbar = 0;
    const int wave_s = __builtin_amdgcn_readfirstlane((int)threadIdx.x >> 6);
    if (P.ph_hi - P.ph_lo > 1) cg::this_grid().sync();
    { volatile LAS unsigned* xst = (volatile LAS unsigned*)(lds + CTR_OFF + 64);
      const unsigned xcc = (unsigned)__builtin_amdgcn_s_getreg((3 << 11) | 20) & 0xFu;
      if (threadIdx.x == 0) { xst[0] = 0u; xst[1] = 0u; (void)xb_add(&ctl[XB_XCNT(xcc)], 1u); }
      __syncthreads(); }
    for (int ph = P.ph_lo; ph < P.ph_hi; ++ph) {
        const int wave = wave_s;
#define PHASE_IDS const int lane = lane_now(); const int tid = (wave_s << 6) | lane; (void)tid; (void)lane;
        if (ph == 0) { PHASE_IDS for (int rp = 0; rp < NREP_P0; ++rp) phase_p0(P, lds, wave, lane, tid); }
        else if (ph == NPHASE - 1) { PHASE_IDS phase_rows<true>(P, wave, lane, false); }
        else {
            const int l = (ph - 1) / 10, s = (ph - 1) % 10;
            if (s == 0) { PHASE_IDS
                S.init(NTOK, 7168, gridDim.x, blockIdx.x);
                Gemm g{xn, (const bf16_t*)(ws + OFF_WIN) + (size_t)l * 7168 * 1024, NTOK, 7168, 1024};
                EpiIn E{(bf16_t*)(dout + DO_U), (bf16_t*)(ws + OFF_QO), (bf16_t*)(dout + DO_K), (bf16_t*)(dout + DO_V), (bf16_t*)(ws + OFF_CG), Gt, P.in[I_BGATE] + l * 3072};
                gemm_phase<EpiIn, StaticOrder, false>(lds, g, S, E, nullptr, tid);
            } else if (s == 1) { PHASE_IDS
                LAS unsigned* lctr = (LAS unsigned*)(lds + CTR_OFF);
                if (tid == 0) lctr[0] = 0u;
                __syncthreads();
                const int grp = blockIdx.x & 7, rank = blockIdx.x >> 3; constexpr int per = 128;
                if (wave < 4) { for (int it = blockIdx.x * 4 + wave; it < 1024; it += gridDim.x * 4) s5_item(P, l, it, lds + wave * S5_WL, lane_now()); }
                LAS unsigned char* vl = lds + ATT_OFF + wave * ATT_WL;
                for (;;) { const int ln = lane_now(); const int k = lds_claim(lctr, ln); const int li = rank * per + k; if (k >= per || li >= 4096) break;
                    const int b = grp + 8 * (li >> 10), rest = li & 1023;
                    if (rest < 512) attn_item<1>(P, b * 512 + rest, vl, ln); else attn_item<2>(P, b * 512 + rest - 512, vl, ln); }
            } else if (s == 2) { PHASE_IDS
                LAS unsigned* lctr = (LAS unsigned*)(lds + CTR_OFF);
                if (tid == 0) lctr[0] = 0u;
                { const unsigned* cwg = (const unsigned*)(ws + OFF_CONVW) + (size_t)l * 31 * 256;
                  for (int i = tid; i < 31 * 64; i += 512) *(LAS u32x4*)(lds + i * 16) = *(const u32x4*)(cwg + i * 4); }
                __syncthreads();
                const int grp = blockIdx.x & 7, rank = blockIdx.x >> 3; constexpr int per = 96;
                LAS unsigned char* vl = lds + ATT_OFF + wave * ATT_WL;
                for (;;) { const int ln = lane_now(); const int k = lds_claim(lctr, ln); const int li = rank * per + k; if (k >= per || li >= 3072) break;
                    const int b = grp + 8 * (li / 768), rest = li % 768;
                    if (rest < 512) attn_item<0>(P, b * 512 + rest, vl, ln); else conv_item(P, l, b * 256 + rest - 512, ln, lds); }
            } else if (s == 3) { PHASE_IDS
                S.init(NTOK, 2048, gridDim.x, blockIdx.x);
                Gemm g{(const bf16_t*)(dout + DO_Y), (const bf16_t*)(ws + OFF_WGLU) + (size_t)l * 2048 * 512, NTOK, 2048, 512};
                EpiGluMerge E{Mg, Gt};
                gemm_phase<EpiGluMerge, StaticOrder, false>(lds, g, S, E, nullptr, tid);
            } else if (s == 4) { PHASE_IDS
                S.init(NTOK, 1024, gridDim.x, blockIdx.x);
                for (int c = 0; c < 2; ++c) {
                    Gemm g{(const bf16_t*)(ws + (c == 0 ? OFF_HC : OFF_OC)), (const bf16_t*)(ws + (c == 0 ? OFF_WPW2 : OFF_WATT)) + (size_t)l * 1024 * 512, NTOK, 1024, 512};
                    EpiAccMerge E{Mg, Gt, c == 0 ? 2048 : 1024};
                    gemm_phase<EpiAccMerge, StaticOrder, false>(lds, g, S, E, nullptr, tid);
                    __syncthreads();
                }
            } else if (s == 6 || s == 9) { PHASE_IDS
                phase_rows<false>(P, wave, lane, true);
            } else if (s == 5 || s == 8) { PHASE_IDS
                S.init(NTOK, 1024, gridDim.x, blockIdx.x);
                Gemm g{s == 5 ? (const bf16_t*)Mg : (const bf16_t*)Gt, s == 5 ? (const bf16_t*)(ws + OFF_WOUT) + (size_t)l * 1024 * 1024 : (const bf16_t*)(ws + OFF_WF2) + (size_t)l * 1024 * 2816, NTOK, 1024, s == 5 ? 1024 : 2816};
                EpiDelta E{Dl};
                gemm_phase<EpiDelta, StaticOrder, false>(lds, g, S, E, nullptr, tid);
            } else {
                PHASE_IDS
                S.init(NTOK, 5632, gridDim.x, blockIdx.x);
                Gemm g{xn, (const bf16_t*)(ws + OFF_WF1) + (size_t)l * 5632 * 1024, NTOK, 5632, 1024};
                EpiFfn1 E{Gt};
                gemm_phase<EpiFfn1, StaticOrder, false>(lds, g, S, E, nullptr, tid);
            }
        }
        if (ph + 1 < P.ph_hi) xcd_barrier(ctl, lds, (wave_s << 6) | lane_now());
    }
}

extern "C" void kernel_launch(void* const* d_in, const int* in_sizes, int n_in, void* d_out, int out_size, void* d_ws, size_t ws_size, hipStream_t stream) {
    static int grid = 0;
    if (grid == 0) {
        if (n_in != 24 || out_size != NTOK * 1024 || ws_size < WS_END) { fprintf(stderr, "kernel_launch: unexpected problem (n_in %d out %d ws %zu need %zu)\n", n_in, out_size, ws_size, (size_t)WS_END); grid = -1; return; }
        int dev = 0, cus = 0, per_cu = 0;
        hipGetDevice(&dev); hipDeviceGetAttribute(&cus, hipDeviceAttributeMultiprocessorCount, dev);
        if (hipFuncSetAttribute((const void*)fwd_kernel, hipFuncAttributeMaxDynamicSharedMemorySize, LDS_BYTES) != hipSuccess) { fprintf(stderr, "kernel_launch: hipFuncSetAttribute failed\n"); grid = -1; return; }
        hipOccupancyMaxActiveBlocksPerMultiprocessor(&per_cu, (const void*)fwd_kernel, 512, LDS_BYTES);
        if (per_cu < 1) { fprintf(stderr, "kernel_launch: occupancy query says %d blocks/CU\n", per_cu); per_cu = 1; }
        (void)hipGetLastError();
        grid = cus * per_cu; if (grid > 256) grid = 256;
        if (grid != 256) { fprintf(stderr, "kernel_launch: this build partitions its work over exactly 256 workgroups (got %d)\n", grid); grid = -1; return; }
    }
    if (grid < 0) return;
    hipMemsetAsync((unsigned char*)d_ws + OFF_CTL, 0, 16384, stream);
    Params p{};
    for (int i = 0; i < 24; ++i) p.in[i] = (const float*)d_in[i];
    p.out = (float*)d_out; p.ws = (unsigned char*)d_ws;
#if MK_PER_PHASE
    for (int ph = 0; ph < NPHASE; ++ph) { p.ph_lo = ph; p.ph_hi = ph + 1; hipLaunchKernelGGL(fwd_kernel, dim3(grid), dim3(512), LDS_BYTES, stream, p); }
#else
    p.ph_lo = 0; p.ph_hi = NPHASE;
    void* args[] = {&p};
    hipError_t e = hipLaunchCooperativeKernel((const void*)fwd_kernel, dim3(grid), dim3(512), args, LDS_BYTES, stream);
    if (e != hipSuccess) fprintf(stderr, "cooperative launch failed: %s (grid %d)\n", hipGetErrorString(e), grid);
#endif
}
```

```cpp
#include <hip/hip_runtime.h>
#include <hip/hip_cooperative_groups.h>
#include <cstdio>
namespace cg = cooperative_groups;
namespace pg8 {
#define PG8_LAS __attribute__((address_space(3)))
typedef unsigned short bf16_t;
typedef short bf16x8 __attribute__((ext_vector_type(8)));
typedef float f32x4 __attribute__((ext_vector_type(4)));
typedef unsigned u32x4 __attribute__((ext_vector_type(4)));
constexpr int BM = 256, BK = 64, HALF = 128, HTB = HALF * BK * 2  , STAGE_BYTES = 8 * HTB, NXCD = 8, WGM = 8;

__host__ __device__ __forceinline__ int lds_byte(int r, int c) { const int st = (r >> 4) * 2 + (c >> 5), rr = r & 15, cc = c & 31, ob = rr * 64 + cc * 2; return st * 1024 + (ob ^ (((ob >> 9) & 1) << 5)); }
__host__ __device__ __forceinline__ void stage_rc(int b, int& R, int& C) { const int st = b / 1024, sb = b % 1024, swz = sb ^ (((sb >> 9) & 1) << 5); R = (st >> 1) * 16 + swz / 64; C = (st & 1) * 32 + (swz % 64) / 2; }
__host__ __device__ __forceinline__ int perm32(int rho) { const int n = rho >> 4, i = rho & 15; return 8 * (i >> 2) + 4 * n + (i & 3); }

struct Unit { int pm, pn; };
struct Gemm { const bf16_t* A; const bf16_t* Bt; int M, N, K; };

struct StaticOrder {
    int nM, nN, nwg, G, c;
    __host__ __device__ void init(int M, int N, int G_, int c_) { nM = M / BM; nN = N / BM; nwg = nM * nN; G = G_; c = c_; }
    __host__ __device__ bool next(int i, Unit& u) const {
        const long L = (long)i * G + c; if (L >= nwg) return false;
        int wgid = (int)L; { const int q = nwg / NXCD, r = nwg % NXCD, xcd = wgid % NXCD, off = wgid / NXCD; wgid = (xcd < r ? xcd * (q + 1) : r * (q + 1) + (xcd - r) * q) + off; }
        const int nig = WGM * nN, gid = wgid / nig, fm = gid * WGM, gsz = (nM - fm) < WGM ? (nM - fm) : WGM;
        u.pm = fm + ((wgid % nig) % gsz); u.pn = (wgid % nig) / gsz; return true;
    }
    __device__ __forceinline__ void a_ready(const Unit&) const {}
    __device__ __forceinline__ void done(const Unit&) const {}
};
__device__ __forceinline__ unsigned cvt_pk_bf16(float lo, float hi) { unsigned r; asm volatile("s_nop 1\n\tv_cvt_pk_bf16_f32 %0, %1, %2" : "=v"(r) : "v"(lo), "v"(hi)); return r; }
template <class Epi, class Sched, bool STAMP = false>
__device__ __forceinline__ void gemm_phase(PG8_LAS unsigned char* lds, const Gemm g, const Sched& S, const Epi& E, unsigned long long* stamps, int tid_in) {
    int tid_o = tid_in; asm volatile("" : "+v"(tid_o)); const int tid = tid_o, wid = __builtin_amdgcn_readfirstlane(tid >> 6), lane = tid & 63, wr = wid >> 2, wc = wid & 3, fr = lane & 15, fq = lane >> 4;
    const int K = g.K, nt = K / BK;
    int ts_lo = 0, ts_hi = 0, nts = 0; const unsigned long long rt_entry = STAMP ? (unsigned long long)wall_clock64() : 0ull;
#define PG8_STAMP() do { if (STAMP && wid == 0 && nts < 64) { const unsigned long long _c = (unsigned long long)clock64(); \
        ts_lo = (lane == nts) ? (int)(unsigned)_c : ts_lo; ts_hi = (lane == nts) ? (int)(unsigned)(_c >> 32) : ts_hi; ++nts; } } while (0)
    PG8_STAMP();
    unsigned voffA[2], voffB[2];
#pragma unroll
    for (int i = 0; i < 2; ++i) { int R, C; stage_rc(tid * 16 + i * 8192, R, C); const int Rb = Epi::PERM ? ((R & ~31) + perm32(R & 31)) : R;
        voffA[i] = (unsigned)(R * K + C) * 2u; voffB[i] = (unsigned)(Rb * K + C) * 2u; }
    const size_t kstep = (size_t)(BK * 2);
    const size_t hstep = (size_t)HALF * K * 2;
    const size_t tstep = 2 * hstep;
    const unsigned ldsw = (unsigned)wid * 1024u;
    const int aoff = lds_byte(wr * 64 + fr, fq * 8), boff = lds_byte(wc * 32 + fr, fq * 8);
#define PG8_SA(b, h) (((b) * 2 + (h)) * HTB)
#define PG8_SB(b, h) ((4 + (b) * 2 + (h)) * HTB)
#define PG8_STAGE(bufoff, gbase, voff) do { _Pragma("unroll") for (int _i = 0; _i < 2; ++_i) \
        __builtin_amdgcn_global_load_lds((const unsigned*)((const char*)(gbase) + (voff)[_i]), (PG8_LAS unsigned*)(lds + (bufoff) + ldsw + _i * 8192), 16, 0, 0); } while (0)
#define PG8_LDA(dst, b, h) do { _Pragma("unroll") for (int m = 0; m < 4; ++m) _Pragma("unroll") for (int k = 0; k < 2; ++k) dst[m][k] = *(const PG8_LAS bf16x8*)(lds + PG8_SA(b, h) + aoff + m * 2048 + k * 1024); } while (0)
#define PG8_LDB(dst, b, h) do { _Pragma("unroll") for (int n = 0; n < 2; ++n) _Pragma("unroll") for (int k = 0; k < 2; ++k) dst[n][k] = *(const PG8_LAS bf16x8*)(lds + PG8_SB(b, h) + boff + n * 2048 + k * 1024); } while (0)
#define PG8_MMA(ai, bj, At, Bt) do { __builtin_amdgcn_s_setprio(1); _Pragma("unroll") for (int m = 0; m < 4; ++m) _Pragma("unroll") for (int n = 0; n < 2; ++n) _Pragma("unroll") for (int k = 0; k < 2; ++k) \
        acc[ai][bj][m][n] = __builtin_amdgcn_mfma_f32_16x16x32_bf16(Bt[n][k], At[m][k], acc[ai][bj][m][n], 0, 0, 0); __builtin_amdgcn_s_setprio(0); } while (0)
#define PG8_WAIT_V(n) asm volatile("s_waitcnt vmcnt(" #n ")" ::: "memory")
#define PG8_WAIT_L(n) asm volatile("s_waitcnt lgkmcnt(" #n ")" ::: "memory")
#define PG8_BAR __builtin_amdgcn_s_barrier()
#define PG8_SCHED __builtin_amdgcn_sched_barrier(0)
    Unit cur, nxt; int ui = 0;
    if (!S.next(0, cur)) return;
    f32x4 acc[2][2][4][2];
#pragma unroll
    for (int a = 0; a < 2; ++a)
#pragma unroll
        for (int b = 0; b < 2; ++b)
#pragma unroll
            for (int m = 0; m < 4; ++m)
#pragma unroll
                for (int n = 0; n < 2; ++n) acc[a][b][m][n] = (f32x4){0.f, 0.f, 0.f, 0.f};
    bf16x8 At[4][2], B0[2][2], B1[2][2];
    const char* cA = (const char*)g.A + (size_t)cur.pm * tstep; const char* cB = (const char*)g.Bt + (size_t)cur.pn * tstep;
    S.a_ready(cur);
    PG8_STAGE(PG8_SB(0, 0), cB, voffB); PG8_STAGE(PG8_SA(0, 0), cA, voffA); PG8_STAGE(PG8_SB(0, 1), cB + hstep, voffB); PG8_STAGE(PG8_SA(0, 1), cA + hstep, voffA);
    if (wr == 1) PG8_BAR;
    PG8_WAIT_V(4); PG8_BAR;
    PG8_STAGE(PG8_SB(1, 0), cB + kstep, voffB); PG8_STAGE(PG8_SA(1, 0), cA + kstep, voffA); PG8_STAGE(PG8_SB(1, 1), cB + hstep + kstep, voffB);
    PG8_WAIT_V(6); PG8_BAR;
    PG8_STAMP();
    for (;;) {
        const bool has_next = S.next(ui + 1, nxt);
        const char* nA = has_next ? (const char*)g.A + (size_t)nxt.pm * tstep : cA; const char* nB = has_next ? (const char*)g.Bt + (size_t)nxt.pn * tstep : cB;
        for (int t = 0; t < nt; t += 2) {
            const bool last = (t == nt - 2);
            const char* a1 = cA + (size_t)(t + 1) * kstep;
            const char* a2 = last ? nA : cA + (size_t)(t + 2) * kstep; const char* b2 = last ? nB : cB + (size_t)(t + 2) * kstep;
            const char* a3 = a2 + kstep; const char* b3 = b2 + kstep;
            if (last && has_next) S.a_ready(nxt);
            PG8_LDB(B0, 0, 0); PG8_SCHED; PG8_LDA(At, 0, 0); PG8_STAGE(PG8_SA(1, 1), a1 + hstep, voffA);
            PG8_WAIT_L(8); PG8_BAR; PG8_WAIT_L(0); PG8_MMA(0, 0, At, B0); PG8_BAR; PG8_SCHED;
            PG8_LDB(B1, 0, 1); PG8_STAGE(PG8_SB(0, 0), b2, voffB);
            PG8_BAR; PG8_WAIT_L(0); PG8_MMA(0, 1, At, B1); PG8_BAR;
            PG8_LDA(At, 0, 1); PG8_STAGE(PG8_SA(0, 0), a2, voffA);
            PG8_BAR; PG8_WAIT_L(0); PG8_MMA(1, 0, At, B0); PG8_BAR; PG8_SCHED;
            PG8_STAGE(PG8_SB(0, 1), b2 + hstep, voffB);
            PG8_WAIT_V(6); PG8_BAR; PG8_MMA(1, 1, At, B1); PG8_BAR;
            PG8_LDB(B0, 1, 0); PG8_SCHED; PG8_LDA(At, 1, 0); PG8_STAGE(PG8_SA(0, 1), a2 + hstep, voffA);
            PG8_WAIT_L(8); PG8_BAR; PG8_WAIT_L(0); PG8_MMA(0, 0, At, B0); PG8_BAR; PG8_SCHED;
            PG8_LDB(B1, 1, 1); PG8_STAGE(PG8_SB(1, 0), b3, voffB);
            PG8_BAR; PG8_WAIT_L(0); PG8_MMA(0, 1, At, B1); PG8_BAR;
            PG8_LDA(At, 1, 1); PG8_STAGE(PG8_SA(1, 0), a3, voffA);
            PG8_BAR; PG8_WAIT_L(0); PG8_MMA(1, 0, At, B0); PG8_BAR; PG8_SCHED;
            PG8_STAGE(PG8_SB(1, 1), b3 + hstep, voffB);
            PG8_WAIT_V(6); PG8_BAR; PG8_MMA(1, 1, At, B1); PG8_BAR;
        }
        PG8_STAMP();
        if constexpr (!Epi::AFTER_DRAIN) { E(acc, cur, wr, wc, fr, fq); S.done(cur); }
        PG8_STAMP();
        if (!has_next) break;
#pragma unroll
        for (int a = 0; a < 2; ++a)
#pragma unroll
            for (int b = 0; b < 2; ++b)
#pragma unroll
                for (int m = 0; m < 4; ++m)
#pragma unroll
                    for (int n = 0; n < 2; ++n) acc[a][b][m][n] = (f32x4){0.f, 0.f, 0.f, 0.f};
        cur = nxt; cA = nA; cB = nB; ++ui;
    }
    PG8_WAIT_V(0);
    if (wr == 0) PG8_BAR;
    PG8_BAR;
    if constexpr (Epi::AFTER_DRAIN) { E.fused(acc, cur, wr, wc, fr, fq, lds, wid, lane); S.done(cur); }
    PG8_STAMP();
    if (STAMP && wid == 0) { stamps[lane] = lane < nts ? (((unsigned long long)(unsigned)ts_hi << 32) | (unsigned)ts_lo) : 0ull;
        if (lane == 62) stamps[62] = rt_entry; if (lane == 63) stamps[63] = (unsigned long long)wall_clock64(); }
#undef PG8_STAMP
#undef PG8_SA
#undef PG8_SB
#undef PG8_STAGE
#undef PG8_LDA
#undef PG8_LDB
#undef PG8_MMA
#undef PG8_WAIT_V
#undef PG8_WAIT_L
#undef PG8_BAR
#undef PG8_SCHED
}
}

using namespace pg8;
#define LAS __attribute__((address_space(3)))
typedef short s16x4 __attribute__((ext_vector_type(4)));
typedef short v4i16_t __attribute__((ext_vector_type(4)));
typedef float f32x16 __attribute__((ext_vector_type(16)));
typedef unsigned u32x2 __attribute__((ext_vector_type(2)));
typedef float f32x2v __attribute__((ext_vector_type(2)));

#ifndef NREP_S5
#define NREP_S5 1
#endif
#ifndef NREP_B2
#define NREP_B2 1
#endif
#ifndef NREP_P0
#define NREP_P0 1
#endif
#ifndef MK_PER_PHASE
#define MK_PER_PHASE 0
#endif

constexpr int NTOK = 65536, SEQL = 2048;
constexpr float EPSN = 1e-6f;
constexpr int LDS_BYTES = 155648;
constexpr int S5_WL = 25088;
constexpr int ATT_OFF = 4 * S5_WL;
constexpr int VSTR = 192;
constexpr int ATT_WL = 32 * VSTR;
constexpr int CTR_OFF = LDS_BYTES - 256;
static_assert(ATT_OFF + 8 * ATT_WL <= CTR_OFF, "lds");

constexpr size_t OFF_WIN = 0;
constexpr size_t OFF_WGLU = OFF_WIN + 2ull * 7168 * 1024 * 2;
constexpr size_t OFF_WATT = OFF_WGLU + 2ull * 2048 * 512 * 2;
constexpr size_t OFF_WPW2 = OFF_WATT + 2ull * 1024 * 512 * 2;
constexpr size_t OFF_WOUT = OFF_WPW2 + 2ull * 1024 * 512 * 2;
constexpr size_t OFF_WF1 = OFF_WOUT + 2ull * 1024 * 1024 * 2;
constexpr size_t OFF_WF2 = OFF_WF1 + 2ull * 5632 * 1024 * 2;
constexpr size_t OFF_S5BB = OFF_WF2 + 2ull * 1024 * 2816 * 2;
constexpr size_t OFF_S5CM = OFF_S5BB + 2ull * 32 * 128 * 16 * 2;
constexpr size_t OFF_S5A = OFF_S5CM + 2ull * 32 * 16 * 128 * 2;
constexpr size_t OFF_CONVW = OFF_S5A + 2ull * 32 * 64 * 8;
constexpr size_t OFF_CTL = OFF_CONVW + 65536;
constexpr size_t OFF_RSQ1 = OFF_CTL + 16384;
constexpr size_t OFF_RSQ2 = OFF_RSQ1 + 65536ull * 8;
constexpr size_t OFF_LSE = OFF_RSQ2 + 65536ull * 8;
constexpr size_t OFF_XB = OFF_LSE + 2ull * 65536 * 8 * 4;
constexpr size_t OFF_G = OFF_XB + 65536ull * 1024 * 2;
constexpr size_t OFF_QO = OFF_G + 65536ull * 3072 * 2;
constexpr size_t OFF_CG = OFF_QO + 65536ull * 1536 * 2;
constexpr size_t OFF_HC = OFF_CG + 65536ull * 512 * 2;
constexpr size_t OFF_OC = OFF_HC + 65536ull * 512 * 2;
constexpr size_t WS_END = OFF_OC + 65536ull * 512 * 2;
constexpr size_t DO_U = 0, DO_K = 64ull << 20, DO_V = 128ull << 20, DO_Y = 192ull << 20, DO_MG = 64ull << 20;

struct Params {
    const float* in[24];
    float* out; unsigned char* ws;
    int ph_lo, ph_hi;
};
enum { I_X = 0, I_N1G, I_WIN, I_BGATE, I_LRE, I_LIM, I_LOGDT, I_BRE, I_BIM, I_CRE, I_CIM, I_SSMD, I_WGLU, I_WATT, I_CONVW, I_CONVB, I_LNG, I_LNB, I_WPW2, I_WOUT, I_N2G, I_WF1, I_WF2, I_FING };

__device__ __forceinline__ float bf_lo(unsigned u) { return __uint_as_float(u << 16); }
__device__ __forceinline__ float bf_hi(unsigned u) { return __uint_as_float(u & 0xffff0000u); }
__device__ __forceinline__ float sigm(float x) { return __builtin_amdgcn_rcpf(1.f + __expf(-x)); }
__device__ __forceinline__ unsigned short f2bf(float f) { unsigned u = __float_as_uint(f); u += 0x7FFFu + ((u >> 16) & 1u); return (unsigned short)(u >> 16); }
__device__ __forceinline__ float wave_sum(float v) {
#pragma unroll
    for (int o = 1; o < 64; o <<= 1) v += __shfl_xor(v, o);
    return v;
}
__device__ __forceinline__ s16x4 vtr(const LAS unsigned char* p) { return __builtin_bit_cast(s16x4, __builtin_amdgcn_ds_read_tr16_b64_v4i16((LAS v4i16_t*)p)); }

__device__ __forceinline__ u32x4 pack8(const f32x4 a, const f32x4 b) { u32x4 w; w.x = cvt_pk_bf16(a[0], a[1]); w.y = cvt_pk_bf16(a[2], a[3]); w.z = cvt_pk_bf16(b[0], b[1]); w.w = cvt_pk_bf16(b[2], b[3]); return w; }
__device__ __forceinline__ void unpack8(const u32x4 w, f32x4& a, f32x4& b) { a[0] = bf_lo(w.x); a[1] = bf_hi(w.x); a[2] = bf_lo(w.y); a[3] = bf_hi(w.y); b[0] = bf_lo(w.z); b[1] = bf_hi(w.z); b[2] = bf_lo(w.w); b[3] = bf_hi(w.w); }

struct EpiIn {
    static constexpr bool PERM = true, AFTER_DRAIN = false;
    bf16_t *U, *QO, *Kb, *Vb, *CG, *G; const float* bgate;
    __device__ __forceinline__ void operator()(const f32x4 (&acc)[2][2][4][2], const Unit& u, int wr, int wc, int fr, int fq) const {
        const int row0 = u.pm * 256 + wr * 64 + fr, cl = wc * 32 + 8 * fq, pn = u.pn;
        if (pn < 12) {
            bf16_t* base; int ld, col0;
            if (pn < 2) { base = U; ld = 512; col0 = pn * 256; }
            else if (pn < 8) { base = QO; ld = 1536; col0 = (pn - 2) * 256; }
            else if (pn < 10) { base = Kb; ld = 512; col0 = (pn - 8) * 256; }
            else { base = Vb; ld = 512; col0 = (pn - 10) * 256; }
#pragma unroll
            for (int ai = 0; ai < 2; ++ai)
#pragma unroll
                for (int m = 0; m < 4; ++m) { const int r = row0 + ai * 128 + m * 16;
#pragma unroll
                    for (int bj = 0; bj < 2; ++bj) *(u32x4*)(base + (size_t)r * ld + col0 + bj * 128 + cl) = pack8(acc[ai][bj][m][0], acc[ai][bj][m][1]); }
        } else if (pn < 16) {
            const int c0 = (pn - 12) * 128 + cl;
#pragma unroll
            for (int ai = 0; ai < 2; ++ai)
#pragma unroll
                for (int m = 0; m < 4; ++m) { const int r = row0 + ai * 128 + m * 16;
                    f32x4 o[2];
#pragma unroll
                    for (int n = 0; n < 2; ++n)
#pragma unroll
                        for (int j = 0; j < 4; ++j) o[n][j] = acc[ai][0][m][n][j] * sigm(acc[ai][1][m][n][j]);
                    *(u32x4*)(CG + (size_t)r * 512 + c0) = pack8(o[0], o[1]); }
        } else {
            const int c0 = (pn - 16) * 256 + cl;
            f32x4 bv[2][2];
#pragma unroll
            for (int bj = 0; bj < 2; ++bj)
#pragma unroll
                for (int n = 0; n < 2; ++n) bv[bj][n] = *(const f32x4*)(bgate + c0 + bj * 128 + 4 * n);
#pragma unroll
            for (int ai = 0; ai < 2; ++ai)
#pragma unroll
                for (int m = 0; m < 4; ++m) { const int r = row0 + ai * 128 + m * 16;
#pragma unroll
                    for (int bj = 0; bj < 2; ++bj) { f32x4 o[2];
#pragma unroll
                        for (int n = 0; n < 2; ++n)
#pragma unroll
                            for (int j = 0; j < 4; ++j) o[n][j] = sigm(acc[ai][bj][m][n][j] + bv[bj][n][j]);
                        *(u32x4*)(G + (size_t)r * 3072 + c0 + bj * 128) = pack8(o[0], o[1]); } }
        }
    }
};
struct EpiGluMerge {
    static constexpr bool PERM = true, AFTER_DRAIN = false;
    bf16_t* Mg; const bf16_t* G;
    __device__ __forceinline__ void operator()(const f32x4 (&acc)[2][2][4][2], const Unit& u, int wr, int wc, int fr, int fq) const {
        const int row0 = u.pm * 256 + wr * 64 + fr, c0 = u.pn * 128 + wc * 32 + 8 * fq;
        u32x4 gv[2][4];
#pragma unroll
        for (int ai = 0; ai < 2; ++ai)
#pragma unroll
            for (int m = 0; m < 4; ++m) gv[ai][m] = *(const u32x4*)(G + (size_t)(row0 + ai * 128 + m * 16) * 3072 + c0);
#pragma unroll
        for (int ai = 0; ai < 2; ++ai)
#pragma unroll
            for (int m = 0; m < 4; ++m) { const int r = row0 + ai * 128 + m * 16;
                f32x4 g0, g1; unpack8(gv[ai][m], g0, g1);
                f32x4 o[2];
#pragma unroll
                for (int j = 0; j < 4; ++j) { o[0][j] = g0[j] * acc[ai][0][m][0][j] * sigm(acc[ai][1][m][0][j]); o[1][j] = g1[j] * acc[ai][0][m][1][j] * sigm(acc[ai][1][m][1][j]); }
                *(u32x4*)(Mg + (size_t)r * 1024 + c0) = pack8(o[0], o[1]); }
    }
};
struct EpiAccMerge {
    static constexpr bool PERM = true, AFTER_DRAIN = false;
    bf16_t* Mg; const bf16_t* G; int gate_off;
    __device__ __forceinline__ void operator()(const f32x4 (&acc)[2][2][4][2], const Unit& u, int wr, int wc, int fr, int fq) const {
        const int row0 = u.pm * 256 + wr * 64 + fr, cb = u.pn * 256 + wc * 32 + 8 * fq;
#pragma unroll
        for (int ai = 0; ai < 2; ++ai)
#pragma unroll
          for (int mh = 0; mh < 2; ++mh) {
            u32x4 gv[2][2], mv[2][2];
#pragma unroll
            for (int mm = 0; mm < 2; ++mm)
#pragma unroll
                for (int bj = 0; bj < 2; ++bj) { const int r = row0 + ai * 128 + (2 * mh + mm) * 16, c0 = cb + bj * 128;
                    gv[mm][bj] = *(const u32x4*)(G + (size_t)r * 3072 + gate_off + c0); mv[mm][bj] = *(const u32x4*)(Mg + (size_t)r * 1024 + c0); }
#pragma unroll
            for (int mm = 0; mm < 2; ++mm)
#pragma unroll
                for (int bj = 0; bj < 2; ++bj) { const int m = 2 * mh + mm; const int r = row0 + ai * 128 + m * 16, c0 = cb + bj * 128;
                    f32x4 g0, g1, m0, m1; unpack8(gv[mm][bj], g0, g1); unpack8(mv[mm][bj], m0, m1);
                    *(u32x4*)(Mg + (size_t)r * 1024 + c0) = pack8(m0 + g0 * acc[ai][bj][m][0], m1 + g1 * acc[ai][bj][m][1]); }
            asm volatile("" ::: "memory");
          }
    }
};
struct EpiDelta {
    static constexpr bool PERM = true, AFTER_DRAIN = false;
    bf16_t* D;
    __device__ __forceinline__ void operator()(const f32x4 (&acc)[2][2][4][2], const Unit& u, int wr, int wc, int fr, int fq) const {
        const int row0 = u.pm * 256 + wr * 64 + fr, cb = u.pn * 256 + wc * 32 + 8 * fq;
#pragma unroll
        for (int ai = 0; ai < 2; ++ai)
#pragma unroll
            for (int m = 0; m < 4; ++m)
#pragma unroll
                for (int bj = 0; bj < 2; ++bj) *(u32x4*)(D + (size_t)(row0 + ai * 128 + m * 16) * 1024 + cb + bj * 128) = pack8(acc[ai][bj][m][0], acc[ai][bj][m][1]);
    }
};
struct EpiFfn1 {
    static constexpr bool PERM = true, AFTER_DRAIN = false;
    bf16_t* Hf;
    __device__ __forceinline__ void operator()(const f32x4 (&acc)[2][2][4][2], const Unit& u, int wr, int wc, int fr, int fq) const {
        const int row0 = u.pm * 256 + wr * 64 + fr, c0 = u.pn * 128 + wc * 32 + 8 * fq;
#pragma unroll
        for (int ai = 0; ai < 2; ++ai)
#pragma unroll
            for (int m = 0; m < 4; ++m) { const int r = row0 + ai * 128 + m * 16;
                f32x4 o[2];
#pragma unroll
                for (int n = 0; n < 2; ++n)
#pragma unroll
                    for (int j = 0; j < 4; ++j) { const float a = acc[ai][0][m][n][j], b = acc[ai][1][m][n][j]; o[n][j] = a * sigm(a) * b; }
                *(u32x4*)(Hf + (size_t)r * 2816 + c0) = pack8(o[0], o[1]); }
    }
};

__device__ __forceinline__ void p0_tr_item(const float* W, int K, int N, bf16_t* WT, int kb, int nd0, int ns0, const float* gk, float scale, LAS float* scr, int lane) {
    const int k0 = 64 * kb;
#pragma unroll 8
    for (int i = 0; i < 32; ++i) { const int kk = 2 * i + (lane >> 5); float s = scale; if (gk) s *= gk[k0 + kk]; scr[kk * 33 + (lane & 31)] = W[(size_t)(k0 + kk) * N + ns0 + (lane & 31)] * s; }
    asm volatile("" ::: "memory");
    const int c = lane & 7;
#pragma unroll
    for (int j = 0; j < 4; ++j) { const int n = (lane >> 3) + 8 * j; const LAS float* s = scr + (8 * c) * 33 + n;
        u32x4 o; o.x = cvt_pk_bf16(s[0 * 33], s[1 * 33]); o.y = cvt_pk_bf16(s[2 * 33], s[3 * 33]); o.z = cvt_pk_bf16(s[4 * 33], s[5 * 33]); o.w = cvt_pk_bf16(s[6 * 33], s[7 * 33]);
        *(u32x4*)(WT + (size_t)(nd0 + n) * K + k0 + 8 * c) = o; }
    asm volatile("" ::: "memory");
}
__device__ __forceinline__ void phase_p0(const Params& P, LAS unsigned char* lds, int wave, int lane, int tid) {
    unsigned char* ws = P.ws;
    const int gw = blockIdx.x * 8 + wave, NGW = gridDim.x * 8;
    LAS float* scr = (LAS float*)(lds + wave * 16384);
    constexpr int PER_L = 3584 + 512 + 256 + 256 + 512 + 2816 + 1408;
    for (int it = gw; it < 2 * PER_L; it += NGW) {
        const int l = it / PER_L; int r = it % PER_L;
        const float* W; bf16_t* WT; int K, N, type = 0; const float* gk = nullptr;
        if (r < 3584) { W = P.in[I_WIN] + (size_t)l * 1024 * 7168; WT = (bf16_t*)(ws + OFF_WIN) + (size_t)l * 7168 * 1024; K = 1024; N = 7168; type = 1; gk = P.in[I_N1G] + l * 1024; }
        else if ((r -= 3584) < 512) { W = P.in[I_WGLU] + (size_t)l * 512 * 2048; WT = (bf16_t*)(ws + OFF_WGLU) + (size_t)l * 2048 * 512; K = 512; N = 2048; type = 3; }
        else if ((r -= 512) < 256) { W = P.in[I_WATT] + (size_t)l * 512 * 1024; WT = (bf16_t*)(ws + OFF_WATT) + (size_t)l * 1024 * 512; K = 512; N = 1024; }
        else if ((r -= 256) < 256) { W = P.in[I_WPW2] + (size_t)l * 512 * 1024; WT = (bf16_t*)(ws + OFF_WPW2) + (size_t)l * 1024 * 512; K = 512; N = 1024; }
        else if ((r -= 256) < 512) { W = P.in[I_WOUT] + (size_t)l * 1024 * 1024; WT = (bf16_t*)(ws + OFF_WOUT) + (size_t)l * 1024 * 1024; K = 1024; N = 1024; }
        else if ((r -= 512) < 2816) { W = P.in[I_WF1] + (size_t)l * 1024 * 5632; WT = (bf16_t*)(ws + OFF_WF1) + (size_t)l * 5632 * 1024; K = 1024; N = 5632; type = 2; gk = P.in[I_N2G] + l * 1024; }
        else { r -= 2816; W = P.in[I_WF2] + (size_t)l * 2816 * 1024; WT = (bf16_t*)(ws + OFF_WF2) + (size_t)l * 1024 * 2816; K = 2816; N = 1024; }
        const int nblk = N / 32, kb = r / nblk, nd0 = (r % nblk) * 32;
        int ns0 = nd0; float scale = 1.f;
        if (type == 1) { if (nd0 >= 3072 && nd0 < 4096) { const int t = nd0 - 3072, j = t & 255; ns0 = 3072 + (t >> 8) * 128 + (j & 127) + (j >= 128 ? 512 : 0); }
                         if (nd0 >= 512 && nd0 < 2048) scale = 0.125f * 1.4426950408889634f; }
        else if (type == 2) { const int j = nd0 & 255; ns0 = (nd0 >> 8) * 128 + (j & 127) + (j >= 128 ? 2816 : 0); }
        else if (type == 3) { const int j = nd0 & 255; ns0 = (nd0 >> 8) * 128 + (j & 127) + (j >= 128 ? 1024 : 0); }
        p0_tr_item(W, K, N, WT, kb, nd0, ns0, gk, scale, scr, lane);
    }
    { const float* x = P.in[I_X]; bf16_t* xb = (bf16_t*)(ws + OFF_XB); bf16_t* xn0 = (bf16_t*)(ws + OFF_HC);
      for (int row0 = 2 * gw; row0 < NTOK; row0 += 2 * NGW) { f32x4 t[2][4];
#pragma unroll
          for (int q = 0; q < 2; ++q)
#pragma unroll
              for (int j = 0; j < 4; ++j) t[q][j] = *(const f32x4*)(x + (size_t)(row0 + q) * 1024 + 4 * lane + 256 * j);
#pragma unroll
          for (int q = 0; q < 2; ++q) { const int row = row0 + q; float ss = 0.f; f32x4 v[4];
#pragma unroll
              for (int j = 0; j < 4; ++j) { u32x2 w; w.x = cvt_pk_bf16(t[q][j][0], t[q][j][1]); w.y = cvt_pk_bf16(t[q][j][2], t[q][j][3]);
                  *(u32x2*)(xb + (size_t)row * 1024 + 4 * lane + 256 * j) = w; v[j][0] = bf_lo(w.x); v[j][1] = bf_hi(w.x); v[j][2] = bf_lo(w.y); v[j][3] = bf_hi(w.y);
                  ss += v[j][0] * v[j][0] + v[j][1] * v[j][1] + v[j][2] * v[j][2] + v[j][3] * v[j][3]; }
              ss = wave_sum(ss); const float rs = rsqrtf(ss * (1.f / 1024.f) + EPSN);
#pragma unroll
              for (int j = 0; j < 4; ++j) { u32x2 w; w.x = cvt_pk_bf16(v[j][0] * rs, v[j][1] * rs); w.y = cvt_pk_bf16(v[j][2] * rs, v[j][3] * rs); *(u32x2*)(xn0 + (size_t)row * 1024 + 4 * lane + 256 * j) = w; } } } }
    const int gt = blockIdx.x * 512 + tid, NGT = gridDim.x * 512;
    for (int idx = gt; idx < 2 * 32 * 64; idx += NGT) {
        const int lg = idx >> 6, p = idx & 63;
        const float lre = P.in[I_LRE][idx], lim = P.in[I_LIM][idx], dt = expf(P.in[I_LOGDT][lg]);
        const float mag = expf(lre * dt);
        const double rev = (double)lim * (double)dt * 0.15915494309189535; const float frc = (float)(rev - rint(rev));
        const float sn = __builtin_amdgcn_sinf(frc), cs = __builtin_amdgcn_cosf(frc);
        const float are = mag * cs, aim = mag * sn, nr = are - 1.f, ni = aim, den = lre * lre + lim * lim;
        const float zre = (nr * lre + ni * lim) / den, zim = (ni * lre - nr * lim) / den;
        { f32x2v t2; t2.x = are; t2.y = aim; ((f32x2v*)(ws + OFF_S5A))[idx] = t2; }
        bf16_t* bbt = (bf16_t*)(ws + OFF_S5BB) + (size_t)lg * 128 * 16; bf16_t* cm = (bf16_t*)(ws + OFF_S5CM) + (size_t)lg * 16 * 128;
        for (int h = 0; h < 16; ++h) { const float br = P.in[I_BRE][(size_t)idx * 16 + h], bi = P.in[I_BIM][(size_t)idx * 16 + h];
            bbt[p * 16 + h] = f2bf(zre * br - zim * bi); bbt[(64 + p) * 16 + h] = f2bf(zre * bi + zim * br);
            cm[h * 128 + p] = f2bf(P.in[I_CRE][((size_t)lg * 16 + h) * 64 + p]); cm[h * 128 + 64 + p] = f2bf(-P.in[I_CIM][((size_t)lg * 16 + h) * 64 + p]); }
    }
    for (int idx = gt; idx < 2 * 31 * 256; idx += NGT) { const float a = P.in[I_CONVW][2 * idx], b = P.in[I_CONVW][2 * idx + 1]; ((unsigned*)(ws + OFF_CONVW))[idx] = cvt_pk_bf16(a, b); }
}
template <bool FINAL> __device__ __forceinline__ void phase_rows(const Params& P, int wave, int lane, bool want_xn) {
    const int gw = blockIdx.x * 8 + wave, NGW = gridDim.x * 8;
    bf16_t* xb = (bf16_t*)(P.ws + OFF_XB); const bf16_t* D = (const bf16_t*)(P.ws + OFF_QO); bf16_t* xn = (bf16_t*)(P.ws + OFF_HC); const float* fg = P.in[I_FING];
    for (int row = gw; row < NTOK; row += NGW) {
        const size_t o0 = (size_t)row * 1024 + 8 * lane, o1 = o0 + 512;
        const u32x4 w0 = *(const u32x4*)(xb + o0), w1 = *(const u32x4*)(xb + o1), d0 = *(const u32x4*)(D + o0), d1 = *(const u32x4*)(D + o1);
        f32x4 a0, a1, b0, b1, e0, e1, g0, g1; unpack8(w0, a0, a1); unpack8(w1, b0, b1); unpack8(d0, e0, e1); unpack8(d1, g0, g1);
        const u32x4 n0 = pack8(a0 + e0, a1 + e1), n1 = pack8(b0 + g0, b1 + g1);
        unpack8(n0, a0, a1); unpack8(n1, b0, b1);
        float ss = 0.f;
#pragma unroll
        for (int j = 0; j < 4; ++j) ss += a0[j] * a0[j] + a1[j] * a1[j] + b0[j] * b0[j] + b1[j] * b1[j];
        ss = wave_sum(ss);
        const float rs = rsqrtf(ss * (1.f / 1024.f) + EPSN);
        if (!FINAL) { if (lane == 0) ((float*)(P.ws + OFF_RSQ1))[row] = rs; *(u32x4*)(xb + o0) = n0; *(u32x4*)(xb + o1) = n1; if (want_xn) { *(u32x4*)(xn + o0) = pack8(a0 * rs, a1 * rs); *(u32x4*)(xn + o1) = pack8(b0 * rs, b1 * rs); } }
        else { const f32x4 q0 = *(const f32x4*)(fg + 8 * lane), q1 = *(const f32x4*)(fg + 8 * lane + 4), q2 = *(const f32x4*)(fg + 512 + 8 * lane), q3 = *(const f32x4*)(fg + 512 + 8 * lane + 4);
            float* o = P.out + (size_t)row * 1024;
            *(f32x4*)(o + 8 * lane) = a0 * q0 * rs; *(f32x4*)(o + 8 * lane + 4) = a1 * q1 * rs; *(f32x4*)(o + 512 + 8 * lane) = b0 * q2 * rs; *(f32x4*)(o + 512 + 8 * lane + 4) = b1 * q3 * rs; }
    }
}

__device__ __forceinline__ void s5_item(const Params& P, int l, int it, LAS unsigned char* wl, int lane) {
    const int b = it >> 5, g = it & 31, lg = l * 32 + g;
    LAS float* bu = (LAS float*)wl; LAS unsigned char* sl = wl + 16384;
    const int c32 = lane & 31, hi = lane >> 5, fr = lane & 15, fq = lane >> 4;
    const bf16_t* bbt = (const bf16_t*)(P.ws + OFF_S5BB) + (size_t)lg * 128 * 16; const bf16_t* cm = (const bf16_t*)(P.ws + OFF_S5CM) + (size_t)lg * 16 * 128;
    bf16x8 bbreg[4], cmreg[4];
#pragma unroll
    for (int j = 0; j < 4; ++j) { bbreg[j] = *(const bf16x8*)(bbt + (32 * j + c32) * 16 + 8 * hi); cmreg[j] = *(const bf16x8*)(cm + fr * 128 + 32 * j + 8 * fq); }
    const f32x2v av = ((const f32x2v*)(P.ws + OFF_S5A))[lg * 64 + lane]; const float a_re = av.x, a_im = av.y;
    const float dsk = P.in[I_SSMD][l * 512 + g * 16 + fr];
    float s_re = 0.f, s_im = 0.f;
    const bf16_t* Ub = (const bf16_t*)((unsigned char*)P.out + DO_U) + (size_t)b * SEQL * 512 + g * 16; bf16_t* Yb = (bf16_t*)((unsigned char*)P.out + DO_Y) + (size_t)b * SEQL * 512 + g * 16;
    for (int c = 0; c < 64; ++c) {
        const int t0 = c * 32;
        const bf16x8 ureg = *(const bf16x8*)(Ub + (size_t)(t0 + c32) * 512 + 8 * hi);
        unsigned short uep[2][4];
#pragma unroll
        for (int mt = 0; mt < 2; ++mt)
#pragma unroll
            for (int i = 0; i < 4; ++i) uep[mt][i] = Ub[(size_t)(t0 + 16 * mt + 4 * fq + i) * 512 + fr];
#pragma unroll
        for (int j = 0; j < 4; ++j) { f32x16 a;
#pragma unroll
            for (int r = 0; r < 16; ++r) a[r] = 0.f;
            a = __builtin_amdgcn_mfma_f32_32x32x16_bf16(ureg, bbreg[j], a, 0, 0, 0);
#pragma unroll
            for (int r = 0; r < 16; ++r) { const int tok = (r & 3) + 8 * (r >> 2) + 4 * hi; bu[tok * 128 + ((32 * (j & 1) + c32) << 1) + (j >> 1)] = a[r]; } }
        asm volatile("" ::: "memory");
#pragma unroll 8
        for (int t = 0; t < 32; ++t) { const f32x2v v = *(const LAS f32x2v*)(bu + t * 128 + 2 * lane);
            const float nre = fmaf(a_re, s_re, fmaf(-a_im, s_im, v.x)), nim = fmaf(a_re, s_im, fmaf(a_im, s_re, v.y)); s_re = nre; s_im = nim;
            *(LAS unsigned short*)(sl + t * 272 + lane * 2) = f2bf(s_re); *(LAS unsigned short*)(sl + t * 272 + 128 + lane * 2) = f2bf(s_im); }
        asm volatile("" ::: "memory");
#pragma unroll
        for (int mt = 0; mt < 2; ++mt) { f32x4 ya = {0.f, 0.f, 0.f, 0.f};
#pragma unroll
            for (int ks = 0; ks < 4; ++ks) { const bf16x8 a = *(const LAS bf16x8*)(sl + (16 * mt + fr) * 272 + (32 * ks + 8 * fq) * 2); ya = __builtin_amdgcn_mfma_f32_16x16x32_bf16(a, cmreg[ks], ya, 0, 0, 0); }
#pragma unroll
            for (int i = 0; i < 4; ++i) { const float y = ya[i] + dsk * __uint_as_float((unsigned)uep[mt][i] << 16);
                const float ge = y * sigm(1.5957691216057308f * (y + 0.044715f * y * y * y));
                Yb[(size_t)(t0 + 16 * mt + 4 * fq + i) * 512 + fr] = f2bf(ge); } }
        asm volatile("" ::: "memory");
    }
}

template <int PAT> __device__ __forceinline__ void attn_item(const Params& P, int it, LAS unsigned char* vl, int lane) {
    constexpr int d = PAT == 0 ? 1 : (PAT == 1 ? 4 : 16);
    constexpr int ngrp = (SEQL / d) / 32;
    constexpr int KSTR = 144;
    const int j = it % ngrp; int t = it / ngrp; const int r = t % d; t /= d; const int h = t & 7, b = t >> 3;
    const int c32 = lane & 31, hi = lane >> 5, i0 = 32 * j;
    const int lrow = lane >> 3, lch = lane & 7;
    const size_t tokbase = (size_t)b * SEQL;
    bf16_t* QO = (bf16_t*)(P.ws + OFF_QO); const bf16_t* Kb = (const bf16_t*)((unsigned char*)P.out + DO_K); const bf16_t* Vb = (const bf16_t*)((unsigned char*)P.out + DO_V);
    float* LSE = (float*)(P.ws + OFF_LSE);
    const unsigned char* qrow0 = (const unsigned char*)QO + ((tokbase + (size_t)i0 * d + r) * 1536 + PAT * 512 + h * 64) * 2;
    const unsigned char* krow0 = (const unsigned char*)Kb + ((tokbase + (size_t)(i0 - 128) * d + r) * 512 + h * 64) * 2;
    const unsigned char* vrow0 = (const unsigned char*)Vb + ((tokbase + (size_t)(i0 - 128) * d + r) * 512 + h * 64) * 2;
    const unsigned qlo = (unsigned)(lrow * d * 3072 + lch * 16), klo = (unsigned)(lrow * d * 1024 + lch * 16);
    u32x4 qraw[4], kraw[5][4];
#pragma unroll
    for (int i4 = 0; i4 < 4; ++i4) qraw[i4] = *(const u32x4*)(qrow0 + (qlo + (unsigned)(8 * i4 * d * 3072)));
#pragma unroll
    for (int kt = 0; kt < 5; ++kt) { const int kb = i0 - 128 + 32 * kt;
        if (kb >= 0) {
#pragma unroll
            for (int i4 = 0; i4 < 4; ++i4) kraw[kt][i4] = *(const u32x4*)(krow0 + (klo + (unsigned)((32 * kt + 8 * i4) * d * 1024))); } }
    bf16x8 qreg[4];
#pragma unroll
    for (int i4 = 0; i4 < 4; ++i4) *(LAS u32x4*)(vl + (lrow + 8 * i4) * KSTR + lch * 16) = qraw[i4];
    asm volatile("" ::: "memory");
#pragma unroll
    for (int ks = 0; ks < 4; ++ks) qreg[ks] = *(const LAS bf16x8*)(vl + c32 * KSTR + (16 * ks + 8 * hi) * 2);
    asm volatile("" ::: "memory");
    f32x16 s[5];
#pragma unroll
    for (int kt = 0; kt < 5; ++kt) { const int kb = i0 - 128 + 32 * kt;
        f32x16 a;
        if (kb >= 0) {
#pragma unroll
            for (int q = 0; q < 16; ++q) a[q] = 0.f;
#pragma unroll
            for (int i4 = 0; i4 < 4; ++i4) *(LAS u32x4*)(vl + (lrow + 8 * i4) * KSTR + lch * 16) = kraw[kt][i4];
            asm volatile("" ::: "memory");
#pragma unroll
            for (int ks = 0; ks < 4; ++ks) { const bf16x8 kreg = *(const LAS bf16x8*)(vl + c32 * KSTR + (16 * ks + 8 * hi) * 2); a = __builtin_amdgcn_mfma_f32_32x32x16_bf16(kreg, qreg[ks], a, 0, 0, 0); }
            asm volatile("" ::: "memory");
        } else {
#pragma unroll
            for (int q = 0; q < 16; ++q) a[q] = (-__builtin_inff());
        }
        s[kt] = a; }
    u32x4 vreg[5][4];
#pragma unroll
    for (int kt = 0; kt < 3; ++kt) { const int kb = i0 - 128 + 32 * kt;
        if (kb >= 0) {
#pragma unroll
            for (int i4 = 0; i4 < 4; ++i4) vreg[kt][i4] = *(const u32x4*)(vrow0 + (klo + (unsigned)((32 * kt + 8 * i4) * d * 1024))); } }
#pragma unroll
    for (int q = 0; q < 16; ++q) { const int kr = (q & 3) + 8 * (q >> 2) + 4 * hi; if (kr < c32) s[0][q] = (-__builtin_inff()); if (kr > c32) s[4][q] = (-__builtin_inff()); }
    float mx = (-__builtin_inff());
#pragma unroll
    for (int kt = 0; kt < 5; ++kt)
#pragma unroll
        for (int q = 0; q < 16; ++q) mx = fmaxf(mx, s[kt][q]);
    mx = fmaxf(mx, __shfl_xor(mx, 32));
    float den = 0.f;
#pragma unroll
    for (int kt = 0; kt < 5; ++kt)
#pragma unroll
        for (int q = 0; q < 16; ++q) { const float p = __builtin_amdgcn_exp2f(s[kt][q] - mx); s[kt][q] = p; den += p; }
    den += __shfl_xor(den, 32);
    u32x4 pw[5][2];
#pragma unroll
    for (int kt = 0; kt < 5; ++kt)
#pragma unroll
        for (int ks2 = 0; ks2 < 2; ++ks2) { pw[kt][ks2].x = cvt_pk_bf16(s[kt][8 * ks2 + 0], s[kt][8 * ks2 + 1]); pw[kt][ks2].y = cvt_pk_bf16(s[kt][8 * ks2 + 2], s[kt][8 * ks2 + 3]);
            pw[kt][ks2].z = cvt_pk_bf16(s[kt][8 * ks2 + 4], s[kt][8 * ks2 + 5]); pw[kt][ks2].w = cvt_pk_bf16(s[kt][8 * ks2 + 6], s[kt][8 * ks2 + 7]); }
#pragma unroll
    for (int kt = 3; kt < 5; ++kt) { const int kb = i0 - 128 + 32 * kt;
        if (kb >= 0) {
#pragma unroll
            for (int i4 = 0; i4 < 4; ++i4) vreg[kt][i4] = *(const u32x4*)(vrow0 + (klo + (unsigned)((32 * kt + 8 * i4) * d * 1024))); } }
    u32x4 mraw[2][4]; float l2b = 0.f, l2c = 0.f;
    if (PAT == 0) {
#pragma unroll
        for (int pp = 0; pp < 2; ++pp)
#pragma unroll
            for (int i4 = 0; i4 < 4; ++i4) mraw[pp][i4] = *(const u32x4*)(qrow0 + (qlo + (unsigned)(8 * i4 * 3072 + (pp + 1) * 1024)));
        l2b = LSE[((size_t)(0 * 32 + b) * 8 + h) * SEQL + i0 + c32]; l2c = LSE[((size_t)(1 * 32 + b) * 8 + h) * SEQL + i0 + c32];
    }
    f32x16 o[2];
#pragma unroll
    for (int q = 0; q < 16; ++q) { o[0][q] = 0.f; o[1][q] = 0.f; }
    const int gi = lane >> 4, li = lane & 15;
    const LAS unsigned char* vrd = vl + (4 * hi + (li >> 2)) * VSTR + (16 * (gi & 1) + 4 * (li & 3)) * 2;
#pragma unroll
    for (int kt = 0; kt < 5; ++kt) { const int kb = i0 - 128 + 32 * kt;
        if (kb >= 0) {
#pragma unroll
            for (int i4 = 0; i4 < 4; ++i4) *(LAS u32x4*)(vl + (lrow + 8 * i4) * VSTR + lch * 16) = vreg[kt][i4];
            asm volatile("" ::: "memory");
#pragma unroll
            for (int ks2 = 0; ks2 < 2; ++ks2) {
                const bf16x8 pb = __builtin_bit_cast(bf16x8, pw[kt][ks2]);
#pragma unroll
                for (int mt = 0; mt < 2; ++mt) { const LAS unsigned char* a1 = vrd + (16 * ks2) * VSTR + 64 * mt;
                    const s16x4 lo = vtr(a1), up = vtr(a1 + 8 * VSTR);
                    bf16x8 av; av[0] = lo[0]; av[1] = lo[1]; av[2] = lo[2]; av[3] = lo[3]; av[4] = up[0]; av[5] = up[1]; av[6] = up[2]; av[7] = up[3];
                    o[mt] = __builtin_amdgcn_mfma_f32_32x32x16_bf16(av, pb, o[mt], 0, 0, 0); } }
            asm volatile("" ::: "memory");
        } }
    const float inv = __builtin_amdgcn_rcpf(den);
    const float l2 = mx + __builtin_amdgcn_logf(den);
    const LAS unsigned char* frd = vl + c32 * KSTR + 8 * hi;
    float w1 = inv;
    if (PAT == 0) {
        const float M = fmaxf(l2, fmaxf(l2b, l2c));
        float e1 = __builtin_amdgcn_exp2f(l2 - M), e2 = __builtin_amdgcn_exp2f(l2b - M), e3 = __builtin_amdgcn_exp2f(l2c - M);
        const float wi = __builtin_amdgcn_rcpf(e1 + e2 + e3); w1 = e1 * wi * inv; const float wo[2] = {e2 * wi, e3 * wi};
#pragma unroll
        for (int q = 0; q < 16; ++q) { o[0][q] *= w1; o[1][q] *= w1; }
#pragma unroll
        for (int pp = 0; pp < 2; ++pp) {
#pragma unroll
            for (int i4 = 0; i4 < 4; ++i4) *(LAS u32x4*)(vl + (lrow + 8 * i4) * KSTR + lch * 16) = mraw[pp][i4];
            asm volatile("" ::: "memory");
#pragma unroll
            for (int mt = 0; mt < 2; ++mt)
#pragma unroll
                for (int rg = 0; rg < 4; ++rg) { const u32x2 bb = *(const LAS u32x2*)(frd + 64 * mt + 16 * rg);
                    o[mt][4 * rg] += wo[pp] * bf_lo(bb.x); o[mt][4 * rg + 1] += wo[pp] * bf_hi(bb.x); o[mt][4 * rg + 2] += wo[pp] * bf_lo(bb.y); o[mt][4 * rg + 3] += wo[pp] * bf_hi(bb.y); }
            asm volatile("" ::: "memory");
        }
    } else {
#pragma unroll
        for (int q = 0; q < 16; ++q) { o[0][q] *= w1; o[1][q] *= w1; }
    }
#pragma unroll
    for (int mt = 0; mt < 2; ++mt)
#pragma unroll
        for (int rg = 0; rg < 4; ++rg) { u32x2 w; w.x = cvt_pk_bf16(o[mt][4 * rg], o[mt][4 * rg + 1]); w.y = cvt_pk_bf16(o[mt][4 * rg + 2], o[mt][4 * rg + 3]);
            *(LAS u32x2*)(vl + c32 * KSTR + 8 * hi + 64 * mt + 16 * rg) = w; }
    asm volatile("" ::: "memory");
    if (PAT != 0) {
#pragma unroll
        for (int i4 = 0; i4 < 4; ++i4) *(u32x4*)((unsigned char*)qrow0 + (qlo + (unsigned)(8 * i4 * d * 3072))) = *(const LAS u32x4*)(vl + (lrow + 8 * i4) * KSTR + lch * 16);
        if (hi == 0) LSE[((size_t)((PAT - 1) * 32 + b) * 8 + h) * SEQL + (size_t)(i0 + c32) * d + r] = l2;
    } else {
        bf16_t* OC = (bf16_t*)(P.ws + OFF_OC);
#pragma unroll
        for (int i4 = 0; i4 < 4; ++i4) *(u32x4*)(OC + (tokbase + (size_t)(i0 + lrow + 8 * i4)) * 512 + h * 64 + lch * 8) = *(const LAS u32x4*)(vl + (lrow + 8 * i4) * KSTR + lch * 16);
    }
    asm volatile("" ::: "memory");
}

__device__ __forceinline__ void conv_item(const Params& P, int l, int it, int lane, const LAS unsigned char* wlds) {
    const int b = it >> 8, t0 = (it & 255) * 8, ch0 = 8 * lane;
    const bf16_t* in = (const bf16_t*)(P.ws + OFF_CG) + (size_t)b * SEQL * 512 + ch0;
    const LAS unsigned char* cw = wlds + 16 * lane;
    float acc[8][8], win[8][8];
    { const f32x4 b0 = *(const f32x4*)(P.in[I_CONVB] + l * 512 + ch0), b1 = *(const f32x4*)(P.in[I_CONVB] + l * 512 + ch0 + 4);
#pragma unroll
      for (int i = 0; i < 8; ++i) { acc[i][0] = b0[0]; acc[i][1] = b0[1]; acc[i][2] = b0[2]; acc[i][3] = b0[3]; acc[i][4] = b1[0]; acc[i][5] = b1[1]; acc[i][6] = b1[2]; acc[i][7] = b1[3]; } }
#define CONV_LOADROW(rr, dst) do { const int t_ = t0 - 30 + (rr); if (t_ >= 0) { const u32x4 v_ = *(const u32x4*)(in + (size_t)t_ * 512); \
        dst[0] = bf_lo(v_.x); dst[1] = bf_hi(v_.x); dst[2] = bf_lo(v_.y); dst[3] = bf_hi(v_.y); dst[4] = bf_lo(v_.z); dst[5] = bf_hi(v_.z); dst[6] = bf_lo(v_.w); dst[7] = bf_hi(v_.w); } \
        else { _Pragma("unroll") for (int c_ = 0; c_ < 8; ++c_) dst[c_] = 0.f; } } while (0)
#pragma unroll
    for (int rr = 0; rr < 8; ++rr) CONV_LOADROW(rr, win[rr]);
    for (int jb = 0; jb < 32; jb += 8) {
        asm volatile("" ::: "memory");
#pragma unroll
        for (int jj = 0; jj < 8; ++jj) { const int j = jb + jj;
            if (j < 31) { const u32x4 wv = *(const LAS u32x4*)(cw + j * 1024);
                float w[8]; w[0] = bf_lo(wv.x); w[1] = bf_hi(wv.x); w[2] = bf_lo(wv.y); w[3] = bf_hi(wv.y); w[4] = bf_lo(wv.z); w[5] = bf_hi(wv.z); w[6] = bf_lo(wv.w); w[7] = bf_hi(wv.w);
#pragma unroll
                for (int i = 0; i < 8; ++i)
#pragma unroll
                    for (int c = 0; c < 8; ++c) acc[i][c] = fmaf(w[c], win[(jj + i) & 7][c], acc[i][c]);
                if (j + 8 < 38) CONV_LOADROW(j + 8, win[jj]); } }
    }
#undef CONV_LOADROW
    const f32x4 g0 = *(const f32x4*)(P.in[I_LNG] + l * 512 + ch0), g1 = *(const f32x4*)(P.in[I_LNG] + l * 512 + ch0 + 4);
    const f32x4 e0 = *(const f32x4*)(P.in[I_LNB] + l * 512 + ch0), e1 = *(const f32x4*)(P.in[I_LNB] + l * 512 + ch0 + 4);
    bf16_t* outp = (bf16_t*)(P.ws + OFF_HC) + ((size_t)b * SEQL + t0) * 512 + ch0;
#pragma unroll
    for (int i = 0; i < 8; ++i) { float s1 = 0.f, s2 = 0.f;
#pragma unroll
        for (int c = 0; c < 8; ++c) { s1 += acc[i][c]; s2 += acc[i][c] * acc[i][c]; }
        s1 = wave_sum(s1); s2 = wave_sum(s2);
        const float mean = s1 * (1.f / 512.f), var = fmaxf(s2 * (1.f / 512.f) - mean * mean, 0.f), rs = rsqrtf(var + EPSN);
        f32x4 y0, y1;
#pragma unroll
        for (int c = 0; c < 4; ++c) { const float h0 = (acc[i][c] - mean) * rs * g0[c] + e0[c], h1 = (acc[i][4 + c] - mean) * rs * g1[c] + e1[c]; y0[c] = h0 * sigm(h0); y1[c] = h1 * sigm(h1); }
        *(u32x4*)(outp + (size_t)i * 512) = pack8(y0, y1); }
}

__device__ __forceinline__ int xcc_id() { return (int)(__builtin_amdgcn_s_getreg((3 << 11) | 20) & 7u); }
__device__ __forceinline__ int claim_issue(unsigned* ctr, int& lane) { asm volatile("" : "+v"(lane)); int v = 0; if (lane == 0) v = (int)atomicAdd(ctr, 1u); return v; }
__device__ __forceinline__ int lane_now() { int l = (int)__builtin_amdgcn_mbcnt_hi(~0u, __builtin_amdgcn_mbcnt_lo(~0u, 0u)); asm volatile("" : "+v"(l)); return l; }
__device__ __forceinline__ int lds_claim(LAS unsigned* ctr, int lane) { int v = 0; if (lane == 0) v = (int)__hip_atomic_fetch_add(ctr, 1u, __ATOMIC_RELAXED, __HIP_MEMORY_SCOPE_WORKGROUP); return __builtin_amdgcn_readfirstlane(v); }
__device__ __forceinline__ int claim(unsigned* ctr, int& lane) { asm volatile("" : "+v"(lane)); int v = 0; if (lane == 0) v = (int)atomicAdd(ctr, 1u); return __builtin_amdgcn_readfirstlane(v); }


__device__ __forceinline__ void grid_barrier(unsigned* bar, unsigned target, int tid) {
    asm volatile("s_waitcnt vmcnt(0) lgkmcnt(0)" ::: "memory");
    __syncthreads();
    if (tid == 0) {
        __builtin_amdgcn_fence(__ATOMIC_RELEASE, "agent");
        asm volatile("s_waitcnt vmcnt(0) lgkmcnt(0)" ::: "memory");
        __hip_atomic_fetch_add(bar, 1u, __ATOMIC_RELAXED, __HIP_MEMORY_SCOPE_AGENT);
        while (__hip_atomic_load(bar, __ATOMIC_RELAXED, __HIP_MEMORY_SCOPE_AGENT) < target) __builtin_amdgcn_s_sleep(2);
        __builtin_amdgcn_fence(__ATOMIC_ACQUIRE, "agent");
        asm volatile("s_waitcnt vmcnt(0) lgkmcnt(0)" ::: "memory");
    }
    __syncthreads();
}


#define XB_TMO      128
#define XB_XCNT(j)  (256  + 64 * (j))
#define XB_XSUB(j)  (1280 + 64 * (j))
#define XB_XGEN(j)  (2304 + 64 * (j))
#define XB_TOP      3328
#define XB_TOPGEN   3392
#define XB_SPIN_CAP (1u << 22)
__device__ __forceinline__ unsigned xb_ld(unsigned* p)              { return __hip_atomic_load(p, __ATOMIC_RELAXED, __HIP_MEMORY_SCOPE_AGENT); }
__device__ __forceinline__ unsigned xb_add(unsigned* p, unsigned v) { return __hip_atomic_fetch_add(p, v, __ATOMIC_RELAXED, __HIP_MEMORY_SCOPE_AGENT); }
#define XB_SPIN(cond, bar) do { unsigned _sp = 0; while (cond) { __builtin_amdgcn_s_sleep(1); \
    if ((++_sp & 255u) == 0u) { if (xb_ld(&(bar)[XB_TMO])) break; if (_sp > XB_SPIN_CAP) { atomicAdd(&(bar)[XB_TMO], 1u); break; } } } } while (0)
__device__ __forceinline__ void xcd_barrier_complete(unsigned* bar, unsigned x, unsigned& nloc, unsigned& nx) {
    const unsigned G = gridDim.x;
    unsigned sum, cnt, mine, sp = 0u;
    for (;;) {
        sum = 0u; cnt = 0u; mine = 0u;
#pragma unroll
        for (unsigned j = 0; j < 16; ++j) { const unsigned c = xb_ld(&bar[XB_XCNT(j)]); sum += c; cnt += (c > 0u) ? 1u : 0u; mine = (j == x) ? c : mine; }
        if (sum == G) break;
        __builtin_amdgcn_s_sleep(1);
        if ((++sp & 255u) == 0u) { if (xb_ld(&bar[XB_TMO])) break; if (sp > XB_SPIN_CAP) { atomicAdd(&bar[XB_TMO], 1u); break; } }
    }
    nloc = mine > 0u ? mine : 1u; nx = cnt > 0u ? cnt : 1u;
}
__device__ __forceinline__ void xcd_barrier(unsigned* bar, LAS unsigned char* lds, int tid) {
    const unsigned x = (unsigned)__builtin_amdgcn_s_getreg((3 << 11) | 20) & 0xFu; volatile LAS unsigned* st = (volatile LAS unsigned*)(lds + CTR_OFF + 64);
    asm volatile("s_waitcnt vmcnt(0) lgkmcnt(0)" ::: "memory");
    __syncthreads();
    if (tid == 0) {
        unsigned nloc = st[0], nx = st[1];
        if (nloc == 0u) { xcd_barrier_complete(bar, x, nloc, nx); st[0] = nloc; st[1] = nx; }
        const unsigned old = xb_add(&bar[XB_XSUB(x)], 1u);
        const unsigned gen = old / nloc;
        if (old + 1u == (gen + 1u) * nloc) {
            __builtin_amdgcn_fence(__ATOMIC_RELEASE, "agent");
            asm volatile("s_waitcnt vmcnt(0)" ::: "memory");
            const unsigned og = xb_add(&bar[XB_TOP], 1u);
            const unsigned tg = og / nx;
            if (og + 1u == (tg + 1u) * nx) xb_add(&bar[XB_TOPGEN], 1u);
            else XB_SPIN(xb_ld(&bar[XB_TOPGEN]) == tg, bar);
            __builtin_amdgcn_fence(__ATOMIC_ACQUIRE, "agent");
            xb_add(&bar[XB_XGEN(x)], 1u);
            asm volatile("s_waitcnt vmcnt(0)" ::: "memory");
        } else {
            XB_SPIN(xb_ld(&bar[XB_XGEN(x)]) == gen, bar);
            __builtin_amdgcn_fence(__ATOMIC_ACQUIRE, "agent");
            asm volatile("s_waitcnt vmcnt(0)" ::: "memory");
        }
    }
    __syncthreads();
}

constexpr int NPHASE = 21;
__global__ void __launch_bounds__(512, 2) fwd_kernel(Params P) {
    extern __shared__ __attribute__((aligned(16))) unsigned char shm[];
    LAS unsigned char* lds = (LAS unsigned char*)shm;
        unsigned char* ws = P.ws; unsigned char* dout = (unsigned char*)P.out;
    bf16_t* xb = (bf16_t*)(ws + OFF_XB); bf16_t* Gt = (bf16_t*)(ws + OFF_G); bf16_t* Mg = (bf16_t*)(dout + DO_MG);
    bf16_t* xn = (bf16_t*)(ws + OFF_HC); bf16_t* Dl = (bf16_t*)(ws + OFF_QO);
    unsigned* ctl = (unsigned*)(ws + OFF_CTL);
    StaticOrder S;
    unsigned nbar = 0;
    const int wave_s = __builtin_amdgcn_readfirstlane((int)threadIdx.x >> 6);
    if (P.ph_hi - P.ph_lo > 1) cg::this_grid().sync();
    { volatile LAS unsigned* xst = (volatile LAS unsigned*)(lds + CTR_OFF + 64);
      const unsigned xcc = (unsigned)__builtin_amdgcn_s_getreg((3 << 11) | 20) & 0xFu;
      if (threadIdx.x == 0) { xst[0] = 0u; xst[1] = 0u; (void)xb_add(&ctl[XB_XCNT(xcc)], 1u); }
      __syncthreads(); }
    for (int ph = P.ph_lo; ph < P.ph_hi; ++ph) {
        const int wave = wave_s;
#define PHASE_IDS const int lane = lane_now(); const int tid = (wave_s << 6) | lane; (void)tid; (void)lane;
        if (ph == 0) { PHASE_IDS for (int rp = 0; rp < NREP_P0; ++rp) phase_p0(P, lds, wave, lane, tid); }
        else if (ph == NPHASE - 1) { PHASE_IDS phase_rows<true>(P, wave, lane, false); }
        else {
            const int l = (ph - 1) / 10, s = (ph - 1) % 10;
            if (s == 0) { PHASE_IDS
                S.init(NTOK, 7168, gridDim.x, blockIdx.x);
                Gemm g{xn, (const bf16_t*)(ws + OFF_WIN) + (size_t)l * 7168 * 1024, NTOK, 7168, 1024};
                EpiIn E{(bf16_t*)(dout + DO_U), (bf16_t*)(ws + OFF_QO), (bf16_t*)(dout + DO_K), (bf16_t*)(dout + DO_V), (bf16_t*)(ws + OFF_CG), Gt, P.in[I_BGATE] + l * 3072};
                gemm_phase<EpiIn, StaticOrder, false>(lds, g, S, E, nullptr, tid);
            } else if (s == 1) { PHASE_IDS
                LAS unsigned* lctr = (LAS unsigned*)(lds + CTR_OFF);
                if (tid == 0) lctr[0] = 0u;
                __syncthreads();
                const int grp = blockIdx.x & 7, rank = blockIdx.x >> 3; constexpr int per = 128;
                if (wave < 4) { for (int it = blockIdx.x * 4 + wave; it < 1024; it += gridDim.x * 4) s5_item(P, l, it, lds + wave * S5_WL, lane_now()); }
                LAS unsigned char* vl = lds + ATT_OFF + wave * ATT_WL;
                for (;;) { const int ln = lane_now(); const int k = lds_claim(lctr, ln); const int li = rank * per + k; if (k >= per || li >= 4096) break;
                    const int b = grp + 8 * (li >> 10), rest = li & 1023;
                    if (rest < 512) attn_item<1>(P, b * 512 + rest, vl, ln); else attn_item<2>(P, b * 512 + rest - 512, vl, ln); }
            } else if (s == 2) { PHASE_IDS
                LAS unsigned* lctr = (LAS unsigned*)(lds + CTR_OFF);
                if (tid == 0) lctr[0] = 0u;
                { const unsigned* cwg = (const unsigned*)(ws + OFF_CONVW) + (size_t)l * 31 * 256;
                  for (int i = tid; i < 31 * 64; i += 512) *(LAS u32x4*)(lds + i * 16) = *(const u32x4*)(cwg + i * 4); }
                __syncthreads();
                const int grp = blockIdx.x & 7, rank = blockIdx.x >> 3; constexpr int per = 96;
                LAS unsigned char* vl = lds + ATT_OFF + wave * ATT_WL;
                for (;;) { const int ln = lane_now(); const int k = lds_claim(lctr, ln); const int li = rank * per + k; if (k >= per || li >= 3072) break;
                    const int b = grp + 8 * (li / 768), rest = li % 768;
                    if (rest < 512) attn_item<0>(P, b * 512 + rest, vl, ln); else conv_item(P, l, b * 256 + rest - 512, ln, lds); }
            } else if (s == 3) { PHASE_IDS
                S.init(NTOK, 2048, gridDim.x, blockIdx.x);
                Gemm g{(const bf16_t*)(dout + DO_Y), (const bf16_t*)(ws + OFF_WGLU) + (size_t)l * 2048 * 512, NTOK, 2048, 512};
                EpiGluMerge E{Mg, Gt};
                gemm_phase<EpiGluMerge, StaticOrder, false>(lds, g, S, E, nullptr, tid);
            } else if (s == 4) { PHASE_IDS
                S.init(NTOK, 1024, gridDim.x, blockIdx.x);
                for (int c = 0; c < 2; ++c) {
                    Gemm g{(const bf16_t*)(ws + (c == 0 ? OFF_HC : OFF_OC)), (const bf16_t*)(ws + (c == 0 ? OFF_WPW2 : OFF_WATT)) + (size_t)l * 1024 * 512, NTOK, 1024, 512};
                    EpiAccMerge E{Mg, Gt, c == 0 ? 2048 : 1024};
                    gemm_phase<EpiAccMerge, StaticOrder, false>(lds, g, S, E, nullptr, tid);
                    __syncthreads();
                }
            } else if (s == 6 || s == 9) { PHASE_IDS
                phase_rows<false>(P, wave, lane, true);
            } else if (s == 5 || s == 8) { PHASE_IDS
                S.init(NTOK, 1024, gridDim.x, blockIdx.x);
                Gemm g{s == 5 ? (const bf16_t*)Mg : (const bf16_t*)Gt, s == 5 ? (const bf16_t*)(ws + OFF_WOUT) + (size_t)l * 1024 * 1024 : (const bf16_t*)(ws + OFF_WF2) + (size_t)l * 1024 * 2816, NTOK, 1024, s == 5 ? 1024 : 2816};
                EpiDelta E{Dl};
                gemm_phase<EpiDelta, StaticOrder, false>(lds, g, S, E, nullptr, tid);
            } else {
                PHASE_IDS
                S.init(NTOK, 5632, gridDim.x, blockIdx.x);
                Gemm g{xn, (const bf16_t*)(ws + OFF_WF1) + (size_t)l * 5632 * 1024, NTOK, 5632, 1024};
                EpiFfn1 E{Gt};
                gemm_phase<EpiFfn1, StaticOrder, false>(lds, g, S, E, nullptr, tid);
            }
        }
        if (ph + 1 < P.ph_hi) xcd_barrier(ctl, lds, (wave_s << 6) | lane_now());
    }
}

extern "C" void kernel_launch(void* const* d_in, const int* in_sizes, int n_in, void* d_out, int out_size, void* d_ws, size_t ws_size, hipStream_t stream) {
    static int grid = 0;
    if (grid == 0) {
        if (n_in != 24 || out_size != NTOK * 1024 || ws_size < WS_END) { fprintf(stderr, "kernel_launch: unexpected problem (n_in %d out %d ws %zu need %zu)\n", n_in, out_size, ws_size, (size_t)WS_END); grid = -1; return; }
        int dev = 0, cus = 0, per_cu = 0;
        hipGetDevice(&dev); hipDeviceGetAttribute(&cus, hipDeviceAttributeMultiprocessorCount, dev);
        if (hipFuncSetAttribute((const void*)fwd_kernel, hipFuncAttributeMaxDynamicSharedMemorySize, LDS_BYTES) != hipSuccess) { fprintf(stderr, "kernel_launch: hipFuncSetAttribute failed\n"); grid = -1; return; }
        hipOccupancyMaxActiveBlocksPerMultiprocessor(&per_cu, (const void*)fwd_kernel, 512, LDS_BYTES);
        if (per_cu < 1) { fprintf(stderr, "kernel_launch: occupancy query says %d blocks/CU\n", per_cu); per_cu = 1; }
        (void)hipGetLastError();
        grid = cus * per_cu; if (grid > 256) grid = 256;
        if (grid != 256) { fprintf(stderr, "kernel_launch: this build partitions its work over exactly 256 workgroups (got %d)\n", grid); grid = -1; return; }
    }
    if (grid < 0) return;
    hipMemsetAsync((unsigned char*)d_ws + OFF_CTL, 0, 16384, stream);
    Params p{};
    for (int i = 0; i < 24; ++i) p.in[i] = (const float*)d_in[i];
    p.out = (float*)d_out; p.ws = (unsigned char*)d_ws;
#if MK_PER_PHASE
    for (int ph = 0; ph < NPHASE; ++ph) { p.ph_lo = ph; p.ph_hi = ph + 1; hipLaunchKernelGGL(fwd_kernel, dim3(grid), dim3(512), LDS_BYTES, stream, p); }
#else
    p.ph_lo = 0; p.ph_hi = NPHASE;
    void* args[] = {&p};
    hipError_t e = hipLaunchCooperativeKernel((const void*)fwd_kernel, dim3(grid), dim3(512), args, LDS_BYTES, stream);
    if (e != hipSuccess) fprintf(stderr, "cooperative launch failed: %s (grid %d)\n", hipGetErrorString(e), grid);
#endif
}
```

```cpp
#include <hip/hip_runtime.h>
#include <hip/hip_cooperative_groups.h>
#include <cstdio>
namespace cg = cooperative_groups;
namespace pg8 {
#define PG8_LAS __attribute__((address_space(3)))
typedef unsigned short bf16_t;
typedef short bf16x8 __attribute__((ext_vector_type(8)));
typedef float f32x4 __attribute__((ext_vector_type(4)));
typedef unsigned u32x4 __attribute__((ext_vector_type(4)));
constexpr int BM = 256, BK = 64, HALF = 128, HTB = HALF * BK * 2  , STAGE_BYTES = 8 * HTB, NXCD = 8, WGM = 8;

__host__ __device__ __forceinline__ int lds_byte(int r, int c) { const int st = (r >> 4) * 2 + (c >> 5), rr = r & 15, cc = c & 31, ob = rr * 64 + cc * 2; return st * 1024 + (ob ^ (((ob >> 9) & 1) << 5)); }
__host__ __device__ __forceinline__ void stage_rc(int b, int& R, int& C) { const int st = b / 1024, sb = b % 1024, swz = sb ^ (((sb >> 9) & 1) << 5); R = (st >> 1) * 16 + swz / 64; C = (st & 1) * 32 + (swz % 64) / 2; }
__host__ __device__ __forceinline__ int perm32(int rho) { const int n = rho >> 4, i = rho & 15; return 8 * (i >> 2) + 4 * n + (i & 3); }

struct Unit { int pm, pn; };
struct Gemm { const bf16_t* A; const bf16_t* Bt; int M, N, K; };

struct StaticOrder {
    int nM, nN, nwg, G, c;
    __host__ __device__ void init(int M, int N, int G_, int c_) { nM = M / BM; nN = N / BM; nwg = nM * nN; G = G_; c = c_; }
    __host__ __device__ bool next(int i, Unit& u) const {
        const long L = (long)i * G + c; if (L >= nwg) return false;
        int wgid = (int)L; { const int q = nwg / NXCD, r = nwg % NXCD, xcd = wgid % NXCD, off = wgid / NXCD; wgid = (xcd < r ? xcd * (q + 1) : r * (q + 1) + (xcd - r) * q) + off; }
        const int nig = WGM * nN, gid = wgid / nig, fm = gid * WGM, gsz = (nM - fm) < WGM ? (nM - fm) : WGM;
        u.pm = fm + ((wgid % nig) % gsz); u.pn = (wgid % nig) / gsz; return true;
    }
    __device__ __forceinline__ void a_ready(const Unit&) const {}
    __device__ __forceinline__ void done(const Unit&) const {}
};
__device__ __forceinline__ unsigned cvt_pk_bf16(float lo, float hi) { unsigned r; asm volatile("s_nop 1\n\tv_cvt_pk_bf16_f32 %0, %1, %2" : "=v"(r) : "v"(lo), "v"(hi)); return r; }
template <class Epi, class Sched, bool STAMP = false>
__device__ __forceinline__ void gemm_phase(PG8_LAS unsigned char* lds, const Gemm g, const Sched& S, const Epi& E, unsigned long long* stamps, int tid_in) {
    int tid_o = tid_in; asm volatile("" : "+v"(tid_o)); const int tid = tid_o, wid = __builtin_amdgcn_readfirstlane(tid >> 6), lane = tid & 63, wr = wid >> 2, wc = wid & 3, fr = lane & 15, fq = lane >> 4;
    const int K = g.K, nt = K / BK;
    int ts_lo = 0, ts_hi = 0, nts = 0; const unsigned long long rt_entry = STAMP ? (unsigned long long)wall_clock64() : 0ull;
#define PG8_STAMP() do { if (STAMP && wid == 0 && nts < 64) { const unsigned long long _c = (unsigned long long)clock64(); \
        ts_lo = (lane == nts) ? (int)(unsigned)_c : ts_lo; ts_hi = (lane == nts) ? (int)(unsigned)(_c >> 32) : ts_hi; ++nts; } } while (0)
    PG8_STAMP();
    unsigned voffA[2], voffB[2];
#pragma unroll
    for (int i = 0; i < 2; ++i) { int R, C; stage_rc(tid * 16 + i * 8192, R, C); const int Rb = Epi::PERM ? ((R & ~31) + perm32(R & 31)) : R;
        voffA[i] = (unsigned)(R * K + C) * 2u; voffB[i] = (unsigned)(Rb * K + C) * 2u; }
    const size_t kstep = (size_t)(BK * 2);
    const size_t hstep = (size_t)HALF * K * 2;
    const size_t tstep = 2 * hstep;
    const unsigned ldsw = (unsigned)wid * 1024u;
    const int aoff = lds_byte(wr * 64 + fr, fq * 8), boff = lds_byte(wc * 32 + fr, fq * 8);
#define PG8_SA(b, h) (((b) * 2 + (h)) * HTB)
#define PG8_SB(b, h) ((4 + (b) * 2 + (h)) * HTB)
#define PG8_STAGE(bufoff, gbase, voff) do { _Pragma("unroll") for (int _i = 0; _i < 2; ++_i) \
        __builtin_amdgcn_global_load_lds((const unsigned*)((const char*)(gbase) + (voff)[_i]), (PG8_LAS unsigned*)(lds + (bufoff) + ldsw + _i * 8192), 16, 0, 0); } while (0)
#define PG8_LDA(dst, b, h) do { _Pragma("unroll") for (int m = 0; m < 4; ++m) _Pragma("unroll") for (int k = 0; k < 2; ++k) dst[m][k] = *(const PG8_LAS bf16x8*)(lds + PG8_SA(b, h) + aoff + m * 2048 + k * 1024); } while (0)
#define PG8_LDB(dst, b, h) do { _Pragma("unroll") for (int n = 0; n < 2; ++n) _Pragma("unroll") for (int k = 0; k < 2; ++k) dst[n][k] = *(const PG8_LAS bf16x8*)(lds + PG8_SB(b, h) + boff + n * 2048 + k * 1024); } while (0)
#define PG8_MMA(ai, bj, At, Bt) do { __builtin_amdgcn_s_setprio(1); _Pragma("unroll") for (int m = 0; m < 4; ++m) _Pragma("unroll") for (int n = 0; n < 2; ++n) _Pragma("unroll") for (int k = 0; k < 2; ++k) \
        acc[ai][bj][m][n] = __builtin_amdgcn_mfma_f32_16x16x32_bf16(Bt[n][k], At[m][k], acc[ai][bj][m][n], 0, 0, 0); __builtin_amdgcn_s_setprio(0); } while (0)
#define PG8_WAIT_V(n) asm volatile("s_waitcnt vmcnt(" #n ")" ::: "memory")
#define PG8_WAIT_L(n) asm volatile("s_waitcnt lgkmcnt(" #n ")" ::: "memory")
#define PG8_BAR __builtin_amdgcn_s_barrier()
#define PG8_SCHED __builtin_amdgcn_sched_barrier(0)
    Unit cur, nxt; int ui = 0;
    if (!S.next(0, cur)) return;
    f32x4 acc[2][2][4][2];
#pragma unroll
    for (int a = 0; a < 2; ++a)
#pragma unroll
        for (int b = 0; b < 2; ++b)
#pragma unroll
            for (int m = 0; m < 4; ++m)
#pragma unroll
                for (int n = 0; n < 2; ++n) acc[a][b][m][n] = (f32x4){0.f, 0.f, 0.f, 0.f};
    bf16x8 At[4][2], B0[2][2], B1[2][2];
    const char* cA = (const char*)g.A + (size_t)cur.pm * tstep; const char* cB = (const char*)g.Bt + (size_t)cur.pn * tstep;
    S.a_ready(cur);
    PG8_STAGE(PG8_SB(0, 0), cB, voffB); PG8_STAGE(PG8_SA(0, 0), cA, voffA); PG8_STAGE(PG8_SB(0, 1), cB + hstep, voffB); PG8_STAGE(PG8_SA(0, 1), cA + hstep, voffA);
    if (wr == 1) PG8_BAR;
    PG8_WAIT_V(4); PG8_BAR;
    PG8_STAGE(PG8_SB(1, 0), cB + kstep, voffB); PG8_STAGE(PG8_SA(1, 0), cA + kstep, voffA); PG8_STAGE(PG8_SB(1, 1), cB + hstep + kstep, voffB);
    PG8_WAIT_V(6); PG8_BAR;
    PG8_STAMP();
    for (;;) {
        const bool has_next = S.next(ui + 1, nxt);
        const char* nA = has_next ? (const char*)g.A + (size_t)nxt.pm * tstep : cA; const char* nB = has_next ? (const char*)g.Bt + (size_t)nxt.pn * tstep : cB;
        for (int t = 0; t < nt; t += 2) {
            const bool last = (t == nt - 2);
            const char* a1 = cA + (size_t)(t + 1) * kstep;
            const char* a2 = last ? nA : cA + (size_t)(t + 2) * kstep; const char* b2 = last ? nB : cB + (size_t)(t + 2) * kstep;
            const char* a3 = a2 + kstep; const char* b3 = b2 + kstep;
            if (last && has_next) S.a_ready(nxt);
            PG8_LDB(B0, 0, 0); PG8_SCHED; PG8_LDA(At, 0, 0); PG8_STAGE(PG8_SA(1, 1), a1 + hstep, voffA);
            PG8_WAIT_L(8); PG8_BAR; PG8_WAIT_L(0); PG8_MMA(0, 0, At, B0); PG8_BAR; PG8_SCHED;
            PG8_LDB(B1, 0, 1); PG8_STAGE(PG8_SB(0, 0), b2, voffB);
            PG8_BAR; PG8_WAIT_L(0); PG8_MMA(0, 1, At, B1); PG8_BAR;
            PG8_LDA(At, 0, 1); PG8_STAGE(PG8_SA(0, 0), a2, voffA);
            PG8_BAR; PG8_WAIT_L(0); PG8_MMA(1, 0, At, B0); PG8_BAR; PG8_SCHED;
            PG8_STAGE(PG8_SB(0, 1), b2 + hstep, voffB);
            PG8_WAIT_V(6); PG8_BAR; PG8_MMA(1, 1, At, B1); PG8_BAR;
            PG8_LDB(B0, 1, 0); PG8_SCHED; PG8_LDA(At, 1, 0); PG8_STAGE(PG8_SA(0, 1), a2 + hstep, voffA);
            PG8_WAIT_L(8); PG8_BAR; PG8_WAIT_L(0); PG8_MMA(0, 0, At, B0); PG8_BAR; PG8_SCHED;
            PG8_LDB(B1, 1, 1); PG8_STAGE(PG8_SB(1, 0), b3, voffB);
            PG8_BAR; PG8_WAIT_L(0); PG8_MMA(0, 1, At, B1); PG8_BAR;
            PG8_LDA(At, 1, 1); PG8_STAGE(PG8_SA(1, 0), a3, voffA);
            PG8_BAR; PG8_WAIT_L(0); PG8_MMA(1, 0, At, B0); PG8_BAR; PG8_SCHED;
            PG8_STAGE(PG8_SB(1, 1), b3 + hstep, voffB);
            PG8_WAIT_V(6); PG8_BAR; PG8_MMA(1, 1, At, B1); PG8_BAR;
        }
        PG8_STAMP();
        if constexpr (!Epi::AFTER_DRAIN) { E(acc, cur, wr, wc, fr, fq); S.done(cur); }
        PG8_STAMP();
        if (!has_next) break;
#pragma unroll
        for (int a = 0; a < 2; ++a)
#pragma unroll
            for (int b = 0; b < 2; ++b)
#pragma unroll
                for (int m = 0; m < 4; ++m)
#pragma unroll
                    for (int n = 0; n < 2; ++n) acc[a][b][m][n] = (f32x4){0.f, 0.f, 0.f, 0.f};
        cur = nxt; cA = nA; cB = nB; ++ui;
    }
    PG8_WAIT_V(0);
    if (wr == 0) PG8_BAR;
    PG8_BAR;
    if constexpr (Epi::AFTER_DRAIN) { E.fused(acc, cur, wr, wc, fr, fq, lds, wid, lane); S.done(cur); }
    PG8_STAMP();
    if (STAMP && wid == 0) { stamps[lane] = lane < nts ? (((unsigned long long)(unsigned)ts_hi << 32) | (unsigned)ts_lo) : 0ull;
        if (lane == 62) stamps[62] = rt_entry; if (lane == 63) stamps[63] = (unsigned long long)wall_clock64(); }
#undef PG8_STAMP
#undef PG8_SA
#undef PG8_SB
#undef PG8_STAGE
#undef PG8_LDA
#undef PG8_LDB
#undef PG8_MMA
#undef PG8_WAIT_V
#undef PG8_WAIT_L
#undef PG8_BAR
#undef PG8_SCHED
}
}

using namespace pg8;
#define LAS __attribute__((address_space(3)))
typedef short s16x4 __attribute__((ext_vector_type(4)));
typedef short v4i16_t __attribute__((ext_vector_type(4)));
typedef float f32x16 __attribute__((ext_vector_type(16)));
typedef unsigned u32x2 __attribute__((ext_vector_type(2)));
typedef float f32x2v __attribute__((ext_vector_type(2)));

#ifndef NREP_S5
#define NREP_S5 1
#endif
#ifndef NREP_B2
#define NREP_B2 1
#endif
#ifndef NREP_P0
#define NREP_P0 1
#endif
#ifndef MK_PER_PHASE
#define MK_PER_PHASE 0
#endif

constexpr int NTOK = 65536, SEQL = 2048;
constexpr float EPSN = 1e-6f;
constexpr int LDS_BYTES = 155648;
constexpr int S5_WL = 25088;
constexpr int ATT_OFF = 4 * S5_WL;
constexpr int VSTR = 192;
constexpr int ATT_WL = 32 * VSTR;
constexpr int CTR_OFF = LDS_BYTES - 256;
static_assert(ATT_OFF + 8 * ATT_WL <= CTR_OFF, "lds");

constexpr size_t OFF_WIN = 0;
constexpr size_t OFF_WGLU = OFF_WIN + 2ull * 7168 * 1024 * 2;
constexpr size_t OFF_WATT = OFF_WGLU + 2ull * 2048 * 512 * 2;
constexpr size_t OFF_WPW2 = OFF_WATT + 2ull * 1024 * 512 * 2;
constexpr size_t OFF_WOUT = OFF_WPW2 + 2ull * 1024 * 512 * 2;
constexpr size_t OFF_WF1 = OFF_WOUT + 2ull * 1024 * 1024 * 2;
constexpr size_t OFF_WF2 = OFF_WF1 + 2ull * 5632 * 1024 * 2;
constexpr size_t OFF_S5BB = OFF_WF2 + 2ull * 1024 * 2816 * 2;
constexpr size_t OFF_S5CM = OFF_S5BB + 2ull * 32 * 128 * 16 * 2;
constexpr size_t OFF_S5A = OFF_S5CM + 2ull * 32 * 16 * 128 * 2;
constexpr size_t OFF_CONVW = OFF_S5A + 2ull * 32 * 64 * 8;
constexpr size_t OFF_CTL = OFF_CONVW + 65536;
constexpr size_t OFF_RSQ1 = OFF_CTL + 16384;
constexpr size_t OFF_RSQ2 = OFF_RSQ1 + 65536ull * 8;
constexpr size_t OFF_LSE = OFF_RSQ2 + 65536ull * 8;
constexpr size_t OFF_XB = OFF_LSE + 2ull * 65536 * 8 * 4;
constexpr size_t OFF_G = OFF_XB + 65536ull * 1024 * 2;
constexpr size_t OFF_QO = OFF_G + 65536ull * 3072 * 2;
constexpr size_t OFF_CG = OFF_QO + 65536ull * 1536 * 2;
constexpr size_t OFF_HC = OFF_CG + 65536ull * 512 * 2;
constexpr size_t OFF_OC = OFF_HC + 65536ull * 512 * 2;
constexpr size_t WS_END = OFF_OC + 65536ull * 512 * 2;
constexpr size_t DO_U = 0, DO_K = 64ull << 20, DO_V = 128ull << 20, DO_Y = 192ull << 20, DO_MG = 64ull << 20;

struct Params {
    const float* in[24];
    float* out; unsigned char* ws;
    int ph_lo, ph_hi;
};
enum { I_X = 0, I_N1G, I_WIN, I_BGATE, I_LRE, I_LIM, I_LOGDT, I_BRE, I_BIM, I_CRE, I_CIM, I_SSMD, I_WGLU, I_WATT, I_CONVW, I_CONVB, I_LNG, I_LNB, I_WPW2, I_WOUT, I_N2G, I_WF1, I_WF2, I_FING };

__device__ __forceinline__ float bf_lo(unsigned u) { return __uint_as_float(u << 16); }
__device__ __forceinline__ float bf_hi(unsigned u) { return __uint_as_float(u & 0xffff0000u); }
__device__ __forceinline__ float sigm(float x) { return __builtin_amdgcn_rcpf(1.f + __expf(-x)); }
__device__ __forceinline__ unsigned short f2bf(float f) { unsigned u = __float_as_uint(f); u += 0x7FFFu + ((u >> 16) & 1u); return (unsigned short)(u >> 16); }
__device__ __forceinline__ float wave_sum(float v) {
#pragma unroll
    for (int o = 1; o < 64; o <<= 1) v += __shfl_xor(v, o);
    return v;
}
__device__ __forceinline__ s16x4 vtr(const LAS unsigned char* p) { return __builtin_bit_cast(s16x4, __builtin_amdgcn_ds_read_tr16_b64_v4i16((LAS v4i16_t*)p)); }

__device__ __forceinline__ u32x4 pack8(const f32x4 a, const f32x4 b) { u32x4 w; w.x = cvt_pk_bf16(a[0], a[1]); w.y = cvt_pk_bf16(a[2], a[3]); w.z = cvt_pk_bf16(b[0], b[1]); w.w = cvt_pk_bf16(b[2], b[3]); return w; }
__device__ __forceinline__ void unpack8(const u32x4 w, f32x4& a, f32x4& b) { a[0] = bf_lo(w.x); a[1] = bf_hi(w.x); a[2] = bf_lo(w.y); a[3] = bf_hi(w.y); b[0] = bf_lo(w.z); b[1] = bf_hi(w.z); b[2] = bf_lo(w.w); b[3] = bf_hi(w.w); }

struct EpiIn {
    static constexpr bool PERM = true, AFTER_DRAIN = false;
    bf16_t *U, *QO, *Kb, *Vb, *CG, *G; const float* bgate;
    __device__ __forceinline__ void operator()(const f32x4 (&acc)[2][2][4][2], const Unit& u, int wr, int wc, int fr, int fq) const {
        const int row0 = u.pm * 256 + wr * 64 + fr, cl = wc * 32 + 8 * fq, pn = u.pn;
        if (pn < 12) {
            bf16_t* base; int ld, col0;
            if (pn < 2) { base = U; ld = 512; col0 = pn * 256; }
            else if (pn < 8) { base = QO; ld = 1536; col0 = (pn - 2) * 256; }
            else if (pn < 10) { base = Kb; ld = 512; col0 = (pn - 8) * 256; }
            else { base = Vb; ld = 512; col0 = (pn - 10) * 256; }
#pragma unroll
            for (int ai = 0; ai < 2; ++ai)
#pragma unroll
                for (int m = 0; m < 4; ++m) { const int r = row0 + ai * 128 + m * 16;
#pragma unroll
                    for (int bj = 0; bj < 2; ++bj) *(u32x4*)(base + (size_t)r * ld + col0 + bj * 128 + cl) = pack8(acc[ai][bj][m][0], acc[ai][bj][m][1]); }
        } else if (pn < 16) {
            const int c0 = (pn - 12) * 128 + cl;
#pragma unroll
            for (int ai = 0; ai < 2; ++ai)
#pragma unroll
                for (int m = 0; m < 4; ++m) { const int r = row0 + ai * 128 + m * 16;
                    f32x4 o[2];
#pragma unroll
                    for (int n = 0; n < 2; ++n)
#pragma unroll
                        for (int j = 0; j < 4; ++j) o[n][j] = acc[ai][0][m][n][j] * sigm(acc[ai][1][m][n][j]);
                    *(u32x4*)(CG + (size_t)r * 512 + c0) = pack8(o[0], o[1]); }
        } else {
            const int c0 = (pn - 16) * 256 + cl;
            f32x4 bv[2][2];
#pragma unroll
            for (int bj = 0; bj < 2; ++bj)
#pragma unroll
                for (int n = 0; n < 2; ++n) bv[bj][n] = *(const f32x4*)(bgate + c0 + bj * 128 + 4 * n);
#pragma unroll
            for (int ai = 0; ai < 2; ++ai)
#pragma unroll
                for (int m = 0; m < 4; ++m) { const int r = row0 + ai * 128 + m * 16;
#pragma unroll
                    for (int bj = 0; bj < 2; ++bj) { f32x4 o[2];
#pragma unroll
                        for (int n = 0; n < 2; ++n)
#pragma unroll
                            for (int j = 0; j < 4; ++j) o[n][j] = sigm(acc[ai][bj][m][n][j] + bv[bj][n][j]);
                        *(u32x4*)(G + (size_t)r * 3072 + c0 + bj * 128) = pack8(o[0], o[1]); } }
        }
    }
};
struct EpiGluMerge {
    static constexpr bool PERM = true, AFTER_DRAIN = false;
    bf16_t* Mg; const bf16_t* G;
    __device__ __forceinline__ void operator()(const f32x4 (&acc)[2][2][4][2], const Unit& u, int wr, int wc, int fr, int fq) const {
        const int row0 = u.pm * 256 + wr * 64 + fr, c0 = u.pn * 128 + wc * 32 + 8 * fq;
        u32x4 gv[2][4];
#pragma unroll
        for (int ai = 0; ai < 2; ++ai)
#pragma unroll
            for (int m = 0; m < 4; ++m) gv[ai][m] = *(const u32x4*)(G + (size_t)(row0 + ai * 128 + m * 16) * 3072 + c0);
#pragma unroll
        for (int ai = 0; ai < 2; ++ai)
#pragma unroll
            for (int m = 0; m < 4; ++m) { const int r = row0 + ai * 128 + m * 16;
                f32x4 g0, g1; unpack8(gv[ai][m], g0, g1);
                f32x4 o[2];
#pragma unroll
                for (int j = 0; j < 4; ++j) { o[0][j] = g0[j] * acc[ai][0][m][0][j] * sigm(acc[ai][1][m][0][j]); o[1][j] = g1[j] * acc[ai][0][m][1][j] * sigm(acc[ai][1][m][1][j]); }
                *(u32x4*)(Mg + (size_t)r * 1024 + c0) = pack8(o[0], o[1]); }
    }
};
struct EpiAccMerge {
    static constexpr bool PERM = true, AFTER_DRAIN = false;
    bf16_t* Mg; const bf16_t* G; int gate_off;
    __device__ __forceinline__ void operator()(const f32x4 (&acc)[2][2][4][2], const Unit& u, int wr, int wc, int fr, int fq) const {
        const int row0 = u.pm * 256 + wr * 64 + fr, cb = u.pn * 256 + wc * 32 + 8 * fq;
#pragma unroll
        for (int ai = 0; ai < 2; ++ai)
#pragma unroll
          for (int mh = 0; mh < 2; ++mh) {
            u32x4 gv[2][2], mv[2][2];
#pragma unroll
            for (int mm = 0; mm < 2; ++mm)
#pragma unroll
                for (int bj = 0; bj < 2; ++bj) { const int r = row0 + ai * 128 + (2 * mh + mm) * 16, c0 = cb + bj * 128;
                    gv[mm][bj] = *(const u32x4*)(G + (size_t)r * 3072 + gate_off + c0); mv[mm][bj] = *(const u32x4*)(Mg + (size_t)r * 1024 + c0); }
#pragma unroll
            for (int mm = 0; mm < 2; ++mm)
#pragma unroll
                for (int bj = 0; bj < 2; ++bj) { const int m = 2 * mh + mm; const int r = row0 + ai * 128 + m * 16, c0 = cb + bj * 128;
                    f32x4 g0, g1, m0, m1; unpack8(gv[mm][bj], g0, g1); unpack8(mv[mm][bj], m0, m1);
                    *(u32x4*)(Mg + (size_t)r * 1024 + c0) = pack8(m0 + g0 * acc[ai][bj][m][0], m1 + g1 * acc[ai][bj][m][1]); }
            asm volatile("" ::: "memory");
          }
    }
};
struct EpiDelta {
    static constexpr bool PERM = true, AFTER_DRAIN = false;
    bf16_t* D;
    __device__ __forceinline__ void operator()(const f32x4 (&acc)[2][2][4][2], const Unit& u, int wr, int wc, int fr, int fq) const {
        const int row0 = u.pm * 256 + wr * 64 + fr, cb = u.pn * 256 + wc * 32 + 8 * fq;
#pragma unroll
        for (int ai = 0; ai < 2; ++ai)
#pragma unroll
            for (int m = 0; m < 4; ++m)
#pragma unroll
                for (int bj = 0; bj < 2; ++bj) *(u32x4*)(D + (size_t)(row0 + ai * 128 + m * 16) * 1024 + cb + bj * 128) = pack8(acc[ai][bj][m][0], acc[ai][bj][m][1]);
    }
};
struct EpiFfn1 {
    static constexpr bool PERM = true, AFTER_DRAIN = false;
    bf16_t* Hf;
    __device__ __forceinline__ void operator()(const f32x4 (&acc)[2][2][4][2], const Unit& u, int wr, int wc, int fr, int fq) const {
        const int row0 = u.pm * 256 + wr * 64 + fr, c0 = u.pn * 128 + wc * 32 + 8 * fq;
#pragma unroll
        for (int ai = 0; ai < 2; ++ai)
#pragma unroll
            for (int m = 0; m < 4; ++m) { const int r = row0 + ai * 128 + m * 16;
                f32x4 o[2];
#pragma unroll
                for (int n = 0; n < 2; ++n)
#pragma unroll
                    for (int j = 0; j < 4; ++j) { const float a = acc[ai][0][m][n][j], b = acc[ai][1][m][n][j]; o[n][j] = a * sigm(a) * b; }
                *(u32x4*)(Hf + (size_t)r * 2816 + c0) = pack8(o[0], o[1]); }
    }
};

__device__ __forceinline__ void p0_tr_item(const float* W, int K, int N, bf16_t* WT, int kb, int nd0, int ns0, const float* gk, float scale, LAS float* scr, int lane) {
    const int k0 = 64 * kb;
#pragma unroll 8
    for (int i = 0; i < 32; ++i) { const int kk = 2 * i + (lane >> 5); float s = scale; if (gk) s *= gk[k0 + kk]; scr[kk * 33 + (lane & 31)] = W[(size_t)(k0 + kk) * N + ns0 + (lane & 31)] * s; }
    asm volatile("" ::: "memory");
    const int c = lane & 7;
#pragma unroll
    for (int j = 0; j < 4; ++j) { const int n = (lane >> 3) + 8 * j; const LAS float* s = scr + (8 * c) * 33 + n;
        u32x4 o; o.x = cvt_pk_bf16(s[0 * 33], s[1 * 33]); o.y = cvt_pk_bf16(s[2 * 33], s[3 * 33]); o.z = cvt_pk_bf16(s[4 * 33], s[5 * 33]); o.w = cvt_pk_bf16(s[6 * 33], s[7 * 33]);
        *(u32x4*)(WT + (size_t)(nd0 + n) * K + k0 + 8 * c) = o; }
    asm volatile("" ::: "memory");
}
__device__ __forceinline__ void phase_p0(const Params& P, LAS unsigned char* lds, int wave, int lane, int tid) {
    unsigned char* ws = P.ws;
    const int gw = blockIdx.x * 8 + wave, NGW = gridDim.x * 8;
    LAS float* scr = (LAS float*)(lds + wave * 16384);
    constexpr int PER_L = 3584 + 512 + 256 + 256 + 512 + 2816 + 1408;
    for (int it = gw; it < 2 * PER_L; it += NGW) {
        const int l = it / PER_L; int r = it % PER_L;
        const float* W; bf16_t* WT; int K, N, type = 0; const float* gk = nullptr;
        if (r < 3584) { W = P.in[I_WIN] + (size_t)l * 1024 * 7168; WT = (bf16_t*)(ws + OFF_WIN) + (size_t)l * 7168 * 1024; K = 1024; N = 7168; type = 1; gk = P.in[I_N1G] + l * 1024; }
        else if ((r -= 3584) < 512) { W = P.in[I_WGLU] + (size_t)l * 512 * 2048; WT = (bf16_t*)(ws + OFF_WGLU) + (size_t)l * 2048 * 512; K = 512; N = 2048; type = 3; }
        else if ((r -= 512) < 256) { W = P.in[I_WATT] + (size_t)l * 512 * 1024; WT = (bf16_t*)(ws + OFF_WATT) + (size_t)l * 1024 * 512; K = 512; N = 1024; }
        else if ((r -= 256) < 256) { W = P.in[I_WPW2] + (size_t)l * 512 * 1024; WT = (bf16_t*)(ws + OFF_WPW2) + (size_t)l * 1024 * 512; K = 512; N = 1024; }
        else if ((r -= 256) < 512) { W = P.in[I_WOUT] + (size_t)l * 1024 * 1024; WT = (bf16_t*)(ws + OFF_WOUT) + (size_t)l * 1024 * 1024; K = 1024; N = 1024; }
        else if ((r -= 512) < 2816) { W = P.in[I_WF1] + (size_t)l * 1024 * 5632; WT = (bf16_t*)(ws + OFF_WF1) + (size_t)l * 5632 * 1024; K = 1024; N = 5632; type = 2; gk = P.in[I_N2G] + l * 1024; }
        else { r -= 2816; W = P.in[I_WF2] + (size_t)l * 2816 * 1024; WT = (bf16_t*)(ws + OFF_WF2) + (size_t)l * 1024 * 2816; K = 2816; N = 1024; }
        const int nblk = N / 32, kb = r / nblk, nd0 = (r % nblk) * 32;
        int ns0 = nd0; float scale = 1.f;
        if (type == 1) { if (nd0 >= 3072 && nd0 < 4096) { const int t = nd0 - 3072, j = t & 255; ns0 = 3072 + (t >> 8) * 128 + (j & 127) + (j >= 128 ? 512 : 0); }
                         if (nd0 >= 512 && nd0 < 2048) scale = 0.125f * 1.4426950408889634f; }
        else if (type == 2) { const int j = nd0 & 255; ns0 = (nd0 >> 8) * 128 + (j & 127) + (j >= 128 ? 2816 : 0); }
        else if (type == 3) { const int j = nd0 & 255; ns0 = (nd0 >> 8) * 128 + (j & 127) + (j >= 128 ? 1024 : 0); }
        p0_tr_item(W, K, N, WT, kb, nd0, ns0, gk, scale, scr, lane);
    }
    { const float* x = P.in[I_X]; bf16_t* xb = (bf16_t*)(ws + OFF_XB); bf16_t* xn0 = (bf16_t*)(ws + OFF_HC);
      for (int row0 = 2 * gw; row0 < NTOK; row0 += 2 * NGW) { f32x4 t[2][4];
#pragma unroll
          for (int q = 0; q < 2; ++q)
#pragma unroll
              for (int j = 0; j < 4; ++j) t[q][j] = *(const f32x4*)(x + (size_t)(row0 + q) * 1024 + 4 * lane + 256 * j);
#pragma unroll
          for (int q = 0; q < 2; ++q) { const int row = row0 + q; float ss = 0.f; f32x4 v[4];
#pragma unroll
              for (int j = 0; j < 4; ++j) { u32x2 w; w.x = cvt_pk_bf16(t[q][j][0], t[q][j][1]); w.y = cvt_pk_bf16(t[q][j][2], t[q][j][3]);
                  *(u32x2*)(xb + (size_t)row * 1024 + 4 * lane + 256 * j) = w; v[j][0] = bf_lo(w.x); v[j][1] = bf_hi(w.x); v[j][2] = bf_lo(w.y); v[j][3] = bf_hi(w.y);
                  ss += v[j][0] * v[j][0] + v[j][1] * v[j][1] + v[j][2] * v[j][2] + v[j][3] * v[j][3]; }
              ss = wave_sum(ss); const float rs = rsqrtf(ss * (1.f / 1024.f) + EPSN);
#pragma unroll
              for (int j = 0; j < 4; ++j) { u32x2 w; w.x = cvt_pk_bf16(v[j][0] * rs, v[j][1] * rs); w.y = cvt_pk_bf16(v[j][2] * rs, v[j][3] * rs); *(u32x2*)(xn0 + (size_t)row * 1024 + 4 * lane + 256 * j) = w; } } } }
    const int gt = blockIdx.x * 512 + tid, NGT = gridDim.x * 512;
    for (int idx = gt; idx < 2 * 32 * 64; idx += NGT) {
        const int lg = idx >> 6, p = idx & 63;
        const float lre = P.in[I_LRE][idx], lim = P.in[I_LIM][idx], dt = expf(P.in[I_LOGDT][lg]);
        const float mag = expf(lre * dt);
        const double rev = (double)lim * (double)dt * 0.15915494309189535; const float frc = (float)(rev - rint(rev));
        const float sn = __builtin_amdgcn_sinf(frc), cs = __builtin_amdgcn_cosf(frc);
        const float are = mag * cs, aim = mag * sn, nr = are - 1.f, ni = aim, den = lre * lre + lim * lim;
        const float zre = (nr * lre + ni * lim) / den, zim = (ni * lre - nr * lim) / den;
        { f32x2v t2; t2.x = are; t2.y = aim; ((f32x2v*)(ws + OFF_S5A))[idx] = t2; }
        bf16_t* bbt = (bf16_t*)(ws + OFF_S5BB) + (size_t)lg * 128 * 16; bf16_t* cm = (bf16_t*)(ws + OFF_S5CM) + (size_t)lg * 16 * 128;
        for (int h = 0; h < 16; ++h) { const float br = P.in[I_BRE][(size_t)idx * 16 + h], bi = P.in[I_BIM][(size_t)idx * 16 + h];
            bbt[p * 16 + h] = f2bf(zre * br - zim * bi); bbt[(64 + p) * 16 + h] = f2bf(zre * bi + zim * br);
            cm[h * 128 + p] = f2bf(P.in[I_CRE][((size_t)lg * 16 + h) * 64 + p]); cm[h * 128 + 64 + p] = f2bf(-P.in[I_CIM][((size_t)lg * 16 + h) * 64 + p]); }
    }
    for (int idx = gt; idx < 2 * 31 * 256; idx += NGT) { const float a = P.in[I_CONVW][2 * idx], b = P.in[I_CONVW][2 * idx + 1]; ((unsigned*)(ws + OFF_CONVW))[idx] = cvt_pk_bf16(a, b); }
}
template <bool FINAL> __device__ __forceinline__ void phase_rows(const Params& P, int wave, int lane, bool want_xn) {
    const int gw = blockIdx.x * 8 + wave, NGW = gridDim.x * 8;
    bf16_t* xb = (bf16_t*)(P.ws + OFF_XB); const bf16_t* D = (const bf16_t*)(P.ws + OFF_QO); bf16_t* xn = (bf16_t*)(P.ws + OFF_HC); const float* fg = P.in[I_FING];
    for (int row = gw; row < NTOK; row += NGW) {
        const size_t o0 = (size_t)row * 1024 + 8 * lane, o1 = o0 + 512;
        const u32x4 w0 = *(const u32x4*)(xb + o0), w1 = *(const u32x4*)(xb + o1), d0 = *(const u32x4*)(D + o0), d1 = *(const u32x4*)(D + o1);
        f32x4 a0, a1, b0, b1, e0, e1, g0, g1; unpack8(w0, a0, a1); unpack8(w1, b0, b1); unpack8(d0, e0, e1); unpack8(d1, g0, g1);
        const u32x4 n0 = pack8(a0 + e0, a1 + e1), n1 = pack8(b0 + g0, b1 + g1);
        unpack8(n0, a0, a1); unpack8(n1, b0, b1);
        float ss = 0.f;
#pragma unroll
        for (int j = 0; j < 4; ++j) ss += a0[j] * a0[j] + a1[j] * a1[j] + b0[j] * b0[j] + b1[j] * b1[j];
        ss = wave_sum(ss);
        const float rs = rsqrtf(ss * (1.f / 1024.f) + EPSN);
        if (!FINAL) { if (lane == 0) ((float*)(P.ws + OFF_RSQ1))[row] = rs; *(u32x4*)(xb + o0) = n0; *(u32x4*)(xb + o1) = n1; if (want_xn) { *(u32x4*)(xn + o0) = pack8(a0 * rs, a1 * rs); *(u32x4*)(xn + o1) = pack8(b0 * rs, b1 * rs); } }
        else { const f32x4 q0 = *(const f32x4*)(fg + 8 * lane), q1 = *(const f32x4*)(fg + 8 * lane + 4), q2 = *(const f32x4*)(fg + 512 + 8 * lane), q3 = *(const f32x4*)(fg + 512 + 8 * lane + 4);
            float* o = P.out + (size_t)row * 1024;
            *(f32x4*)(o + 8 * lane) = a0 * q0 * rs; *(f32x4*)(o + 8 * lane + 4) = a1 * q1 * rs; *(f32x4*)(o + 512 + 8 * lane) = b0 * q2 * rs; *(f32x4*)(o + 512 + 8 * lane + 4) = b1 * q3 * rs; }
    }
}

__device__ __forceinline__ void s5_item(const Params& P, int l, int it, LAS unsigned char* wl, int lane) {
    const int b = it >> 5, g = it & 31, lg = l * 32 + g;
    LAS float* bu = (LAS float*)wl; LAS unsigned char* sl = wl + 16384;
    const int c32 = lane & 31, hi = lane >> 5, fr = lane & 15, fq = lane >> 4;
    const bf16_t* bbt = (const bf16_t*)(P.ws + OFF_S5BB) + (size_t)lg * 128 * 16; const bf16_t* cm = (const bf16_t*)(P.ws + OFF_S5CM) + (size_t)lg * 16 * 128;
    bf16x8 bbreg[4], cmreg[4];
#pragma unroll
    for (int j = 0; j < 4; ++j) { bbreg[j] = *(const bf16x8*)(bbt + (32 * j + c32) * 16 + 8 * hi); cmreg[j] = *(const bf16x8*)(cm + fr * 128 + 32 * j + 8 * fq); }
    const f32x2v av = ((const f32x2v*)(P.ws + OFF_S5A))[lg * 64 + lane]; const float a_re = av.x, a_im = av.y;
    const float dsk = P.in[I_SSMD][l * 512 + g * 16 + fr];
    float s_re = 0.f, s_im = 0.f;
    const bf16_t* Ub = (const bf16_t*)((unsigned char*)P.out + DO_U) + (size_t)b * SEQL * 512 + g * 16; bf16_t* Yb = (bf16_t*)((unsigned char*)P.out + DO_Y) + (size_t)b * SEQL * 512 + g * 16;
    for (int c = 0; c < 64; ++c) {
        const int t0 = c * 32;
        const bf16x8 ureg = *(const bf16x8*)(Ub + (size_t)(t0 + c32) * 512 + 8 * hi);
        unsigned short uep[2][4];
#pragma unroll
        for (int mt = 0; mt < 2; ++mt)
#pragma unroll
            for (int i = 0; i < 4; ++i) uep[mt][i] = Ub[(size_t)(t0 + 16 * mt + 4 * fq + i) * 512 + fr];
#pragma unroll
        for (int j = 0; j < 4; ++j) { f32x16 a;
#pragma unroll
            for (int r = 0; r < 16; ++r) a[r] = 0.f;
            a = __builtin_amdgcn_mfma_f32_32x32x16_bf16(ureg, bbreg[j], a, 0, 0, 0);
#pragma unroll
            for (int r = 0; r < 16; ++r) { const int tok = (r & 3) + 8 * (r >> 2) + 4 * hi; bu[tok * 128 + ((32 * (j & 1) + c32) << 1) + (j >> 1)] = a[r]; } }
        asm volatile("" ::: "memory");
#pragma unroll 8
        for (int t = 0; t < 32; ++t) { const f32x2v v = *(const LAS f32x2v*)(bu + t * 128 + 2 * lane);
            const float nre = fmaf(a_re, s_re, fmaf(-a_im, s_im, v.x)), nim = fmaf(a_re, s_im, fmaf(a_im, s_re, v.y)); s_re = nre; s_im = nim;
            *(LAS unsigned short*)(sl + t * 272 + lane * 2) = f2bf(s_re); *(LAS unsigned short*)(sl + t * 272 + 128 + lane * 2) = f2bf(s_im); }
        asm volatile("" ::: "memory");
#pragma unroll
        for (int mt = 0; mt < 2; ++mt) { f32x4 ya = {0.f, 0.f, 0.f, 0.f};
#pragma unroll
            for (int ks = 0; ks < 4; ++ks) { const bf16x8 a = *(const LAS bf16x8*)(sl + (16 * mt + fr) * 272 + (32 * ks + 8 * fq) * 2); ya = __builtin_amdgcn_mfma_f32_16x16x32_bf16(a, cmreg[ks], ya, 0, 0, 0); }
#pragma unroll
            for (int i = 0; i < 4; ++i) { const float y = ya[i] + dsk * __uint_as_float((unsigned)uep[mt][i] << 16);
                const float ge = y * sigm(1.5957691216057308f * (y + 0.044715f * y * y * y));
                Yb[(size_t)(t0 + 16 * mt + 4 * fq + i) * 512 + fr] = f2bf(ge); } }
        asm volatile("" ::: "memory");
    }
}

template <int PAT> __device__ __forceinline__ void attn_item(const Params& P, int it, LAS unsigned char* vl, int lane) {
    constexpr int d = PAT == 0 ? 1 : (PAT == 1 ? 4 : 16);
    constexpr int ngrp = (SEQL / d) / 32;
    constexpr int KSTR = 144;
    const int j = it % ngrp; int t = it / ngrp; const int r = t % d; t /= d; const int h = t & 7, b = t >> 3;
    const int c32 = lane & 31, hi = lane >> 5, i0 = 32 * j;
    const int lrow = lane >> 3, lch = lane & 7;
    const size_t tokbase = (size_t)b * SEQL;
    bf16_t* QO = (bf16_t*)(P.ws + OFF_QO); const bf16_t* Kb = (const bf16_t*)((unsigned char*)P.out + DO_K); const bf16_t* Vb = (const bf16_t*)((unsigned char*)P.out + DO_V);
    float* LSE = (float*)(P.ws + OFF_LSE);
    const unsigned char* qrow0 = (const unsigned char*)QO + ((tokbase + (size_t)i0 * d + r) * 1536 + PAT * 512 + h * 64) * 2;
    const unsigned char* krow0 = (const unsigned char*)Kb + ((tokbase + (size_t)(i0 - 128) * d + r) * 512 + h * 64) * 2;
    const unsigned char* vrow0 = (const unsigned char*)Vb + ((tokbase + (size_t)(i0 - 128) * d + r) * 512 + h * 64) * 2;
    const unsigned qlo = (unsigned)(lrow * d * 3072 + lch * 16), klo = (unsigned)(lrow * d * 1024 + lch * 16);
    u32x4 qraw[4], kraw[5][4];
#pragma unroll
    for (int i4 = 0; i4 < 4; ++i4) qraw[i4] = *(const u32x4*)(qrow0 + (qlo + (unsigned)(8 * i4 * d * 3072)));
#pragma unroll
    for (int kt = 0; kt < 5; ++kt) { const int kb = i0 - 128 + 32 * kt;
        if (kb >= 0) {
#pragma unroll
            for (int i4 = 0; i4 < 4; ++i4) kraw[kt][i4] = *(const u32x4*)(krow0 + (klo + (unsigned)((32 * kt + 8 * i4) * d * 1024))); } }
    bf16x8 qreg[4];
#pragma unroll
    for (int i4 = 0; i4 < 4; ++i4) *(LAS u32x4*)(vl + (lrow + 8 * i4) * KSTR + lch * 16) = qraw[i4];
    asm volatile("" ::: "memory");
#pragma unroll
    for (int ks = 0; ks < 4; ++ks) qreg[ks] = *(const LAS bf16x8*)(vl + c32 * KSTR + (16 * ks + 8 * hi) * 2);
    asm volatile("" ::: "memory");
    f32x16 s[5];
#pragma unroll
    for (int kt = 0; kt < 5; ++kt) { const int kb = i0 - 128 + 32 * kt;
        f32x16 a;
        if (kb >= 0) {
#pragma unroll
            for (int q = 0; q < 16; ++q) a[q] = 0.f;
#pragma unroll
            for (int i4 = 0; i4 < 4; ++i4) *(LAS u32x4*)(vl + (lrow + 8 * i4) * KSTR + lch * 16) = kraw[kt][i4];
            asm volatile("" ::: "memory");
#pragma unroll
            for (int ks = 0; ks < 4; ++ks) { const bf16x8 kreg = *(const LAS bf16x8*)(vl + c32 * KSTR + (16 * ks + 8 * hi) * 2); a = __builtin_amdgcn_mfma_f32_32x32x16_bf16(kreg, qreg[ks], a, 0, 0, 0); }
            asm volatile("" ::: "memory");
        } else {
#pragma unroll
            for (int q = 0; q < 16; ++q) a[q] = (-__builtin_inff());
        }
        s[kt] = a; }
    u32x4 vreg[5][4];
#pragma unroll
    for (int kt = 0; kt < 3; ++kt) { const int kb = i0 - 128 + 32 * kt;
        if (kb >= 0) {
#pragma unroll
            for (int i4 = 0; i4 < 4; ++i4) vreg[kt][i4] = *(const u32x4*)(vrow0 + (klo + (unsigned)((32 * kt + 8 * i4) * d * 1024))); } }
#pragma unroll
    for (int q = 0; q < 16; ++q) { const int kr = (q & 3) + 8 * (q >> 2) + 4 * hi; if (kr < c32) s[0][q] = (-__builtin_inff()); if (kr > c32) s[4][q] = (-__builtin_inff()); }
    float mx = (-__builtin_inff());
#pragma unroll
    for (int kt = 0; kt < 5; ++kt)
#pragma unroll
        for (int q = 0; q < 16; ++q) mx = fmaxf(mx, s[kt][q]);
    mx = fmaxf(mx, __shfl_xor(mx, 32));
    float den = 0.f;
#pragma unroll
    for (int kt = 0; kt < 5; ++kt)
#pragma unroll
        for (int q = 0; q < 16; ++q) { const float p = __builtin_amdgcn_exp2f(s[kt][q] - mx); s[kt][q] = p; den += p; }
    den += __shfl_xor(den, 32);
    u32x4 pw[5][2];
#pragma unroll
    for (int kt = 0; kt < 5; ++kt)
#pragma unroll
        for (int ks2 = 0; ks2 < 2; ++ks2) { pw[kt][ks2].x = cvt_pk_bf16(s[kt][8 * ks2 + 0], s[kt][8 * ks2 + 1]); pw[kt][ks2].y = cvt_pk_bf16(s[kt][8 * ks2 + 2], s[kt][8 * ks2 + 3]);
            pw[kt][ks2].z = cvt_pk_bf16(s[kt][8 * ks2 + 4], s[kt][8 * ks2 + 5]); pw[kt][ks2].w = cvt_pk_bf16(s[kt][8 * ks2 + 6], s[kt][8 * ks2 + 7]); }
#pragma unroll
    for (int kt = 3; kt < 5; ++kt) { const int kb = i0 - 128 + 32 * kt;
        if (kb >= 0) {
#pragma unroll
            for (int i4 = 0; i4 < 4; ++i4) vreg[kt][i4] = *(const u32x4*)(vrow0 + (klo + (unsigned)((32 * kt + 8 * i4) * d * 1024))); } }
    u32x4 mraw[2][4]; float l2b = 0.f, l2c = 0.f;
    if (PAT == 0) {
#pragma unroll
        for (int pp = 0; pp < 2; ++pp)
#pragma unroll
            for (int i4 = 0; i4 < 4; ++i4) mraw[pp][i4] = *(const u32x4*)(qrow0 + (qlo + (unsigned)(8 * i4 * 3072 + (pp + 1) * 1024)));
        l2b = LSE[((size_t)(0 * 32 + b) * 8 + h) * SEQL + i0 + c32]; l2c = LSE[((size_t)(1 * 32 + b) * 8 + h) * SEQL + i0 + c32];
    }
    f32x16 o[2];
#pragma unroll
    for (int q = 0; q < 16; ++q) { o[0][q] = 0.f; o[1][q] = 0.f; }
    const int gi = lane >> 4, li = lane & 15;
    const LAS unsigned char* vrd = vl + (4 * hi + (li >> 2)) * VSTR + (16 * (gi & 1) + 4 * (li & 3)) * 2;
#pragma unroll
    for (int kt = 0; kt < 5; ++kt) { const int kb = i0 - 128 + 32 * kt;
        if (kb >= 0) {
#pragma unroll
            for (int i4 = 0; i4 < 4; ++i4) *(LAS u32x4*)(vl + (lrow + 8 * i4) * VSTR + lch * 16) = vreg[kt][i4];
            asm volatile("" ::: "memory");
#pragma unroll
            for (int ks2 = 0; ks2 < 2; ++ks2) {
                const bf16x8 pb = __builtin_bit_cast(bf16x8, pw[kt][ks2]);
#pragma unroll
                for (int mt = 0; mt < 2; ++mt) { const LAS unsigned char* a1 = vrd + (16 * ks2) * VSTR + 64 * mt;
                    const s16x4 lo = vtr(a1), up = vtr(a1 + 8 * VSTR);
                    bf16x8 av; av[0] = lo[0]; av[1] = lo[1]; av[2] = lo[2]; av[3] = lo[3]; av[4] = up[0]; av[5] = up[1]; av[6] = up[2]; av[7] = up[3];
                    o[mt] = __builtin_amdgcn_mfma_f32_32x32x16_bf16(av, pb, o[mt], 0, 0, 0); } }
            asm volatile("" ::: "memory");
        } }
    const float inv = __builtin_amdgcn_rcpf(den);
    const float l2 = mx + __builtin_amdgcn_logf(den);
    const LAS unsigned char* frd = vl + c32 * KSTR + 8 * hi;
    float w1 = inv;
    if (PAT == 0) {
        const float M = fmaxf(l2, fmaxf(l2b, l2c));
        float e1 = __builtin_amdgcn_exp2f(l2 - M), e2 = __builtin_amdgcn_exp2f(l2b - M), e3 = __builtin_amdgcn_exp2f(l2c - M);
        const float wi = __builtin_amdgcn_rcpf(e1 + e2 + e3); w1 = e1 * wi * inv; const float wo[2] = {e2 * wi, e3 * wi};
#pragma unroll
        for (int q = 0; q < 16; ++q) { o[0][q] *= w1; o[1][q] *= w1; }
#pragma unroll
        for (int pp = 0; pp < 2; ++pp) {
#pragma unroll
            for (int i4 = 0; i4 < 4; ++i4) *(LAS u32x4*)(vl + (lrow + 8 * i4) * KSTR + lch * 16) = mraw[pp][i4];
            asm volatile("" ::: "memory");
#pragma unroll
            for (int mt = 0; mt < 2; ++mt)
#pragma unroll
                for (int rg = 0; rg < 4; ++rg) { const u32x2 bb = *(const LAS u32x2*)(frd + 64 * mt + 16 * rg);
                    o[mt][4 * rg] += wo[pp] * bf_lo(bb.x); o[mt][4 * rg + 1] += wo[pp] * bf_hi(bb.x); o[mt][4 * rg + 2] += wo[pp] * bf_lo(bb.y); o[mt][4 * rg + 3] += wo[pp] * bf_hi(bb.y); }
            asm volatile("" ::: "memory");
        }
    } else {
#pragma unroll
        for (int q = 0; q < 16; ++q) { o[0][q] *= w1; o[1][q] *= w1; }
    }
#pragma unroll
    for (int mt = 0; mt < 2; ++mt)
#pragma unroll
        for (int rg = 0; rg < 4; ++rg) { u32x2 w; w.x = cvt_pk_bf16(o[mt][4 * rg], o[mt][4 * rg + 1]); w.y = cvt_pk_bf16(o[mt][4 * rg + 2], o[mt][4 * rg + 3]);
            *(LAS u32x2*)(vl + c32 * KSTR + 8 * hi + 64 * mt + 16 * rg) = w; }
    asm volatile("" ::: "memory");
    if (PAT != 0) {
#pragma unroll
        for (int i4 = 0; i4 < 4; ++i4) *(u32x4*)((unsigned char*)qrow0 + (qlo + (unsigned)(8 * i4 * d * 3072))) = *(const LAS u32x4*)(vl + (lrow + 8 * i4) * KSTR + lch * 16);
        if (hi == 0) LSE[((size_t)((PAT - 1) * 32 + b) * 8 + h) * SEQL + (size_t)(i0 + c32) * d + r] = l2;
    } else {
        bf16_t* OC = (bf16_t*)(P.ws + OFF_OC);
#pragma unroll
        for (int i4 = 0; i4 < 4; ++i4) *(u32x4*)(OC + (tokbase + (size_t)(i0 + lrow + 8 * i4)) * 512 + h * 64 + lch * 8) = *(const LAS u32x4*)(vl + (lrow + 8 * i4) * KSTR + lch * 16);
    }
    asm volatile("" ::: "memory");
}

__device__ __forceinline__ void conv_item(const Params& P, int l, int it, int lane, const LAS unsigned char* wlds) {
    const int b = it >> 8, t0 = (it & 255) * 8, ch0 = 8 * lane;
    const bf16_t* in = (const bf16_t*)(P.ws + OFF_CG) + (size_t)b * SEQL * 512 + ch0;
    const LAS unsigned char* cw = wlds + 16 * lane;
    float acc[8][8], win[8][8];
    { const f32x4 b0 = *(const f32x4*)(P.in[I_CONVB] + l * 512 + ch0), b1 = *(const f32x4*)(P.in[I_CONVB] + l * 512 + ch0 + 4);
#pragma unroll
      for (int i = 0; i < 8; ++i) { acc[i][0] = b0[0]; acc[i][1] = b0[1]; acc[i][2] = b0[2]; acc[i][3] = b0[3]; acc[i][4] = b1[0]; acc[i][5] = b1[1]; acc[i][6] = b1[2]; acc[i][7] = b1[3]; } }
#define CONV_LOADROW(rr, dst) do { const int t_ = t0 - 30 + (rr); if (t_ >= 0) { const u32x4 v_ = *(const u32x4*)(in + (size_t)t_ * 512); \
        dst[0] = bf_lo(v_.x); dst[1] = bf_hi(v_.x); dst[2] = bf_lo(v_.y); dst[3] = bf_hi(v_.y); dst[4] = bf_lo(v_.z); dst[5] = bf_hi(v_.z); dst[6] = bf_lo(v_.w); dst[7] = bf_hi(v_.w); } \
        else { _Pragma("unroll") for (int c_ = 0; c_ < 8; ++c_) dst[c_] = 0.f; } } while (0)
#pragma unroll
    for (int rr = 0; rr < 8; ++rr) CONV_LOADROW(rr, win[rr]);
    for (int jb = 0; jb < 32; jb += 8) {
        asm volatile("" ::: "memory");
#pragma unroll
        for (int jj = 0; jj < 8; ++jj) { const int j = jb + jj;
            if (j < 31) { const u32x4 wv = *(const LAS u32x4*)(cw + j * 1024);
                float w[8]; w[0] = bf_lo(wv.x); w[1] = bf_hi(wv.x); w[2] = bf_lo(wv.y); w[3] = bf_hi(wv.y); w[4] = bf_lo(wv.z); w[5] = bf_hi(wv.z); w[6] = bf_lo(wv.w); w[7] = bf_hi(wv.w);
#pragma unroll
                for (int i = 0; i < 8; ++i)
#pragma unroll
                    for (int c = 0; c < 8; ++c) acc[i][c] = fmaf(w[c], win[(jj + i) & 7][c], acc[i][c]);
                if (j + 8 < 38) CONV_LOADROW(j + 8, win[jj]); } }
    }
#undef CONV_LOADROW
    const f32x4 g0 = *(const f32x4*)(P.in[I_LNG] + l * 512 + ch0), g1 = *(const f32x4*)(P.in[I_LNG] + l * 512 + ch0 + 4);
    const f32x4 e0 = *(const f32x4*)(P.in[I_LNB] + l * 512 + ch0), e1 = *(const f32x4*)(P.in[I_LNB] + l * 512 + ch0 + 4);
    bf16_t* outp = (bf16_t*)(P.ws + OFF_HC) + ((size_t)b * SEQL + t0) * 512 + ch0;
#pragma unroll
    for (int i = 0; i < 8; ++i) { float s1 = 0.f, s2 = 0.f;
#pragma unroll
        for (int c = 0; c < 8; ++c) { s1 += acc[i][c]; s2 += acc[i][c] * acc[i][c]; }
        s1 = wave_sum(s1); s2 = wave_sum(s2);
        const float mean = s1 * (1.f / 512.f), var = fmaxf(s2 * (1.f / 512.f) - mean * mean, 0.f), rs = rsqrtf(var + EPSN);
        f32x4 y0, y1;
#pragma unroll
        for (int c = 0; c < 4; ++c) { const float h0 = (acc[i][c] - mean) * rs * g0[c] + e0[c], h1 = (acc[i][4 + c] - mean) * rs * g1[c] + e1[c]; y0[c] = h0 * sigm(h0); y1[c] = h1 * sigm(h1); }
        *(u32x4*)(outp + (size_t)i * 512) = pack8(y0, y1); }
}

__device__ __forceinline__ int xcc_id() { return (int)(__builtin_amdgcn_s_getreg((3 << 11) | 20) & 7u); }
__device__ __forceinline__ int claim_issue(unsigned* ctr, int& lane) { asm volatile("" : "+v"(lane)); int v = 0; if (lane == 0) v = (int)atomicAdd(ctr, 1u); return v; }
__device__ __forceinline__ int lane_now() { int l = (int)__builtin_amdgcn_mbcnt_hi(~0u, __builtin_amdgcn_mbcnt_lo(~0u, 0u)); asm volatile("" : "+v"(l)); return l; }
__device__ __forceinline__ int lds_claim(LAS unsigned* ctr, int lane) { int v = 0; if (lane == 0) v = (int)__hip_atomic_fetch_add(ctr, 1u, __ATOMIC_RELAXED, __HIP_MEMORY_SCOPE_WORKGROUP); return __builtin_amdgcn_readfirstlane(v); }
__device__ __forceinline__ int claim(unsigned* ctr, int& lane) { asm volatile("" : "+v"(lane)); int v = 0; if (lane == 0) v = (int)atomicAdd(ctr, 1u); return __builtin_amdgcn_readfirstlane(v); }


__device__ __forceinline__ void grid_barrier(unsigned* bar, unsigned target, int tid) {
    asm volatile("s_waitcnt vmcnt(0) lgkmcnt(0)" ::: "memory");
    __syncthreads();
    if (tid == 0) {
        __builtin_amdgcn_fence(__ATOMIC_RELEASE, "agent");
        asm volatile("s_waitcnt vmcnt(0) lgkmcnt(0)" ::: "memory");
        __hip_atomic_fetch_add(bar, 1u, __ATOMIC_RELAXED, __HIP_MEMORY_SCOPE_AGENT);
        while (__hip_atomic_load(bar, __ATOMIC_RELAXED, __HIP_MEMORY_SCOPE_AGENT) < target) __builtin_amdgcn_s_sleep(2);
        __builtin_amdgcn_fence(__ATOMIC_ACQUIRE, "agent");
        asm volatile("s_waitcnt vmcnt(0) lgkmcnt(0)" ::: "memory");
    }
    __syncthreads();
}


#define XB_TMO      128
#define XB_XCNT(j)  (256  + 64 * (j))
#define XB_XSUB(j)  (1280 + 64 * (j))
#define XB_XGEN(j)  (2304 + 64 * (j))
#define XB_TOP      3328
#define XB_TOPGEN   3392
#define XB_SPIN_CAP (1u << 22)
__device__ __forceinline__ unsigned xb_ld(unsigned* p)              { return __hip_atomic_load(p, __ATOMIC_RELAXED, __HIP_MEMORY_SCOPE_AGENT); }
__device__ __forceinline__ unsigned xb_add(unsigned* p, unsigned v) { return __hip_atomic_fetch_add(p, v, __ATOMIC_RELAXED, __HIP_MEMORY_SCOPE_AGENT); }
#define XB_SPIN(cond, bar) do { unsigned _sp = 0; while (cond) { __builtin_amdgcn_s_sleep(1); \
    if ((++_sp & 255u) == 0u) { if (xb_ld(&(bar)[XB_TMO])) break; if (_sp > XB_SPIN_CAP) { atomicAdd(&(bar)[XB_TMO], 1u); break; } } } } while (0)
__device__ __forceinline__ void xcd_barrier_complete(unsigned* bar, unsigned x, unsigned& nloc, unsigned& nx) {
    const unsigned G = gridDim.x;
    unsigned sum, cnt, mine, sp = 0u;
    for (;;) {
        sum = 0u; cnt = 0u; mine = 0u;
#pragma unroll
        for (unsigned j = 0; j < 16; ++j) { const unsigned c = xb_ld(&bar[XB_XCNT(j)]); sum += c; cnt += (c > 0u) ? 1u : 0u; mine = (j == x) ? c : mine; }
        if (sum == G) break;
        __builtin_amdgcn_s_sleep(1);
        if ((++sp & 255u) == 0u) { if (xb_ld(&bar[XB_TMO])) break; if (sp > XB_SPIN_CAP) { atomicAdd(&bar[XB_TMO], 1u); break; } }
    }
    nloc = mine > 0u ? mine : 1u; nx = cnt > 0u ? cnt : 1u;
}
__device__ __forceinline__ void xcd_barrier(unsigned* bar, LAS unsigned char* lds, int tid) {
    const unsigned x = (unsigned)__builtin_amdgcn_s_getreg((3 << 11) | 20) & 0xFu; volatile LAS unsigned* st = (volatile LAS unsigned*)(lds + CTR_OFF + 64);
    asm volatile("s_waitcnt vmcnt(0) lgkmcnt(0)" ::: "memory");
    __syncthreads();
    if (tid == 0) {
        unsigned nloc = st[0], nx = st[1];
        if (nloc == 0u) { xcd_barrier_complete(bar, x, nloc, nx); st[0] = nloc; st[1] = nx; }
        const unsigned old = xb_add(&bar[XB_XSUB(x)], 1u);
        const unsigned gen = old / nloc;
        if (old + 1u == (gen + 1u) * nloc) {
            __builtin_amdgcn_fence(__ATOMIC_RELEASE, "agent");
            asm volatile("s_waitcnt vmcnt(0)" ::: "memory");
            const unsigned og = xb_add(&bar[XB_TOP], 1u);
            const unsigned tg = og / nx;
            if (og + 1u == (tg + 1u) * nx) xb_add(&bar[XB_TOPGEN], 1u);
            else XB_SPIN(xb_ld(&bar[XB_TOPGEN]) == tg, bar);
            __builtin_amdgcn_fence(__ATOMIC_ACQUIRE, "agent");
            xb_add(&bar[XB_XGEN(x)], 1u);
            asm volatile("s_waitcnt vmcnt(0)" ::: "memory");
        } else {
            XB_SPIN(xb_ld(&bar[XB_XGEN(x)]) == gen, bar);
            __builtin_amdgcn_fence(__ATOMIC_ACQUIRE, "agent");
            asm volatile("s_waitcnt vmcnt(0)" ::: "memory");
        }
    }
    __syncthreads();
}

constexpr int NPHASE = 21;
__global__ void __launch_bounds__(512, 2) fwd_kernel(Params P) {
    extern __shared__ __attribute__((aligned(16))) unsigned char shm[];
    LAS unsigned char* lds = (LAS unsigned char*)shm;
        unsigned char* ws = P.ws; unsigned char* dout = (unsigned char*)P.out;
    bf16_t* xb = (bf16_t*)(ws + OFF_XB); bf16_t* Gt = (bf16_t*)(ws + OFF_G); bf16_t* Mg = (bf16_t*)(dout + DO_MG);
    bf16_t* xn = (bf16_t*)(ws + OFF_HC); bf16_t* Dl = (bf16_t*)(ws + OFF_QO);
    unsigned* ctl = (unsigned*)(ws + OFF_CTL);
    StaticOrder S;
    unsigned nbar = 0;
    const int wave_s = __builtin_amdgcn_readfirstlane((int)threadIdx.x >> 6);
    if (P.ph_hi - P.ph_lo > 1) cg::this_grid().sync();
    { volatile LAS unsigned* xst = (volatile LAS unsigned*)(lds + CTR_OFF + 64);
      const unsigned xcc = (unsigned)__builtin_amdgcn_s_getreg((3 << 11) | 20) & 0xFu;
      if (threadIdx.x == 0) { xst[0] = 0u; xst[1] = 0u; (void)xb_add(&ctl[XB_XCNT(xcc)], 1u); }
      __syncthreads(); }
    for (int ph = P.ph_lo; ph < P.ph_hi; ++ph) {
        const int wave = wave_s;
#define PHASE_IDS const int lane = lane_now(); const int tid = (wave_s << 6) | lane; (void)tid; (void)lane;
        if (ph == 0) { PHASE_IDS for (int rp = 0; rp < NREP_P0; ++rp) phase_p0(P, lds, wave, lane, tid); }
        else if (ph == NPHASE - 1) { PHASE_IDS phase_rows<true>(P, wave, lane, false); }
        else {
            const int l = (ph - 1) / 10, s = (ph - 1) % 10;
            if (s == 0) { PHASE_IDS
                S.init(NTOK, 7168, gridDim.x, blockIdx.x);
                Gemm g{xn, (const bf16_t*)(ws + OFF_WIN) + (size_t)l * 7168 * 1024, NTOK, 7168, 1024};
                EpiIn E{(bf16_t*)(dout + DO_U), (bf16_t*)(ws + OFF_QO), (bf16_t*)(dout + DO_K), (bf16_t*)(dout + DO_V), (bf16_t*)(ws + OFF_CG), Gt, P.in[I_BGATE] + l * 3072};
                gemm_phase<EpiIn, StaticOrder, false>(lds, g, S, E, nullptr, tid);
            } else if (s == 1) { PHASE_IDS
                LAS unsigned* lctr = (LAS unsigned*)(lds + CTR_OFF);
                if (tid == 0) lctr[0] = 0u;
                __syncthreads();
                const int grp = blockIdx.x & 7, rank = blockIdx.x >> 3; constexpr int per = 128;
                if (wave < 4) { for (int it = blockIdx.x * 4 + wave; it < 1024; it += gridDim.x * 4) s5_item(P, l, it, lds + wave * S5_WL, lane_now()); }
                LAS unsigned char* vl = lds + ATT_OFF + wave * ATT_WL;
                for (;;) { const int ln = lane_now(); const int k = lds_claim(lctr, ln); if (k >= per) break;
                    const int idx = rank * 64 + (k >> 1); const int b = grp + 8 * (idx >> 9), rest = idx & 511;
                    if ((k & 1) == 0) attn_item<1>(P, b * 512 + rest, vl, ln); else attn_item<2>(P, b * 512 + rest, vl, ln); }
            } else if (s == 2) { PHASE_IDS
                LAS unsigned* lctr = (LAS unsigned*)(lds + CTR_OFF);
                if (tid == 0) lctr[0] = 0u;
                { const unsigned* cwg = (const unsigned*)(ws + OFF_CONVW) + (size_t)l * 31 * 256;
                  for (int i = tid; i < 31 * 64; i += 512) *(LAS u32x4*)(lds + i * 16) = *(const u32x4*)(cwg + i * 4); }
                __syncthreads();
                const int grp = blockIdx.x & 7, rank = blockIdx.x >> 3; constexpr int per = 96;
                LAS unsigned char* vl = lds + ATT_OFF + wave * ATT_WL;
                for (;;) { const int ln = lane_now(); const int k = lds_claim(lctr, ln); if (k >= per) break;
                    if (k < 32) { const int ci = rank * 32 + k; const int b = grp + 8 * (ci >> 8); conv_item(P, l, b * 256 + (ci & 255), ln, lds); }
                    else { const int pi = rank * 64 + (k - 32); const int b = grp + 8 * (pi >> 9); attn_item<0>(P, b * 512 + (pi & 511), vl, ln); } }
            } else if (s == 3) { PHASE_IDS
                S.init(NTOK, 2048, gridDim.x, blockIdx.x);
                Gemm g{(const bf16_t*)(dout + DO_Y), (const bf16_t*)(ws + OFF_WGLU) + (size_t)l * 2048 * 512, NTOK, 2048, 512};
                EpiGluMerge E{Mg, Gt};
                gemm_phase<EpiGluMerge, StaticOrder, false>(lds, g, S, E, nullptr, tid);
            } else if (s == 4) { PHASE_IDS
                S.init(NTOK, 1024, gridDim.x, blockIdx.x);
                for (int c = 0; c < 2; ++c) {
                    Gemm g{(const bf16_t*)(ws + (c == 0 ? OFF_HC : OFF_OC)), (const bf16_t*)(ws + (c == 0 ? OFF_WPW2 : OFF_WATT)) + (size_t)l * 1024 * 512, NTOK, 1024, 512};
                    EpiAccMerge E{Mg, Gt, c == 0 ? 2048 : 1024};
                    gemm_phase<EpiAccMerge, StaticOrder, false>(lds, g, S, E, nullptr, tid);
                    __syncthreads();
                }
            } else if (s == 6 || s == 9) { PHASE_IDS
                phase_rows<false>(P, wave, lane, true);
            } else if (s == 5 || s == 8) { PHASE_IDS
                S.init(NTOK, 1024, gridDim.x, blockIdx.x);
                Gemm g{s == 5 ? (const bf16_t*)Mg : (const bf16_t*)Gt, s == 5 ? (const bf16_t*)(ws + OFF_WOUT) + (size_t)l * 1024 * 1024 : (const bf16_t*)(ws + OFF_WF2) + (size_t)l * 1024 * 2816, NTOK, 1024, s == 5 ? 1024 : 2816};
                EpiDelta E{Dl};
                gemm_phase<EpiDelta, StaticOrder, false>(lds, g, S, E, nullptr, tid);
            } else {
                PHASE_IDS
                S.init(NTOK, 5632, gridDim.x, blockIdx.x);
                Gemm g{xn, (const bf16_t*)(ws + OFF_WF1) + (size_t)l * 5632 * 1024, NTOK, 5632, 1024};
                EpiFfn1 E{Gt};
                gemm_phase<EpiFfn1, StaticOrder, false>(lds, g, S, E, nullptr, tid);
            }
        }
        if (ph + 1 < P.ph_hi) xcd_barrier(ctl, lds, (wave_s << 6) | lane_now());
    }
}

extern "C" void kernel_launch(void* const* d_in, const int* in_sizes, int n_in, void* d_out, int out_size, void* d_ws, size_t ws_size, hipStream_t stream) {
    static int grid = 0;
    if (grid == 0) {
        if (n_in != 24 || out_size != NTOK * 1024 || ws_size < WS_END) { fprintf(stderr, "kernel_launch: unexpected problem (n_in %d out %d ws %zu need %zu)\n", n_in, out_size, ws_size, (size_t)WS_END); grid = -1; return; }
        int dev = 0, cus = 0, per_cu = 0;
        hipGetDevice(&dev); hipDeviceGetAttribute(&cus, hipDeviceAttributeMultiprocessorCount, dev);
        if (hipFuncSetAttribute((const void*)fwd_kernel, hipFuncAttributeMaxDynamicSharedMemorySize, LDS_BYTES) != hipSuccess) { fprintf(stderr, "kernel_launch: hipFuncSetAttribute failed\n"); grid = -1; return; }
        hipOccupancyMaxActiveBlocksPerMultiprocessor(&per_cu, (const void*)fwd_kernel, 512, LDS_BYTES);
        if (per_cu < 1) { fprintf(stderr, "kernel_launch: occupancy query says %d blocks/CU\n", per_cu); per_cu = 1; }
        (void)hipGetLastError();
        grid = cus * per_cu; if (grid > 256) grid = 256;
        if (grid != 256) { fprintf(stderr, "kernel_launch: this build partitions its work over exactly 256 workgroups (got %d)\n", grid); grid = -1; return; }
    }
    if (grid < 0) return;
    hipMemsetAsync((unsigned char*)d_ws + OFF_CTL, 0, 16384, stream);
    Params p{};
    for (int i = 0; i < 24; ++i) p.in[i] = (const float*)d_in[i];
    p.out = (float*)d_out; p.ws = (unsigned char*)d_ws;
#if MK_PER_PHASE
    for (int ph = 0; ph < NPHASE; ++ph) { p.ph_lo = ph; p.ph_hi = ph + 1; hipLaunchKernelGGL(fwd_kernel, dim3(grid), dim3(512), LDS_BYTES, stream, p); }
#else
    p.ph_lo = 0; p.ph_hi = NPHASE;
    void* args[] = {&p};
    hipError_t e = hipLaunchCooperativeKernel((const void*)fwd_kernel, dim3(grid), dim3(512), args, LDS_BYTES, stream);
    if (e != hipSuccess) fprintf(stderr, "cooperative launch failed: %s (grid %d)\n", hipGetErrorString(e), grid);
#endif
}
```
